# Optimizing an MI355X kernel written in HIP

```python
import math
import jax, jax.numpy as jnp
from jax import lax
import numpy as np

D_MODEL = 2048
BATCH = 32
SEQ = 256
DEPTH = 4
DEC_BATCH = 8
DEC_SEQ = 4096
PAST_LEN = 256

GRID_W = 64
N_EVEN = (DEPTH + 1) // 2
N_ODD = DEPTH // 2
S5_GROUP_CH = 16
S5_WIDTH = D_MODEL // 4
S5_GROUPS = S5_WIDTH // S5_GROUP_CH
S5_STATE = 64
HEAD_DIM = 128
NA_HEADS = D_MODEL // (2 * HEAD_DIM)
NA_WIDTH = NA_HEADS * HEAD_DIM
NA_WIN_R = 8
NA_WIN_C = 16
NA_QC = 16
NA_KC = 2 * NA_QC
AB_IN = S5_WIDTH + 3 * NA_WIDTH
AB_OUT = S5_WIDTH + NA_WIDTH
D_FF = 4 * D_MODEL
Q_BLOCK = 128
NORM_EPS = 1e-6
NEG_INF = -1e30

kernel_name = "hybrid_s5_natten_shortconv_diffusion_step"


def rms_norm(x, g):
    x32 = x.astype(jnp.float32)
    y = x32 * lax.rsqrt(jnp.mean(x32 * x32, axis=-1, keepdims=True) + NORM_EPS)
    return (y * g.astype(jnp.float32)).astype(x.dtype)


def ada_params(cvec, w, b):
    m = jax.nn.silu(cvec) @ w + b
    m = m.reshape(m.shape[0], 1, 6, D_MODEL)
    return tuple(m[:, :, i] for i in range(6))


def modulate(x, g, shift, scale):
    return rms_norm(x, g) * (1 + scale) + shift


def _complex_affine_combine(e1, e2):
    a1r, a1i, b1r, b1i = e1
    a2r, a2i, b2r, b2i = e2
    return (a2r * a1r - a2i * a1i,
            a2r * a1i + a2i * a1r,
            a2r * b1r - a2i * b1i + b2r,
            a2r * b1i + a2i * b1r + b2i)


def s5_scan(u, h0, lam_re, lam_im, log_dt, b_re, b_im, c_re, c_im):
    seq_len = u.shape[1]
    dt = jnp.exp(log_dt)[:, None]
    ar, ai = lam_re * dt, lam_im * dt
    decay = jnp.exp(ar)
    abar_re, abar_im = decay * jnp.cos(ai), decay * jnp.sin(ai)
    den = lam_re * lam_re + lam_im * lam_im
    nr = abar_re - 1.0
    f_re = (nr * lam_re + abar_im * lam_im) / den
    f_im = (abar_im * lam_re - nr * lam_im) / den
    bb_re = f_re[..., None] * b_re - f_im[..., None] * b_im
    bb_im = f_re[..., None] * b_im + f_im[..., None] * b_re
    bu_re = jnp.einsum('blgn,gpn->blgp', u, bb_re)
    bu_im = jnp.einsum('blgn,gpn->blgp', u, bb_im)
    a_re = jnp.broadcast_to(abar_re, (1, seq_len) + abar_re.shape)
    a_im = jnp.broadcast_to(abar_im, (1, seq_len) + abar_im.shape)
    _, _, x_re, x_im = lax.associative_scan(_complex_affine_combine, (a_re, a_im, bu_re, bu_im), axis=1)
    if h0 is not None:
        steps = jnp.arange(1, seq_len + 1, dtype=jnp.float32)[:, None, None]
        pw_mag = jnp.exp(steps * ar)
        pw_re, pw_im = pw_mag * jnp.cos(steps * ai), pw_mag * jnp.sin(steps * ai)
        h_re, h_im = h0[0][:, None], h0[1][:, None]
        x_re = x_re + pw_re * h_re - pw_im * h_im
        x_im = x_im + pw_re * h_im + pw_im * h_re
    y = jnp.einsum('blgp,gnp->blgn', x_re, c_re) - jnp.einsum('blgp,gnp->blgn', x_im, c_im)
    return y, x_re, x_im


def s5_mixer(u, h0_re, h0_im, lam_re, lam_im, log_dt, b_re, b_im, c_re, c_im, d, glu_w, glu_b):
    f32 = jnp.float32
    bsz, seq_len, _ = u.shape
    u32 = u.astype(f32).reshape(bsz, seq_len, S5_GROUPS, S5_GROUP_CH)
    y = d.astype(f32).reshape(S5_GROUPS, S5_GROUP_CH) * u32
    last_re, last_im = [], []
    for direction in range(2):
        ud = u32 if direction == 0 else u32[:, ::-1]
        h0 = None if h0_re is None else (h0_re[:, direction].astype(f32), h0_im[:, direction].astype(f32))
        yd, x_re, x_im = s5_scan(ud, h0, lam_re[direction].astype(f32), lam_im[direction].astype(f32),
                                 log_dt[direction].astype(f32), b_re[direction].astype(f32),
                                 b_im[direction].astype(f32), c_re[direction].astype(f32),
                                 c_im[direction].astype(f32))
        y = y + (yd if direction == 0 else yd[:, ::-1])
        if h0_re is None:
            last_re.append(x_re[:, -1])
            last_im.append(x_im[:, -1])
    g = jax.nn.gelu(y.reshape(bsz, seq_len, S5_WIDTH))
    out = (g * jax.nn.sigmoid(g @ glu_w.astype(f32) + glu_b.astype(f32))).astype(u.dtype)
    if h0_re is None:
        return out, jnp.stack(last_re, axis=1), jnp.stack(last_im, axis=1)
    return out


def ab_projection(h, w_in, qn_g, kn_g):
    bsz, seq_len, _ = h.shape
    proj = h @ w_in
    u = proj[..., :S5_WIDTH]
    q, k, v = jnp.split(proj[..., S5_WIDTH:], 3, axis=-1)
    q = rms_norm(q.reshape(bsz, seq_len, NA_HEADS, HEAD_DIM), qn_g)
    k = rms_norm(k.reshape(bsz, seq_len, NA_HEADS, HEAD_DIM), kn_g)
    v = v.reshape(bsz, seq_len, NA_HEADS, HEAD_DIM)
    return u, q, k, v


def context_attention(q, k, v):
    bsz, ctx_len, n_heads, hd = q.shape
    scale = hd ** -0.5
    qb = q.reshape(bsz, ctx_len // Q_BLOCK, Q_BLOCK, n_heads, hd).transpose(1, 0, 2, 3, 4)

    def block(qi):
        s = jnp.einsum('bqhd,bkhd->bhqk', qi, k, preferred_element_type=jnp.float32) * scale
        p = jax.nn.softmax(s, axis=-1).astype(v.dtype)
        return jnp.einsum('bhqk,bkhd->bqhd', p, v)

    o = lax.map(block, qb)
    return o.transpose(1, 0, 2, 3, 4).reshape(bsz, ctx_len, n_heads * hd)


def neighbourhood_attention(q, k, v, k_ctx, v_ctx, rpb):
    f32 = jnp.float32
    bsz, n_tok, n_heads, hd = q.shape
    rows = n_tok // GRID_W
    wr = min(NA_WIN_R, rows)
    n_cb = GRID_W // NA_QC
    scale = hd ** -0.5
    qg = q.reshape(bsz, rows, GRID_W, n_heads, hd)
    kg = k.reshape(bsz, rows, GRID_W, n_heads, hd)
    vg = v.reshape(bsz, rows, GRID_W, n_heads, hd)
    q_cols = np.arange(GRID_W).reshape(n_cb, NA_QC)
    c0 = np.clip(q_cols - NA_WIN_C // 2, 0, GRID_W - NA_WIN_C)
    kc0 = np.clip(np.arange(n_cb) * NA_QC - NA_WIN_C // 2, 0, GRID_W - NA_KC)
    k_cols = kc0[:, None] + np.arange(NA_KC)[None, :]
    col_ok = (k_cols[:, None, :] >= c0[:, :, None]) & (k_cols[:, None, :] < c0[:, :, None] + NA_WIN_C)
    n_loc = wr * NA_KC
    mask = np.broadcast_to(col_ok[:, None, :, None, :], (n_cb, 1, NA_QC, wr, NA_KC)).reshape(n_cb, 1, NA_QC, n_loc)
    dc_idx = np.clip(k_cols[:, None, :] - q_cols[:, :, None] + NA_WIN_C - 1, 0, 2 * NA_WIN_C - 2)

    def row_block(r):
        r0 = jnp.clip(r - wr // 2, 0, rows - wr)
        k_blk = lax.dynamic_slice_in_dim(kg, r0, wr, axis=1)[:, :, k_cols]
        v_blk = lax.dynamic_slice_in_dim(vg, r0, wr, axis=1)[:, :, k_cols]
        k_blk = k_blk.transpose(0, 2, 1, 3, 4, 5).reshape(bsz, n_cb, n_loc, n_heads, hd)
        v_blk = v_blk.transpose(0, 2, 1, 3, 4, 5).reshape(bsz, n_cb, n_loc, n_heads, hd)
        q_row = lax.dynamic_index_in_dim(qg, r, axis=1, keepdims=False).reshape(bsz, n_cb, NA_QC, n_heads, hd)
        dr_idx = r0 + jnp.arange(wr) - r + NA_WIN_R - 1
        bias = rpb[:, dr_idx[:, None, None, None], dc_idx[None]]
        bias = bias.transpose(2, 0, 3, 1, 4).reshape(n_cb, n_heads, NA_QC, n_loc).astype(f32)
        s_loc = jnp.einsum('bjqhd,bjkhd->bjhqk', q_row, k_blk, preferred_element_type=f32) * scale + bias
        s_loc = jnp.where(mask, s_loc, NEG_INF)
        s_ctx = jnp.einsum('bjqhd,bchd->bjhqc', q_row, k_ctx, preferred_element_type=f32) * scale
        p = jax.nn.softmax(jnp.concatenate([s_loc, s_ctx], axis=-1), axis=-1).astype(v.dtype)
        o = (jnp.einsum('bjhqk,bjkhd->bjqhd', p[..., :n_loc], v_blk)
             + jnp.einsum('bjhqc,bchd->bjqhd', p[..., n_loc:], v_ctx))
        return o.reshape(bsz, GRID_W, n_heads, hd)

    out = lax.map(row_block, jnp.arange(rows))
    return out.transpose(1, 0, 2, 3, 4).reshape(bsz, n_tok, n_heads * hd)


def ab_mixer_context(h, w_in, w_out, qn_g, kn_g, s5p):
    u, q, k, v = ab_projection(h, w_in, qn_g, kn_g)
    s5_out, s_re, s_im = s5_mixer(u, None, None, *s5p)
    attn = context_attention(q, k, v)
    out = jnp.concatenate([s5_out, attn], axis=-1) @ w_out
    return out, k, v, s_re, s_im


def ab_mixer_latent(h, k_ctx, v_ctx, h0_re, h0_im, w_in, w_out, qn_g, kn_g, rpb, s5p):
    u, q, k, v = ab_projection(h, w_in, qn_g, kn_g)
    s5_out = s5_mixer(u, h0_re, h0_im, *s5p)
    attn = neighbourhood_attention(q, k, v, k_ctx, v_ctx, rpb)
    return jnp.concatenate([s5_out, attn], axis=-1) @ w_out


def short_conv_mixer(h, w_in, conv_w, conv_b, w_out):
    gate_b, gate_c, xt = jnp.split(h @ w_in, 3, axis=-1)
    z = jnp.pad(gate_c * xt, ((0, 0), (1, 1), (0, 0)))
    conv = z[:, :-2] * conv_w[0] + z[:, 1:-1] * conv_w[1] + z[:, 2:] * conv_w[2] + conv_b
    return (gate_b * conv) @ w_out


def sq_relu_mlp(h, w1, w2):
    a = jax.nn.relu(h @ w1)
    return (a * a) @ w2


def setup_inputs(seed: int = 0) -> dict:
    key = jax.random.key(seed)
    ks = iter(jax.random.split(key, 40))
    f32 = jnp.float32

    def nrm(shape, scale):
        return jax.random.normal(next(ks), shape, f32) * scale

    inp = {}
    inp['x_prompt'] = nrm((BATCH, SEQ, D_MODEL), 1.0)
    inp['x_sample'] = nrm((DEC_BATCH, DEC_SEQ, D_MODEL), 1.0)
    inp['c'] = nrm((DEC_BATCH, D_MODEL), 1.0)
    inp['cache_k'] = nrm((DEC_BATCH, N_EVEN, PAST_LEN, NA_HEADS, HEAD_DIM), 1.0)
    inp['cache_v'] = nrm((DEC_BATCH, N_EVEN, PAST_LEN, NA_HEADS, HEAD_DIM), 1.0)
    inp['state_ssm_re'] = nrm((DEC_BATCH, N_EVEN, 2, S5_GROUPS, S5_STATE), 0.3)
    inp['state_ssm_im'] = nrm((DEC_BATCH, N_EVEN, 2, S5_GROUPS, S5_STATE), 0.3)
    inp['c_ctx'] = nrm((D_MODEL,), 1.0)
    inp['ada_w'] = nrm((DEPTH, D_MODEL, 6 * D_MODEL), 0.5 * D_MODEL ** -0.5)
    inp['ada_b'] = nrm((DEPTH, 6 * D_MODEL), 0.01)
    inp['norm1_g'] = 1.0 + nrm((DEPTH, D_MODEL), 0.02)
    inp['norm2_g'] = 1.0 + nrm((DEPTH, D_MODEL), 0.02)
    inp['ab_w_in'] = nrm((N_EVEN, D_MODEL, AB_IN), D_MODEL ** -0.5)
    inp['ab_w_out'] = nrm((N_EVEN, AB_OUT, D_MODEL), AB_OUT ** -0.5)
    inp['s5_lam_re'] = -0.5 + nrm((N_EVEN, 2, S5_GROUPS, S5_STATE), 0.01)
    inp['s5_lam_im'] = jnp.pi * jnp.arange(S5_STATE, dtype=f32) + nrm((N_EVEN, 2, S5_GROUPS, S5_STATE), 0.01)
    inp['s5_log_dt'] = jax.random.uniform(next(ks), (N_EVEN, 2, S5_GROUPS), f32, math.log(1e-3), math.log(1e-1))
    inp['s5_b_re'] = nrm((N_EVEN, 2, S5_GROUPS, S5_STATE, S5_GROUP_CH), (2 * S5_GROUP_CH) ** -0.5)
    inp['s5_b_im'] = nrm((N_EVEN, 2, S5_GROUPS, S5_STATE, S5_GROUP_CH), (2 * S5_GROUP_CH) ** -0.5)
    inp['s5_c_re'] = nrm((N_EVEN, 2, S5_GROUPS, S5_GROUP_CH, S5_STATE), S5_STATE ** -0.5)
    inp['s5_c_im'] = nrm((N_EVEN, 2, S5_GROUPS, S5_GROUP_CH, S5_STATE), S5_STATE ** -0.5)
    inp['s5_d'] = nrm((N_EVEN, S5_WIDTH), 1.0)
    inp['s5_glu_w'] = nrm((N_EVEN, S5_WIDTH, S5_WIDTH), S5_WIDTH ** -0.5)
    inp['s5_glu_b'] = nrm((N_EVEN, S5_WIDTH), 0.01)
    inp['q_norm_g'] = 1.0 + nrm((N_EVEN, HEAD_DIM), 0.02)
    inp['k_norm_g'] = 1.0 + nrm((N_EVEN, HEAD_DIM), 0.02)
    inp['na_rpb'] = nrm((N_EVEN, NA_HEADS, 2 * NA_WIN_R - 1, 2 * NA_WIN_C - 1), 0.1)
    inp['conv_w_in'] = nrm((N_ODD, D_MODEL, 3 * D_MODEL), D_MODEL ** -0.5)
    inp['conv_w'] = nrm((N_ODD, 3, D_MODEL), 3 ** -0.5)
    inp['conv_b'] = nrm((N_ODD, D_MODEL), 0.01)
    inp['conv_w_out'] = nrm((N_ODD, D_MODEL, D_MODEL), D_MODEL ** -0.5)
    inp['mlp_w1'] = nrm((DEPTH, D_MODEL, D_FF), D_MODEL ** -0.5)
    inp['mlp_w2'] = nrm((DEPTH, D_FF, D_MODEL), D_FF ** -0.5)
    return inp


def reference(x_prompt, x_sample, c, cache_k, cache_v, state_ssm_re, state_ssm_im, c_ctx,
              ada_w, ada_b, norm1_g, norm2_g, ab_w_in, ab_w_out,
              s5_lam_re, s5_lam_im, s5_log_dt, s5_b_re, s5_b_im, s5_c_re, s5_c_im, s5_d,
              s5_glu_w, s5_glu_b, q_norm_g, k_norm_g, na_rpb,
              conv_w_in, conv_w, conv_b, conv_w_out, mlp_w1, mlp_w2):
    xp, xs = x_prompt, x_sample
    ks, vs, srs, sis = [], [], [], []
    for layer in range(DEPTH):
        sh1p, sc1p, g1p, sh2p, sc2p, g2p = ada_params(c_ctx[None], ada_w[layer], ada_b[layer])
        sh1s, sc1s, g1s, sh2s, sc2s, g2s = ada_params(c, ada_w[layer], ada_b[layer])
        hp = modulate(xp, norm1_g[layer], sh1p, sc1p)
        hs = modulate(xs, norm1_g[layer], sh1s, sc1s)
        if layer % 2 == 0:
            e = layer // 2
            s5p = (s5_lam_re[e], s5_lam_im[e], s5_log_dt[e], s5_b_re[e], s5_b_im[e],
                   s5_c_re[e], s5_c_im[e], s5_d[e], s5_glu_w[e], s5_glu_b[e])
            yp, kp, vp, srp, sip = ab_mixer_context(hp, ab_w_in[e], ab_w_out[e], q_norm_g[e], k_norm_g[e], s5p)
            ys = ab_mixer_latent(hs, cache_k[:, e], cache_v[:, e], state_ssm_re[:, e], state_ssm_im[:, e],
                                 ab_w_in[e], ab_w_out[e], q_norm_g[e], k_norm_g[e], na_rpb[e], s5p)
            ks.append(kp)
            vs.append(vp)
            srs.append(srp)
            sis.append(sip)
        else:
            o = layer // 2
            yp = short_conv_mixer(hp, conv_w_in[o], conv_w[o], conv_b[o], conv_w_out[o])
            ys = short_conv_mixer(hs, conv_w_in[o], conv_w[o], conv_b[o], conv_w_out[o])
        xp = xp + g1p * yp
        xs = xs + g1s * ys
        xp = xp + g2p * sq_relu_mlp(modulate(xp, norm2_g[layer], sh2p, sc2p), mlp_w1[layer], mlp_w2[layer])
        xs = xs + g2s * sq_relu_mlp(modulate(xs, norm2_g[layer], sh2s, sc2s), mlp_w1[layer], mlp_w2[layer])
    new_cache_k = jnp.stack(ks, axis=1)
    new_cache_v = jnp.stack(vs, axis=1)
    new_state_ssm_re = jnp.stack(srs, axis=1)
    new_state_ssm_im = jnp.stack(sis, axis=1)
    return (xp, xs, new_cache_k, new_cache_v, new_state_ssm_re, new_state_ssm_im)
```

```cpp
#include <hip/hip_runtime.h>
#include <cstdio>
#include <cstdint>

#ifndef MK_PER_PHASE
#define MK_PER_PHASE 0
#endif

namespace pg8 {
#define PG8_LAS __attribute__((address_space(3)))
typedef unsigned short bf16_t;
typedef short bf16x8 __attribute__((ext_vector_type(8)));
typedef float f32x4 __attribute__((ext_vector_type(4)));
typedef unsigned u32x4 __attribute__((ext_vector_type(4)));
constexpr int BM = 256, BK = 64, HALF = 128, HTB = HALF * BK * 2  , STAGE_BYTES = 8 * HTB, NXCD = 8, WGM = 8;

__host__ __device__ __forceinline__ int lds_byte(int r, int c) { const int st = (r >> 4) * 2 + (c >> 5), rr = r & 15, cc = c & 31, ob = rr * 64 + cc * 2; return st * 1024 + (ob ^ (((ob >> 9) & 1) << 5)); }
__host__ __device__ __forceinline__ void stage_rc(int b, int& R, int& C) { const int st = b / 1024, sb = b % 1024, swz = sb ^ (((sb >> 9) & 1) << 5); R = (st >> 1) * 16 + swz / 64; C = (st & 1) * 32 + (swz % 64) / 2; }
__host__ __device__ __forceinline__ int perm32(int rho) { const int n = rho >> 4, i = rho & 15; return 8 * (i >> 2) + 4 * n + (i & 3); }

struct Unit { int pm, pn; };
struct Gemm { const bf16_t* A; const bf16_t* Bt; int M, N, K; };

struct StaticOrder {
    int nM, nN, nwg, G, c;
    __host__ __device__ void init(int M, int N, int G_, int c_) { nM = M / BM; nN = N / BM; nwg = nM * nN; G = G_; c = c_; }
    __host__ __device__ bool next(int i, Unit& u) const {
        const long L = (long)i * G + c; if (L >= nwg) return false;
        int wgid = (int)L; { const int q = nwg / NXCD, r = nwg % NXCD, xcd = wgid % NXCD, off = wgid / NXCD; wgid = (xcd < r ? xcd * (q + 1) : r * (q + 1) + (xcd - r) * q) + off; }
        const int nig = WGM * nN, gid = wgid / nig, fm = gid * WGM, gsz = (nM - fm) < WGM ? (nM - fm) : WGM;
        u.pm = fm + ((wgid % nig) % gsz); u.pn = (wgid % nig) / gsz; return true;
    }
    __device__ __forceinline__ void a_ready(const Unit&) const {}
    __device__ __forceinline__ void done(const Unit&) const {}
};

__device__ __forceinline__ unsigned cvt_pk_bf16(float lo, float hi) { unsigned r; asm volatile("v_cvt_pk_bf16_f32 %0, %1, %2" : "=v"(r) : "v"(lo), "v"(hi)); return r; }

constexpr int DM = 2048;
__device__ __forceinline__ int ada_row_of_panel(int pm) { return pm < 32 ? 0 : 1 + ((pm - 32) >> 4); }

struct EpiAbIn {
    static constexpr bool PERM = true, AFTER_DRAIN = false;
    bf16_t* U; bf16_t* Q; size_t qkv_stride;
    __device__ __forceinline__ void operator()(const f32x4 (&acc)[2][2][4][2], const Unit& u, int wr, int wc, int fr, int fq) const {
        const int row0 = u.pm * BM + wr * 64 + fr;
        bf16_t* base; int ldc, colt;
        if (u.pn < 2) { base = U; ldc = 512; colt = u.pn * BM; }
        else { const int t = (u.pn - 2) >> 2; base = Q + (size_t)t * qkv_stride; ldc = 1024; colt = ((u.pn - 2) & 3) * BM; }
        const int col0 = colt + wc * 32 + 8 * fq;
#pragma unroll
        for (int ai = 0; ai < 2; ++ai)
#pragma unroll
            for (int m = 0; m < 4; ++m) { bf16_t* rowp = base + (size_t)(row0 + ai * HALF + m * 16) * ldc + col0;
#pragma unroll
                for (int bj = 0; bj < 2; ++bj) { const f32x4 v0 = acc[ai][bj][m][0], v1 = acc[ai][bj][m][1];
                    u32x4 w; w.x = cvt_pk_bf16(v0[0], v0[1]); w.y = cvt_pk_bf16(v0[2], v0[3]); w.z = cvt_pk_bf16(v1[0], v1[1]); w.w = cvt_pk_bf16(v1[2], v1[3]);
                    *(u32x4*)(rowp + bj * HALF) = w; } }
    }
};
struct EpiRelu2 {
    static constexpr bool PERM = true, AFTER_DRAIN = false;
    bf16_t* O; int ldc;
    __device__ __forceinline__ void operator()(const f32x4 (&acc)[2][2][4][2], const Unit& u, int wr, int wc, int fr, int fq) const {
        const int row0 = u.pm * BM + wr * 64 + fr, col0 = u.pn * BM + wc * 32 + 8 * fq;
#pragma unroll
        for (int ai = 0; ai < 2; ++ai)
#pragma unroll
            for (int m = 0; m < 4; ++m) { bf16_t* rowp = O + (size_t)(row0 + ai * HALF + m * 16) * ldc + col0;
#pragma unroll
                for (int bj = 0; bj < 2; ++bj) { f32x4 v0 = acc[ai][bj][m][0], v1 = acc[ai][bj][m][1];
#pragma unroll
                    for (int j = 0; j < 4; ++j) { const float a = fmaxf(v0[j], 0.f), b = fmaxf(v1[j], 0.f); v0[j] = a * a; v1[j] = b * b; }
                    u32x4 w; w.x = cvt_pk_bf16(v0[0], v0[1]); w.y = cvt_pk_bf16(v0[2], v0[3]); w.z = cvt_pk_bf16(v1[0], v1[1]); w.w = cvt_pk_bf16(v1[2], v1[3]);
                    *(u32x4*)(rowp + bj * HALF) = w; } }
    }
};
struct EpiConvIn {
    static constexpr bool PERM = true, AFTER_DRAIN = false;
    bf16_t* Z; bf16_t* GB;
    __device__ __forceinline__ void operator()(const f32x4 (&acc)[2][2][4][2], const Unit& u, int wr, int wc, int fr, int fq) const {
        const int row0 = u.pm * BM + wr * 64 + fr;
        if (u.pn < 16) {
            const int col0 = u.pn * HALF + wc * 32 + 8 * fq;
#pragma unroll
            for (int ai = 0; ai < 2; ++ai)
#pragma unroll
                for (int m = 0; m < 4; ++m) { bf16_t* rowp = Z + (size_t)(row0 + ai * HALF + m * 16) * DM + col0;
                    const f32x4 v0 = acc[ai][0][m][0] * acc[ai][1][m][0], v1 = acc[ai][0][m][1] * acc[ai][1][m][1];
                    u32x4 w; w.x = cvt_pk_bf16(v0[0], v0[1]); w.y = cvt_pk_bf16(v0[2], v0[3]); w.z = cvt_pk_bf16(v1[0], v1[1]); w.w = cvt_pk_bf16(v1[2], v1[3]);
                    *(u32x4*)rowp = w; }
        } else {
            const int col0 = (u.pn - 16) * BM + wc * 32 + 8 * fq;
#pragma unroll
            for (int ai = 0; ai < 2; ++ai)
#pragma unroll
                for (int m = 0; m < 4; ++m) { bf16_t* rowp = GB + (size_t)(row0 + ai * HALF + m * 16) * DM + col0;
#pragma unroll
                    for (int bj = 0; bj < 2; ++bj) { const f32x4 v0 = acc[ai][bj][m][0], v1 = acc[ai][bj][m][1];
                        u32x4 w; w.x = cvt_pk_bf16(v0[0], v0[1]); w.y = cvt_pk_bf16(v0[2], v0[3]); w.z = cvt_pk_bf16(v1[0], v1[1]); w.w = cvt_pk_bf16(v1[2], v1[3]);
                        *(u32x4*)(rowp + bj * HALF) = w; } }
        }
    }
};
struct EpiRes {
    static constexpr bool PERM = false, AFTER_DRAIN = false;
    const float* base0; const float* base1; float* out; const float* gate;
    __device__ __forceinline__ void operator()(const f32x4 (&acc)[2][2][4][2], const Unit& u, int wr, int wc, int fr, int fq) const {
        const int row0 = u.pm * BM + wr * 64 + fr, col0 = u.pn * BM + wc * 32 + 4 * fq;
        const float* g = gate + ada_row_of_panel(u.pm) * 12288 + col0;
        const float* bs = u.pm < 32 ? base0 : base1;
        f32x4 gv[2][2];
#pragma unroll
        for (int bj = 0; bj < 2; ++bj)
#pragma unroll
            for (int n = 0; n < 2; ++n) gv[bj][n] = *(const f32x4*)(g + bj * HALF + n * 16);
#pragma unroll
        for (int ai = 0; ai < 2; ++ai)
#pragma unroll
            for (int m = 0; m < 4; ++m) { const size_t off = (size_t)(row0 + ai * HALF + m * 16) * DM + col0;
#pragma unroll
                for (int bj = 0; bj < 2; ++bj)
#pragma unroll
                    for (int n = 0; n < 2; ++n) { const f32x4 b = *(const f32x4*)(bs + off + bj * HALF + n * 16);
                        *(f32x4*)(out + off + bj * HALF + n * 16) = b + gv[bj][n] * acc[ai][bj][m][n]; }
                asm volatile("" ::: "memory"); }
    }
};

template <class Epi, class Sched, bool ALIGN_EPI = false, bool SP2 = false>
__device__ __forceinline__ void gemm_phase(PG8_LAS unsigned char* lds, const Gemm g, const Sched& S, const Epi& E) {
    int tid_ = threadIdx.x; asm volatile("" : "+v"(tid_));
    const int tid = tid_, wid = __builtin_amdgcn_readfirstlane(tid >> 6), lane = tid & 63, wr = wid >> 2, wc = wid & 3, fr = lane & 15, fq = lane >> 4;
    const int K = g.K, nt = K / BK;
    unsigned voffA[2], voffB[2];
#pragma unroll
    for (int i = 0; i < 2; ++i) { int R, C; stage_rc(tid * 16 + i * 8192, R, C); const int Rb = Epi::PERM ? ((R & ~31) + perm32(R & 31)) : R;
        voffA[i] = (unsigned)(R * K + C) * 2u; voffB[i] = (unsigned)(Rb * K + C) * 2u; }
    const size_t kstep = (size_t)(BK * 2);
    const size_t hstep = (size_t)HALF * K * 2;
    const size_t tstep = 2 * hstep;
    const unsigned ldsw = (unsigned)wid * 1024u;
    const int aoff = lds_byte(wr * 64 + fr, fq * 8), boff = lds_byte(wc * 32 + fr, fq * 8);
#define PG8_SA(b, h) (((b) * 2 + (h)) * HTB)
#define PG8_SB(b, h) ((4 + (b) * 2 + (h)) * HTB)
#define PG8_STAGE(bufoff, gbase, voff) do { _Pragma("unroll") for (int _i = 0; _i < 2; ++_i) \
        __builtin_amdgcn_global_load_lds((const unsigned*)((const char*)(gbase) + (voff)[_i]), (PG8_LAS unsigned*)(lds + (bufoff) + ldsw + _i * 8192), 16, 0, 0); } while (0)
#define PG8_LDA(dst, b, h) do { _Pragma("unroll") for (int m = 0; m < 4; ++m) _Pragma("unroll") for (int k = 0; k < 2; ++k) dst[m][k] = *(const PG8_LAS bf16x8*)(lds + PG8_SA(b, h) + aoff + m * 2048 + k * 1024); } while (0)
#define PG8_LDB(dst, b, h) do { _Pragma("unroll") for (int n = 0; n < 2; ++n) _Pragma("unroll") for (int k = 0; k < 2; ++k) dst[n][k] = *(const PG8_LAS bf16x8*)(lds + PG8_SB(b, h) + boff + n * 2048 + k * 1024); } while (0)
#define PG8_MMA(ai, bj, At, Bt) do { __builtin_amdgcn_s_setprio(1); _Pragma("unroll") for (int m = 0; m < 4; ++m) _Pragma("unroll") for (int n = 0; n < 2; ++n) _Pragma("unroll") for (int k = 0; k < 2; ++k) \
        acc[ai][bj][m][n] = __builtin_amdgcn_mfma_f32_16x16x32_bf16(Bt[n][k], At[m][k], acc[ai][bj][m][n], 0, 0, 0); __builtin_amdgcn_s_setprio(0); } while (0)
#define PG8_WAIT_V(n) asm volatile("s_waitcnt vmcnt(" #n ")" ::: "memory")
#define PG8_WAIT_L(n) asm volatile("s_waitcnt lgkmcnt(" #n ")" ::: "memory")
#define PG8_BAR __builtin_amdgcn_s_barrier()
#define PG8_SCHED __builtin_amdgcn_sched_barrier(0)
    Unit cur, nxt; int ui = 0;
    if (!S.next(0, cur)) return;
    f32x4 acc[2][2][4][2];
#pragma unroll
    for (int a = 0; a < 2; ++a)
#pragma unroll
        for (int b = 0; b < 2; ++b)
#pragma unroll
            for (int m = 0; m < 4; ++m)
#pragma unroll
                for (int n = 0; n < 2; ++n) acc[a][b][m][n] = (f32x4){0.f, 0.f, 0.f, 0.f};
    bf16x8 At[4][2], B0[2][2], B1[2][2];
    const char* cA = (const char*)g.A + (size_t)cur.pm * tstep; const char* cB = (const char*)g.Bt + (size_t)cur.pn * tstep;
    S.a_ready(cur);
    if constexpr (SP2) {
        PG8_STAGE(PG8_SB(0, 0), cB, voffB); PG8_STAGE(PG8_SB(0, 1), cB + hstep, voffB); PG8_STAGE(PG8_SA(0, 0), cA, voffA); PG8_STAGE(PG8_SA(0, 1), cA + hstep, voffA);
        if (wr == 1) PG8_BAR;
        PG8_WAIT_V(2); PG8_BAR;
        PG8_STAGE(PG8_SB(1, 0), cB + kstep, voffB); PG8_STAGE(PG8_SA(1, 0), cA + kstep, voffA); PG8_STAGE(PG8_SB(1, 1), cB + hstep + kstep, voffB);
        PG8_WAIT_V(6); PG8_BAR;
    } else {
        PG8_STAGE(PG8_SB(0, 0), cB, voffB); PG8_STAGE(PG8_SA(0, 0), cA, voffA); PG8_STAGE(PG8_SB(0, 1), cB + hstep, voffB); PG8_STAGE(PG8_SA(0, 1), cA + hstep, voffA);
        if (wr == 1) PG8_BAR;
        PG8_WAIT_V(4); PG8_BAR;
        PG8_STAGE(PG8_SB(1, 0), cB + kstep, voffB); PG8_STAGE(PG8_SA(1, 0), cA + kstep, voffA); PG8_STAGE(PG8_SB(1, 1), cB + hstep + kstep, voffB);
        PG8_WAIT_V(6); PG8_BAR;
    }
    for (;;) {
        const bool has_next = S.next(ui + 1, nxt);
        const char* nA = has_next ? (const char*)g.A + (size_t)nxt.pm * tstep : cA; const char* nB = has_next ? (const char*)g.Bt + (size_t)nxt.pn * tstep : cB;
        for (int t = 0; t < nt; t += 2) {
            const bool last = (t == nt - 2);
            const char* a1 = cA + (size_t)(t + 1) * kstep;
            const char* a2 = last ? nA : cA + (size_t)(t + 2) * kstep; const char* b2 = last ? nB : cB + (size_t)(t + 2) * kstep;
            const char* a3 = a2 + kstep; const char* b3 = b2 + kstep;
            if (last && has_next) S.a_ready(nxt);
            if constexpr (SP2) {
            PG8_LDB(B0, 0, 0); PG8_LDB(B1, 0, 1); PG8_SCHED; PG8_LDA(At, 0, 0); PG8_STAGE(PG8_SA(1, 1), a1 + hstep, voffA);
            PG8_WAIT_V(8); PG8_WAIT_L(0); PG8_BAR; PG8_MMA(0, 0, At, B0); PG8_MMA(0, 1, At, B1); PG8_BAR; PG8_SCHED;
            PG8_LDA(At, 0, 1); PG8_STAGE(PG8_SB(0, 0), b2, voffB); PG8_STAGE(PG8_SB(0, 1), b2 + hstep, voffB); PG8_STAGE(PG8_SA(0, 0), a2, voffA);
            PG8_WAIT_V(8); PG8_WAIT_L(0); PG8_BAR; PG8_MMA(1, 0, At, B0); PG8_MMA(1, 1, At, B1); PG8_BAR; PG8_SCHED;
            PG8_LDB(B0, 1, 0); PG8_LDB(B1, 1, 1); PG8_SCHED; PG8_LDA(At, 1, 0); PG8_STAGE(PG8_SA(0, 1), a2 + hstep, voffA);
            PG8_WAIT_V(8); PG8_WAIT_L(0); PG8_BAR; PG8_MMA(0, 0, At, B0); PG8_MMA(0, 1, At, B1); PG8_BAR; PG8_SCHED;
            PG8_LDA(At, 1, 1); PG8_STAGE(PG8_SB(1, 0), b3, voffB); PG8_STAGE(PG8_SB(1, 1), b3 + hstep, voffB); PG8_STAGE(PG8_SA(1, 0), a3, voffA);
            PG8_WAIT_V(8); PG8_WAIT_L(0); PG8_BAR; PG8_MMA(1, 0, At, B0); PG8_MMA(1, 1, At, B1); PG8_BAR; PG8_SCHED;
            } else {
            PG8_LDB(B0, 0, 0); PG8_SCHED; PG8_LDA(At, 0, 0); PG8_STAGE(PG8_SA(1, 1), a1 + hstep, voffA);
            PG8_WAIT_L(8); PG8_BAR; PG8_WAIT_L(0); PG8_MMA(0, 0, At, B0); PG8_BAR; PG8_SCHED;
            PG8_LDB(B1, 0, 1); PG8_STAGE(PG8_SB(0, 0), b2, voffB);
            PG8_BAR; PG8_WAIT_L(0); PG8_MMA(0, 1, At, B1); PG8_BAR;
            PG8_LDA(At, 0, 1); PG8_STAGE(PG8_SA(0, 0), a2, voffA);
            PG8_BAR; PG8_WAIT_L(0); PG8_MMA(1, 0, At, B0); PG8_BAR; PG8_SCHED;
            PG8_STAGE(PG8_SB(0, 1), b2 + hstep, voffB);
            PG8_WAIT_V(6); PG8_BAR; PG8_MMA(1, 1, At, B1); PG8_BAR;
            PG8_LDB(B0, 1, 0); PG8_SCHED; PG8_LDA(At, 1, 0); PG8_STAGE(PG8_SA(0, 1), a2 + hstep, voffA);
            PG8_WAIT_L(8); PG8_BAR; PG8_WAIT_L(0); PG8_MMA(0, 0, At, B0); PG8_BAR; PG8_SCHED;
            PG8_LDB(B1, 1, 1); PG8_STAGE(PG8_SB(1, 0), b3, voffB);
            PG8_BAR; PG8_WAIT_L(0); PG8_MMA(0, 1, At, B1); PG8_BAR;
            PG8_LDA(At, 1, 1); PG8_STAGE(PG8_SA(1, 0), a3, voffA);
            PG8_BAR; PG8_WAIT_L(0); PG8_MMA(1, 0, At, B0); PG8_BAR; PG8_SCHED;
            PG8_STAGE(PG8_SB(1, 1), b3 + hstep, voffB);
            PG8_WAIT_V(6); PG8_BAR; PG8_MMA(1, 1, At, B1); PG8_BAR;
            }
        }
        if constexpr (ALIGN_EPI) { if (wr == 0) PG8_BAR; }
        if constexpr (!Epi::AFTER_DRAIN) { E(acc, cur, wr, wc, fr, fq); S.done(cur); }
        if (!has_next) break;
#pragma unroll
        for (int a = 0; a < 2; ++a)
#pragma unroll
            for (int b = 0; b < 2; ++b)
#pragma unroll
                for (int m = 0; m < 4; ++m)
#pragma unroll
                    for (int n = 0; n < 2; ++n) acc[a][b][m][n] = (f32x4){0.f, 0.f, 0.f, 0.f};
        cur = nxt; cA = nA; cB = nB; ++ui;
        if constexpr (ALIGN_EPI) { if (wr == 1) PG8_BAR; }
    }
    PG8_WAIT_V(0);
    if constexpr (!ALIGN_EPI) { if (wr == 0) PG8_BAR; }
    PG8_BAR;
    if constexpr (Epi::AFTER_DRAIN) { E.fused(acc, cur, wr, wc, fr, fq, lds, wid, lane); S.done(cur); }
#undef PG8_SA
#undef PG8_SB
#undef PG8_STAGE
#undef PG8_LDA
#undef PG8_LDB
#undef PG8_MMA
#undef PG8_WAIT_V
#undef PG8_WAIT_L
#undef PG8_BAR
#undef PG8_SCHED
}
}

#define GAS __attribute__((address_space(1)))
#define LAS __attribute__((address_space(3)))
typedef unsigned short bf16_t;
typedef short bf16x8 __attribute__((ext_vector_type(8)));
typedef short s16x4 __attribute__((ext_vector_type(4)));
typedef float f32x4 __attribute__((ext_vector_type(4)));
typedef float f32x16 __attribute__((ext_vector_type(16)));
typedef unsigned u32x4 __attribute__((ext_vector_type(4)));
typedef unsigned u32x2 __attribute__((ext_vector_type(2)));
#define SBAR() __builtin_amdgcn_sched_barrier(0)
__device__ __forceinline__ unsigned cvtpk(float lo, float hi) { unsigned r; asm volatile("v_cvt_pk_bf16_f32 %0, %1, %2" : "=v"(r) : "v"(lo), "v"(hi)); return r; }
__device__ __forceinline__ float bf2f(unsigned short b) { return __uint_as_float(((unsigned)b) << 16); }
__device__ __forceinline__ float bflo(unsigned w) { return __uint_as_float(w << 16); }
__device__ __forceinline__ float bfhi(unsigned w) { return __uint_as_float(w & 0xffff0000u); }
__device__ __forceinline__ unsigned short f2bf(float f) { return (unsigned short)(cvtpk(f, 0.f) & 0xffffu); }

namespace att {
constexpr int D = 128, NW = 8, QBLK = 32, KVBLK = 64, LD = 1024;
constexpr float SCALE = 0.088388347648318440f, THR = 8.f;
constexpr int SHM_V = KVBLK * D * 2, SHM_K = KVBLK * D * 2;
constexpr int OFF_V = 0, OFF_K = 2 * SHM_V, OFF_WS = 2 * SHM_V + 2 * SHM_K, OFF_BIAS = OFF_WS + NW * 64 * 4, LDS_BYTES = OFF_BIAS + 16 * 32 * 4;
#define KSWZ(row, colB) ((row) * 256 + ((colB) ^ (((row) & 7) << 4)))
__device__ __forceinline__ int crow(int r, int hi) { return (r & 3) + 8 * (r >> 2) + 4 * hi; }

__device__ __forceinline__ void partialSM(f32x16& p0, f32x16& p1, float& m_reg, float& mn, float& alpha) {
  constexpr float C = SCALE * 1.4426950408889634f;
  float pmax = p0[0];
#pragma unroll
  for (int r = 1; r < 16; ++r) pmax = fmaxf(pmax, p0[r]);
#pragma unroll
  for (int r = 0; r < 16; ++r) pmax = fmaxf(pmax, p1[r]);
  { auto rr = __builtin_amdgcn_permlane32_swap(__float_as_uint(pmax), __float_as_uint(pmax), false, false);
    pmax = fmaxf(__uint_as_float(rr[0]), __uint_as_float(rr[1])); }
  if (__builtin_expect(__all(pmax - m_reg <= THR / SCALE), 1)) { mn = m_reg; alpha = 1.f; }
  else { mn = fmaxf(m_reg, pmax); alpha = __builtin_amdgcn_exp2f((m_reg - mn) * C); m_reg = mn; }
  float mnC = -mn * C;
#pragma unroll
  for (int r = 0; r < 16; ++r) p0[r] = fmaf(p0[r], C, mnC);
#pragma unroll
  for (int r = 0; r < 16; ++r) p1[r] = fmaf(p1[r], C, mnC);
#pragma unroll
  for (int r = 0; r < 16; ++r) p0[r] = __builtin_amdgcn_exp2f(p0[r]);
}
__device__ __forceinline__ void finishSM(f32x16& p0, f32x16& p1, float alpha, float& l_reg, bf16x8& pa0, bf16x8& pa1, bf16x8& pa2, bf16x8& pa3) {
#pragma unroll
  for (int r = 0; r < 16; ++r) p1[r] = __builtin_amdgcn_exp2f(p1[r]);
  float ps = 0;
#pragma unroll
  for (int r = 0; r < 16; ++r) ps += p0[r];
#pragma unroll
  for (int r = 0; r < 16; ++r) ps += p1[r];
  { auto rr = __builtin_amdgcn_permlane32_swap(__float_as_uint(ps), __float_as_uint(ps), false, false);
    ps = __uint_as_float(rr[0]) + __uint_as_float(rr[1]); }
  l_reg = l_reg * alpha + ps;
#define PK4(P, BASE, OUT) do { unsigned a0 = cvtpk(P[BASE + 0], P[BASE + 1]), a1 = cvtpk(P[BASE + 2], P[BASE + 3]);   \
    unsigned b0 = cvtpk(P[BASE + 4], P[BASE + 5]), b1 = cvtpk(P[BASE + 6], P[BASE + 7]);                              \
    auto r0 = __builtin_amdgcn_permlane32_swap(a0, b0, false, false); auto r1 = __builtin_amdgcn_permlane32_swap(a1, b1, false, false); \
    u32x4 w = {r0[0], r1[0], r0[1], r1[1]}; OUT = *reinterpret_cast<bf16x8*>(&w); } while (0)
  PK4(p0, 0, pa0); PK4(p0, 8, pa1); PK4(p1, 0, pa2); PK4(p1, 8, pa3);
#undef PK4
}
__device__ __forceinline__ void qkt(f32x16& p0, f32x16& p1, const LAS char* Ks, const bf16x8* qr, int r32, int hi) {
  p0 = f32x16{}; p1 = f32x16{};
#pragma unroll
  for (int d0 = 0; d0 < 8; ++d0) { const int cb = (d0 * 16 + hi * 8) * 2;
    const bf16x8 b0 = *(const LAS bf16x8*)(Ks + KSWZ(r32, cb));
    const bf16x8 b1 = *(const LAS bf16x8*)(Ks + KSWZ(32 + r32, cb));
    p0 = __builtin_amdgcn_mfma_f32_32x32x16_bf16(b0, qr[d0], p0, 0, 0, 0);
    p1 = __builtin_amdgcn_mfma_f32_32x32x16_bf16(b1, qr[d0], p1, 0, 0, 0); }
}
__device__ __forceinline__ int v_st(int k, int c) { const int kk = (k & ~0xC) | ((k & 4) << 1) | ((k & 8) >> 1); return ((kk >> 3) * 4 + (c >> 5)) * 512 + ((kk & 7) * 32 + (c & 31)) * 2; }
__device__ __forceinline__ int v_rd_base(int lane) { return ((lane & 3) << 3) | (((lane >> 2) & 3) << 6) | (((lane >> 4) & 1) << 5) | (((lane >> 5) & 1) << 8); }
constexpr int v_rd_off(int d0, int ks, int half) { return d0 * 512 + ks * 4096 + half * 2048; }
template <int OFF> __device__ __forceinline__ s16x4 tr_read(int vb) {
  s16x4 r; asm volatile("ds_read_b64_tr_b16 %0, %1 offset:%2" : "=&v"(r) : "v"(vb), "i"(OFF) : "memory"); return r;
}
template <int D0> __device__ __forceinline__ void pv_one(f32x16& od, int vb, bf16x8 pa0, bf16x8 pa1, bf16x8 pa2, bf16x8 pa3) {
  const s16x4 l0 = tr_read<v_rd_off(D0, 0, 0)>(vb), h0 = tr_read<v_rd_off(D0, 0, 1)>(vb), l1 = tr_read<v_rd_off(D0, 1, 0)>(vb), h1 = tr_read<v_rd_off(D0, 1, 1)>(vb);
  const s16x4 l2 = tr_read<v_rd_off(D0, 2, 0)>(vb), h2 = tr_read<v_rd_off(D0, 2, 1)>(vb), l3 = tr_read<v_rd_off(D0, 3, 0)>(vb), h3 = tr_read<v_rd_off(D0, 3, 1)>(vb);
  asm volatile("s_waitcnt lgkmcnt(0)" ::: "memory"); SBAR();
#define PK(L, H) (bf16x8){L[0], L[1], L[2], L[3], H[0], H[1], H[2], H[3]}
  od = __builtin_amdgcn_mfma_f32_32x32x16_bf16(pa0, PK(l0, h0), od, 0, 0, 0);
  od = __builtin_amdgcn_mfma_f32_32x32x16_bf16(pa1, PK(l1, h1), od, 0, 0, 0);
  od = __builtin_amdgcn_mfma_f32_32x32x16_bf16(pa2, PK(l2, h2), od, 0, 0, 0);
  od = __builtin_amdgcn_mfma_f32_32x32x16_bf16(pa3, PK(l3, h3), od, 0, 0, 0);
#undef PK
}
__device__ __forceinline__ void pv_d0(f32x16* o, int vb, bf16x8 pa0, bf16x8 pa1, bf16x8 pa2, bf16x8 pa3) {
  pv_one<0>(o[0], vb, pa0, pa1, pa2, pa3); pv_one<1>(o[1], vb, pa0, pa1, pa2, pa3); pv_one<2>(o[2], vb, pa0, pa1, pa2, pa3); pv_one<3>(o[3], vb, pa0, pa1, pa2, pa3);
}

__device__ __forceinline__ void na_mask(f32x16& p0, f32x16& p1, int kr, int qrow, int qc, unsigned cmask, int hi, const LAS float* biasL) {
  int r0 = qrow - 4; r0 = r0 < 0 ? 0 : (r0 > 56 ? 56 : r0);
  const bool rowok = (kr >= r0) && (kr < r0 + 8);
  const unsigned em = rowok ? cmask : 0u;
  const int dr = rowok ? (kr - qrow + 7) : 0;
  const LAS float* brow = biasL + dr * 32 + (15 - qc + 4 * hi);
#pragma unroll
  for (int i4 = 0; i4 < 4; ++i4) {
#pragma unroll
    for (int ii = 0; ii < 4; ++ii) { const int i = i4 * 4 + ii, kc = (i & 3) + 8 * (i >> 2);
      const bool ok0 = (em >> i) & 1u, ok1 = (em >> (16 + i)) & 1u;
      const float b0 = brow[kc], b1 = brow[kc + 32];
      p0[i] = ok0 ? p0[i] + b0 : -1e30f; p1[i] = ok1 ? p1[i] + b1 : -1e30f; }
    asm volatile("" ::: "memory"); }
}

template <bool NA, int SDEPTH>
__device__ __forceinline__ void attn_unit(LAS char* lds, const bf16_t* __restrict__ Qb, const bf16_t* __restrict__ K0, const bf16_t* __restrict__ V0, int nt0,
                                          const bf16_t* __restrict__ K1, const bf16_t* __restrict__ V1, int NT, bf16_t* __restrict__ Ob, int ldo, int R, int kr0) {
  int tid_ = threadIdx.x; asm volatile("" : "+v"(tid_));
  const int tid = tid_, wid = tid >> 6, lane = tid & 63, r32 = lane & 31, hi = lane >> 5;
  LAS char* V_lds = lds + OFF_V; LAS char* K_lds = lds + OFF_K;
  LAS float* ws = (LAS float*)(lds + OFF_WS) + wid * 64; LAS float* li_l = ws; LAS float* al_l = ws + 32;
  const LAS float* biasL = (const LAS float*)(lds + OFF_BIAS);
  float m_reg = -1e30f, l_reg = 0; f32x16 o[4] = {}; bf16x8 qr[8];
  const bf16_t* Qw = Qb + (long)(wid * QBLK + r32) * LD + hi * 8;
#pragma unroll
  for (int d0 = 0; d0 < 8; ++d0) qr[d0] = *(const bf16x8*)(Qw + d0 * 16);
  const int sr = tid >> 4, sc = (tid & 15) * 8, vst0 = v_st(sr, sc), vst1 = v_st(32 + sr, sc);
  const int vb0 = (int)(uintptr_t)V_lds + v_rd_base(lane);
  const int qrow = R + (wid >> 1), qc = 32 * (wid & 1) + r32;
  unsigned cmask = 0;
  if (NA) { int c0 = qc - 8; c0 = c0 < 0 ? 0 : (c0 > 48 ? 48 : c0);
#pragma unroll
    for (int i = 0; i < 16; ++i) { const int kc = crow(i, hi); if ((unsigned)(kc - c0) < 16u) cmask |= 1u << i; if ((unsigned)(kc + 32 - c0) < 16u) cmask |= 1u << (16 + i); } }
  struct { bf16x8 vs0, vs1, ks0, ks1; } sr_[SDEPTH];
#define TILE_K(t) (((t) < nt0 ? K0 + (long)(t) * (KVBLK * LD) : K1 + (long)((t) - nt0) * (KVBLK * LD)))
#define TILE_V(t) (((t) < nt0 ? V0 + (long)(t) * (KVBLK * LD) : V1 + (long)((t) - nt0) * (KVBLK * LD)))
#define SLOAD(i, t) do { const bf16_t* kp_ = TILE_K(t); const bf16_t* vp_ = TILE_V(t); \
    sr_[i].vs0 = *(const bf16x8*)(vp_ + (long)sr * LD + sc); sr_[i].vs1 = *(const bf16x8*)(vp_ + (long)(32 + sr) * LD + sc); \
    sr_[i].ks0 = *(const bf16x8*)(kp_ + (long)sr * LD + sc); sr_[i].ks1 = *(const bf16x8*)(kp_ + (long)(32 + sr) * LD + sc); } while (0)
#define SWRITE(b, i) do { *(LAS bf16x8*)(V_lds + (b) * SHM_V + vst0) = sr_[i].vs0;          \
    *(LAS bf16x8*)(V_lds + (b) * SHM_V + vst1) = sr_[i].vs1; const int kc_ = sc * 2;               \
    *(LAS bf16x8*)(K_lds + (b) * SHM_K + KSWZ(sr, kc_)) = sr_[i].ks0;                       \
    *(LAS bf16x8*)(K_lds + (b) * SHM_K + KSWZ(32 + sr, kc_)) = sr_[i].ks1; } while (0)
#define SWAIT() do { if constexpr (SDEPTH == 2) asm volatile("s_waitcnt vmcnt(4)" ::: "memory"); else asm volatile("s_waitcnt vmcnt(0)" ::: "memory"); } while (0)
#define RESC(a) do { if (__any((a) < 1.f)) { if (hi == 0) al_l[r32] = (a); asm volatile("s_waitcnt lgkmcnt(0)" ::: "memory"); \
    _Pragma("unroll") for (int d = 0; d < 4; ++d) _Pragma("unroll") for (int r = 0; r < 16; ++r) o[d][r] *= al_l[crow(r, hi)]; } } while (0)
#define MASK(P0, P1, t) do { if (NA && (t) >= nt0) na_mask(P0, P1, kr0 + (t) - nt0, qrow, qc, cmask, hi, biasL); } while (0)
  f32x16 pA0, pA1, pB0, pB1; float mnA, mnB, alA, alB; bf16x8 pa0, pa1, pa2, pa3;
  constexpr int SE = 0, SO = SDEPTH - 1;
  SLOAD(SE, 0); asm volatile("s_waitcnt vmcnt(0)" ::: "memory"); SWRITE(0, SE); __syncthreads();
  qkt(pA0, pA1, K_lds, qr, r32, hi); MASK(pA0, pA1, 0); partialSM(pA0, pA1, m_reg, mnA, alA);
  SLOAD(SO, 1); if constexpr (SDEPTH == 2) { if (2 < NT) SLOAD(SE, 2); }
  SWAIT(); SWRITE(1, SO); __syncthreads();
  for (int j = 1; j + 1 < NT; j += 2) {
    SBAR(); qkt(pB0, pB1, K_lds + SHM_K, qr, r32, hi);
    finishSM(pA0, pA1, alA, l_reg, pa0, pa1, pa2, pa3); SBAR();
    SLOAD(SO, j + SDEPTH); SBAR();
    pv_d0(o, vb0, pa0, pa1, pa2, pa3); MASK(pB0, pB1, j); partialSM(pB0, pB1, m_reg, mnB, alB);
    __syncthreads(); SWAIT(); SWRITE(0, SE);
    RESC(alB); __syncthreads();
    SBAR(); qkt(pA0, pA1, K_lds, qr, r32, hi);
    finishSM(pB0, pB1, alB, l_reg, pa0, pa1, pa2, pa3); SBAR();
    if (SDEPTH == 1 || j + 3 < NT) SLOAD(SE, j + 1 + SDEPTH); SBAR();
    pv_d0(o, vb0 + SHM_V, pa0, pa1, pa2, pa3); MASK(pA0, pA1, j + 1); partialSM(pA0, pA1, m_reg, mnA, alA);
    __syncthreads(); SWAIT(); SWRITE(1, SO);
    RESC(alA); __syncthreads();
  }
  SBAR(); qkt(pB0, pB1, K_lds + SHM_K, qr, r32, hi);
  finishSM(pA0, pA1, alA, l_reg, pa0, pa1, pa2, pa3); SBAR();
  pv_d0(o, vb0, pa0, pa1, pa2, pa3); MASK(pB0, pB1, NT - 1); partialSM(pB0, pB1, m_reg, mnB, alB);
  __syncthreads(); RESC(alB);
  finishSM(pB0, pB1, alB, l_reg, pa0, pa1, pa2, pa3); SBAR();
  pv_d0(o, vb0 + SHM_V, pa0, pa1, pa2, pa3);
  if (hi == 0) li_l[r32] = l_reg; asm volatile("s_waitcnt lgkmcnt(0)" ::: "memory");
  float rli[16];
#pragma unroll
  for (int r = 0; r < 16; ++r) rli[r] = __builtin_amdgcn_rcpf(li_l[crow(r, hi)]);
  bf16_t* Ow = Ob + (long)(wid * QBLK) * ldo;
#pragma unroll
  for (int r = 0; r < 16; ++r) { const int orow = crow(r, hi);
#pragma unroll
    for (int d0 = 0; d0 < 4; ++d0) Ow[(long)orow * ldo + d0 * 32 + r32] = f2bf(o[d0][r] * rli[r]); }
#undef SLOAD
#undef SWRITE
#undef SWAIT
#undef RESC
#undef MASK
#undef TILE_K
#undef TILE_V
}
}

constexpr int DM = 2048, NCTX = 8192, NLAT = 32768, MTOK = NCTX + NLAT;
constexpr int CTX_L = 256, LAT_L = 4096, NLAYER = 4, DFF = 8192;
constexpr int ABIN = 3584, ABOUT = 1536, S5W = 512;
constexpr float NORM_EPS = 1e-6f;
constexpr int S5T = 32;
constexpr int NCHUNK = MTOK / S5T;
__device__ __forceinline__ int ada_row_of_token(int m) { return m < NCTX ? 0 : 1 + ((m - NCTX) >> 12); }

namespace s5 {
constexpr int XROW = 272;
constexpr int XBYTES = S5T * XROW;
constexpr int GROW = 1040;
constexpr int OFF_X = 0, OFF_G = 8 * XBYTES, LDS_BYTES = OFF_G + S5T * GROW;

__device__ __forceinline__ void bu_chunk(const bf16_t* __restrict__ U, int m0, int g, int dir, const bf16_t* __restrict__ BB, int lane, float (&bre)[32], float (&bim)[32]) {
  const int r = lane & 31, h = lane >> 5, tok = dir ? 31 - r : r;
  const bf16x8 ua = *(const bf16x8*)(U + (size_t)(m0 + tok) * S5W + g * 16 + h * 8);
  const bf16x8 br0 = *(const bf16x8*)(BB + (0 * 64 + r) * 16 + h * 8), br1 = *(const bf16x8*)(BB + (0 * 64 + 32 + r) * 16 + h * 8);
  const bf16x8 bi0 = *(const bf16x8*)(BB + (1 * 64 + r) * 16 + h * 8), bi1 = *(const bf16x8*)(BB + (1 * 64 + 32 + r) * 16 + h * 8);
  const f32x16 z = {};
  const f32x16 dr0 = __builtin_amdgcn_mfma_f32_32x32x16_bf16(ua, br0, z, 0, 0, 0), dr1 = __builtin_amdgcn_mfma_f32_32x32x16_bf16(ua, br1, z, 0, 0, 0);
  const f32x16 di0 = __builtin_amdgcn_mfma_f32_32x32x16_bf16(ua, bi0, z, 0, 0, 0), di1 = __builtin_amdgcn_mfma_f32_32x32x16_bf16(ua, bi1, z, 0, 0, 0);
#pragma unroll
  for (int i = 0; i < 16; ++i) { const int c0 = (i & 3) + 8 * (i >> 2);
    auto a = __builtin_amdgcn_permlane32_swap(__float_as_uint(dr0[i]), __float_as_uint(dr1[i]), false, false);
    bre[c0] = __uint_as_float(a[0]); bre[c0 + 4] = __uint_as_float(a[1]);
    auto b = __builtin_amdgcn_permlane32_swap(__float_as_uint(di0[i]), __float_as_uint(di1[i]), false, false);
    bim[c0] = __uint_as_float(b[0]); bim[c0 + 4] = __uint_as_float(b[1]); }
}

__device__ __forceinline__ void phase_a(int e, const bf16_t* U, const float4* S5A, const bf16_t* S5BB, float* E, int G, int vcu) {
  int tid_ = threadIdx.x; asm volatile("" : "+v"(tid_));
  const int tid = tid_, wid = tid >> 6, lane = tid & 63;
  for (int ci = vcu; ci < NCHUNK; ci += G) {
    const int m0 = ci * S5T;
#pragma unroll 1
    for (int q = 0; q < 8; ++q) { const int g = wid * 4 + (q >> 1), dir = q & 1;
      const int tb = ((e * 2 + dir) * 32 + g);
      const float4 a4 = S5A[tb * 64 + lane];
      float bre[32], bim[32];
      bu_chunk(U, m0, g, dir, S5BB + (size_t)tb * 2048, lane, bre, bim);
      float xr = 0.f, xi = 0.f;
#pragma unroll
      for (int i = 0; i < 32; ++i) { const float nr = fmaf(a4.x, xr, fmaf(-a4.y, xi, bre[i])), ni = fmaf(a4.x, xi, fmaf(a4.y, xr, bim[i])); xr = nr; xi = ni; }
      float* ep = E + (((size_t)ci * 32 + g) * 2 + dir) * 128;
      ep[lane] = xr; ep[64 + lane] = xi;
    }
  }
}

__device__ __forceinline__ void phase_b(LAS char* lds, int e, const bf16_t* U, const float4* S5A, const bf16_t* S5BB, const bf16_t* S5CM, const float* E,
                                        const float* h0re, const float* h0im, const float* dvec, const bf16_t* Wglu, const float* bglu,
                                        bf16_t* AO, float* st_re, float* st_im, int G, int vcu) {
  int tid_ = threadIdx.x; asm volatile("" : "+v"(tid_));
  const int tid = tid_, wid = tid >> 6, lane = tid & 63;
  LAS char* X = lds + OFF_X + wid * XBYTES; LAS char* Gt = lds + OFF_G;
  for (int ci = vcu; ci < NCHUNK; ci += G) {
    const int m0 = ci * S5T;
    int c, nC, b; const bool isctx = m0 < NCTX;
    if (isctx) { b = m0 / CTX_L; c = (m0 % CTX_L) / S5T; nC = CTX_L / S5T; } else { b = (m0 - NCTX) / LAT_L; c = ((m0 - NCTX) % LAT_L) / S5T; nC = LAT_L / S5T; }
#pragma unroll 1
    for (int gq = 0; gq < 4; ++gq) { const int g = wid * 4 + gq;
      f32x4 yacc[2] = {{0.f, 0.f, 0.f, 0.f}, {0.f, 0.f, 0.f, 0.f}};
#pragma unroll 1
      for (int dir = 0; dir < 2; ++dir) {
        const int tb = ((e * 2 + dir) * 32 + g);
        const float4 a4 = S5A[tb * 64 + lane];
        float sr = 0.f, si = 0.f;
        if (!isctx) { const size_t hi_ = ((((size_t)b * 2 + e) * 2 + dir) * 32 + g) * 64 + lane; sr = h0re[hi_]; si = h0im[hi_]; }
        { const int n = dir ? (nC - 1 - c) : c; const int cstart = dir ? (ci - c + nC - 1) : (ci - c); const int cstep = dir ? -1 : 1;
          const float* ep = E + (((size_t)cstart * 32 + g) * 2 + dir) * 128 + lane; const long estep = (long)cstep * 32 * 2 * 128;
          int k = 0;
          for (; k + 4 <= n; k += 4) { float er[4], ei[4];
#pragma unroll
            for (int j = 0; j < 4; ++j) { er[j] = ep[(long)(k + j) * estep]; ei[j] = ep[(long)(k + j) * estep + 64]; }
#pragma unroll
            for (int j = 0; j < 4; ++j) { const float nr = fmaf(a4.z, sr, fmaf(-a4.w, si, er[j])), ni = fmaf(a4.z, si, fmaf(a4.w, sr, ei[j])); sr = nr; si = ni; } }
          for (; k < n; ++k) { const float er = ep[(long)k * estep], ei = ep[(long)k * estep + 64];
            const float nr = fmaf(a4.z, sr, fmaf(-a4.w, si, er)), ni = fmaf(a4.z, si, fmaf(a4.w, sr, ei)); sr = nr; si = ni; } }
        float bre[32], bim[32];
        bu_chunk(U, m0, g, dir, S5BB + (size_t)tb * 2048, lane, bre, bim);
        float xr = sr, xi = si;
#pragma unroll
        for (int i = 0; i < 32; ++i) { const float nr = fmaf(a4.x, xr, fmaf(-a4.y, xi, bre[i])), ni = fmaf(a4.x, xi, fmaf(a4.y, xr, bim[i])); xr = nr; xi = ni; bre[i] = nr; bim[i] = ni; }
        if (isctx && ((dir == 0 && c == nC - 1) || (dir == 1 && c == 0))) { const size_t so = ((((size_t)b * 2 + e) * 2 + dir) * 32 + g) * 64 + lane; st_re[so] = xr; st_im[so] = xi; }
#pragma unroll
        for (int i = 0; i < 32; ++i) { const int tok = dir ? 31 - i : i;
          *(LAS unsigned short*)(X + tok * XROW + lane * 2) = f2bf(bre[i]); *(LAS unsigned short*)(X + tok * XROW + 128 + lane * 2) = f2bf(bim[i]); }
        const bf16_t* cm = S5CM + (size_t)tb * 2048 + (lane & 15) * 128 + (lane >> 4) * 8;
        bf16x8 bf[4];
#pragma unroll
        for (int ks = 0; ks < 4; ++ks) bf[ks] = *(const bf16x8*)(cm + ks * 32);
        asm volatile("s_waitcnt lgkmcnt(0)" ::: "memory");
#pragma unroll
        for (int rb = 0; rb < 2; ++rb)
#pragma unroll
          for (int ks = 0; ks < 4; ++ks) { const bf16x8 af = *(const LAS bf16x8*)(X + (rb * 16 + (lane & 15)) * XROW + (ks * 32 + (lane >> 4) * 8) * 2);
            yacc[rb] = __builtin_amdgcn_mfma_f32_16x16x32_bf16(af, bf[ks], yacc[rb], 0, 0, 0); }
        asm volatile("s_waitcnt lgkmcnt(0)" ::: "memory");
      }
      const int n = lane & 15, col = g * 16 + n; const float dv = dvec[col];
#pragma unroll
      for (int rb = 0; rb < 2; ++rb)
#pragma unroll
        for (int i = 0; i < 4; ++i) { const int tok = rb * 16 + (lane >> 4) * 4 + i;
          const float uu = bf2f(U[(size_t)(m0 + tok) * S5W + col]);
          const float y = yacc[rb][i] + dv * uu;
          const float z2 = 1.5957691216057308f * (y + 0.044715f * y * y * y);
          const float gl = y - y / (1.f + __expf(z2));
          *(LAS unsigned short*)(Gt + tok * GROW + col * 2) = f2bf(gl); }
    }
    __syncthreads();
    { f32x4 acc[2][4];
#pragma unroll
      for (int rb = 0; rb < 2; ++rb)
#pragma unroll
        for (int cb = 0; cb < 4; ++cb) acc[rb][cb] = (f32x4){0.f, 0.f, 0.f, 0.f};
      const bf16_t* wp = Wglu + (size_t)(wid * 64 + (lane & 15)) * 512 + (lane >> 4) * 8;
#pragma unroll 4
      for (int ks = 0; ks < 16; ++ks) {
        bf16x8 af[2], bfr[4];
#pragma unroll
        for (int cb = 0; cb < 4; ++cb) bfr[cb] = *(const bf16x8*)(wp + (size_t)cb * 16 * 512 + ks * 32);
#pragma unroll
        for (int rb = 0; rb < 2; ++rb) af[rb] = *(const LAS bf16x8*)(Gt + (rb * 16 + (lane & 15)) * GROW + (ks * 32 + (lane >> 4) * 8) * 2);
#pragma unroll
        for (int rb = 0; rb < 2; ++rb)
#pragma unroll
          for (int cb = 0; cb < 4; ++cb) acc[rb][cb] = __builtin_amdgcn_mfma_f32_16x16x32_bf16(af[rb], bfr[cb], acc[rb][cb], 0, 0, 0);
      }
#pragma unroll
      for (int cb = 0; cb < 4; ++cb) { const int col = wid * 64 + cb * 16 + (lane & 15); const float bb = bglu[col];
#pragma unroll
        for (int rb = 0; rb < 2; ++rb)
#pragma unroll
          for (int i = 0; i < 4; ++i) { const int tok = rb * 16 + (lane >> 4) * 4 + i;
            const float gv = bf2f(*(const LAS unsigned short*)(Gt + tok * GROW + col * 2));
            const float zz = acc[rb][cb][i] + bb;
            AO[(size_t)(m0 + tok) * ABOUT + col] = f2bf(gv / (1.f + __expf(-zz))); } }
    }
    __syncthreads();
  }
}
}

constexpr size_t MiB = 1u << 20;
constexpr size_t WS_CTL = 0, CTL_ZERO_BYTES = 1 * MiB;
constexpr size_t WS_ADA = 1 * MiB;
constexpr size_t WS_S5A = 3 * MiB, WS_S5BB = 4 * MiB, WS_S5CM = 5 * MiB;
constexpr size_t WS_CK = 6 * MiB, WS_CV = 14 * MiB;
constexpr size_t WS_WGLU = 22 * MiB;
constexpr size_t WS_WABIN = 24 * MiB;
constexpr size_t WS_WABOUT = 52 * MiB;
constexpr size_t WS_WCVIN = 64 * MiB;
constexpr size_t WS_WCVOUT = 112 * MiB;
constexpr size_t WS_WUP = 128 * MiB;
constexpr size_t WS_WDN = 256 * MiB;
constexpr size_t WS_H = 384 * MiB;
constexpr size_t WS_BIG = 544 * MiB;
constexpr size_t WS_U = WS_BIG, WS_Q = WS_BIG + 40 * MiB, WS_K = WS_BIG + 120 * MiB, WS_V = WS_BIG + 200 * MiB, WS_AO = WS_BIG + 280 * MiB, WS_E = WS_BIG + 400 * MiB;
static_assert(WS_V - WS_K == WS_K - WS_Q, "q/k/v equally spaced");
constexpr size_t WS_Z = WS_BIG, WS_GB = WS_BIG + 160 * MiB, WS_A2 = WS_BIG + 320 * MiB;
constexpr size_t WS_END = WS_BIG + 640 * MiB;
constexpr int CW_TMO = 0, CW_BAR = 4096;

constexpr int RING_BYTES = 131072;
constexpr int LDSCTL_OFF = RING_BYTES, MISC_OFF = LDSCTL_OFF + 320;
constexpr int LDS_BYTES = 147456;
static_assert(att::LDS_BYTES <= RING_BYTES && s5::LDS_BYTES <= RING_BYTES, "phase scratch fits the ring region");
constexpr int NWAVES = 8;

typedef GAS unsigned gu32;
#define RLX_AGENT __ATOMIC_RELAXED, __HIP_MEMORY_SCOPE_AGENT
#define LDS_WAIT() asm volatile("s_waitcnt lgkmcnt(0)" ::: "memory")
#define VM_WAIT() asm volatile("s_waitcnt vmcnt(0)" ::: "memory")

#define XB_TMO      128
#define XB_XCNT(j)  (256  + 64 * (j))
#define XB_XSUB(j)  (1280 + 64 * (j))
#define XB_XGEN(j)  (2304 + 64 * (j))
#define XB_TOP      3328
#define XB_TOPGEN   3392
#define XCD_BAR_WORDS 3456
#define XB_SPIN_CAP (1u << 18)
__device__ __forceinline__ unsigned xb_ld(unsigned* p)              { return __hip_atomic_load(p, __ATOMIC_RELAXED, __HIP_MEMORY_SCOPE_AGENT); }
__device__ __forceinline__ unsigned xb_add(unsigned* p, unsigned v) { return __hip_atomic_fetch_add(p, v, __ATOMIC_RELAXED, __HIP_MEMORY_SCOPE_AGENT); }
__device__ __forceinline__ unsigned xb_xcc_id() { return (unsigned)__builtin_amdgcn_s_getreg((3 << 11) | 20) & 0xFu; }
#define XB_SPIN(cond, bar) do { unsigned _sp = 0; while (cond) { __builtin_amdgcn_s_sleep(1); \
    if ((++_sp & 255u) == 0u) { if (xb_ld(&(bar)[XB_TMO])) break; if (_sp > XB_SPIN_CAP) { atomicAdd(&(bar)[XB_TMO], 1u); break; } } } } while (0)
struct XcdBarrier { unsigned* bar; unsigned x; volatile LAS unsigned* st; };
__device__ __forceinline__ XcdBarrier xcd_barrier_post(unsigned* bar, volatile LAS unsigned* st) {
    XcdBarrier b; b.bar = bar; b.x = xb_xcc_id(); b.st = st;
    if (threadIdx.x == 0) (void)xb_add(&bar[XB_XCNT(b.x)], 1u);
    return b;
}
__device__ __forceinline__ void xcd_barrier_complete(unsigned* bar, unsigned x, unsigned& nloc, unsigned& nx) {
    const unsigned G = gridDim.x * gridDim.y * gridDim.z;
    unsigned sum, cnt, mine, sp = 0u;
    for (;;) {
        sum = 0u; cnt = 0u; mine = 0u;
#pragma unroll
        for (unsigned j = 0; j < 16; ++j) { const unsigned c = xb_ld(&bar[XB_XCNT(j)]); sum += c; cnt += (c > 0u) ? 1u : 0u; mine = (j == x) ? c : mine; }
        if (sum == G) break;
        __builtin_amdgcn_s_sleep(1);
        if ((++sp & 255u) == 0u) { if (xb_ld(&bar[XB_TMO])) break; if (sp > XB_SPIN_CAP) { atomicAdd(&bar[XB_TMO], 1u); break; } }
    }
    nloc = mine > 0u ? mine : 1u; nx = cnt > 0u ? cnt : 1u;
}
__device__ __forceinline__ void xcd_barrier(const XcdBarrier& b) {
    asm volatile("s_waitcnt vmcnt(0)" ::: "memory");
    __syncthreads();
    if (threadIdx.x == 0) {
        unsigned* bar = b.bar; asm volatile("" : "+s"(bar));
        __builtin_amdgcn_s_waitcnt(0);
        unsigned nloc = b.st[0], nx = b.st[1];
        if (nloc == 0u) { xcd_barrier_complete(bar, b.x, nloc, nx); b.st[0] = nloc; b.st[1] = nx; }
        const unsigned old = xb_add(&bar[XB_XSUB(b.x)], 1u);
        const unsigned gen = old / nloc;
        if (old + 1u == (gen + 1u) * nloc) {
            __builtin_amdgcn_fence(__ATOMIC_RELEASE, "agent");
            asm volatile("s_waitcnt vmcnt(0)" ::: "memory");
            const unsigned og = xb_add(&bar[XB_TOP], 1u);
            const unsigned tg = og / nx;
            if (og + 1u == (tg + 1u) * nx) xb_add(&bar[XB_TOPGEN], 1u);
            else XB_SPIN(xb_ld(&bar[XB_TOPGEN]) == tg, bar);
            __builtin_amdgcn_fence(__ATOMIC_ACQUIRE, "agent");
            xb_add(&bar[XB_XGEN(b.x)], 1u);
            asm volatile("s_waitcnt vmcnt(0)" ::: "memory");
        } else {
            XB_SPIN(xb_ld(&bar[XB_XGEN(b.x)]) == gen, bar);
            __builtin_amdgcn_fence(__ATOMIC_ACQUIRE, "agent");
            asm volatile("s_waitcnt vmcnt(0)" ::: "memory");
        }
    }
    __syncthreads();
}

struct Args { const float* in[33]; float* out; unsigned char* ws; int ph_lo, ph_hi; };
enum { I_XP = 0, I_XS, I_C, I_CK, I_CV, I_SRE, I_SIM, I_CCTX, I_ADAW, I_ADAB, I_N1G, I_N2G, I_ABWIN, I_ABWOUT, I_LAMRE, I_LAMIM, I_LOGDT, I_BRE, I_BIM, I_CRE, I_CIM, I_S5D,
       I_GLUW, I_GLUB, I_QNG, I_KNG, I_RPB, I_CVWIN, I_CVW, I_CVB, I_CVWOUT, I_W1, I_W2 };
constexpr size_t O_X = 0, O_CK = (size_t)MTOK * DM, O_CV = O_CK + (size_t)32 * 2 * 256 * 1024, O_SRE = O_CV + (size_t)32 * 2 * 256 * 1024, O_SIM = O_SRE + 32 * 2 * 2 * 32 * 64;

__device__ __forceinline__ float lane_xor(float v, int lane, int m) { return __uint_as_float((unsigned)__builtin_amdgcn_ds_bpermute((lane ^ m) << 2, (int)__float_as_uint(v))); }
__device__ __forceinline__ float wave_sum(float v, int lane) {
#pragma unroll
    for (int o = 1; o < 64; o <<= 1) v += lane_xor(v, lane, o);
    return v;
}
__device__ __forceinline__ unsigned pk2(float lo, float hi) { return cvtpk(lo, hi); }

__device__ __forceinline__ int dest_row(int n0, int mode) {
    if (mode == 0) return n0;
    if (n0 < 2048) return 4096 + n0;
    if (n0 < 4096) { const int c = n0 - 2048; return (c >> 7) * 256 + (c & 127); }
    const int c = n0 - 4096; return (c >> 7) * 256 + 128 + (c & 127);
}
__device__ __forceinline__ void p0_transpose_item(const float* W, int K, int N, bf16_t* WT, int mode, LAS float* scr, int item, int lane) {
    const int nblk = N / 32, kb = item / nblk, nb = item % nblk, k0 = 64 * kb, n0 = 32 * nb;
#pragma unroll 8
    for (int i = 0; i < 32; ++i) { const int kk = 2 * i + (lane >> 5); scr[kk * 33 + (lane & 31)] = W[(size_t)(k0 + kk) * N + n0 + (lane & 31)]; }
    LDS_WAIT(); asm volatile("" ::: "memory");
    const int c = lane & 7; const int r0 = dest_row(n0, mode);
#pragma unroll
    for (int j = 0; j < 4; ++j) { const int n = (lane >> 3) + 8 * j; const LAS float* s = scr + (8 * c) * 33 + n;
        u32x4 o; o.x = pk2(s[0 * 33], s[1 * 33]); o.y = pk2(s[2 * 33], s[3 * 33]); o.z = pk2(s[4 * 33], s[5 * 33]); o.w = pk2(s[6 * 33], s[7 * 33]);
        *(GAS u32x4*)(WT + (size_t)(r0 + n) * K + k0 + 8 * c) = o; }
    LDS_WAIT(); asm volatile("" ::: "memory");
}
__device__ __forceinline__ void sincos_d(double x, double& s, double& c) {
    const double k = rint(x * 0.63661977236758134308);
    double r = fma(-k, 1.5707963267948966, x); r = fma(-k, 6.123233995736766e-17, r);
    const double r2 = r * r;
    double ps = 1.0 / 355687428096000.0;
    ps = fma(ps, r2, -1.0 / 1307674368000.0); ps = fma(ps, r2, 1.0 / 6227020800.0); ps = fma(ps, r2, -1.0 / 39916800.0); ps = fma(ps, r2, 1.0 / 362880.0);
    ps = fma(ps, r2, -1.0 / 5040.0); ps = fma(ps, r2, 1.0 / 120.0); ps = fma(ps, r2, -1.0 / 6.0); ps = fma(ps * r2, r, r);
    double pc = 1.0 / 6402373705728000.0;
    pc = fma(pc, r2, -1.0 / 20922789888000.0); pc = fma(pc, r2, 1.0 / 87178291200.0); pc = fma(pc, r2, -1.0 / 479001600.0); pc = fma(pc, r2, 1.0 / 3628800.0);
    pc = fma(pc, r2, -1.0 / 40320.0); pc = fma(pc, r2, 1.0 / 720.0); pc = fma(pc, r2, -1.0 / 24.0); pc = fma(pc, r2, 0.5); pc = fma(-pc, r2, 1.0);
    const int q = ((int)k) & 3;
    s = (q == 0) ? ps : (q == 1) ? pc : (q == 2) ? -ps : -pc;
    c = (q == 0) ? pc : (q == 1) ? -ps : (q == 2) ? -pc : ps;
}
__device__ __forceinline__ double exp_small_d(double x) {
    double p = 1.0 / 87178291200.0;
    p = fma(p, x, 1.0 / 6227020800.0); p = fma(p, x, 1.0 / 479001600.0); p = fma(p, x, 1.0 / 39916800.0); p = fma(p, x, 1.0 / 3628800.0); p = fma(p, x, 1.0 / 362880.0);
    p = fma(p, x, 1.0 / 40320.0); p = fma(p, x, 1.0 / 5040.0); p = fma(p, x, 1.0 / 720.0); p = fma(p, x, 1.0 / 120.0); p = fma(p, x, 1.0 / 24.0); p = fma(p, x, 1.0 / 6.0);
    p = fma(p, x, 0.5); p = fma(p, x, 1.0); p = fma(p, x, 1.0); return p;
}
__device__ __forceinline__ double exp_d(double x) {
    const double k = rint(x * 1.4426950408889634); const double r = fma(-k, 0.6931471805599453, x) ;
    double e = exp_small_d(r * 0.25); e = e * e; e = e * e;
    return ldexp(e, (int)k);
}

struct Frame {
    LAS unsigned char* lds;
    int tid, lane, wave, vcu, G;
    const float* const* in;
    float* out; unsigned char* ws;
};

__device__ __forceinline__ void p0_ada_item(Frame& F, int item) {
    const int l = item / 48, cb = item % 48;
    LAS float* sl = (LAS float*)F.lds;
    for (int i = F.tid; i < 9 * 2048; i += 512) { const int j = i / 2048, k = i % 2048; const float c = j == 0 ? F.in[I_CCTX][k] : F.in[I_C][(j - 1) * 2048 + k]; sl[k * 12 + j] = c / (1.f + __expf(-c)); }
    __syncthreads();
    const float* W = F.in[I_ADAW] + (size_t)l * 2048 * 12288 + (size_t)(F.wave * 256) * 12288 + cb * 256 + F.lane * 4;
    f32x4 acc[9];
#pragma unroll
    for (int j = 0; j < 9; ++j) acc[j] = (f32x4){0.f, 0.f, 0.f, 0.f};
    for (int k0 = 0; k0 < 256; k0 += 8) {
        f32x4 w[8];
#pragma unroll
        for (int u = 0; u < 8; ++u) w[u] = *(const f32x4*)(W + (size_t)(k0 + u) * 12288);
#pragma unroll
        for (int u = 0; u < 8; ++u) { const LAS f32x4* sp = (const LAS f32x4*)(sl + (F.wave * 256 + k0 + u) * 12);
            const f32x4 s0 = sp[0], s1 = sp[1], s2 = sp[2];
            acc[0] += w[u] * s0[0]; acc[1] += w[u] * s0[1]; acc[2] += w[u] * s0[2]; acc[3] += w[u] * s0[3];
            acc[4] += w[u] * s1[0]; acc[5] += w[u] * s1[1]; acc[6] += w[u] * s1[2]; acc[7] += w[u] * s1[3]; acc[8] += w[u] * s2[0]; }
    }
    __syncthreads();
    LAS f32x4* pp = (LAS f32x4*)F.lds;
#pragma unroll
    for (int j = 0; j < 9; ++j) pp[(F.wave * 9 + j) * 64 + F.lane] = acc[j];
    __syncthreads();
    float* ADA = (float*)(F.ws + WS_ADA) + (size_t)l * 9 * 12288;
    const float* bias = F.in[I_ADAB] + (size_t)l * 12288;
    for (int i = F.tid; i < 9 * 64; i += 512) { const int j = i / 64, q = i % 64; f32x4 s = pp[(0 * 9 + j) * 64 + q];
#pragma unroll
        for (int w = 1; w < 8; ++w) s += pp[(w * 9 + j) * 64 + q];
        const int col = cb * 256 + q * 4; s += *(const f32x4*)(bias + col);
        *(f32x4*)(ADA + (size_t)j * 12288 + col) = s; }
    __syncthreads();
}
__device__ __forceinline__ void p0_s5_tables(Frame& F) {
    const int gt = F.vcu * 512 + F.tid;
    if (gt >= 2 * 2 * 32 * 64) return;
    const int p = gt & 63, g = (gt >> 6) & 31, dir = (gt >> 11) & 1, e = gt >> 12;
    const int gi = (e * 2 + dir) * 32 + g;
    const double lre = (double)F.in[I_LAMRE][gi * 64 + p], lim = (double)F.in[I_LAMIM][gi * 64 + p];
    const double dt = exp_d((double)F.in[I_LOGDT][gi]);
    const double ar = lre * dt, ai = lim * dt;
    double s, c; sincos_d(ai, s, c); const double dec = exp_d(ar);
    const double are = dec * c, aim = dec * s;
    double sT, cT; sincos_d(ai * S5T, sT, cT); const double decT = exp_d(ar * S5T);
    float4* A = (float4*)(F.ws + WS_S5A);
    A[gi * 64 + p] = make_float4((float)are, (float)aim, (float)(decT * cT), (float)(decT * sT));
    const double den = lre * lre + lim * lim, nr = are - 1.0;
    const double fre = (nr * lre + aim * lim) / den, fim = (aim * lre - nr * lim) / den;
    bf16_t* BB = (bf16_t*)(F.ws + WS_S5BB) + (size_t)gi * 2048;
    const float* bre = F.in[I_BRE] + ((size_t)gi * 64 + p) * 16; const float* bim = F.in[I_BIM] + ((size_t)gi * 64 + p) * 16;
#pragma unroll
    for (int n = 0; n < 16; ++n) { const double br = bre[n], bi = bim[n];
        BB[(0 * 64 + p) * 16 + n] = f2bf((float)(fre * br - fim * bi)); BB[(1 * 64 + p) * 16 + n] = f2bf((float)(fre * bi + fim * br)); }
    bf16_t* CM = (bf16_t*)(F.ws + WS_S5CM) + (size_t)gi * 2048;
    const float* cre = F.in[I_CRE] + (size_t)gi * 16 * 64; const float* cim = F.in[I_CIM] + (size_t)gi * 16 * 64;
#pragma unroll
    for (int n = 0; n < 16; ++n) { CM[n * 128 + p] = f2bf(cre[n * 64 + p]); CM[n * 128 + 64 + p] = f2bf(-cim[n * 64 + p]); }
}
__device__ __forceinline__ void p0_prologue(Frame& F) {
    if (F.vcu < 192) p0_ada_item(F, F.vcu);
    p0_s5_tables(F);
    { const size_t n8 = (size_t)8 * 2 * 256 * 1024 / 8; const size_t gth = (size_t)F.vcu * 512 + F.tid, nth = (size_t)F.G * 512;
      for (size_t i = gth; i < 2 * n8; i += nth) { const bool isk = i < n8; const size_t j = isk ? i : i - n8;
        const float* src = (isk ? F.in[I_CK] : F.in[I_CV]) + j * 8; bf16_t* dst = (bf16_t*)(F.ws + (isk ? WS_CK : WS_CV)) + j * 8;
        const f32x4 a = *(const f32x4*)src, b = *(const f32x4*)(src + 4);
        u32x4 o; o.x = pk2(a[0], a[1]); o.y = pk2(a[2], a[3]); o.z = pk2(b[0], b[1]); o.w = pk2(b[2], b[3]); *(u32x4*)dst = o; } }
    LAS float* scr = (LAS float*)(F.lds + F.wave * 16384);
    const int gw = F.vcu * NWAVES + F.wave, NGW = F.G * NWAVES;
    constexpr int I_ABI = 32 * 112, I_ABO = 24 * 64, I_CVI = 32 * 192, I_CVO = 32 * 64, I_UP = 32 * 256, I_DN = 128 * 64, I_GLU = 8 * 16;
    constexpr int NITEMS = 2 * I_ABI + 2 * I_ABO + 2 * I_CVI + 2 * I_CVO + 4 * I_UP + 4 * I_DN + 2 * I_GLU;
    for (int it = gw; it < NITEMS; it += NGW) {
        int r = it;
        if (r < 2 * I_ABI) { const int e = r / I_ABI; p0_transpose_item(F.in[I_ABWIN] + (size_t)e * DM * ABIN, DM, ABIN, (bf16_t*)(F.ws + WS_WABIN) + (size_t)e * ABIN * DM, 0, scr, r % I_ABI, F.lane); continue; } r -= 2 * I_ABI;
        if (r < 2 * I_ABO) { const int e = r / I_ABO; p0_transpose_item(F.in[I_ABWOUT] + (size_t)e * ABOUT * DM, ABOUT, DM, (bf16_t*)(F.ws + WS_WABOUT) + (size_t)e * DM * ABOUT, 0, scr, r % I_ABO, F.lane); continue; } r -= 2 * I_ABO;
        if (r < 2 * I_CVI) { const int e = r / I_CVI; p0_transpose_item(F.in[I_CVWIN] + (size_t)e * DM * 3 * DM, DM, 3 * DM, (bf16_t*)(F.ws + WS_WCVIN) + (size_t)e * 3 * DM * DM, 1, scr, r % I_CVI, F.lane); continue; } r -= 2 * I_CVI;
        if (r < 2 * I_CVO) { const int e = r / I_CVO; p0_transpose_item(F.in[I_CVWOUT] + (size_t)e * DM * DM, DM, DM, (bf16_t*)(F.ws + WS_WCVOUT) + (size_t)e * DM * DM, 0, scr, r % I_CVO, F.lane); continue; } r -= 2 * I_CVO;
        if (r < 4 * I_UP) { const int e = r / I_UP; p0_transpose_item(F.in[I_W1] + (size_t)e * DM * DFF, DM, DFF, (bf16_t*)(F.ws + WS_WUP) + (size_t)e * DFF * DM, 0, scr, r % I_UP, F.lane); continue; } r -= 4 * I_UP;
        if (r < 4 * I_DN) { const int e = r / I_DN; p0_transpose_item(F.in[I_W2] + (size_t)e * DFF * DM, DFF, DM, (bf16_t*)(F.ws + WS_WDN) + (size_t)e * DM * DFF, 0, scr, r % I_DN, F.lane); continue; } r -= 4 * I_DN;
        { const int e = r / I_GLU; p0_transpose_item(F.in[I_GLUW] + (size_t)e * S5W * S5W, S5W, S5W, (bf16_t*)(F.ws + WS_WGLU) + (size_t)e * S5W * S5W, 0, scr, r % I_GLU, F.lane); }
    }
}

__device__ __forceinline__ void norm_phase(Frame& F, int l, int which  , bool first) {
    int tid_o = F.tid; asm volatile("" : "+v"(tid_o)); const int tid = tid_o, lane = tid & 63, wave = __builtin_amdgcn_readfirstlane(tid >> 6); (void)tid; (void)lane; (void)wave;
    unsigned char* ws = F.ws; asm volatile("" : "+s"(ws));

    const int gw = F.vcu * NWAVES + wave, NGW = F.G * NWAVES;
    const float* ADA = (const float*)(ws + WS_ADA) + (size_t)l * 9 * 12288;
    const float* gn = F.in[which ? I_N2G : I_N1G] + (size_t)l * DM;
    bf16_t* H = (bf16_t*)(ws + WS_H);
    for (int m = gw; m < MTOK; m += NGW) {
        const float* xrow = first ? (m < NCTX ? F.in[I_XP] + (size_t)m * DM : F.in[I_XS] + (size_t)(m - NCTX) * DM) : F.out + (size_t)m * DM;
        const f32x4* xr = (const f32x4*)xrow + lane;
        f32x4 v[8]; float s = 0.f;
#pragma unroll
        for (int j = 0; j < 8; ++j) { v[j] = xr[64 * j]; s += (v[j][0] * v[j][0] + v[j][1] * v[j][1]) + (v[j][2] * v[j][2] + v[j][3] * v[j][3]); }
        const float rstd = 1.f / sqrtf(wave_sum(s, lane) * (1.f / DM) + NORM_EPS);
        const float* ad = ADA + (size_t)ada_row_of_token(m) * 12288 + (which ? 3 : 0) * DM;
        u32x2* o8 = (u32x2*)(H + (size_t)m * DM) + lane;
#pragma unroll
        for (int j = 0; j < 8; ++j) { const int col = 4 * lane + 256 * j;
            const f32x4 g = *(const f32x4*)(gn + col), sh = *(const f32x4*)(ad + col), sc = *(const f32x4*)(ad + DM + col);
            const f32x4 h = v[j] * rstd * g * (sc + 1.f) + sh;
            u32x2 w; w.x = pk2(h[0], h[1]); w.y = pk2(h[2], h[3]); o8[64 * j] = w; }
    }
}
__device__ __forceinline__ void qknorm_phase(Frame& F, int e) {
    int tid_o = F.tid; asm volatile("" : "+v"(tid_o)); const int tid = tid_o, lane = tid & 63, wave = __builtin_amdgcn_readfirstlane(tid >> 6); (void)tid; (void)lane; (void)wave;
    unsigned char* ws = F.ws; asm volatile("" : "+s"(ws));

    const int gw = F.vcu * NWAVES + wave, NGW = F.G * NWAVES;
    bf16_t* Q = (bf16_t*)(ws + WS_Q); bf16_t* Kb = (bf16_t*)(ws + WS_K); const bf16_t* V = (const bf16_t*)(ws + WS_V);
    const int d0 = (lane & 7) * 16;
    float gq[16], gk[16];
#pragma unroll
    for (int i = 0; i < 16; ++i) { gq[i] = F.in[I_QNG][e * 128 + d0 + i]; gk[i] = F.in[I_KNG][e * 128 + d0 + i]; }
    for (int m = gw; m < MTOK; m += NGW) {
#pragma unroll
        for (int t = 0; t < 2; ++t) {
            bf16_t* row = (t ? Kb : Q) + (size_t)m * 1024 + lane * 16;
            const u32x4 a = *(const u32x4*)row, b = *(const u32x4*)(row + 8);
            float x[16];
#pragma unroll
            for (int i = 0; i < 4; ++i) { x[2 * i] = bflo(a[i]); x[2 * i + 1] = bfhi(a[i]); x[8 + 2 * i] = bflo(b[i]); x[8 + 2 * i + 1] = bfhi(b[i]); }
            float s = 0.f;
#pragma unroll
            for (int i = 0; i < 16; ++i) s += x[i] * x[i];
            s += lane_xor(s, lane, 1); s += lane_xor(s, lane, 2); s += lane_xor(s, lane, 4);
            const float rstd = 1.f / sqrtf(s * (1.f / 128.f) + NORM_EPS);
#pragma unroll
            for (int i = 0; i < 16; ++i) x[i] = x[i] * rstd * (t ? gk[i] : gq[i]);
            u32x4 oa, ob;
#pragma unroll
            for (int i = 0; i < 4; ++i) { oa[i] = pk2(x[2 * i], x[2 * i + 1]); ob[i] = pk2(x[8 + 2 * i], x[8 + 2 * i + 1]); }
            *(u32x4*)row = oa; *(u32x4*)(row + 8) = ob;
            if (t == 1 && m < NCTX) { const int b_ = m >> 8, tt = m & 255; float* o = F.out + O_CK + (((size_t)b_ * 2 + e) * 256 + tt) * 1024 + lane * 16;
#pragma unroll
                for (int i = 0; i < 4; ++i) *(f32x4*)(o + 4 * i) = (f32x4){x[4 * i], x[4 * i + 1], x[4 * i + 2], x[4 * i + 3]}; }
        }
        if (m < NCTX) { const int b_ = m >> 8, tt = m & 255; float* o = F.out + O_CV + (((size_t)b_ * 2 + e) * 256 + tt) * 1024 + lane * 16;
            const bf16_t* row = V + (size_t)m * 1024 + lane * 16; const u32x4 a = *(const u32x4*)row, b = *(const u32x4*)(row + 8);
            *(f32x4*)(o + 0) = (f32x4){bflo(a[0]), bfhi(a[0]), bflo(a[1]), bfhi(a[1])}; *(f32x4*)(o + 4) = (f32x4){bflo(a[2]), bfhi(a[2]), bflo(a[3]), bfhi(a[3])};
            *(f32x4*)(o + 8) = (f32x4){bflo(b[0]), bfhi(b[0]), bflo(b[1]), bfhi(b[1])}; *(f32x4*)(o + 12) = (f32x4){bflo(b[2]), bfhi(b[2]), bflo(b[3]), bfhi(b[3])}; }
    }
}
__device__ __forceinline__ void conv_phase(Frame& F, int o) {
    int tid_o = F.tid; asm volatile("" : "+v"(tid_o)); const int tid = tid_o, lane = tid & 63, wave = __builtin_amdgcn_readfirstlane(tid >> 6); (void)tid; (void)lane; (void)wave;
    unsigned char* ws = F.ws; asm volatile("" : "+s"(ws));

    const int gw = F.vcu * NWAVES + wave, NGW = F.G * NWAVES;
    const bf16_t* Z = (const bf16_t*)(ws + WS_Z); const bf16_t* GB = (const bf16_t*)(ws + WS_GB); bf16_t* A2 = (bf16_t*)(ws + WS_A2);
    const float* cw = F.in[I_CVW] + (size_t)o * 3 * DM; const float* cb = F.in[I_CVB] + (size_t)o * DM;
    for (int it = gw; it < (MTOK / 16) * 4; it += NGW) {
        const int rc = it >> 2, cq = it & 3, m0 = rc * 16, col = cq * 512 + lane * 8;
        float w0[8], w1[8], w2[8], bb[8];
#pragma unroll
        for (int i = 0; i < 8; ++i) { w0[i] = cw[col + i]; w1[i] = cw[DM + col + i]; w2[i] = cw[2 * DM + col + i]; bb[i] = cb[col + i]; }
        const int L = m0 < NCTX ? CTX_L : LAT_L; const int t0 = (m0 < NCTX ? m0 : m0 - NCTX) % L;
        u32x4 zp = (u32x4){0u, 0u, 0u, 0u}, zc, zn;
        if (t0 > 0) zp = *(const u32x4*)(Z + (size_t)(m0 - 1) * DM + col);
        zc = *(const u32x4*)(Z + (size_t)m0 * DM + col);
#pragma unroll 4
        for (int r = 0; r < 16; ++r) { const int m = m0 + r;
            zn = (u32x4){0u, 0u, 0u, 0u}; if (t0 + r + 1 < L) zn = *(const u32x4*)(Z + (size_t)(m + 1) * DM + col);
            const u32x4 gb = *(const u32x4*)(GB + (size_t)m * DM + col);
            float ov[8];
#pragma unroll
            for (int i = 0; i < 4; ++i) {
                const float c0 = w0[2 * i] * bflo(zp[i]) + w1[2 * i] * bflo(zc[i]) + w2[2 * i] * bflo(zn[i]) + bb[2 * i];
                const float c1 = w0[2 * i + 1] * bfhi(zp[i]) + w1[2 * i + 1] * bfhi(zc[i]) + w2[2 * i + 1] * bfhi(zn[i]) + bb[2 * i + 1];
                ov[2 * i] = bflo(gb[i]) * c0; ov[2 * i + 1] = bfhi(gb[i]) * c1; }
            u32x4 ow; ow.x = pk2(ov[0], ov[1]); ow.y = pk2(ov[2], ov[3]); ow.z = pk2(ov[4], ov[5]); ow.w = pk2(ov[6], ov[7]);
            *(u32x4*)(A2 + (size_t)m * DM + col) = ow;
            zp = zc; zc = zn; }
    }
}
#ifndef ATT_SDEPTH
#define ATT_SDEPTH 2
#endif
__device__ __forceinline__ void attn_phase(Frame& F, int e) {
    int tid_o = F.tid; asm volatile("" : "+v"(tid_o)); const int tid = tid_o, lane = tid & 63, wave = __builtin_amdgcn_readfirstlane(tid >> 6); (void)tid; (void)lane; (void)wave;
    unsigned char* ws = F.ws; asm volatile("" : "+s"(ws));

    const bf16_t* Q = (const bf16_t*)(ws + WS_Q); const bf16_t* Kb = (const bf16_t*)(ws + WS_K); const bf16_t* V = (const bf16_t*)(ws + WS_V);
    bf16_t* AO = (bf16_t*)(ws + WS_AO);
    const bf16_t* CK = (const bf16_t*)(ws + WS_CK); const bf16_t* CV = (const bf16_t*)(ws + WS_CV);
    LAS char* lds = (LAS char*)F.lds;
    for (int u = F.vcu; u < 1024 + 256; u += F.G) {
        __syncthreads();
        if (u < 1024) {
            const int b = u >> 7, h = (u >> 4) & 7, R = (u & 15) * 4;
            int kr0 = R - 4; kr0 = kr0 < 0 ? 0 : (kr0 > 52 ? 52 : kr0);
            LAS float* bl = (LAS float*)(lds + att::OFF_BIAS);
            { int t2 = tid; asm volatile("" : "+v"(t2));
              if (t2 < 15 * 32) { const int dr = t2 >> 5, dc = t2 & 31; bl[t2] = dc < 31 ? F.in[I_RPB][((size_t)(e * 8 + h) * 15 + dr) * 31 + dc] * 11.313708498984761f : 0.f; } }
            const size_t seq0 = (size_t)NCTX + (size_t)b * LAT_L;
            const bf16_t* Qb = Q + (seq0 + (size_t)R * 64) * 1024 + h * 128;
            const bf16_t* K0 = CK + (((size_t)b * 2 + e) * 256) * 1024 + h * 128; const bf16_t* V0 = CV + (((size_t)b * 2 + e) * 256) * 1024 + h * 128;
            const bf16_t* K1 = Kb + (seq0 + (size_t)kr0 * 64) * 1024 + h * 128; const bf16_t* V1 = V + (seq0 + (size_t)kr0 * 64) * 1024 + h * 128;
            bf16_t* Ob = AO + (seq0 + (size_t)R * 64) * ABOUT + S5W + h * 128;
            att::attn_unit<true, ATT_SDEPTH>(lds, Qb, K0, V0, 4, K1, V1, 16, Ob, ABOUT, R, kr0);
        } else {
            const int uc = u - 1024, b = uc >> 3, h = uc & 7;
            const size_t seq0 = (size_t)b * CTX_L;
            const bf16_t* Qb = Q + seq0 * 1024 + h * 128; const bf16_t* K0 = Kb + seq0 * 1024 + h * 128; const bf16_t* V0 = V + seq0 * 1024 + h * 128;
            bf16_t* Ob = AO + seq0 * ABOUT + S5W + h * 128;
            att::attn_unit<false, ATT_SDEPTH>(lds, Qb, K0, V0, 4, K0, V0, 4, Ob, ABOUT, 0, 0);
        }
    }
}

constexpr int NPHASE = 1 + 8 * NLAYER;
#ifndef PG8_SP2
#define PG8_SP2 true
#endif
#ifndef PG8_ALIGN
#define PG8_ALIGN true
#endif

__global__ void __launch_bounds__(NWAVES * 64, 2) fwd(Args args) {
    extern __shared__ __attribute__((aligned(16))) unsigned char lds[];
    Frame F;
    F.lds = (LAS unsigned char*)lds;
    F.tid = threadIdx.x; F.lane = F.tid & 63; F.wave = __builtin_amdgcn_readfirstlane(F.tid >> 6);
    F.G = gridDim.x; { const int bx = blockIdx.x; F.vcu = (F.G % 8 == 0) ? (bx % 8) * (F.G / 8) + bx / 8 : bx; }
    F.in = args.in; F.out = args.out; F.ws = args.ws;
    for (int u = F.tid; u < (LDS_BYTES - LDSCTL_OFF) / 4; u += NWAVES * 64) ((LAS unsigned*)(F.lds + LDSCTL_OFF))[u] = 0u;
    __syncthreads();
    volatile LAS unsigned* MISC = (volatile LAS unsigned*)(F.lds + MISC_OFF);
    XcdBarrier bar = xcd_barrier_post((unsigned*)(F.ws + WS_CTL) + CW_BAR, MISC + 8);
    const int lo = args.ph_lo, hi = args.ph_hi;
#define IN(k) (lo <= (k) && (k) < hi)
#define SEAM(k) do { if (lo <= (k) && (k) + 1 < hi) xcd_barrier(bar); } while (0)
    LAS unsigned char* ring = F.lds;
    const int bx = (int)blockIdx.x;

    if (IN(0)) { p0_prologue(F); }
    SEAM(0);
#pragma unroll 1
    for (int l = 0; l < NLAYER; ++l) {
        const int pb = 1 + 8 * l, e = l >> 1;
        const float* ADA = (const float*)(F.ws + WS_ADA) + (size_t)l * 9 * 12288;
        const float* rb0 = l == 0 ? F.in[I_XP] : F.out; const float* rb1 = l == 0 ? F.in[I_XS] - (size_t)NCTX * DM : F.out;
        if (IN(pb + 0)) norm_phase(F, l, 0, l == 0);
        SEAM(pb + 0);
        if ((l & 1) == 0) {
            if (IN(pb + 1)) { unsigned char* ws = F.ws; asm volatile("" : "+s"(ws)); pg8::Gemm g{(const bf16_t*)(ws + WS_H), (const bf16_t*)(ws + WS_WABIN) + (size_t)e * ABIN * DM, MTOK, ABIN, DM}; pg8::StaticOrder S; S.init(MTOK, ABIN, F.G, bx);
                pg8::EpiAbIn E{(bf16_t*)(ws + WS_U), (bf16_t*)(ws + WS_Q), (size_t)(WS_K - WS_Q) / 2};
                pg8::gemm_phase<pg8::EpiAbIn, pg8::StaticOrder, PG8_ALIGN, PG8_SP2>(ring, g, S, E); }
            SEAM(pb + 1);
            if (IN(pb + 2)) { unsigned char* ws = F.ws; asm volatile("" : "+s"(ws)); qknorm_phase(F, e);
                s5::phase_a(e, (const bf16_t*)(ws + WS_U), (const float4*)(ws + WS_S5A), (const bf16_t*)(ws + WS_S5BB), (float*)(ws + WS_E), F.G, F.vcu); }
            SEAM(pb + 2);
            if (IN(pb + 3)) { unsigned char* ws = F.ws; asm volatile("" : "+s"(ws));
                s5::phase_b((LAS char*)F.lds, e, (const bf16_t*)(ws + WS_U), (const float4*)(ws + WS_S5A), (const bf16_t*)(ws + WS_S5BB), (const bf16_t*)(ws + WS_S5CM), (const float*)(ws + WS_E),
                            F.in[I_SRE], F.in[I_SIM], F.in[I_S5D] + (size_t)e * S5W, (const bf16_t*)(ws + WS_WGLU) + (size_t)e * S5W * S5W, F.in[I_GLUB] + (size_t)e * S5W,
                            (bf16_t*)(ws + WS_AO), F.out + O_SRE, F.out + O_SIM, F.G, F.vcu);
                attn_phase(F, e); }
            SEAM(pb + 3);
            if (IN(pb + 4)) { unsigned char* ws = F.ws; asm volatile("" : "+s"(ws)); pg8::Gemm g{(const bf16_t*)(ws + WS_AO), (const bf16_t*)(ws + WS_WABOUT) + (size_t)e * DM * ABOUT, MTOK, DM, ABOUT}; pg8::StaticOrder S; S.init(MTOK, DM, F.G, bx);
                pg8::EpiRes E{rb0, rb1, F.out, ADA + 2 * DM};
                pg8::gemm_phase<pg8::EpiRes, pg8::StaticOrder, PG8_ALIGN, PG8_SP2>(ring, g, S, E); }
            SEAM(pb + 4);
        } else {
            if (IN(pb + 1)) { unsigned char* ws = F.ws; asm volatile("" : "+s"(ws)); pg8::Gemm g{(const bf16_t*)(ws + WS_H), (const bf16_t*)(ws + WS_WCVIN) + (size_t)e * 3 * DM * DM, MTOK, 3 * DM, DM}; pg8::StaticOrder S; S.init(MTOK, 3 * DM, F.G, bx);
                pg8::EpiConvIn E{(bf16_t*)(ws + WS_Z), (bf16_t*)(ws + WS_GB)};
                pg8::gemm_phase<pg8::EpiConvIn, pg8::StaticOrder, PG8_ALIGN, PG8_SP2>(ring, g, S, E); }
            SEAM(pb + 1);
            if (IN(pb + 2)) conv_phase(F, e);
            SEAM(pb + 3);
            if (IN(pb + 4)) { unsigned char* ws = F.ws; asm volatile("" : "+s"(ws)); pg8::Gemm g{(const bf16_t*)(ws + WS_A2), (const bf16_t*)(ws + WS_WCVOUT) + (size_t)e * DM * DM, MTOK, DM, DM}; pg8::StaticOrder S; S.init(MTOK, DM, F.G, bx);
                pg8::EpiRes E{rb0, rb1, F.out, ADA + 2 * DM};
                pg8::gemm_phase<pg8::EpiRes, pg8::StaticOrder, PG8_ALIGN, PG8_SP2>(ring, g, S, E); }
            SEAM(pb + 4);
        }
        if (IN(pb + 5)) norm_phase(F, l, 1, false);
        SEAM(pb + 5);
        if (IN(pb + 6)) { unsigned char* ws = F.ws; asm volatile("" : "+s"(ws)); pg8::Gemm g{(const bf16_t*)(ws + WS_H), (const bf16_t*)(ws + WS_WUP) + (size_t)l * DFF * DM, MTOK, DFF, DM}; pg8::StaticOrder S; S.init(MTOK, DFF, F.G, bx);
            pg8::EpiRelu2 E{(bf16_t*)(ws + WS_BIG), DFF};
            pg8::gemm_phase<pg8::EpiRelu2, pg8::StaticOrder, PG8_ALIGN, PG8_SP2>(ring, g, S, E); }
        SEAM(pb + 6);
        if (IN(pb + 7)) { unsigned char* ws = F.ws; asm volatile("" : "+s"(ws)); pg8::Gemm g{(const bf16_t*)(ws + WS_BIG), (const bf16_t*)(ws + WS_WDN) + (size_t)l * DM * DFF, MTOK, DM, DFF}; pg8::StaticOrder S; S.init(MTOK, DM, F.G, bx);
            pg8::EpiRes E{F.out, F.out, F.out, ADA + 5 * DM};
            pg8::gemm_phase<pg8::EpiRes, pg8::StaticOrder, PG8_ALIGN, PG8_SP2>(ring, g, S, E); }
        SEAM(pb + 7);
    }
#undef IN
#undef SEAM
}

extern "C" void kernel_launch(void* const* d_in, const int* in_sizes, int n_in, void* d_out, int out_size, void* d_ws, size_t ws_size, hipStream_t stream) {
    static int grid = 0;
    if (grid == 0) {
        if (n_in != 33 || ws_size < WS_END) { fprintf(stderr, "kernel_launch: n_in %d ws %zu (need 33, >= %zu)\n", n_in, ws_size, (size_t)WS_END); grid = -1; return; }
        int dev = 0, cus = 0;
        if (hipGetDevice(&dev) != hipSuccess || hipDeviceGetAttribute(&cus, hipDeviceAttributeMultiprocessorCount, dev) != hipSuccess) { grid = -1; return; }
        if (hipFuncSetAttribute((const void*)fwd, hipFuncAttributeMaxDynamicSharedMemorySize, LDS_BYTES) != hipSuccess) { fprintf(stderr, "kernel_launch: hipFuncSetAttribute failed\n"); grid = -1; return; }
        int per_cu = 0;
        if (hipOccupancyMaxActiveBlocksPerMultiprocessor(&per_cu, (const void*)fwd, NWAVES * 64, LDS_BYTES) != hipSuccess || per_cu < 1) fprintf(stderr, "kernel_launch: occupancy query says %d\n", per_cu);
        (void)hipGetLastError();
        grid = cus;
    }
    if (grid < 0) return;
    (void)hipMemsetAsync((char*)d_ws + WS_CTL, 0, CTL_ZERO_BYTES, stream);
    Args a{};
    for (int i = 0; i < 33; ++i) a.in[i] = (const float*)d_in[i];
    a.out = (float*)d_out; a.ws = (unsigned char*)d_ws;
#if MK_PER_PHASE
    for (int p = 0; p < NPHASE; ++p) {
        if (p > 0) { const int l = (p - 1) / 8, k = (p - 1) % 8; if ((l & 1) && k == 3) continue; }
        a.ph_lo = p; a.ph_hi = p + 1;
        hipLaunchKernelGGL(fwd, dim3(grid), dim3(NWAVES * 64), LDS_BYTES, stream, a);
    }
#else
    a.ph_lo = 0; a.ph_hi = NPHASE;
    hipLaunchKernelGGL(fwd, dim3(grid), dim3(NWAVES * 64), LDS_BYTES, stream, a);
#endif
    const hipError_t le = hipPeekAtLastError();
    if (le != hipSuccess) fprintf(stderr, "kernel_launch: launch failed: %s\n", hipGetErrorName(le));
}
```

```cpp
#define ATT_SDEPTH 1
#include <hip/hip_runtime.h>
#include <cstdio>
#include <cstdint>

#ifndef MK_PER_PHASE
#define MK_PER_PHASE 0
#endif

__device__ __forceinline__ int lane_id_opaque() { int l; asm volatile("v_mbcnt_lo_u32_b32 %0, -1, 0\n\tv_mbcnt_hi_u32_b32 %0, -1, %0" : "=v"(l)); return l; }

namespace pg8 {
#define PG8_LAS __attribute__((address_space(3)))
typedef unsigned short bf16_t;
typedef short bf16x8 __attribute__((ext_vector_type(8)));
typedef float f32x4 __attribute__((ext_vector_type(4)));
typedef unsigned u32x4 __attribute__((ext_vector_type(4)));
constexpr int BM = 256, BK = 64, HALF = 128, HTB = HALF * BK * 2  , STAGE_BYTES = 8 * HTB, NXCD = 8, WGM = 8;

__host__ __device__ __forceinline__ int lds_byte(int r, int c) { const int st = (r >> 4) * 2 + (c >> 5), rr = r & 15, cc = c & 31, ob = rr * 64 + cc * 2; return st * 1024 + (ob ^ (((ob >> 9) & 1) << 5)); }
__host__ __device__ __forceinline__ void stage_rc(int b, int& R, int& C) { const int st = b / 1024, sb = b % 1024, swz = sb ^ (((sb >> 9) & 1) << 5); R = (st >> 1) * 16 + swz / 64; C = (st & 1) * 32 + (swz % 64) / 2; }
__host__ __device__ __forceinline__ int perm32(int rho) { const int n = rho >> 4, i = rho & 15; return 8 * (i >> 2) + 4 * n + (i & 3); }

struct Unit { int pm, pn; };
struct Gemm { const bf16_t* A; const bf16_t* Bt; int M, N, K; };

struct StaticOrder {
    int nM, nN, nwg, G, c;
    __host__ __device__ void init(int M, int N, int G_, int c_) { nM = M / BM; nN = N / BM; nwg = nM * nN; G = G_; c = c_; }
    __host__ __device__ bool next(int i, Unit& u) const {
        const long L = (long)i * G + c; if (L >= nwg) return false;
        int wgid = (int)L; { const int q = nwg / NXCD, r = nwg % NXCD, xcd = wgid % NXCD, off = wgid / NXCD; wgid = (xcd < r ? xcd * (q + 1) : r * (q + 1) + (xcd - r) * q) + off; }
        const int nig = WGM * nN, gid = wgid / nig, fm = gid * WGM, gsz = (nM - fm) < WGM ? (nM - fm) : WGM;
        u.pm = fm + ((wgid % nig) % gsz); u.pn = (wgid % nig) / gsz; return true;
    }
    __device__ __forceinline__ void a_ready(const Unit&) const {}
    __device__ __forceinline__ void done(const Unit&) const {}
};

__device__ __forceinline__ unsigned cvt_pk_bf16(float lo, float hi) { unsigned r; asm volatile("v_cvt_pk_bf16_f32 %0, %1, %2" : "=v"(r) : "v"(lo), "v"(hi)); return r; }

constexpr int DM = 2048;
__device__ __forceinline__ int ada_row_of_panel(int pm) { return pm < 32 ? 0 : 1 + ((pm - 32) >> 4); }

struct NormIn {
    const float* ssq; const float* bias; int N;
    __device__ __forceinline__ void load(const Unit& u, int wr, int wc, int fr, int fq, float (&rs)[2][4], f32x4 (&bv)[2][2]) const {
        const int row0 = u.pm * BM + wr * 64 + fr;
#pragma unroll
        for (int ai = 0; ai < 2; ++ai)
#pragma unroll
            for (int m = 0; m < 4; ++m) rs[ai][m] = 1.0f / sqrtf(ssq[row0 + ai * HALF + m * 16] * (1.0f / DM) + 1e-6f);
        const float* b = bias + (size_t)ada_row_of_panel(u.pm) * N + u.pn * BM + wc * 32 + 8 * fq;
#pragma unroll
        for (int bj = 0; bj < 2; ++bj)
#pragma unroll
            for (int n = 0; n < 2; ++n) bv[bj][n] = *(const f32x4*)(b + bj * HALF + 4 * n);
    }
};
struct EpiAbIn {
    static constexpr bool PERM = true, AFTER_DRAIN = false;
    bf16_t* U; bf16_t* Q; size_t qkv_stride;
    NormIn nin;
    __device__ __forceinline__ void operator()(const f32x4 (&acc)[2][2][4][2], const Unit& u, int wr, int wc, int fr, int fq) const {
        const int row0 = u.pm * BM + wr * 64 + fr;
        bf16_t* base; int ldc, colt;
        if (u.pn < 2) { base = U; ldc = 512; colt = u.pn * BM; }
        else { const int t = (u.pn - 2) >> 2; base = Q + (size_t)t * qkv_stride; ldc = 1024; colt = ((u.pn - 2) & 3) * BM; }
        const int col0 = colt + wc * 32 + 8 * fq;
        float rs[2][4]; f32x4 bv[2][2]; nin.load(u, wr, wc, fr, fq, rs, bv);
#pragma unroll
        for (int ai = 0; ai < 2; ++ai)
#pragma unroll
            for (int m = 0; m < 4; ++m) { bf16_t* rowp = base + (size_t)(row0 + ai * HALF + m * 16) * ldc + col0;
#pragma unroll
                for (int bj = 0; bj < 2; ++bj) { const f32x4 v0 = acc[ai][bj][m][0] * rs[ai][m] + bv[bj][0], v1 = acc[ai][bj][m][1] * rs[ai][m] + bv[bj][1];
                    u32x4 w; w.x = cvt_pk_bf16(v0[0], v0[1]); w.y = cvt_pk_bf16(v0[2], v0[3]); w.z = cvt_pk_bf16(v1[0], v1[1]); w.w = cvt_pk_bf16(v1[2], v1[3]);
                    *(u32x4*)(rowp + bj * HALF) = w; } }
    }
};
struct EpiRelu2 {
    static constexpr bool PERM = true, AFTER_DRAIN = false;
    bf16_t* O; int ldc; NormIn nin;
    __device__ __forceinline__ void operator()(const f32x4 (&acc)[2][2][4][2], const Unit& u, int wr, int wc, int fr, int fq) const {
        const int row0 = u.pm * BM + wr * 64 + fr, col0 = u.pn * BM + wc * 32 + 8 * fq;
        float rs[2][4]; f32x4 bv[2][2]; nin.load(u, wr, wc, fr, fq, rs, bv);
#pragma unroll
        for (int ai = 0; ai < 2; ++ai)
#pragma unroll
            for (int m = 0; m < 4; ++m) { bf16_t* rowp = O + (size_t)(row0 + ai * HALF + m * 16) * ldc + col0;
#pragma unroll
                for (int bj = 0; bj < 2; ++bj) { f32x4 v0 = acc[ai][bj][m][0] * rs[ai][m] + bv[bj][0], v1 = acc[ai][bj][m][1] * rs[ai][m] + bv[bj][1];
#pragma unroll
                    for (int j = 0; j < 4; ++j) { const float a = fmaxf(v0[j], 0.f), b = fmaxf(v1[j], 0.f); v0[j] = a * a; v1[j] = b * b; }
                    u32x4 w; w.x = cvt_pk_bf16(v0[0], v0[1]); w.y = cvt_pk_bf16(v0[2], v0[3]); w.z = cvt_pk_bf16(v1[0], v1[1]); w.w = cvt_pk_bf16(v1[2], v1[3]);
                    *(u32x4*)(rowp + bj * HALF) = w; } }
    }
};
struct EpiConvIn {
    static constexpr bool PERM = true, AFTER_DRAIN = false;
    bf16_t* Z; bf16_t* GB; NormIn nin;
    __device__ __forceinline__ void operator()(const f32x4 (&acc)[2][2][4][2], const Unit& u, int wr, int wc, int fr, int fq) const {
        const int row0 = u.pm * BM + wr * 64 + fr;
        float rs[2][4]; f32x4 bv[2][2]; nin.load(u, wr, wc, fr, fq, rs, bv);
        if (u.pn < 16) {
            const int col0 = u.pn * HALF + wc * 32 + 8 * fq;
#pragma unroll
            for (int ai = 0; ai < 2; ++ai)
#pragma unroll
                for (int m = 0; m < 4; ++m) { bf16_t* rowp = Z + (size_t)(row0 + ai * HALF + m * 16) * DM + col0;
                    const f32x4 v0 = (acc[ai][0][m][0] * rs[ai][m] + bv[0][0]) * (acc[ai][1][m][0] * rs[ai][m] + bv[1][0]), v1 = (acc[ai][0][m][1] * rs[ai][m] + bv[0][1]) * (acc[ai][1][m][1] * rs[ai][m] + bv[1][1]);
                    u32x4 w; w.x = cvt_pk_bf16(v0[0], v0[1]); w.y = cvt_pk_bf16(v0[2], v0[3]); w.z = cvt_pk_bf16(v1[0], v1[1]); w.w = cvt_pk_bf16(v1[2], v1[3]);
                    *(u32x4*)rowp = w; }
        } else {
            const int col0 = (u.pn - 16) * BM + wc * 32 + 8 * fq;
#pragma unroll
            for (int ai = 0; ai < 2; ++ai)
#pragma unroll
                for (int m = 0; m < 4; ++m) { bf16_t* rowp = GB + (size_t)(row0 + ai * HALF + m * 16) * DM + col0;
#pragma unroll
                    for (int bj = 0; bj < 2; ++bj) { const f32x4 v0 = acc[ai][bj][m][0] * rs[ai][m] + bv[bj][0], v1 = acc[ai][bj][m][1] * rs[ai][m] + bv[bj][1];
                        u32x4 w; w.x = cvt_pk_bf16(v0[0], v0[1]); w.y = cvt_pk_bf16(v0[2], v0[3]); w.z = cvt_pk_bf16(v1[0], v1[1]); w.w = cvt_pk_bf16(v1[2], v1[3]);
                        *(u32x4*)(rowp + bj * HALF) = w; } }
        }
    }
};
template <bool NEXT> struct EpiRes {
    static constexpr bool PERM = false, AFTER_DRAIN = false;
    const float* base0; const float* base1; float* out; const float* gate;
    const float* gvn; bf16_t* Hn; float* ssqn;
    __device__ __forceinline__ void operator()(const f32x4 (&acc)[2][2][4][2], const Unit& u, int wr, int wc, int fr, int fq) const {
        const int row0 = u.pm * BM + wr * 64 + fr, col0 = u.pn * BM + wc * 32 + 4 * fq;
        const int j = ada_row_of_panel(u.pm);
        const float* g = gate + j * 12288 + col0;
        const char* bs = (const char*)(u.pm < 32 ? base0 : base1); char* ob = (char*)out; char* hb = (char*)Hn;
        const unsigned o0 = (unsigned)(row0 * DM + col0) * 4u;
        f32x4 gv[2][2], gn[2][2];
#pragma unroll
        for (int bj = 0; bj < 2; ++bj)
#pragma unroll
            for (int n = 0; n < 2; ++n) { gv[bj][n] = *(const f32x4*)(g + bj * HALF + n * 16); if (NEXT) gn[bj][n] = *(const f32x4*)(gvn + j * DM + col0 + bj * HALF + n * 16); }
#pragma unroll
        for (int am = 0; am < 4; ++am) { const int ai = am >> 1, mh = (am & 1) * 2;
            f32x4 b[2][2][2];
#pragma unroll
            for (int mm = 0; mm < 2; ++mm)
#pragma unroll
                for (int bj = 0; bj < 2; ++bj)
#pragma unroll
                    for (int n = 0; n < 2; ++n) b[mm][bj][n] = *(const f32x4*)(bs + (o0 + (unsigned)(((ai * HALF + (mh + mm) * 16) * DM + bj * HALF + n * 16) * 4)));
#pragma unroll
            for (int mm = 0; mm < 2; ++mm) { const int m = mh + mm; float sq = 0.f;
#pragma unroll
                for (int bj = 0; bj < 2; ++bj)
#pragma unroll
                    for (int n = 0; n < 2; ++n) { const unsigned o = o0 + (unsigned)(((ai * HALF + m * 16) * DM + bj * HALF + n * 16) * 4);
                        const f32x4 x = b[mm][bj][n] + gv[bj][n] * acc[ai][bj][m][n];
                        *(f32x4*)(ob + o) = x;
                        if (NEXT) { sq += (x[0] * x[0] + x[1] * x[1]) + (x[2] * x[2] + x[3] * x[3]); const f32x4 h = x * gn[bj][n];
                            typedef unsigned u32x2v __attribute__((ext_vector_type(2))); u32x2v w; w.x = cvt_pk_bf16(h[0], h[1]); w.y = cvt_pk_bf16(h[2], h[3]);
                            *(u32x2v*)(hb + (o >> 1)) = w; } }
                if (NEXT) {
                    auto t = __builtin_amdgcn_permlane16_swap(__float_as_uint(sq), __float_as_uint(sq), false, false); sq = __uint_as_float(t[0]) + __uint_as_float(t[1]);
                    auto v = __builtin_amdgcn_permlane32_swap(__float_as_uint(sq), __float_as_uint(sq), false, false); sq = __uint_as_float(v[0]) + __uint_as_float(v[1]);
                    if (fq == 0) __hip_atomic_fetch_add(ssqn + row0 + ai * HALF + m * 16, sq, __ATOMIC_RELAXED, __HIP_MEMORY_SCOPE_AGENT); } }
            asm volatile("" ::: "memory"); }
    }
};

template <class Epi, class Sched, bool ALIGN_EPI = false, bool SP2 = false>
__device__ __forceinline__ void gemm_phase(PG8_LAS unsigned char* lds, const Gemm g, const Sched& S, const Epi& E, const int wv  ) {
    const int lane = lane_id_opaque(), wid = wv, tid = wv * 64 + lane, wr = wid >> 2, wc = wid & 3, fr = lane & 15, fq = lane >> 4;
    const int K = g.K, nt = K / BK;
    unsigned voffA[2], voffB[2];
#pragma unroll
    for (int i = 0; i < 2; ++i) { int R, C; stage_rc(tid * 16 + i * 8192, R, C); const int Rb = Epi::PERM ? ((R & ~31) + perm32(R & 31)) : R;
        voffA[i] = (unsigned)(R * K + C) * 2u; voffB[i] = (unsigned)(Rb * K + C) * 2u; }
    const size_t kstep = (size_t)(BK * 2);
    const size_t hstep = (size_t)HALF * K * 2;
    const size_t tstep = 2 * hstep;
    const unsigned ldsw = (unsigned)wid * 1024u;
    const int aoff = lds_byte(wr * 64 + fr, fq * 8), boff = lds_byte(wc * 32 + fr, fq * 8);
#define PG8_SA(b, h) (((b) * 2 + (h)) * HTB)
#define PG8_SB(b, h) ((4 + (b) * 2 + (h)) * HTB)
#define PG8_STAGE(bufoff, gbase, voff) do { _Pragma("unroll") for (int _i = 0; _i < 2; ++_i) \
        __builtin_amdgcn_global_load_lds((const unsigned*)((const char*)(gbase) + (voff)[_i]), (PG8_LAS unsigned*)(lds + (bufoff) + ldsw + _i * 8192), 16, 0, 0); } while (0)
#define PG8_LDA(dst, b, h) do { _Pragma("unroll") for (int m = 0; m < 4; ++m) _Pragma("unroll") for (int k = 0; k < 2; ++k) dst[m][k] = *(const PG8_LAS bf16x8*)(lds + PG8_SA(b, h) + aoff + m * 2048 + k * 1024); } while (0)
#define PG8_LDB(dst, b, h) do { _Pragma("unroll") for (int n = 0; n < 2; ++n) _Pragma("unroll") for (int k = 0; k < 2; ++k) dst[n][k] = *(const PG8_LAS bf16x8*)(lds + PG8_SB(b, h) + boff + n * 2048 + k * 1024); } while (0)
#define PG8_MMA(ai, bj, At, Bt) do { __builtin_amdgcn_s_setprio(1); _Pragma("unroll") for (int m = 0; m < 4; ++m) _Pragma("unroll") for (int n = 0; n < 2; ++n) _Pragma("unroll") for (int k = 0; k < 2; ++k) \
        acc[ai][bj][m][n] = __builtin_amdgcn_mfma_f32_16x16x32_bf16(Bt[n][k], At[m][k], acc[ai][bj][m][n], 0, 0, 0); __builtin_amdgcn_s_setprio(0); } while (0)
#define PG8_WAIT_V(n) asm volatile("s_waitcnt vmcnt(" #n ")" ::: "memory")
#define PG8_WAIT_L(n) asm volatile("s_waitcnt lgkmcnt(" #n ")" ::: "memory")
#define PG8_BAR __builtin_amdgcn_s_barrier()
#define PG8_SCHED __builtin_amdgcn_sched_barrier(0)
    Unit cur, nxt; int ui = 0;
    if (!S.next(0, cur)) return;
    f32x4 acc[2][2][4][2];
#pragma unroll
    for (int a = 0; a < 2; ++a)
#pragma unroll
        for (int b = 0; b < 2; ++b)
#pragma unroll
            for (int m = 0; m < 4; ++m)
#pragma unroll
                for (int n = 0; n < 2; ++n) acc[a][b][m][n] = (f32x4){0.f, 0.f, 0.f, 0.f};
    bf16x8 At[4][2], B0[2][2], B1[2][2];
    const char* cA = (const char*)g.A + (size_t)cur.pm * tstep; const char* cB = (const char*)g.Bt + (size_t)cur.pn * tstep;
    S.a_ready(cur);
    if constexpr (SP2) {
        PG8_STAGE(PG8_SB(0, 0), cB, voffB); PG8_STAGE(PG8_SB(0, 1), cB + hstep, voffB); PG8_STAGE(PG8_SA(0, 0), cA, voffA); PG8_STAGE(PG8_SA(0, 1), cA + hstep, voffA);
        if (wr == 1) PG8_BAR;
        PG8_WAIT_V(2); PG8_BAR;
        PG8_STAGE(PG8_SB(1, 0), cB + kstep, voffB); PG8_STAGE(PG8_SA(1, 0), cA + kstep, voffA); PG8_STAGE(PG8_SB(1, 1), cB + hstep + kstep, voffB);
        PG8_WAIT_V(6); PG8_BAR;
    } else {
        PG8_STAGE(PG8_SB(0, 0), cB, voffB); PG8_STAGE(PG8_SA(0, 0), cA, voffA); PG8_STAGE(PG8_SB(0, 1), cB + hstep, voffB); PG8_STAGE(PG8_SA(0, 1), cA + hstep, voffA);
        if (wr == 1) PG8_BAR;
        PG8_WAIT_V(4); PG8_BAR;
        PG8_STAGE(PG8_SB(1, 0), cB + kstep, voffB); PG8_STAGE(PG8_SA(1, 0), cA + kstep, voffA); PG8_STAGE(PG8_SB(1, 1), cB + hstep + kstep, voffB);
        PG8_WAIT_V(6); PG8_BAR;
    }
    for (;;) {
        const bool has_next = S.next(ui + 1, nxt);
        const char* nA = has_next ? (const char*)g.A + (size_t)nxt.pm * tstep : cA; const char* nB = has_next ? (const char*)g.Bt + (size_t)nxt.pn * tstep : cB;
        for (int t = 0; t < nt; t += 2) {
            const bool last = (t == nt - 2);
            const char* a1 = cA + (size_t)(t + 1) * kstep;
            const char* a2 = last ? nA : cA + (size_t)(t + 2) * kstep; const char* b2 = last ? nB : cB + (size_t)(t + 2) * kstep;
            const char* a3 = a2 + kstep; const char* b3 = b2 + kstep;
            if (last && has_next) S.a_ready(nxt);
            if constexpr (SP2) {
            PG8_LDB(B0, 0, 0); PG8_LDB(B1, 0, 1); PG8_SCHED; PG8_LDA(At, 0, 0); PG8_STAGE(PG8_SA(1, 1), a1 + hstep, voffA);
            PG8_WAIT_V(8); PG8_WAIT_L(0); PG8_BAR; PG8_MMA(0, 0, At, B0); PG8_MMA(0, 1, At, B1); PG8_BAR; PG8_SCHED;
            PG8_LDA(At, 0, 1); PG8_STAGE(PG8_SB(0, 0), b2, voffB); PG8_STAGE(PG8_SB(0, 1), b2 + hstep, voffB); PG8_STAGE(PG8_SA(0, 0), a2, voffA);
            PG8_WAIT_V(8); PG8_WAIT_L(0); PG8_BAR; PG8_MMA(1, 0, At, B0); PG8_MMA(1, 1, At, B1); PG8_BAR; PG8_SCHED;
            PG8_LDB(B0, 1, 0); PG8_LDB(B1, 1, 1); PG8_SCHED; PG8_LDA(At, 1, 0); PG8_STAGE(PG8_SA(0, 1), a2 + hstep, voffA);
            PG8_WAIT_V(8); PG8_WAIT_L(0); PG8_BAR; PG8_MMA(0, 0, At, B0); PG8_MMA(0, 1, At, B1); PG8_BAR; PG8_SCHED;
            PG8_LDA(At, 1, 1); PG8_STAGE(PG8_SB(1, 0), b3, voffB); PG8_STAGE(PG8_SB(1, 1), b3 + hstep, voffB); PG8_STAGE(PG8_SA(1, 0), a3, voffA);
            PG8_WAIT_V(8); PG8_WAIT_L(0); PG8_BAR; PG8_MMA(1, 0, At, B0); PG8_MMA(1, 1, At, B1); PG8_BAR; PG8_SCHED;
            } else {
            PG8_LDB(B0, 0, 0); PG8_SCHED; PG8_LDA(At, 0, 0); PG8_STAGE(PG8_SA(1, 1), a1 + hstep, voffA);
            PG8_WAIT_L(8); PG8_BAR; PG8_WAIT_L(0); PG8_MMA(0, 0, At, B0); PG8_BAR; PG8_SCHED;
            PG8_LDB(B1, 0, 1); PG8_STAGE(PG8_SB(0, 0), b2, voffB);
            PG8_BAR; PG8_WAIT_L(0); PG8_MMA(0, 1, At, B1); PG8_BAR;
            PG8_LDA(At, 0, 1); PG8_STAGE(PG8_SA(0, 0), a2, voffA);
            PG8_BAR; PG8_WAIT_L(0); PG8_MMA(1, 0, At, B0); PG8_BAR; PG8_SCHED;
            PG8_STAGE(PG8_SB(0, 1), b2 + hstep, voffB);
            PG8_WAIT_V(6); PG8_BAR; PG8_MMA(1, 1, At, B1); PG8_BAR;
            PG8_LDB(B0, 1, 0); PG8_SCHED; PG8_LDA(At, 1, 0); PG8_STAGE(PG8_SA(0, 1), a2 + hstep, voffA);
            PG8_WAIT_L(8); PG8_BAR; PG8_WAIT_L(0); PG8_MMA(0, 0, At, B0); PG8_BAR; PG8_SCHED;
            PG8_LDB(B1, 1, 1); PG8_STAGE(PG8_SB(1, 0), b3, voffB);
            PG8_BAR; PG8_WAIT_L(0); PG8_MMA(0, 1, At, B1); PG8_BAR;
            PG8_LDA(At, 1, 1); PG8_STAGE(PG8_SA(1, 0), a3, voffA);
            PG8_BAR; PG8_WAIT_L(0); PG8_MMA(1, 0, At, B0); PG8_BAR; PG8_SCHED;
            PG8_STAGE(PG8_SB(1, 1), b3 + hstep, voffB);
            PG8_WAIT_V(6); PG8_BAR; PG8_MMA(1, 1, At, B1); PG8_BAR;
            }
        }
        if constexpr (ALIGN_EPI) { if (wr == 0) PG8_BAR; }
        if constexpr (!Epi::AFTER_DRAIN) { E(acc, cur, wr, wc, fr, fq); S.done(cur); }
        if (!has_next) break;
#pragma unroll
        for (int a = 0; a < 2; ++a)
#pragma unroll
            for (int b = 0; b < 2; ++b)
#pragma unroll
                for (int m = 0; m < 4; ++m)
#pragma unroll
                    for (int n = 0; n < 2; ++n) acc[a][b][m][n] = (f32x4){0.f, 0.f, 0.f, 0.f};
        cur = nxt; cA = nA; cB = nB; ++ui;
        if constexpr (ALIGN_EPI) { if (wr == 1) PG8_BAR; }
    }
    PG8_WAIT_V(0);
    if constexpr (!ALIGN_EPI) { if (wr == 0) PG8_BAR; }
    PG8_BAR;
    if constexpr (Epi::AFTER_DRAIN) { E.fused(acc, cur, wr, wc, fr, fq, lds, wid, lane); S.done(cur); }
#undef PG8_SA
#undef PG8_SB
#undef PG8_STAGE
#undef PG8_LDA
#undef PG8_LDB
#undef PG8_MMA
#undef PG8_WAIT_V
#undef PG8_WAIT_L
#undef PG8_BAR
#undef PG8_SCHED
}
}

#define GAS __attribute__((address_space(1)))
#define LAS __attribute__((address_space(3)))
typedef unsigned short bf16_t;
typedef short bf16x8 __attribute__((ext_vector_type(8)));
typedef short s16x4 __attribute__((ext_vector_type(4)));
typedef float f32x4 __attribute__((ext_vector_type(4)));
typedef float f32x16 __attribute__((ext_vector_type(16)));
typedef unsigned u32x4 __attribute__((ext_vector_type(4)));
typedef unsigned u32x2 __attribute__((ext_vector_type(2)));
#define SBAR() __builtin_amdgcn_sched_barrier(0)
__device__ __forceinline__ unsigned cvtpk(float lo, float hi) { unsigned r; asm volatile("v_cvt_pk_bf16_f32 %0, %1, %2" : "=v"(r) : "v"(lo), "v"(hi)); return r; }
__device__ __forceinline__ float bf2f(unsigned short b) { return __uint_as_float(((unsigned)b) << 16); }
__device__ __forceinline__ float bflo(unsigned w) { return __uint_as_float(w << 16); }
__device__ __forceinline__ float bfhi(unsigned w) { return __uint_as_float(w & 0xffff0000u); }
__device__ __forceinline__ unsigned short f2bf(float f) { return (unsigned short)(cvtpk(f, 0.f) & 0xffffu); }

namespace att {
constexpr int D = 128, NW = 8, QBLK = 32, KVBLK = 64, LD = 1024;
constexpr float SCALE = 0.088388347648318440f, THR = 8.f;
constexpr int SHM_V = KVBLK * D * 2, SHM_K = KVBLK * D * 2;
constexpr int OFF_V = 0, OFF_K = 2 * SHM_V, OFF_WS = 2 * SHM_V + 2 * SHM_K, OFF_BIAS = OFF_WS + NW * 64 * 4, LDS_BYTES = OFF_BIAS + 16 * 32 * 4;
#define KSWZ(row, colB) ((row) * 256 + ((colB) ^ (((row) & 7) << 4)))
__device__ __forceinline__ int crow(int r, int hi) { return (r & 3) + 8 * (r >> 2) + 4 * hi; }

__device__ __forceinline__ void partialSM(f32x16& p0, f32x16& p1, float& m_reg, float& mn, float& alpha) {
  constexpr float C = SCALE * 1.4426950408889634f;
  float pmax = p0[0];
#pragma unroll
  for (int r = 1; r < 16; ++r) pmax = fmaxf(pmax, p0[r]);
#pragma unroll
  for (int r = 0; r < 16; ++r) pmax = fmaxf(pmax, p1[r]);
  { auto rr = __builtin_amdgcn_permlane32_swap(__float_as_uint(pmax), __float_as_uint(pmax), false, false);
    pmax = fmaxf(__uint_as_float(rr[0]), __uint_as_float(rr[1])); }
  if (__builtin_expect(__all(pmax - m_reg <= THR / SCALE), 1)) { mn = m_reg; alpha = 1.f; }
  else { mn = fmaxf(m_reg, pmax); alpha = __builtin_amdgcn_exp2f((m_reg - mn) * C); m_reg = mn; }
  float mnC = -mn * C;
#pragma unroll
  for (int r = 0; r < 16; ++r) p0[r] = fmaf(p0[r], C, mnC);
#pragma unroll
  for (int r = 0; r < 16; ++r) p1[r] = fmaf(p1[r], C, mnC);
#pragma unroll
  for (int r = 0; r < 16; ++r) p0[r] = __builtin_amdgcn_exp2f(p0[r]);
}
__device__ __forceinline__ void finishSM(f32x16& p0, f32x16& p1, float alpha, float& l_reg, bf16x8& pa0, bf16x8& pa1, bf16x8& pa2, bf16x8& pa3) {
#pragma unroll
  for (int r = 0; r < 16; ++r) p1[r] = __builtin_amdgcn_exp2f(p1[r]);
  float ps = 0;
#pragma unroll
  for (int r = 0; r < 16; ++r) ps += p0[r];
#pragma unroll
  for (int r = 0; r < 16; ++r) ps += p1[r];
  { auto rr = __builtin_amdgcn_permlane32_swap(__float_as_uint(ps), __float_as_uint(ps), false, false);
    ps = __uint_as_float(rr[0]) + __uint_as_float(rr[1]); }
  l_reg = l_reg * alpha + ps;
#define PK4(P, BASE, OUT) do { unsigned a0 = cvtpk(P[BASE + 0], P[BASE + 1]), a1 = cvtpk(P[BASE + 2], P[BASE + 3]);   \
    unsigned b0 = cvtpk(P[BASE + 4], P[BASE + 5]), b1 = cvtpk(P[BASE + 6], P[BASE + 7]);                              \
    auto r0 = __builtin_amdgcn_permlane32_swap(a0, b0, false, false); auto r1 = __builtin_amdgcn_permlane32_swap(a1, b1, false, false); \
    u32x4 w = {r0[0], r1[0], r0[1], r1[1]}; OUT = *reinterpret_cast<bf16x8*>(&w); } while (0)
  PK4(p0, 0, pa0); PK4(p0, 8, pa1); PK4(p1, 0, pa2); PK4(p1, 8, pa3);
#undef PK4
}
__device__ __forceinline__ void qkt(f32x16& p0, f32x16& p1, const LAS char* Ks, const bf16x8* qr, int r32, int hi) {
  p0 = f32x16{}; p1 = f32x16{};
#pragma unroll
  for (int d0 = 0; d0 < 8; ++d0) { const int cb = (d0 * 16 + hi * 8) * 2;
    const bf16x8 b0 = *(const LAS bf16x8*)(Ks + KSWZ(r32, cb));
    const bf16x8 b1 = *(const LAS bf16x8*)(Ks + KSWZ(32 + r32, cb));
    p0 = __builtin_amdgcn_mfma_f32_32x32x16_bf16(b0, qr[d0], p0, 0, 0, 0);
    p1 = __builtin_amdgcn_mfma_f32_32x32x16_bf16(b1, qr[d0], p1, 0, 0, 0); }
}
__device__ __forceinline__ int v_st(int k, int c) { const int kk = (k & ~0xC) | ((k & 4) << 1) | ((k & 8) >> 1); return ((kk >> 3) * 4 + (c >> 5)) * 512 + ((kk & 7) * 32 + (c & 31)) * 2; }
__device__ __forceinline__ int v_rd_base(int lane) { return ((lane & 3) << 3) | (((lane >> 2) & 3) << 6) | (((lane >> 4) & 1) << 5) | (((lane >> 5) & 1) << 8); }
constexpr int v_rd_off(int d0, int ks, int half) { return d0 * 512 + ks * 4096 + half * 2048; }
template <int OFF> __device__ __forceinline__ s16x4 tr_read(int vb) {
  s16x4 r; asm volatile("ds_read_b64_tr_b16 %0, %1 offset:%2" : "=&v"(r) : "v"(vb), "i"(OFF) : "memory"); return r;
}
template <int D0> __device__ __forceinline__ void pv_one(f32x16& od, int vb, bf16x8 pa0, bf16x8 pa1, bf16x8 pa2, bf16x8 pa3) {
  const s16x4 l0 = tr_read<v_rd_off(D0, 0, 0)>(vb), h0 = tr_read<v_rd_off(D0, 0, 1)>(vb), l1 = tr_read<v_rd_off(D0, 1, 0)>(vb), h1 = tr_read<v_rd_off(D0, 1, 1)>(vb);
  const s16x4 l2 = tr_read<v_rd_off(D0, 2, 0)>(vb), h2 = tr_read<v_rd_off(D0, 2, 1)>(vb), l3 = tr_read<v_rd_off(D0, 3, 0)>(vb), h3 = tr_read<v_rd_off(D0, 3, 1)>(vb);
  asm volatile("s_waitcnt lgkmcnt(0)" ::: "memory"); SBAR();
#define PK(L, H) (bf16x8){L[0], L[1], L[2], L[3], H[0], H[1], H[2], H[3]}
  od = __builtin_amdgcn_mfma_f32_32x32x16_bf16(pa0, PK(l0, h0), od, 0, 0, 0);
  od = __builtin_amdgcn_mfma_f32_32x32x16_bf16(pa1, PK(l1, h1), od, 0, 0, 0);
  od = __builtin_amdgcn_mfma_f32_32x32x16_bf16(pa2, PK(l2, h2), od, 0, 0, 0);
  od = __builtin_amdgcn_mfma_f32_32x32x16_bf16(pa3, PK(l3, h3), od, 0, 0, 0);
#undef PK
}
__device__ __forceinline__ void pv_d0(f32x16* o, int vb, bf16x8 pa0, bf16x8 pa1, bf16x8 pa2, bf16x8 pa3) {
  pv_one<0>(o[0], vb, pa0, pa1, pa2, pa3); pv_one<1>(o[1], vb, pa0, pa1, pa2, pa3); pv_one<2>(o[2], vb, pa0, pa1, pa2, pa3); pv_one<3>(o[3], vb, pa0, pa1, pa2, pa3);
}

__device__ __forceinline__ void na_mask(f32x16& p0, f32x16& p1, int kr, int qrow, int qc, unsigned cmask, int hi, const LAS float* biasL) {
  int r0 = qrow - 4; r0 = r0 < 0 ? 0 : (r0 > 56 ? 56 : r0);
  const bool rowok = (kr >= r0) && (kr < r0 + 8);
  const unsigned em = rowok ? cmask : 0u;
  const int dr = rowok ? (kr - qrow + 7) : 0;
  const LAS float* brow = biasL + dr * 32 + (15 - qc + 4 * hi);
#pragma unroll
  for (int i4 = 0; i4 < 4; ++i4) {
#pragma unroll
    for (int ii = 0; ii < 4; ++ii) { const int i = i4 * 4 + ii, kc = (i & 3) + 8 * (i >> 2);
      const bool ok0 = (em >> i) & 1u, ok1 = (em >> (16 + i)) & 1u;
      const float b0 = brow[kc], b1 = brow[kc + 32];
      p0[i] = ok0 ? p0[i] + b0 : -1e30f; p1[i] = ok1 ? p1[i] + b1 : -1e30f; }
    asm volatile("" ::: "memory"); }
}

template <bool NA, int SDEPTH>
__device__ __forceinline__ void attn_unit(LAS char* lds, const bf16_t* __restrict__ Qb, const bf16_t* __restrict__ K0, const bf16_t* __restrict__ V0, int nt0,
                                          const bf16_t* __restrict__ K1, const bf16_t* __restrict__ V1, int NT, bf16_t* __restrict__ Ob, int ldo, int R, int kr0, const int wv) {
  const int lane = lane_id_opaque(), wid = wv, tid = wv * 64 + lane, r32 = lane & 31, hi = lane >> 5;
  LAS char* V_lds = lds + OFF_V; LAS char* K_lds = lds + OFF_K;
  LAS float* ws = (LAS float*)(lds + OFF_WS) + wid * 64; LAS float* li_l = ws; LAS float* al_l = ws + 32;
  const LAS float* biasL = (const LAS float*)(lds + OFF_BIAS);
  float m_reg = -1e30f, l_reg = 0; f32x16 o[4] = {}; bf16x8 qr[8];
  const bf16_t* Qw = Qb + (long)(wid * QBLK + r32) * LD + hi * 8;
#pragma unroll
  for (int d0 = 0; d0 < 8; ++d0) qr[d0] = *(const bf16x8*)(Qw + d0 * 16);
  const int sr = tid >> 4, sc = (tid & 15) * 8, vst0 = v_st(sr, sc), vst1 = v_st(32 + sr, sc);
  const int vb0 = (int)(uintptr_t)V_lds + v_rd_base(lane);
  const int qrow = R + (wid >> 1), qc = 32 * (wid & 1) + r32;
  unsigned cmask = 0;
  if (NA) { int c0 = qc - 8; c0 = c0 < 0 ? 0 : (c0 > 48 ? 48 : c0);
#pragma unroll
    for (int i = 0; i < 16; ++i) { const int kc = crow(i, hi); if ((unsigned)(kc - c0) < 16u) cmask |= 1u << i; if ((unsigned)(kc + 32 - c0) < 16u) cmask |= 1u << (16 + i); } }
  struct { bf16x8 vs0, vs1, ks0, ks1; } sr_[SDEPTH];
#define TILE_K(t) (((t) < nt0 ? K0 + (long)(t) * (KVBLK * LD) : K1 + (long)((t) - nt0) * (KVBLK * LD)))
#define TILE_V(t) (((t) < nt0 ? V0 + (long)(t) * (KVBLK * LD) : V1 + (long)((t) - nt0) * (KVBLK * LD)))
#define SLOAD(i, t) do { const bf16_t* kp_ = TILE_K(t); const bf16_t* vp_ = TILE_V(t); \
    sr_[i].vs0 = *(const bf16x8*)(vp_ + (long)sr * LD + sc); sr_[i].vs1 = *(const bf16x8*)(vp_ + (long)(32 + sr) * LD + sc); \
    sr_[i].ks0 = *(const bf16x8*)(kp_ + (long)sr * LD + sc); sr_[i].ks1 = *(const bf16x8*)(kp_ + (long)(32 + sr) * LD + sc); } while (0)
#define SWRITE(b, i) do { *(LAS bf16x8*)(V_lds + (b) * SHM_V + vst0) = sr_[i].vs0;          \
    *(LAS bf16x8*)(V_lds + (b) * SHM_V + vst1) = sr_[i].vs1; const int kc_ = sc * 2;               \
    *(LAS bf16x8*)(K_lds + (b) * SHM_K + KSWZ(sr, kc_)) = sr_[i].ks0;                       \
    *(LAS bf16x8*)(K_lds + (b) * SHM_K + KSWZ(32 + sr, kc_)) = sr_[i].ks1; } while (0)
#define SWAIT() do { if constexpr (SDEPTH == 2) asm volatile("s_waitcnt vmcnt(4)" ::: "memory"); else asm volatile("s_waitcnt vmcnt(0)" ::: "memory"); } while (0)
#define RESC(a) do { if (__any((a) < 1.f)) { if (hi == 0) al_l[r32] = (a); asm volatile("s_waitcnt lgkmcnt(0)" ::: "memory"); \
    _Pragma("unroll") for (int d = 0; d < 4; ++d) _Pragma("unroll") for (int r = 0; r < 16; ++r) o[d][r] *= al_l[crow(r, hi)]; } } while (0)
#define MASK(P0, P1, t) do { if (NA && (t) >= nt0) na_mask(P0, P1, kr0 + (t) - nt0, qrow, qc, cmask, hi, biasL); } while (0)
  f32x16 pA0, pA1, pB0, pB1; float mnA, mnB, alA, alB; bf16x8 pa0, pa1, pa2, pa3;
  constexpr int SE = 0, SO = SDEPTH - 1;
  SLOAD(SE, 0); asm volatile("s_waitcnt vmcnt(0)" ::: "memory"); SWRITE(0, SE); __syncthreads();
  qkt(pA0, pA1, K_lds, qr, r32, hi); MASK(pA0, pA1, 0); partialSM(pA0, pA1, m_reg, mnA, alA);
  SLOAD(SO, 1); if constexpr (SDEPTH == 2) { if (2 < NT) SLOAD(SE, 2); }
  SWAIT(); SWRITE(1, SO); __syncthreads();
  for (int j = 1; j + 1 < NT; j += 2) {
    SBAR(); qkt(pB0, pB1, K_lds + SHM_K, qr, r32, hi);
    finishSM(pA0, pA1, alA, l_reg, pa0, pa1, pa2, pa3); SBAR();
    SLOAD(SO, j + SDEPTH); SBAR();
    pv_d0(o, vb0, pa0, pa1, pa2, pa3); MASK(pB0, pB1, j); partialSM(pB0, pB1, m_reg, mnB, alB);
    __syncthreads(); SWAIT(); SWRITE(0, SE);
    RESC(alB); __syncthreads();
    SBAR(); qkt(pA0, pA1, K_lds, qr, r32, hi);
    finishSM(pB0, pB1, alB, l_reg, pa0, pa1, pa2, pa3); SBAR();
    if (SDEPTH == 1 || j + 3 < NT) SLOAD(SE, j + 1 + SDEPTH); SBAR();
    pv_d0(o, vb0 + SHM_V, pa0, pa1, pa2, pa3); MASK(pA0, pA1, j + 1); partialSM(pA0, pA1, m_reg, mnA, alA);
    __syncthreads(); SWAIT(); SWRITE(1, SO);
    RESC(alA); __syncthreads();
  }
  SBAR(); qkt(pB0, pB1, K_lds + SHM_K, qr, r32, hi);
  finishSM(pA0, pA1, alA, l_reg, pa0, pa1, pa2, pa3); SBAR();
  pv_d0(o, vb0, pa0, pa1, pa2, pa3); MASK(pB0, pB1, NT - 1); partialSM(pB0, pB1, m_reg, mnB, alB);
  __syncthreads(); RESC(alB);
  finishSM(pB0, pB1, alB, l_reg, pa0, pa1, pa2, pa3); SBAR();
  pv_d0(o, vb0 + SHM_V, pa0, pa1, pa2, pa3);
  if (hi == 0) li_l[r32] = l_reg; asm volatile("s_waitcnt lgkmcnt(0)" ::: "memory");
  float rli[16];
#pragma unroll
  for (int r = 0; r < 16; ++r) rli[r] = __builtin_amdgcn_rcpf(li_l[crow(r, hi)]);
  bf16_t* Ow = Ob + (long)(wid * QBLK) * ldo;
#pragma unroll
  for (int r = 0; r < 16; ++r) { const int orow = crow(r, hi);
#pragma unroll
    for (int d0 = 0; d0 < 4; ++d0) Ow[(long)orow * ldo + d0 * 32 + r32] = f2bf(o[d0][r] * rli[r]); }
#undef SLOAD
#undef SWRITE
#undef SWAIT
#undef RESC
#undef MASK
#undef TILE_K
#undef TILE_V
}
}

constexpr int DM = 2048, NCTX = 8192, NLAT = 32768, MTOK = NCTX + NLAT;
constexpr int CTX_L = 256, LAT_L = 4096, NLAYER = 4, DFF = 8192;
constexpr int ABIN = 3584, ABOUT = 1536, S5W = 512;
constexpr float NORM_EPS = 1e-6f;
constexpr int S5T = 32;
constexpr int NCHUNK = MTOK / S5T;
__device__ __forceinline__ int ada_row_of_token(int m) { return m < NCTX ? 0 : 1 + ((m - NCTX) >> 12); }

namespace s5 {
constexpr int XROW = 272;
constexpr int XBYTES = S5T * XROW;
constexpr int GROW = 1040;
constexpr int OFF_X = 0, OFF_G = 8 * XBYTES, LDS_BYTES = OFF_G + S5T * GROW;

__device__ __forceinline__ void bu_chunk(const bf16_t* __restrict__ U, int m0, int g, int dir, const bf16_t* __restrict__ BB, int lane, float (&bre)[32], float (&bim)[32]) {
  const int r = lane & 31, h = lane >> 5, tok = dir ? 31 - r : r;
  const bf16x8 ua = *(const bf16x8*)(U + (size_t)(m0 + tok) * S5W + g * 16 + h * 8);
  const bf16x8 br0 = *(const bf16x8*)(BB + (0 * 64 + r) * 16 + h * 8), br1 = *(const bf16x8*)(BB + (0 * 64 + 32 + r) * 16 + h * 8);
  const bf16x8 bi0 = *(const bf16x8*)(BB + (1 * 64 + r) * 16 + h * 8), bi1 = *(const bf16x8*)(BB + (1 * 64 + 32 + r) * 16 + h * 8);
  const f32x16 z = {};
  const f32x16 dr0 = __builtin_amdgcn_mfma_f32_32x32x16_bf16(ua, br0, z, 0, 0, 0), dr1 = __builtin_amdgcn_mfma_f32_32x32x16_bf16(ua, br1, z, 0, 0, 0);
  const f32x16 di0 = __builtin_amdgcn_mfma_f32_32x32x16_bf16(ua, bi0, z, 0, 0, 0), di1 = __builtin_amdgcn_mfma_f32_32x32x16_bf16(ua, bi1, z, 0, 0, 0);
#pragma unroll
  for (int i = 0; i < 16; ++i) { const int c0 = (i & 3) + 8 * (i >> 2);
    auto a = __builtin_amdgcn_permlane32_swap(__float_as_uint(dr0[i]), __float_as_uint(dr1[i]), false, false);
    bre[c0] = __uint_as_float(a[0]); bre[c0 + 4] = __uint_as_float(a[1]);
    auto b = __builtin_amdgcn_permlane32_swap(__float_as_uint(di0[i]), __float_as_uint(di1[i]), false, false);
    bim[c0] = __uint_as_float(b[0]); bim[c0 + 4] = __uint_as_float(b[1]); }
}

__device__ __forceinline__ void phase_a(int e, const bf16_t* U, const float4* S5A, const bf16_t* S5BB, float* Ef, float* Ec, int G, int vcu, const int wv) {
  const int lane = lane_id_opaque(), wid = wv; (void)wid;
  for (int task = vcu; task < (MTOK / 128) * 4; task += G) {
    const int cc = task >> 2, g = (task & 3) * 8 + wid;
#pragma unroll 1
    for (int dir = 0; dir < 2; ++dir) {
      const int tb = ((e * 2 + dir) * 32 + g);
      const float4 a4 = S5A[tb * 64 + lane];
      float cr = 0.f, ci = 0.f;
#pragma unroll 1
      for (int k = 0; k < 4; ++k) { const int f = dir ? 3 - k : k; const int ci_f = cc * 4 + f;
        float bre[32], bim[32];
        bu_chunk(U, ci_f * S5T, g, dir, S5BB + (size_t)tb * 2048, lane, bre, bim);
        float xr = 0.f, xi = 0.f;
#pragma unroll
        for (int i = 0; i < 32; ++i) { const float nr = fmaf(a4.x, xr, fmaf(-a4.y, xi, bre[i])), ni = fmaf(a4.x, xi, fmaf(a4.y, xr, bim[i])); xr = nr; xi = ni; }
        float* ep = Ef + (((size_t)ci_f * 32 + g) * 2 + dir) * 128;
        ep[lane] = xr; ep[64 + lane] = xi;
        const float nr = fmaf(a4.z, cr, fmaf(-a4.w, ci, xr)), ni = fmaf(a4.z, ci, fmaf(a4.w, cr, xi)); cr = nr; ci = ni;
      }
      float* ecp = Ec + (((size_t)cc * 32 + g) * 2 + dir) * 128;
      ecp[lane] = cr; ecp[64 + lane] = ci;
    }
  }
}

__device__ __forceinline__ void phase_b(LAS char* lds, int e, const bf16_t* U, const float4* S5A, const float2* S5A128, const bf16_t* S5BB, const bf16_t* S5CM, const float* Ef, const float* Ec,
                                        const float* h0re, const float* h0im, const float* dvec, const bf16_t* Wglu, const float* bglu,
                                        bf16_t* AO, float* st_re, float* st_im, int G, int vcu, const int wv) {
  const int lane = lane_id_opaque(), wid = wv; (void)wid;
  LAS char* X = lds + OFF_X + wid * XBYTES; LAS char* Gt = lds + OFF_G;
  for (int ci = vcu; ci < NCHUNK; ci += G) {
    const int m0 = ci * S5T;
    int c, nC, b; const bool isctx = m0 < NCTX;
    if (isctx) { b = m0 / CTX_L; c = (m0 % CTX_L) / S5T; nC = CTX_L / S5T; } else { b = (m0 - NCTX) / LAT_L; c = ((m0 - NCTX) % LAT_L) / S5T; nC = LAT_L / S5T; }
#pragma unroll 1
    for (int gq = 0; gq < 4; ++gq) { const int g = wid * 4 + gq;
      f32x4 yacc[2] = {{0.f, 0.f, 0.f, 0.f}, {0.f, 0.f, 0.f, 0.f}};
#pragma unroll 1
      for (int dir = 0; dir < 2; ++dir) {
        const int tb = ((e * 2 + dir) * 32 + g);
        const float4 a4 = S5A[tb * 64 + lane];
        float sr = 0.f, si = 0.f;
        if (!isctx) { const size_t hi_ = ((((size_t)b * 2 + e) * 2 + dir) * 32 + g) * 64 + lane; sr = h0re[hi_]; si = h0im[hi_]; }
        {
          const float2 a128 = S5A128[tb * 64 + lane];
          const int C = c >> 2, f = c & 3, nCC = nC >> 2, cc0 = (ci - c) >> 2;
          const int n = dir ? (nCC - 1 - C) : C; const int cstart = dir ? (cc0 + nCC - 1) : cc0; const int cstep = dir ? -1 : 1;
          const float* ep = Ec + (((size_t)cstart * 32 + g) * 2 + dir) * 128 + lane; const long estep = (long)cstep * 32 * 2 * 128;
          int k = 0;
          for (; k + 8 <= n; k += 8) { float er[8], ei[8];
#pragma unroll
            for (int j = 0; j < 8; ++j) { er[j] = ep[(long)(k + j) * estep]; ei[j] = ep[(long)(k + j) * estep + 64]; }
#pragma unroll
            for (int j = 0; j < 8; ++j) { const float nr = fmaf(a128.x, sr, fmaf(-a128.y, si, er[j])), ni = fmaf(a128.x, si, fmaf(a128.y, sr, ei[j])); sr = nr; si = ni; } }
          for (; k < n; ++k) { const float er = ep[(long)k * estep], ei = ep[(long)k * estep + 64];
            const float nr = fmaf(a128.x, sr, fmaf(-a128.y, si, er)), ni = fmaf(a128.x, si, fmaf(a128.y, sr, ei)); sr = nr; si = ni; }
          const int nf = dir ? (3 - f) : f; const int fstart = dir ? (ci - f + 3) : (ci - f);
          const float* fp = Ef + (((size_t)fstart * 32 + g) * 2 + dir) * 128 + lane;
          for (int q = 0; q < nf; ++q) { const float er = fp[(long)q * estep], ei = fp[(long)q * estep + 64];
            const float nr = fmaf(a4.z, sr, fmaf(-a4.w, si, er)), ni = fmaf(a4.z, si, fmaf(a4.w, sr, ei)); sr = nr; si = ni; } }
        float bre[32], bim[32];
        bu_chunk(U, m0, g, dir, S5BB + (size_t)tb * 2048, lane, bre, bim);
        float xr = sr, xi = si;
#pragma unroll
        for (int i = 0; i < 32; ++i) { const float nr = fmaf(a4.x, xr, fmaf(-a4.y, xi, bre[i])), ni = fmaf(a4.x, xi, fmaf(a4.y, xr, bim[i])); xr = nr; xi = ni; bre[i] = nr; bim[i] = ni; }
        if (isctx && ((dir == 0 && c == nC - 1) || (dir == 1 && c == 0))) { const size_t so = ((((size_t)b * 2 + e) * 2 + dir) * 32 + g) * 64 + lane; st_re[so] = xr; st_im[so] = xi; }
#pragma unroll
        for (int i = 0; i < 32; ++i) { const int tok = dir ? 31 - i : i;
          *(LAS unsigned*)(X + tok * XROW + lane * 4) = cvtpk(bre[i], bim[i]); }
        const bf16_t* cm = S5CM + (size_t)tb * 2048 + (lane & 15) * 128 + (lane >> 4) * 8;
        bf16x8 bf[4];
#pragma unroll
        for (int ks = 0; ks < 4; ++ks) bf[ks] = *(const bf16x8*)(cm + ks * 32);
        asm volatile("s_waitcnt lgkmcnt(0)" ::: "memory");
#pragma unroll
        for (int rb = 0; rb < 2; ++rb)
#pragma unroll
          for (int ks = 0; ks < 4; ++ks) { const bf16x8 af = *(const LAS bf16x8*)(X + (rb * 16 + (lane & 15)) * XROW + (ks * 32 + (lane >> 4) * 8) * 2);
            yacc[rb] = __builtin_amdgcn_mfma_f32_16x16x32_bf16(af, bf[ks], yacc[rb], 0, 0, 0); }
        asm volatile("s_waitcnt lgkmcnt(0)" ::: "memory");
      }
      const int n = lane & 15, col = g * 16 + n; const float dv = dvec[col];
#pragma unroll
      for (int rb = 0; rb < 2; ++rb)
#pragma unroll
        for (int i = 0; i < 4; ++i) { const int tok = rb * 16 + (lane >> 4) * 4 + i;
          const float uu = bf2f(U[(size_t)(m0 + tok) * S5W + col]);
          const float y = yacc[rb][i] + dv * uu;
          const float z2 = 1.5957691216057308f * (y + 0.044715f * y * y * y);
          const float gl = y - y / (1.f + __expf(z2));
          *(LAS unsigned short*)(Gt + tok * GROW + col * 2) = f2bf(gl); }
    }
    __syncthreads();
    { f32x4 acc[2][4];
#pragma unroll
      for (int rb = 0; rb < 2; ++rb)
#pragma unroll
        for (int cb = 0; cb < 4; ++cb) acc[rb][cb] = (f32x4){0.f, 0.f, 0.f, 0.f};
      const bf16_t* wp = Wglu + (size_t)(wid * 64 + (lane & 15)) * 512 + (lane >> 4) * 8;
#pragma unroll 4
      for (int ks = 0; ks < 16; ++ks) {
        bf16x8 af[2], bfr[4];
#pragma unroll
        for (int cb = 0; cb < 4; ++cb) bfr[cb] = *(const bf16x8*)(wp + (size_t)cb * 16 * 512 + ks * 32);
#pragma unroll
        for (int rb = 0; rb < 2; ++rb) af[rb] = *(const LAS bf16x8*)(Gt + (rb * 16 + (lane & 15)) * GROW + (ks * 32 + (lane >> 4) * 8) * 2);
#pragma unroll
        for (int rb = 0; rb < 2; ++rb)
#pragma unroll
          for (int cb = 0; cb < 4; ++cb) acc[rb][cb] = __builtin_amdgcn_mfma_f32_16x16x32_bf16(af[rb], bfr[cb], acc[rb][cb], 0, 0, 0);
      }
#pragma unroll
      for (int cb = 0; cb < 4; ++cb) { const int col = wid * 64 + cb * 16 + (lane & 15); const float bb = bglu[col];
#pragma unroll
        for (int rb = 0; rb < 2; ++rb)
#pragma unroll
          for (int i = 0; i < 4; ++i) { const int tok = rb * 16 + (lane >> 4) * 4 + i;
            const float gv = bf2f(*(const LAS unsigned short*)(Gt + tok * GROW + col * 2));
            const float zz = acc[rb][cb][i] + bb;
            AO[(size_t)(m0 + tok) * ABOUT + col] = f2bf(gv / (1.f + __expf(-zz))); } }
    }
    __syncthreads();
  }
}
}

constexpr size_t MiB = 1u << 20;
constexpr size_t WS_CTL = 0, CTL_ZERO_BYTES = 3 * MiB;
constexpr size_t WS_SSQ = 1 * MiB;
constexpr size_t WS_ADA = 3 * MiB;
constexpr size_t WS_S5A = 5 * MiB, WS_S5A128 = 5 * MiB + 512 * 1024, WS_S5BB = 6 * MiB, WS_S5CM = 7 * MiB;
constexpr size_t WS_GV = 8 * MiB;
constexpr size_t WS_BIAS = 9 * MiB;
constexpr size_t WS_CK = 14 * MiB, WS_CV = 22 * MiB;
constexpr size_t WS_WGLU = 30 * MiB;
constexpr size_t WS_WABIN = 32 * MiB;
constexpr size_t WS_WABOUT = 60 * MiB;
constexpr size_t WS_WCVIN = 72 * MiB;
constexpr size_t WS_WCVOUT = 120 * MiB;
constexpr size_t WS_WUP = 136 * MiB;
constexpr size_t WS_WDN = 264 * MiB;
constexpr size_t WS_H = 392 * MiB;
constexpr size_t WS_BIG = 552 * MiB;
constexpr size_t WS_U = WS_BIG, WS_Q = WS_BIG + 40 * MiB, WS_K = WS_BIG + 120 * MiB, WS_V = WS_BIG + 200 * MiB, WS_AO = WS_BIG + 280 * MiB, WS_E = WS_BIG + 400 * MiB, WS_EC = WS_BIG + 440 * MiB;
static_assert(WS_V - WS_K == WS_K - WS_Q, "q/k/v equally spaced");
constexpr size_t WS_Z = WS_BIG, WS_GB = WS_BIG + 160 * MiB, WS_A2 = WS_BIG + 320 * MiB;
constexpr size_t WS_END = WS_BIG + 640 * MiB;
constexpr int CW_TMO = 0, CW_BAR = 4096;

constexpr int RING_BYTES = 131072;
constexpr int LDSCTL_OFF = RING_BYTES, MISC_OFF = LDSCTL_OFF + 320;
constexpr int LDS_BYTES = 147456;
static_assert(att::LDS_BYTES <= RING_BYTES && s5::LDS_BYTES <= RING_BYTES, "phase scratch fits the ring region");
constexpr int NWAVES = 8;

typedef GAS unsigned gu32;
#define RLX_AGENT __ATOMIC_RELAXED, __HIP_MEMORY_SCOPE_AGENT
#define LDS_WAIT() asm volatile("s_waitcnt lgkmcnt(0)" ::: "memory")
#define VM_WAIT() asm volatile("s_waitcnt vmcnt(0)" ::: "memory")

#define XB_TMO      128
#define XB_XCNT(j)  (256  + 64 * (j))
#define XB_XSUB(j)  (1280 + 64 * (j))
#define XB_XGEN(j)  (2304 + 64 * (j))
#define XB_TOP      3328
#define XB_TOPGEN   3392
#define XCD_BAR_WORDS 3456
#define XB_SPIN_CAP (1u << 18)
__device__ __forceinline__ unsigned xb_ld(unsigned* p)              { return __hip_atomic_load(p, __ATOMIC_RELAXED, __HIP_MEMORY_SCOPE_AGENT); }
__device__ __forceinline__ unsigned xb_add(unsigned* p, unsigned v) { return __hip_atomic_fetch_add(p, v, __ATOMIC_RELAXED, __HIP_MEMORY_SCOPE_AGENT); }
__device__ __forceinline__ unsigned xb_xcc_id() { return (unsigned)__builtin_amdgcn_s_getreg((3 << 11) | 20) & 0xFu; }
#define XB_SPIN(cond, bar) do { unsigned _sp = 0; while (cond) { __builtin_amdgcn_s_sleep(1); \
    if ((++_sp & 255u) == 0u) { if (xb_ld(&(bar)[XB_TMO])) break; if (_sp > XB_SPIN_CAP) { atomicAdd(&(bar)[XB_TMO], 1u); break; } } } } while (0)
struct XcdBarrier { unsigned* bar; unsigned x; volatile LAS unsigned* st; };
__device__ __forceinline__ XcdBarrier xcd_barrier_post(unsigned* bar, volatile LAS unsigned* st) {
    XcdBarrier b; b.bar = bar; b.x = xb_xcc_id(); b.st = st;
    if (threadIdx.x == 0) (void)xb_add(&bar[XB_XCNT(b.x)], 1u);
    return b;
}
__device__ __forceinline__ void xcd_barrier_complete(unsigned* bar, unsigned x, unsigned& nloc, unsigned& nx) {
    const unsigned G = gridDim.x * gridDim.y * gridDim.z;
    unsigned sum, cnt, mine, sp = 0u;
    for (;;) {
        sum = 0u; cnt = 0u; mine = 0u;
#pragma unroll
        for (unsigned j = 0; j < 16; ++j) { const unsigned c = xb_ld(&bar[XB_XCNT(j)]); sum += c; cnt += (c > 0u) ? 1u : 0u; mine = (j == x) ? c : mine; }
        if (sum == G) break;
        __builtin_amdgcn_s_sleep(1);
        if ((++sp & 255u) == 0u) { if (xb_ld(&bar[XB_TMO])) break; if (sp > XB_SPIN_CAP) { atomicAdd(&bar[XB_TMO], 1u); break; } }
    }
    nloc = mine > 0u ? mine : 1u; nx = cnt > 0u ? cnt : 1u;
}
__device__ __forceinline__ void xcd_barrier(const XcdBarrier& b, const int wv) {
    asm volatile("s_waitcnt vmcnt(0)" ::: "memory");
    __syncthreads();
    if (wv == 0 && lane_id_opaque() == 0) {
        unsigned* bar = b.bar; asm volatile("" : "+s"(bar));
        __builtin_amdgcn_s_waitcnt(0);
        unsigned nloc = b.st[0], nx = b.st[1];
        if (nloc == 0u) { xcd_barrier_complete(bar, b.x, nloc, nx); b.st[0] = nloc; b.st[1] = nx; }
        const unsigned old = xb_add(&bar[XB_XSUB(b.x)], 1u);
        const unsigned gen = old / nloc;
        if (old + 1u == (gen + 1u) * nloc) {
            __builtin_amdgcn_fence(__ATOMIC_RELEASE, "agent");
            asm volatile("s_waitcnt vmcnt(0)" ::: "memory");
            const unsigned og = xb_add(&bar[XB_TOP], 1u);
            const unsigned tg = og / nx;
            if (og + 1u == (tg + 1u) * nx) xb_add(&bar[XB_TOPGEN], 1u);
            else XB_SPIN(xb_ld(&bar[XB_TOPGEN]) == tg, bar);
            __builtin_amdgcn_fence(__ATOMIC_ACQUIRE, "agent");
            xb_add(&bar[XB_XGEN(b.x)], 1u);
            asm volatile("s_waitcnt vmcnt(0)" ::: "memory");
        } else {
            XB_SPIN(xb_ld(&bar[XB_XGEN(b.x)]) == gen, bar);
            __builtin_amdgcn_fence(__ATOMIC_ACQUIRE, "agent");
            asm volatile("s_waitcnt vmcnt(0)" ::: "memory");
        }
    }
    __syncthreads();
}

struct Args { const float* in[33]; float* out; unsigned char* ws; int ph_lo, ph_hi; };
enum { I_XP = 0, I_XS, I_C, I_CK, I_CV, I_SRE, I_SIM, I_CCTX, I_ADAW, I_ADAB, I_N1G, I_N2G, I_ABWIN, I_ABWOUT, I_LAMRE, I_LAMIM, I_LOGDT, I_BRE, I_BIM, I_CRE, I_CIM, I_S5D,
       I_GLUW, I_GLUB, I_QNG, I_KNG, I_RPB, I_CVWIN, I_CVW, I_CVB, I_CVWOUT, I_W1, I_W2 };
constexpr size_t O_X = 0, O_CK = (size_t)MTOK * DM, O_CV = O_CK + (size_t)32 * 2 * 256 * 1024, O_SRE = O_CV + (size_t)32 * 2 * 256 * 1024, O_SIM = O_SRE + 32 * 2 * 2 * 32 * 64;

__device__ __forceinline__ float lane_xor(float v, int lane, int m) { return __uint_as_float((unsigned)__builtin_amdgcn_ds_bpermute((lane ^ m) << 2, (int)__float_as_uint(v))); }
__device__ __forceinline__ float wave_sum(float v, int lane) {
#pragma unroll
    for (int o = 1; o < 64; o <<= 1) v += lane_xor(v, lane, o);
    return v;
}
__device__ __forceinline__ unsigned pk2(float lo, float hi) { return cvtpk(lo, hi); }
__device__ __forceinline__ float wave_sum_dpp(float v) {
    v += __uint_as_float((unsigned)__builtin_amdgcn_update_dpp(0, (int)__float_as_uint(v), 0x128, 0xf, 0xf, false));
    v += __uint_as_float((unsigned)__builtin_amdgcn_update_dpp(0, (int)__float_as_uint(v), 0x124, 0xf, 0xf, false));
    v += __uint_as_float((unsigned)__builtin_amdgcn_update_dpp(0, (int)__float_as_uint(v), 0x122, 0xf, 0xf, false));
    v += __uint_as_float((unsigned)__builtin_amdgcn_update_dpp(0, (int)__float_as_uint(v), 0x121, 0xf, 0xf, false));
    { auto t = __builtin_amdgcn_permlane16_swap(__float_as_uint(v), __float_as_uint(v), false, false); v = __uint_as_float(t[0]) + __uint_as_float(t[1]); }
    { auto t = __builtin_amdgcn_permlane32_swap(__float_as_uint(v), __float_as_uint(v), false, false); v = __uint_as_float(t[0]) + __uint_as_float(t[1]); }
    return v;
}

__device__ __forceinline__ int dest_row(int n0, int mode) {
    if (mode == 0) return n0;
    if (n0 < 2048) return 4096 + n0;
    if (n0 < 4096) { const int c = n0 - 2048; return (c >> 7) * 256 + (c & 127); }
    const int c = n0 - 4096; return (c >> 7) * 256 + 128 + (c & 127);
}
__device__ __forceinline__ void p0_transpose_item(const float* W, int K, int N, bf16_t* WT, int mode, LAS unsigned* T, int item, int lane) {
    const int nblk = N / 128, kb = item / nblk, nb = item % nblk, k0 = 64 * kb, n0 = 128 * nb;
    const int lr = lane >> 5, lc = lane & 31;
    const float* src = W + (size_t)(k0 + 2 * lr) * N + n0 + 4 * lc;
#pragma unroll 4
    for (int q = 0; q < 16; ++q) { const f32x4 a = *(const f32x4*)(src + (size_t)(4 * q) * N), b = *(const f32x4*)(src + (size_t)(4 * q + 1) * N);
        const int kp = 2 * q + lr; u32x4 w; w.x = pk2(a[0], b[0]); w.y = pk2(a[1], b[1]); w.z = pk2(a[2], b[2]); w.w = pk2(a[3], b[3]);
        *(LAS u32x4*)(T + kp * 128 + ((4 * lc) ^ (((kp >> 2) & 7) << 2))) = w; }
    LDS_WAIT(); asm volatile("" ::: "memory");
    const int kq = lane & 7, nl = lane >> 3; const int r0 = dest_row(n0, mode);
#pragma unroll 4
    for (int j = 0; j < 16; ++j) { const int n = nl + 8 * j; u32x4 o;
        o.x = T[(4 * kq + 0) * 128 + (n ^ (kq << 2))]; o.y = T[(4 * kq + 1) * 128 + (n ^ (kq << 2))]; o.z = T[(4 * kq + 2) * 128 + (n ^ (kq << 2))]; o.w = T[(4 * kq + 3) * 128 + (n ^ (kq << 2))];
        *(GAS u32x4*)(WT + (size_t)(r0 + n) * K + k0 + 8 * kq) = o; }
    LDS_WAIT(); asm volatile("" ::: "memory");
}
__device__ __forceinline__ void sincos_d(double x, double& s, double& c) {
    const double k = rint(x * 0.63661977236758134308);
    double r = fma(-k, 1.5707963267948966, x); r = fma(-k, 6.123233995736766e-17, r);
    const double r2 = r * r;
    double ps = 1.0 / 355687428096000.0;
    ps = fma(ps, r2, -1.0 / 1307674368000.0); ps = fma(ps, r2, 1.0 / 6227020800.0); ps = fma(ps, r2, -1.0 / 39916800.0); ps = fma(ps, r2, 1.0 / 362880.0);
    ps = fma(ps, r2, -1.0 / 5040.0); ps = fma(ps, r2, 1.0 / 120.0); ps = fma(ps, r2, -1.0 / 6.0); ps = fma(ps * r2, r, r);
    double pc = 1.0 / 6402373705728000.0;
    pc = fma(pc, r2, -1.0 / 20922789888000.0); pc = fma(pc, r2, 1.0 / 87178291200.0); pc = fma(pc, r2, -1.0 / 479001600.0); pc = fma(pc, r2, 1.0 / 3628800.0);
    pc = fma(pc, r2, -1.0 / 40320.0); pc = fma(pc, r2, 1.0 / 720.0); pc = fma(pc, r2, -1.0 / 24.0); pc = fma(pc, r2, 0.5); pc = fma(-pc, r2, 1.0);
    const int q = ((int)k) & 3;
    s = (q == 0) ? ps : (q == 1) ? pc : (q == 2) ? -ps : -pc;
    c = (q == 0) ? pc : (q == 1) ? -ps : (q == 2) ? -pc : ps;
}
__device__ __forceinline__ double exp_small_d(double x) {
    double p = 1.0 / 87178291200.0;
    p = fma(p, x, 1.0 / 6227020800.0); p = fma(p, x, 1.0 / 479001600.0); p = fma(p, x, 1.0 / 39916800.0); p = fma(p, x, 1.0 / 3628800.0); p = fma(p, x, 1.0 / 362880.0);
    p = fma(p, x, 1.0 / 40320.0); p = fma(p, x, 1.0 / 5040.0); p = fma(p, x, 1.0 / 720.0); p = fma(p, x, 1.0 / 120.0); p = fma(p, x, 1.0 / 24.0); p = fma(p, x, 1.0 / 6.0);
    p = fma(p, x, 0.5); p = fma(p, x, 1.0); p = fma(p, x, 1.0); return p;
}
__device__ __forceinline__ double exp_d(double x) {
    const double k = rint(x * 1.4426950408889634); const double r = fma(-k, 0.6931471805599453, x) ;
    double e = exp_small_d(r * 0.25); e = e * e; e = e * e;
    return ldexp(e, (int)k);
}

struct Frame {
    LAS unsigned char* lds;
    int wave, vcu, G;
    const float* const* in;
    float* out; unsigned char* ws;
};

__device__ __forceinline__ void p0_ada_item(Frame& F, int item) {
    const int lane = lane_id_opaque(), tid = F.wave * 64 + lane; (void)tid;
    const int l = item / 48, cb = item % 48;
    LAS float* sl = (LAS float*)F.lds;
    for (int i = tid; i < 9 * 2048; i += 512) { const int j = i / 2048, k = i % 2048; const float c = j == 0 ? F.in[I_CCTX][k] : F.in[I_C][(j - 1) * 2048 + k]; sl[k * 12 + j] = c / (1.f + __expf(-c)); }
    __syncthreads();
    const float* W = F.in[I_ADAW] + (size_t)l * 2048 * 12288 + (size_t)(F.wave * 256) * 12288 + cb * 256 + lane * 4;
    f32x4 acc[9];
#pragma unroll
    for (int j = 0; j < 9; ++j) acc[j] = (f32x4){0.f, 0.f, 0.f, 0.f};
    for (int k0 = 0; k0 < 256; k0 += 8) {
        f32x4 w[8];
#pragma unroll
        for (int u = 0; u < 8; ++u) w[u] = *(const f32x4*)(W + (size_t)(k0 + u) * 12288);
#pragma unroll
        for (int u = 0; u < 8; ++u) { const LAS f32x4* sp = (const LAS f32x4*)(sl + (F.wave * 256 + k0 + u) * 12);
            const f32x4 s0 = sp[0], s1 = sp[1], s2 = sp[2];
            acc[0] += w[u] * s0[0]; acc[1] += w[u] * s0[1]; acc[2] += w[u] * s0[2]; acc[3] += w[u] * s0[3];
            acc[4] += w[u] * s1[0]; acc[5] += w[u] * s1[1]; acc[6] += w[u] * s1[2]; acc[7] += w[u] * s1[3]; acc[8] += w[u] * s2[0]; }
    }
    __syncthreads();
    LAS f32x4* pp = (LAS f32x4*)F.lds;
#pragma unroll
    for (int j = 0; j < 9; ++j) pp[(F.wave * 9 + j) * 64 + lane] = acc[j];
    __syncthreads();
    float* ADA = (float*)(F.ws + WS_ADA) + (size_t)l * 9 * 12288;
    const float* bias = F.in[I_ADAB] + (size_t)l * 12288;
    for (int i = tid; i < 9 * 64; i += 512) { const int j = i / 64, q = i % 64; f32x4 s = pp[(0 * 9 + j) * 64 + q];
#pragma unroll
        for (int w = 1; w < 8; ++w) s += pp[(w * 9 + j) * 64 + q];
        const int col = cb * 256 + q * 4; s += *(const f32x4*)(bias + col);
        *(f32x4*)(ADA + (size_t)j * 12288 + col) = s; }
    __syncthreads();
}
__device__ __forceinline__ void p0_s5_tables(Frame& F) {
    const int lane = lane_id_opaque(), tid = F.wave * 64 + lane; (void)tid;
    const int gt = F.vcu * 512 + tid;
    if (gt >= 2 * 2 * 32 * 64) return;
    const int p = gt & 63, g = (gt >> 6) & 31, dir = (gt >> 11) & 1, e = gt >> 12;
    const int gi = (e * 2 + dir) * 32 + g;
    const double lre = (double)F.in[I_LAMRE][gi * 64 + p], lim = (double)F.in[I_LAMIM][gi * 64 + p];
    const double dt = exp_d((double)F.in[I_LOGDT][gi]);
    const double ar = lre * dt, ai = lim * dt;
    double s, c; sincos_d(ai, s, c); const double dec = exp_d(ar);
    const double are = dec * c, aim = dec * s;
    double sT, cT; sincos_d(ai * S5T, sT, cT); const double decT = exp_d(ar * S5T);
    float4* A = (float4*)(F.ws + WS_S5A);
    A[gi * 64 + p] = make_float4((float)are, (float)aim, (float)(decT * cT), (float)(decT * sT));
    { double s4, c4; sincos_d(ai * (4 * S5T), s4, c4); const double dec4 = exp_d(ar * (4 * S5T));
      ((float2*)(F.ws + WS_S5A128))[gi * 64 + p] = make_float2((float)(dec4 * c4), (float)(dec4 * s4)); }
    const double den = lre * lre + lim * lim, nr = are - 1.0;
    const double fre = (nr * lre + aim * lim) / den, fim = (aim * lre - nr * lim) / den;
    bf16_t* BB = (bf16_t*)(F.ws + WS_S5BB) + (size_t)gi * 2048;
    const float* bre = F.in[I_BRE] + ((size_t)gi * 64 + p) * 16; const float* bim = F.in[I_BIM] + ((size_t)gi * 64 + p) * 16;
#pragma unroll
    for (int n = 0; n < 16; ++n) { const double br = bre[n], bi = bim[n];
        BB[(0 * 64 + p) * 16 + n] = f2bf((float)(fre * br - fim * bi)); BB[(1 * 64 + p) * 16 + n] = f2bf((float)(fre * bi + fim * br)); }
    bf16_t* CM = (bf16_t*)(F.ws + WS_S5CM) + (size_t)gi * 2048;
    const float* cre = F.in[I_CRE] + (size_t)gi * 16 * 64; const float* cim = F.in[I_CIM] + (size_t)gi * 16 * 64;
#pragma unroll
    for (int n = 0; n < 16; ++n) { CM[n * 128 + 2 * p] = f2bf(cre[n * 64 + p]); CM[n * 128 + 2 * p + 1] = f2bf(-cim[n * 64 + p]); }
}
__device__ __forceinline__ void p0_prologue(Frame& F) {
    const int lane = lane_id_opaque(), tid = F.wave * 64 + lane; (void)tid;
    if (F.vcu < 192) p0_ada_item(F, F.vcu);
    p0_s5_tables(F);
    { const size_t n8 = (size_t)8 * 2 * 256 * 1024 / 8; const size_t gth = (size_t)F.vcu * 512 + tid, nth = (size_t)F.G * 512;
      for (size_t i = gth; i < 2 * n8; i += nth) { const bool isk = i < n8; const size_t j = isk ? i : i - n8;
        const float* src = (isk ? F.in[I_CK] : F.in[I_CV]) + j * 8; bf16_t* dst = (bf16_t*)(F.ws + (isk ? WS_CK : WS_CV)) + j * 8;
        const f32x4 a = *(const f32x4*)src, b = *(const f32x4*)(src + 4);
        u32x4 o; o.x = pk2(a[0], a[1]); o.y = pk2(a[2], a[3]); o.z = pk2(b[0], b[1]); o.w = pk2(b[2], b[3]); *(u32x4*)dst = o; } }
    LAS unsigned* scr = (LAS unsigned*)(F.lds + F.wave * 16384);
    const int gw = F.vcu * NWAVES + F.wave, NGW = F.G * NWAVES;
    constexpr int I_ABI = 32 * 28, I_ABO = 24 * 16, I_CVI = 32 * 48, I_CVO = 32 * 16, I_UP = 32 * 64, I_DN = 128 * 16, I_GLU = 8 * 4;
    constexpr int NITEMS = 2 * I_ABI + 2 * I_ABO + 2 * I_CVI + 2 * I_CVO + 4 * I_UP + 4 * I_DN + 2 * I_GLU;
    for (int it = gw; it < NITEMS; it += NGW) {
        int r = it;
        if (r < 2 * I_ABI) { const int e = r / I_ABI; p0_transpose_item(F.in[I_ABWIN] + (size_t)e * DM * ABIN, DM, ABIN, (bf16_t*)(F.ws + WS_WABIN) + (size_t)e * ABIN * DM, 0, scr, r % I_ABI, lane); continue; } r -= 2 * I_ABI;
        if (r < 2 * I_ABO) { const int e = r / I_ABO; p0_transpose_item(F.in[I_ABWOUT] + (size_t)e * ABOUT * DM, ABOUT, DM, (bf16_t*)(F.ws + WS_WABOUT) + (size_t)e * DM * ABOUT, 0, scr, r % I_ABO, lane); continue; } r -= 2 * I_ABO;
        if (r < 2 * I_CVI) { const int e = r / I_CVI; p0_transpose_item(F.in[I_CVWIN] + (size_t)e * DM * 3 * DM, DM, 3 * DM, (bf16_t*)(F.ws + WS_WCVIN) + (size_t)e * 3 * DM * DM, 1, scr, r % I_CVI, lane); continue; } r -= 2 * I_CVI;
        if (r < 2 * I_CVO) { const int e = r / I_CVO; p0_transpose_item(F.in[I_CVWOUT] + (size_t)e * DM * DM, DM, DM, (bf16_t*)(F.ws + WS_WCVOUT) + (size_t)e * DM * DM, 0, scr, r % I_CVO, lane); continue; } r -= 2 * I_CVO;
        if (r < 4 * I_UP) { const int e = r / I_UP; p0_transpose_item(F.in[I_W1] + (size_t)e * DM * DFF, DM, DFF, (bf16_t*)(F.ws + WS_WUP) + (size_t)e * DFF * DM, 0, scr, r % I_UP, lane); continue; } r -= 4 * I_UP;
        if (r < 4 * I_DN) { const int e = r / I_DN; p0_transpose_item(F.in[I_W2] + (size_t)e * DFF * DM, DFF, DM, (bf16_t*)(F.ws + WS_WDN) + (size_t)e * DM * DFF, 0, scr, r % I_DN, lane); continue; } r -= 4 * I_DN;
        { const int e = r / I_GLU; p0_transpose_item(F.in[I_GLUW] + (size_t)e * S5W * S5W, S5W, S5W, (bf16_t*)(F.ws + WS_WGLU) + (size_t)e * S5W * S5W, 0, scr, r % I_GLU, lane); }
    }
}

__device__ __forceinline__ const bf16_t* wt_of_norm(const unsigned char* ws, int s, int& N) {
    const int l = s >> 1;
    if (s & 1) { N = DFF; return (const bf16_t*)(ws + WS_WUP) + (size_t)l * DFF * DM; }
    if (l & 1) { N = 3 * DM; return (const bf16_t*)(ws + WS_WCVIN) + (size_t)(l >> 1) * 3 * DM * DM; }
    N = ABIN; return (const bf16_t*)(ws + WS_WABIN) + (size_t)(l >> 1) * ABIN * DM;
}
__device__ __forceinline__ void pre_phase(Frame& F) {
    const int lane = lane_id_opaque(), wave = F.wave, tid = wave * 64 + lane;
    unsigned char* ws = F.ws; asm volatile("" : "+s"(ws));
    const int gw = F.vcu * NWAVES + wave, NGW = F.G * NWAVES;
    const float* ADA0 = (const float*)(ws + WS_ADA);
    { float* GV = (float*)(ws + WS_GV);
      for (int i = F.vcu * 512 + tid; i < 8 * 9 * DM; i += F.G * 512) { const int s = i / (9 * DM), r = i % (9 * DM), j = r / DM, col = r % DM, l = s >> 1, which = s & 1;
        GV[i] = F.in[which ? I_N2G : I_N1G][l * DM + col] * (1.f + ADA0[((size_t)l * 9 + j) * 12288 + (which ? 4 : 1) * DM + col]); } }
    { bf16_t* H = (bf16_t*)(ws + WS_H); float* SSQ = (float*)(ws + WS_SSQ); const float* gn = F.in[I_N1G];
      for (int m = gw; m < MTOK; m += NGW) {
        const float* xrow = m < NCTX ? F.in[I_XP] + (size_t)m * DM : F.in[I_XS] + (size_t)(m - NCTX) * DM;
        const f32x4* xr = (const f32x4*)xrow + lane;
        const float* ad = ADA0 + (size_t)ada_row_of_token(m) * 12288;
        u32x2* o8 = (u32x2*)(H + (size_t)m * DM) + lane; float sq = 0.f;
#pragma unroll
        for (int j = 0; j < 8; ++j) { const int col = 4 * lane + 256 * j; const f32x4 v = xr[64 * j];
            sq += (v[0] * v[0] + v[1] * v[1]) + (v[2] * v[2] + v[3] * v[3]);
            const f32x4 g = *(const f32x4*)(gn + col), sc = *(const f32x4*)(ad + DM + col);
            const f32x4 h = v * g * (sc + 1.f);
            u32x2 w; w.x = pk2(h[0], h[1]); w.y = pk2(h[2], h[3]); o8[64 * j] = w; }
        sq = wave_sum_dpp(sq);
        if (lane == 0) SSQ[m] = sq; } }
    { LAS float* sh = (LAS float*)F.lds; float* BIAS = (float*)(ws + WS_BIAS);
#pragma unroll 1
      for (int s = 0; s < 8; ++s) { const int l = s >> 1, which = s & 1;
        __syncthreads();
        for (int i = tid; i < 9 * DM; i += 512) { const int j = i / DM, k = i % DM; sh[i] = ADA0[((size_t)l * 9 + j) * 12288 + (which ? 3 : 0) * DM + k]; }
        __syncthreads();
        int N; const bf16_t* Wt = wt_of_norm(ws, s, N);
        for (int n0 = gw * 2; n0 < N; n0 += NGW * 2) {
            u32x4 w[2][4];
#pragma unroll
            for (int r = 0; r < 2; ++r)
#pragma unroll
                for (int i = 0; i < 4; ++i) w[r][i] = *(const GAS u32x4*)(Wt + (size_t)(n0 + r) * DM + 8 * lane + 512 * i);
            float acc[2][9];
#pragma unroll
            for (int r = 0; r < 2; ++r)
#pragma unroll
                for (int j = 0; j < 9; ++j) acc[r][j] = 0.f;
            asm volatile("s_waitcnt vmcnt(0)" ::: "memory");
#pragma unroll
            for (int i = 0; i < 4; ++i)
#pragma unroll
                for (int j = 0; j < 9; ++j) { const LAS f32x4* sp = (const LAS f32x4*)(sh + j * DM + 8 * lane + 512 * i); const f32x4 s0 = sp[0], s1 = sp[1];
#pragma unroll
                    for (int r = 0; r < 2; ++r) acc[r][j] += (bflo(w[r][i][0]) * s0[0] + bfhi(w[r][i][0]) * s0[1]) + (bflo(w[r][i][1]) * s0[2] + bfhi(w[r][i][1]) * s0[3])
                                                          + (bflo(w[r][i][2]) * s1[0] + bfhi(w[r][i][2]) * s1[1]) + (bflo(w[r][i][3]) * s1[2] + bfhi(w[r][i][3]) * s1[3]);
                    asm volatile("" : "+v"(acc[0][j]), "+v"(acc[1][j]) :: "memory"); }
#pragma unroll
            for (int r = 0; r < 2; ++r)
#pragma unroll
                for (int j = 0; j < 9; ++j) { const float t = wave_sum_dpp(acc[r][j]); if (lane == 0) BIAS[((size_t)s * 9 + j) * DFF + n0 + r] = t; }
        } }
      __syncthreads(); }
}
__device__ __forceinline__ void qknorm_phase(Frame& F, int e) {
    const int lane = lane_id_opaque(), wave = F.wave, tid = wave * 64 + lane; (void)tid;
    unsigned char* ws = F.ws; asm volatile("" : "+s"(ws));

    const int gw = F.vcu * NWAVES + wave, NGW = F.G * NWAVES;
    bf16_t* Q = (bf16_t*)(ws + WS_Q); bf16_t* Kb = (bf16_t*)(ws + WS_K); const bf16_t* V = (const bf16_t*)(ws + WS_V);
    const int d0 = (lane & 7) * 16;
    float gq[16], gk[16];
#pragma unroll
    for (int i = 0; i < 16; ++i) { gq[i] = F.in[I_QNG][e * 128 + d0 + i]; gk[i] = F.in[I_KNG][e * 128 + d0 + i]; }
    for (int m = gw; m < MTOK; m += NGW) {
#pragma unroll
        for (int t = 0; t < 2; ++t) {
            bf16_t* row = (t ? Kb : Q) + (size_t)m * 1024 + lane * 16;
            const u32x4 a = *(const u32x4*)row, b = *(const u32x4*)(row + 8);
            float x[16];
#pragma unroll
            for (int i = 0; i < 4; ++i) { x[2 * i] = bflo(a[i]); x[2 * i + 1] = bfhi(a[i]); x[8 + 2 * i] = bflo(b[i]); x[8 + 2 * i + 1] = bfhi(b[i]); }
            float s = 0.f;
#pragma unroll
            for (int i = 0; i < 16; ++i) s += x[i] * x[i];
            s += lane_xor(s, lane, 1); s += lane_xor(s, lane, 2); s += lane_xor(s, lane, 4);
            const float rstd = 1.f / sqrtf(s * (1.f / 128.f) + NORM_EPS);
#pragma unroll
            for (int i = 0; i < 16; ++i) x[i] = x[i] * rstd * (t ? gk[i] : gq[i]);
            u32x4 oa, ob;
#pragma unroll
            for (int i = 0; i < 4; ++i) { oa[i] = pk2(x[2 * i], x[2 * i + 1]); ob[i] = pk2(x[8 + 2 * i], x[8 + 2 * i + 1]); }
            *(u32x4*)row = oa; *(u32x4*)(row + 8) = ob;
            if (t == 1 && m < NCTX) { const int b_ = m >> 8, tt = m & 255; float* o = F.out + O_CK + (((size_t)b_ * 2 + e) * 256 + tt) * 1024 + lane * 16;
#pragma unroll
                for (int i = 0; i < 4; ++i) *(f32x4*)(o + 4 * i) = (f32x4){x[4 * i], x[4 * i + 1], x[4 * i + 2], x[4 * i + 3]}; }
        }
        if (m < NCTX) { const int b_ = m >> 8, tt = m & 255; float* o = F.out + O_CV + (((size_t)b_ * 2 + e) * 256 + tt) * 1024 + lane * 16;
            const bf16_t* row = V + (size_t)m * 1024 + lane * 16; const u32x4 a = *(const u32x4*)row, b = *(const u32x4*)(row + 8);
            *(f32x4*)(o + 0) = (f32x4){bflo(a[0]), bfhi(a[0]), bflo(a[1]), bfhi(a[1])}; *(f32x4*)(o + 4) = (f32x4){bflo(a[2]), bfhi(a[2]), bflo(a[3]), bfhi(a[3])};
            *(f32x4*)(o + 8) = (f32x4){bflo(b[0]), bfhi(b[0]), bflo(b[1]), bfhi(b[1])}; *(f32x4*)(o + 12) = (f32x4){bflo(b[2]), bfhi(b[2]), bflo(b[3]), bfhi(b[3])}; }
    }
}
__device__ __forceinline__ void conv_phase(Frame& F, int o) {
    const int lane = lane_id_opaque(), wave = F.wave, tid = wave * 64 + lane; (void)tid;
    unsigned char* ws = F.ws; asm volatile("" : "+s"(ws));

    const int gw = F.vcu * NWAVES + wave, NGW = F.G * NWAVES;
    const bf16_t* Z = (const bf16_t*)(ws + WS_Z); const bf16_t* GB = (const bf16_t*)(ws + WS_GB); bf16_t* A2 = (bf16_t*)(ws + WS_A2);
    const float* cw = F.in[I_CVW] + (size_t)o * 3 * DM; const float* cb = F.in[I_CVB] + (size_t)o * DM;
    for (int it = gw; it < (MTOK / 16) * 4; it += NGW) {
        const int rc = it >> 2, cq = it & 3, m0 = rc * 16, col = cq * 512 + lane * 8;
        float w0[8], w1[8], w2[8], bb[8];
#pragma unroll
        for (int i = 0; i < 8; ++i) { w0[i] = cw[col + i]; w1[i] = cw[DM + col + i]; w2[i] = cw[2 * DM + col + i]; bb[i] = cb[col + i]; }
        const int L = m0 < NCTX ? CTX_L : LAT_L; const int t0 = (m0 < NCTX ? m0 : m0 - NCTX) % L;
        u32x4 zp = (u32x4){0u, 0u, 0u, 0u}, zc, zn;
        if (t0 > 0) zp = *(const u32x4*)(Z + (size_t)(m0 - 1) * DM + col);
        zc = *(const u32x4*)(Z + (size_t)m0 * DM + col);
#pragma unroll 4
        for (int r = 0; r < 16; ++r) { const int m = m0 + r;
            zn = (u32x4){0u, 0u, 0u, 0u}; if (t0 + r + 1 < L) zn = *(const u32x4*)(Z + (size_t)(m + 1) * DM + col);
            const u32x4 gb = *(const u32x4*)(GB + (size_t)m * DM + col);
            float ov[8];
#pragma unroll
            for (int i = 0; i < 4; ++i) {
                const float c0 = w0[2 * i] * bflo(zp[i]) + w1[2 * i] * bflo(zc[i]) + w2[2 * i] * bflo(zn[i]) + bb[2 * i];
                const float c1 = w0[2 * i + 1] * bfhi(zp[i]) + w1[2 * i + 1] * bfhi(zc[i]) + w2[2 * i + 1] * bfhi(zn[i]) + bb[2 * i + 1];
                ov[2 * i] = bflo(gb[i]) * c0; ov[2 * i + 1] = bfhi(gb[i]) * c1; }
            u32x4 ow; ow.x = pk2(ov[0], ov[1]); ow.y = pk2(ov[2], ov[3]); ow.z = pk2(ov[4], ov[5]); ow.w = pk2(ov[6], ov[7]);
            *(u32x4*)(A2 + (size_t)m * DM + col) = ow;
            zp = zc; zc = zn; }
    }
}
#ifndef ATT_SDEPTH
#define ATT_SDEPTH 2
#endif
__device__ __forceinline__ void attn_phase(Frame& F, int e) {
    const int lane = lane_id_opaque(), wave = F.wave, tid = wave * 64 + lane; (void)tid;
    unsigned char* ws = F.ws; asm volatile("" : "+s"(ws));

    const bf16_t* Q = (const bf16_t*)(ws + WS_Q); const bf16_t* Kb = (const bf16_t*)(ws + WS_K); const bf16_t* V = (const bf16_t*)(ws + WS_V);
    bf16_t* AO = (bf16_t*)(ws + WS_AO);
    const bf16_t* CK = (const bf16_t*)(ws + WS_CK); const bf16_t* CV = (const bf16_t*)(ws + WS_CV);
    LAS char* lds = (LAS char*)F.lds;
    for (int u = F.vcu; u < 1024 + 256; u += F.G) {
        __syncthreads();
        if (u < 1024) {
            const int b = u >> 7, h = (u >> 4) & 7, R = (u & 15) * 4;
            int kr0 = R - 4; kr0 = kr0 < 0 ? 0 : (kr0 > 52 ? 52 : kr0);
            LAS float* bl = (LAS float*)(lds + att::OFF_BIAS);
            { const int t2 = wave * 64 + lane_id_opaque();
              if (t2 < 15 * 32) { const int dr = t2 >> 5, dc = t2 & 31; bl[t2] = dc < 31 ? F.in[I_RPB][((size_t)(e * 8 + h) * 15 + dr) * 31 + dc] * 11.313708498984761f : 0.f; } }
            const size_t seq0 = (size_t)NCTX + (size_t)b * LAT_L;
            const bf16_t* Qb = Q + (seq0 + (size_t)R * 64) * 1024 + h * 128;
            const bf16_t* K0 = CK + (((size_t)b * 2 + e) * 256) * 1024 + h * 128; const bf16_t* V0 = CV + (((size_t)b * 2 + e) * 256) * 1024 + h * 128;
            const bf16_t* K1 = Kb + (seq0 + (size_t)kr0 * 64) * 1024 + h * 128; const bf16_t* V1 = V + (seq0 + (size_t)kr0 * 64) * 1024 + h * 128;
            bf16_t* Ob = AO + (seq0 + (size_t)R * 64) * ABOUT + S5W + h * 128;
            att::attn_unit<true, ATT_SDEPTH>(lds, Qb, K0, V0, 4, K1, V1, 16, Ob, ABOUT, R, kr0, wave);
        } else {
            const int uc = u - 1024, b = uc >> 3, h = uc & 7;
            const size_t seq0 = (size_t)b * CTX_L;
            const bf16_t* Qb = Q + seq0 * 1024 + h * 128; const bf16_t* K0 = Kb + seq0 * 1024 + h * 128; const bf16_t* V0 = V + seq0 * 1024 + h * 128;
            bf16_t* Ob = AO + seq0 * ABOUT + S5W + h * 128;
            att::attn_unit<false, ATT_SDEPTH>(lds, Qb, K0, V0, 4, K0, V0, 4, Ob, ABOUT, 0, 0, wave);
        }
    }
}

constexpr int NPHASE = 2 + 6 * NLAYER;
#ifndef REP_PRO
#define REP_PRO 1
#endif
#ifndef REP_PRE
#define REP_PRE 1
#endif
#ifndef REP_S5A
#define REP_S5A 1
#endif
#ifndef REP_S5B
#define REP_S5B 1
#endif
#ifndef REP_ATT
#define REP_ATT 1
#endif
#ifndef REP_CONV
#define REP_CONV 1
#endif
#ifndef REP_UP
#define REP_UP 1
#endif
#ifndef PG8_SP2
#define PG8_SP2 true
#endif
#ifndef PG8_ALIGN
#define PG8_ALIGN true
#endif

__global__ void __launch_bounds__(NWAVES * 64, 2) fwd(Args args) {
    extern __shared__ __attribute__((aligned(16))) unsigned char lds[];
    Frame F;
    F.lds = (LAS unsigned char*)lds;
    F.wave = __builtin_amdgcn_readfirstlane((int)threadIdx.x >> 6);
    F.G = gridDim.x; { const int bx = blockIdx.x; F.vcu = (F.G % 8 == 0) ? (bx % 8) * (F.G / 8) + bx / 8 : bx; }
    F.in = args.in; F.out = args.out; F.ws = args.ws;
    for (int u = threadIdx.x; u < (LDS_BYTES - LDSCTL_OFF) / 4; u += NWAVES * 64) ((LAS unsigned*)(F.lds + LDSCTL_OFF))[u] = 0u;
    __syncthreads();
    volatile LAS unsigned* MISC = (volatile LAS unsigned*)(F.lds + MISC_OFF);
    XcdBarrier bar = xcd_barrier_post((unsigned*)(F.ws + WS_CTL) + CW_BAR, MISC + 8);
#if MK_PER_PHASE
    const int lo = args.ph_lo, hi = args.ph_hi;
#else
    constexpr int lo = 0, hi = NPHASE;
#endif
#define IN(k) (lo <= (k) && (k) < hi)
#define SEAM(k) do { if (lo <= (k) && (k) + 1 < hi) xcd_barrier(bar, F.wave); } while (0)
#define OPAQUE_WS unsigned char* ws = F.ws; asm volatile("" : "+s"(ws)); int bxo = bx; asm volatile("" : "+s"(bxo)); (void)bxo
    LAS unsigned char* ring = F.lds;
    const int bx = (int)blockIdx.x;

    if (IN(0)) { for (int rep = 0; rep < REP_PRO; ++rep) { p0_prologue(F); __syncthreads(); } }
    SEAM(0);
    if (IN(1)) { for (int rep = 0; rep < REP_PRE; ++rep) pre_phase(F); }
    SEAM(1);
#pragma unroll 1
    for (int l = 0; l < NLAYER; ++l) {
        const int pb = 2 + 6 * l, e = l >> 1;
        const float* ADA = (const float*)(F.ws + WS_ADA) + (size_t)l * 9 * 12288;
        const float* rb0 = l == 0 ? F.in[I_XP] : F.out; const float* rb1 = l == 0 ? F.in[I_XS] - (size_t)NCTX * DM : F.out;
        if ((l & 1) == 0) {
            if (IN(pb + 0)) { OPAQUE_WS; pg8::Gemm g{(const bf16_t*)(ws + WS_H), (const bf16_t*)(ws + WS_WABIN) + (size_t)e * ABIN * DM, MTOK, ABIN, DM}; pg8::StaticOrder S; S.init(MTOK, ABIN, F.G, bxo);
                pg8::EpiAbIn E{(bf16_t*)(ws + WS_U), (bf16_t*)(ws + WS_Q), (size_t)(WS_K - WS_Q) / 2, pg8::NormIn{(const float*)(ws + WS_SSQ) + (size_t)(2 * l) * MTOK, (const float*)(ws + WS_BIAS) + (size_t)(2 * l) * 9 * DFF, DFF}};
                pg8::gemm_phase<pg8::EpiAbIn, pg8::StaticOrder, PG8_ALIGN, PG8_SP2>(ring, g, S, E, F.wave); }
            SEAM(pb + 0);
            if (IN(pb + 1)) { OPAQUE_WS; qknorm_phase(F, e);
                for (int rep = 0; rep < REP_S5A; ++rep) s5::phase_a(e, (const bf16_t*)(ws + WS_U), (const float4*)(ws + WS_S5A), (const bf16_t*)(ws + WS_S5BB), (float*)(ws + WS_E), (float*)(ws + WS_EC), F.G, F.vcu, F.wave); }
            SEAM(pb + 1);
            if (IN(pb + 2)) { OPAQUE_WS;
                for (int rep = 0; rep < REP_S5B; ++rep) s5::phase_b((LAS char*)F.lds, e, (const bf16_t*)(ws + WS_U), (const float4*)(ws + WS_S5A), (const float2*)(ws + WS_S5A128), (const bf16_t*)(ws + WS_S5BB), (const bf16_t*)(ws + WS_S5CM), (const float*)(ws + WS_E), (const float*)(ws + WS_EC),
                            F.in[I_SRE], F.in[I_SIM], F.in[I_S5D] + (size_t)e * S5W, (const bf16_t*)(ws + WS_WGLU) + (size_t)e * S5W * S5W, F.in[I_GLUB] + (size_t)e * S5W,
                            (bf16_t*)(ws + WS_AO), F.out + O_SRE, F.out + O_SIM, F.G, F.vcu, F.wave);
                for (int rep = 0; rep < REP_ATT; ++rep) attn_phase(F, e); }
            SEAM(pb + 2);
            if (IN(pb + 3)) { OPAQUE_WS; pg8::Gemm g{(const bf16_t*)(ws + WS_AO), (const bf16_t*)(ws + WS_WABOUT) + (size_t)e * DM * ABOUT, MTOK, DM, ABOUT}; pg8::StaticOrder S; S.init(MTOK, DM, F.G, bxo);
                pg8::EpiRes<true> E{rb0, rb1, F.out, ADA + 2 * DM, (const float*)(ws + WS_GV) + (size_t)(2 * l + 1) * 9 * DM, (bf16_t*)(ws + WS_H), (float*)(ws + WS_SSQ) + (size_t)(2 * l + 1) * MTOK};
                pg8::gemm_phase<pg8::EpiRes<true>, pg8::StaticOrder, PG8_ALIGN, PG8_SP2>(ring, g, S, E, F.wave); }
            SEAM(pb + 3);
        } else {
            if (IN(pb + 0)) { OPAQUE_WS; pg8::Gemm g{(const bf16_t*)(ws + WS_H), (const bf16_t*)(ws + WS_WCVIN) + (size_t)e * 3 * DM * DM, MTOK, 3 * DM, DM}; pg8::StaticOrder S; S.init(MTOK, 3 * DM, F.G, bxo);
                pg8::EpiConvIn E{(bf16_t*)(ws + WS_Z), (bf16_t*)(ws + WS_GB), pg8::NormIn{(const float*)(ws + WS_SSQ) + (size_t)(2 * l) * MTOK, (const float*)(ws + WS_BIAS) + (size_t)(2 * l) * 9 * DFF, DFF}};
                pg8::gemm_phase<pg8::EpiConvIn, pg8::StaticOrder, PG8_ALIGN, PG8_SP2>(ring, g, S, E, F.wave); }
            SEAM(pb + 0);
            if (IN(pb + 1)) { for (int rep = 0; rep < REP_CONV; ++rep) conv_phase(F, e); }
            SEAM(pb + 2);
            if (IN(pb + 3)) { OPAQUE_WS; pg8::Gemm g{(const bf16_t*)(ws + WS_A2), (const bf16_t*)(ws + WS_WCVOUT) + (size_t)e * DM * DM, MTOK, DM, DM}; pg8::StaticOrder S; S.init(MTOK, DM, F.G, bxo);
                pg8::EpiRes<true> E{rb0, rb1, F.out, ADA + 2 * DM, (const float*)(ws + WS_GV) + (size_t)(2 * l + 1) * 9 * DM, (bf16_t*)(ws + WS_H), (float*)(ws + WS_SSQ) + (size_t)(2 * l + 1) * MTOK};
                pg8::gemm_phase<pg8::EpiRes<true>, pg8::StaticOrder, PG8_ALIGN, PG8_SP2>(ring, g, S, E, F.wave); }
            SEAM(pb + 3);
        }
        if (IN(pb + 4)) { OPAQUE_WS; pg8::Gemm g{(const bf16_t*)(ws + WS_H), (const bf16_t*)(ws + WS_WUP) + (size_t)l * DFF * DM, MTOK, DFF, DM}; pg8::StaticOrder S; S.init(MTOK, DFF, F.G, bxo);
            pg8::EpiRelu2 E{(bf16_t*)(ws + WS_BIG), DFF, pg8::NormIn{(const float*)(ws + WS_SSQ) + (size_t)(2 * l + 1) * MTOK, (const float*)(ws + WS_BIAS) + (size_t)(2 * l + 1) * 9 * DFF, DFF}};
            for (int rep = 0; rep < REP_UP; ++rep) pg8::gemm_phase<pg8::EpiRelu2, pg8::StaticOrder, PG8_ALIGN, PG8_SP2>(ring, g, S, E, F.wave); }
        SEAM(pb + 4);
        if (IN(pb + 5)) { OPAQUE_WS; pg8::Gemm g{(const bf16_t*)(ws + WS_BIG), (const bf16_t*)(ws + WS_WDN) + (size_t)l * DM * DFF, MTOK, DM, DFF}; pg8::StaticOrder S; S.init(MTOK, DM, F.G, bxo);
            if (l < NLAYER - 1) { pg8::EpiRes<true> E{F.out, F.out, F.out, ADA + 5 * DM, (const float*)(ws + WS_GV) + (size_t)(2 * l + 2) * 9 * DM, (bf16_t*)(ws + WS_H), (float*)(ws + WS_SSQ) + (size_t)(2 * l + 2) * MTOK};
                pg8::gemm_phase<pg8::EpiRes<true>, pg8::StaticOrder, PG8_ALIGN, PG8_SP2>(ring, g, S, E, F.wave); }
            else { pg8::EpiRes<false> E{F.out, F.out, F.out, ADA + 5 * DM, nullptr, nullptr, nullptr};
                pg8::gemm_phase<pg8::EpiRes<false>, pg8::StaticOrder, PG8_ALIGN, PG8_SP2>(ring, g, S, E, F.wave); } }
        SEAM(pb + 5);
    }
#undef IN
#undef SEAM
#undef OPAQUE_WS
}

extern "C" void kernel_launch(void* const* d_in, const int* in_sizes, int n_in, void* d_out, int out_size, void* d_ws, size_t ws_size, hipStream_t stream) {
    static int grid = 0;
    if (grid == 0) {
        if (n_in != 33 || ws_size < WS_END) { fprintf(stderr, "kernel_launch: n_in %d ws %zu (need 33, >= %zu)\n", n_in, ws_size, (size_t)WS_END); grid = -1; return; }
        int dev = 0, cus = 0;
        if (hipGetDevice(&dev) != hipSuccess || hipDeviceGetAttribute(&cus, hipDeviceAttributeMultiprocessorCount, dev) != hipSuccess) { grid = -1; return; }
        if (hipFuncSetAttribute((const void*)fwd, hipFuncAttributeMaxDynamicSharedMemorySize, LDS_BYTES) != hipSuccess) { fprintf(stderr, "kernel_launch: hipFuncSetAttribute failed\n"); grid = -1; return; }
        int per_cu = 0;
        if (hipOccupancyMaxActiveBlocksPerMultiprocessor(&per_cu, (const void*)fwd, NWAVES * 64, LDS_BYTES) != hipSuccess || per_cu < 1) fprintf(stderr, "kernel_launch: occupancy query says %d\n", per_cu);
        (void)hipGetLastError();
        grid = cus;
    }
    if (grid < 0) return;
    (void)hipMemsetAsync((char*)d_ws + WS_CTL, 0, CTL_ZERO_BYTES, stream);
    Args a{};
    for (int i = 0; i < 33; ++i) a.in[i] = (const float*)d_in[i];
    a.out = (float*)d_out; a.ws = (unsigned char*)d_ws;
#if MK_PER_PHASE
    for (int p = 0; p < NPHASE; ++p) {
        if (p > 1) { const int l = (p - 2) / 6, k = (p - 2) % 6; if ((l & 1) && k == 2) continue; }
        a.ph_lo = p; a.ph_hi = p + 1;
        hipLaunchKernelGGL(fwd, dim3(grid), dim3(NWAVES * 64), LDS_BYTES, stream, a);
    }
#else
    a.ph_lo = 0; a.ph_hi = NPHASE;
    hipLaunchKernelGGL(fwd, dim3(grid), dim3(NWAVES * 64), LDS_BYTES, stream, a);
#endif
    const hipError_t le = hipPeekAtLastError();
    if (le != hipSuccess) fprintf(stderr, "kernel_launch: launch failed: %s\n", hipGetErrorName(le));
}
```

```cpp
#include <hip/hip_runtime.h>
#include <cstdio>
#include <cstdint>

#ifndef MK_PER_PHASE
#define MK_PER_PHASE 0
#endif

__device__ __forceinline__ int lane_id_opaque() { int l; asm volatile("v_mbcnt_lo_u32_b32 %0, -1, 0\n\tv_mbcnt_hi_u32_b32 %0, -1, %0" : "=v"(l)); return l; }

namespace pg8 {
#define PG8_LAS __attribute__((address_space(3)))
typedef unsigned short bf16_t;
typedef short bf16x8 __attribute__((ext_vector_type(8)));
typedef float f32x4 __attribute__((ext_vector_type(4)));
typedef unsigned u32x4 __attribute__((ext_vector_type(4)));
constexpr int BM = 256, BK = 64, HALF = 128, HTB = HALF * BK * 2  , STAGE_BYTES = 8 * HTB, NXCD = 8, WGM = 8;

__host__ __device__ __forceinline__ int lds_byte(int r, int c) { const int st = (r >> 4) * 2 + (c >> 5), rr = r & 15, cc = c & 31, ob = rr * 64 + cc * 2; return st * 1024 + (ob ^ (((ob >> 9) & 1) << 5)); }
__host__ __device__ __forceinline__ void stage_rc(int b, int& R, int& C) { const int st = b / 1024, sb = b % 1024, swz = sb ^ (((sb >> 9) & 1) << 5); R = (st >> 1) * 16 + swz / 64; C = (st & 1) * 32 + (swz % 64) / 2; }
__host__ __device__ __forceinline__ int perm32(int rho) { const int n = rho >> 4, i = rho & 15; return 8 * (i >> 2) + 4 * n + (i & 3); }

struct Unit { int pm, pn; };
struct Gemm { const bf16_t* A; const bf16_t* Bt; int M, N, K; };

struct StaticOrder {
    int nM, nN, nwg, G, c;
    __host__ __device__ void init(int M, int N, int G_, int c_) { nM = M / BM; nN = N / BM; nwg = nM * nN; G = G_; c = c_; }
    __host__ __device__ bool next(int i, Unit& u) const {
        const long L = (long)i * G + c; if (L >= nwg) return false;
        int wgid = (int)L; { const int q = nwg / NXCD, r = nwg % NXCD, xcd = wgid % NXCD, off = wgid / NXCD; wgid = (xcd < r ? xcd * (q + 1) : r * (q + 1) + (xcd - r) * q) + off; }
        const int nig = WGM * nN, gid = wgid / nig, fm = gid * WGM, gsz = (nM - fm) < WGM ? (nM - fm) : WGM;
        u.pm = fm + ((wgid % nig) % gsz); u.pn = (wgid % nig) / gsz; return true;
    }
    __device__ __forceinline__ void a_ready(const Unit&) const {}
    __device__ __forceinline__ void done(const Unit&) const {}
};

__device__ __forceinline__ unsigned cvt_pk_bf16(float lo, float hi) { unsigned r; asm volatile("v_cvt_pk_bf16_f32 %0, %1, %2" : "=v"(r) : "v"(lo), "v"(hi)); return r; }

__device__ __forceinline__ void st16(void* p, u32x4 w) { asm volatile("global_store_dwordx4 %0, %1, off\n\ts_nop 1" :: "v"(p), "v"(w) : "memory"); }
typedef unsigned u32x2 __attribute__((ext_vector_type(2)));
__device__ __forceinline__ void st8(void* p, u32x2 w) { asm volatile("global_store_dwordx2 %0, %1, off\n\ts_nop 1" :: "v"(p), "v"(w) : "memory"); }
constexpr int DM = 2048;
__device__ __forceinline__ int ada_row_of_panel(int pm) { return pm < 32 ? 0 : 1 + ((pm - 32) >> 4); }

constexpr int LDSX_OFF = 131072 + 1024;
struct NormIn {
    const float* ssq; const float* bias; int N;
    __device__ __forceinline__ void prefetch(const Unit& u, PG8_LAS unsigned char* lds, int wv, int lane) const {
        const float* src = wv < 4 ? ssq + u.pm * BM + wv * 64 + lane : bias + (size_t)ada_row_of_panel(u.pm) * N + u.pn * BM + (wv - 4) * 64 + lane;
        __builtin_amdgcn_global_load_lds((const unsigned*)src, (PG8_LAS unsigned*)(lds + LDSX_OFF + wv * 256), 4, 0, 0);
    }
    __device__ __forceinline__ void load(PG8_LAS unsigned char* lds, const int ai, int wr, int wc, int fr, int fq, float (&rs)[4], f32x4 (&bv)[2][2]) const {
        const PG8_LAS float* sx = (const PG8_LAS float*)(lds + LDSX_OFF);
#pragma unroll
        for (int m = 0; m < 4; ++m) rs[m] = __builtin_amdgcn_rsqf(sx[ai * HALF + wr * 64 + m * 16 + fr] * (1.0f / DM) + 1e-6f);
#pragma unroll
        for (int bj = 0; bj < 2; ++bj)
#pragma unroll
            for (int n = 0; n < 2; ++n) bv[bj][n] = *(const PG8_LAS f32x4*)(sx + 256 + bj * HALF + wc * 32 + 8 * fq + 4 * n);
    }
};
struct EpiAbIn {
    static constexpr bool PERM = true, AFTER_DRAIN = false, PREFETCH = true;
    bf16_t* U; bf16_t* Q; size_t qkv_stride;
    NormIn nin;
    __device__ __forceinline__ void prefetch(const Unit& u, PG8_LAS unsigned char* lds, int wv, int lane) const { nin.prefetch(u, lds, wv, lane); }
    __device__ __forceinline__ void half(const f32x4 (&acc)[2][2][4][2], const Unit& u, const int ai, int wr, int wc, int, int, PG8_LAS unsigned char* lds) const {
        const int lz = lane_id_opaque(), fr = lz & 15, fq = lz >> 4;
        const int row0 = u.pm * BM + wr * 64 + fr;
        bf16_t* base; int ldc, colt;
        if (u.pn < 2) { base = U; ldc = 512; colt = u.pn * BM; }
        else { const int t = (u.pn - 2) >> 2; base = Q + (size_t)t * qkv_stride; ldc = 1024; colt = ((u.pn - 2) & 3) * BM; }
        const int col0 = colt + wc * 32 + 8 * fq;
        float rs[4]; f32x4 bv[2][2]; nin.load(lds, ai, wr, wc, fr, fq, rs, bv);
#pragma unroll
        for (int m = 0; m < 4; ++m) { bf16_t* rowp = base + (size_t)(row0 + ai * HALF + m * 16) * ldc + col0;
#pragma unroll
            for (int bj = 0; bj < 2; ++bj) { const f32x4 v0 = acc[ai][bj][m][0] * rs[m] + bv[bj][0], v1 = acc[ai][bj][m][1] * rs[m] + bv[bj][1];
                u32x4 w; w.x = cvt_pk_bf16(v0[0], v0[1]); w.y = cvt_pk_bf16(v0[2], v0[3]); w.z = cvt_pk_bf16(v1[0], v1[1]); w.w = cvt_pk_bf16(v1[2], v1[3]);
                st16(rowp + bj * HALF, w); } }
    }
};
struct EpiRelu2 {
    static constexpr bool PERM = true, AFTER_DRAIN = false, PREFETCH = true;
    bf16_t* O; int ldc; NormIn nin;
    __device__ __forceinline__ void prefetch(const Unit& u, PG8_LAS unsigned char* lds, int wv, int lane) const { nin.prefetch(u, lds, wv, lane); }
    __device__ __forceinline__ void half(const f32x4 (&acc)[2][2][4][2], const Unit& u, const int ai, int wr, int wc, int, int, PG8_LAS unsigned char* lds) const {
        const int lz = lane_id_opaque(), fr = lz & 15, fq = lz >> 4;
        const int row0 = u.pm * BM + wr * 64 + fr, col0 = u.pn * BM + wc * 32 + 8 * fq;
        float rs[4]; f32x4 bv[2][2]; nin.load(lds, ai, wr, wc, fr, fq, rs, bv);
#pragma unroll
        for (int m = 0; m < 4; ++m) { bf16_t* rowp = O + (size_t)(row0 + ai * HALF + m * 16) * ldc + col0;
#pragma unroll
            for (int bj = 0; bj < 2; ++bj) { f32x4 v0 = acc[ai][bj][m][0] * rs[m] + bv[bj][0], v1 = acc[ai][bj][m][1] * rs[m] + bv[bj][1];
#pragma unroll
                for (int j = 0; j < 4; ++j) { const float a = fmaxf(v0[j], 0.f), b = fmaxf(v1[j], 0.f); v0[j] = a * a; v1[j] = b * b; }
                u32x4 w; w.x = cvt_pk_bf16(v0[0], v0[1]); w.y = cvt_pk_bf16(v0[2], v0[3]); w.z = cvt_pk_bf16(v1[0], v1[1]); w.w = cvt_pk_bf16(v1[2], v1[3]);
                st16(rowp + bj * HALF, w); } }
    }
};
struct EpiConvIn {
    static constexpr bool PERM = true, AFTER_DRAIN = false, PREFETCH = true;
    bf16_t* Z; bf16_t* GB; NormIn nin;
    __device__ __forceinline__ void prefetch(const Unit& u, PG8_LAS unsigned char* lds, int wv, int lane) const { nin.prefetch(u, lds, wv, lane); }
    __device__ __forceinline__ void half(const f32x4 (&acc)[2][2][4][2], const Unit& u, const int ai, int wr, int wc, int, int, PG8_LAS unsigned char* lds) const {
        const int lz = lane_id_opaque(), fr = lz & 15, fq = lz >> 4;
        const int row0 = u.pm * BM + wr * 64 + fr;
        float rs[4]; f32x4 bv[2][2]; nin.load(lds, ai, wr, wc, fr, fq, rs, bv);
        if (u.pn < 16) {
            const int col0 = u.pn * HALF + wc * 32 + 8 * fq;
#pragma unroll
            for (int m = 0; m < 4; ++m) { bf16_t* rowp = Z + (size_t)(row0 + ai * HALF + m * 16) * DM + col0;
                const f32x4 v0 = (acc[ai][0][m][0] * rs[m] + bv[0][0]) * (acc[ai][1][m][0] * rs[m] + bv[1][0]), v1 = (acc[ai][0][m][1] * rs[m] + bv[0][1]) * (acc[ai][1][m][1] * rs[m] + bv[1][1]);
                u32x2 wa, wb; wa.x = cvt_pk_bf16(v0[0], v0[1]); wa.y = cvt_pk_bf16(v0[2], v0[3]); wb.x = cvt_pk_bf16(v1[0], v1[1]); wb.y = cvt_pk_bf16(v1[2], v1[3]);
                st8(rowp, wa); st8(rowp + 4, wb); }
        } else {
            const int col0 = (u.pn - 16) * BM + wc * 32 + 8 * fq;
#pragma unroll
            for (int m = 0; m < 4; ++m) { bf16_t* rowp = GB + (size_t)(row0 + ai * HALF + m * 16) * DM + col0;
#pragma unroll
                for (int bj = 0; bj < 2; ++bj) { const f32x4 v0 = acc[ai][bj][m][0] * rs[m] + bv[bj][0], v1 = acc[ai][bj][m][1] * rs[m] + bv[bj][1];
                    u32x4 w; w.x = cvt_pk_bf16(v0[0], v0[1]); w.y = cvt_pk_bf16(v0[2], v0[3]); w.z = cvt_pk_bf16(v1[0], v1[1]); w.w = cvt_pk_bf16(v1[2], v1[3]);
                    st16(rowp + bj * HALF, w); } }
        }
    }
};
template <bool NEXT> struct EpiRes {
    static constexpr bool PERM = false, AFTER_DRAIN = false, PREFETCH = false;
    const float* base0; const float* base1; float* out; const float* gate;
    const float* gvn; bf16_t* Hn; float* ssqn;
    __device__ __forceinline__ void operator()(const f32x4 (&acc)[2][2][4][2], const Unit& u, int wr, int wc, int fr, int fq, PG8_LAS unsigned char* lds) const {
        const int row0 = u.pm * BM + wr * 64 + fr, col0 = u.pn * BM + wc * 32 + 4 * fq;
        const int j = ada_row_of_panel(u.pm);
        const float* g = gate + j * 12288 + col0;
        const char* bs = (const char*)(u.pm < 32 ? base0 : base1); char* ob = (char*)out; char* hb = (char*)Hn;
        const unsigned o0 = (unsigned)(row0 * DM + col0) * 4u;
        f32x4 gv[2][2], gn[2][2];
#pragma unroll
        for (int bj = 0; bj < 2; ++bj)
#pragma unroll
            for (int n = 0; n < 2; ++n) { gv[bj][n] = *(const f32x4*)(g + bj * HALF + n * 16); if (NEXT) gn[bj][n] = *(const f32x4*)(gvn + j * DM + col0 + bj * HALF + n * 16); }
#pragma unroll
        for (int am = 0; am < 4; ++am) { const int ai = am >> 1, mh = (am & 1) * 2;
            f32x4 b[2][2][2];
#pragma unroll
            for (int mm = 0; mm < 2; ++mm)
#pragma unroll
                for (int bj = 0; bj < 2; ++bj)
#pragma unroll
                    for (int n = 0; n < 2; ++n) b[mm][bj][n] = *(const f32x4*)(bs + (o0 + (unsigned)(((ai * HALF + (mh + mm) * 16) * DM + bj * HALF + n * 16) * 4)));
#pragma unroll
            for (int mm = 0; mm < 2; ++mm) { const int m = mh + mm; float sq = 0.f;
#pragma unroll
                for (int bj = 0; bj < 2; ++bj)
#pragma unroll
                    for (int n = 0; n < 2; ++n) { const unsigned o = o0 + (unsigned)(((ai * HALF + m * 16) * DM + bj * HALF + n * 16) * 4);
                        const f32x4 x = b[mm][bj][n] + gv[bj][n] * acc[ai][bj][m][n];
                        *(f32x4*)(ob + o) = x;
                        if (NEXT) { sq += (x[0] * x[0] + x[1] * x[1]) + (x[2] * x[2] + x[3] * x[3]); const f32x4 h = x * gn[bj][n];
                            typedef unsigned u32x2v __attribute__((ext_vector_type(2))); u32x2v w; w.x = cvt_pk_bf16(h[0], h[1]); w.y = cvt_pk_bf16(h[2], h[3]);
                            *(u32x2v*)(hb + (o >> 1)) = w; } }
                if (NEXT) {
                    auto t = __builtin_amdgcn_permlane16_swap(__float_as_uint(sq), __float_as_uint(sq), false, false); sq = __uint_as_float(t[0]) + __uint_as_float(t[1]);
                    auto v = __builtin_amdgcn_permlane32_swap(__float_as_uint(sq), __float_as_uint(sq), false, false); sq = __uint_as_float(v[0]) + __uint_as_float(v[1]);
                    if (fq == 0) __hip_atomic_fetch_add(ssqn + row0 + ai * HALF + m * 16, sq, __ATOMIC_RELAXED, __HIP_MEMORY_SCOPE_AGENT); } }
            asm volatile("" ::: "memory"); }
    }
};

template <class Epi, class Sched, bool ALIGN_EPI = false, bool SP2 = false>
__device__ __forceinline__ void gemm_phase(PG8_LAS unsigned char* lds, const Gemm g, const Sched& S, const Epi& E, const int wv  , unsigned long long* stamp = nullptr  ) {
    int wvo_ = wv; asm volatile("" : "+s"(wvo_));
    const int lane = lane_id_opaque(), wid = wvo_, tid = wid * 64 + lane, wr = wid >> 2, wc = wid & 3, fr = lane & 15, fq = lane >> 4;
    const int K = g.K, nt = K / BK;
    unsigned voffA[2], voffB[2];
#pragma unroll
    for (int i = 0; i < 2; ++i) { int R, C; stage_rc(tid * 16 + i * 8192, R, C); const int Rb = Epi::PERM ? ((R & ~31) + perm32(R & 31)) : R;
        voffA[i] = (unsigned)(R * K + C) * 2u; voffB[i] = (unsigned)(Rb * K + C) * 2u; }
    const size_t kstep = (size_t)(BK * 2);
    const size_t hstep = (size_t)HALF * K * 2;
    const size_t tstep = 2 * hstep;
    const unsigned ldsw = (unsigned)wid * 1024u;
    const int aoff = lds_byte(wr * 64 + fr, fq * 8), boff = lds_byte(wc * 32 + fr, fq * 8);
#define PG8_SA(b, h) (((b) * 2 + (h)) * HTB)
#define PG8_SB(b, h) ((4 + (b) * 2 + (h)) * HTB)
#define PG8_STAGE(bufoff, gbase, voff) do { _Pragma("unroll") for (int _i = 0; _i < 2; ++_i) \
        __builtin_amdgcn_global_load_lds((const unsigned*)((const char*)(gbase) + (voff)[_i]), (PG8_LAS unsigned*)(lds + (bufoff) + ldsw + _i * 8192), 16, 0, 0); } while (0)
#define PG8_LDA(dst, b, h) do { _Pragma("unroll") for (int m = 0; m < 4; ++m) _Pragma("unroll") for (int k = 0; k < 2; ++k) dst[m][k] = *(const PG8_LAS bf16x8*)(lds + PG8_SA(b, h) + aoff + m * 2048 + k * 1024); } while (0)
#define PG8_LDB(dst, b, h) do { _Pragma("unroll") for (int n = 0; n < 2; ++n) _Pragma("unroll") for (int k = 0; k < 2; ++k) dst[n][k] = *(const PG8_LAS bf16x8*)(lds + PG8_SB(b, h) + boff + n * 2048 + k * 1024); } while (0)
#define PG8_MMA(ai, bj, At, Bt) do { __builtin_amdgcn_s_setprio(1); _Pragma("unroll") for (int m = 0; m < 4; ++m) _Pragma("unroll") for (int n = 0; n < 2; ++n) _Pragma("unroll") for (int k = 0; k < 2; ++k) \
        acc[ai][bj][m][n] = __builtin_amdgcn_mfma_f32_16x16x32_bf16(Bt[n][k], At[m][k], acc[ai][bj][m][n], 0, 0, 0); __builtin_amdgcn_s_setprio(0); } while (0)
#define PG8_WAIT_V(n) asm volatile("s_waitcnt vmcnt(" #n ")" ::: "memory")
#define PG8_WAIT_L(n) asm volatile("s_waitcnt lgkmcnt(" #n ")" ::: "memory")
#define PG8_BAR __builtin_amdgcn_s_barrier()
#define PG8_SCHED __builtin_amdgcn_sched_barrier(0)
    Unit cur, nxt; int ui = 0;
    if (!S.next(0, cur)) return;
    f32x4 acc[2][2][4][2];
#pragma unroll
    for (int a = 0; a < 2; ++a)
#pragma unroll
        for (int b = 0; b < 2; ++b)
#pragma unroll
            for (int m = 0; m < 4; ++m)
#pragma unroll
                for (int n = 0; n < 2; ++n) acc[a][b][m][n] = (f32x4){0.f, 0.f, 0.f, 0.f};
    bf16x8 At[4][2], B0[2][2], B1[2][2];
    const char* cA = (const char*)g.A + (size_t)cur.pm * tstep; const char* cB = (const char*)g.Bt + (size_t)cur.pn * tstep;
    S.a_ready(cur);
    if constexpr (SP2) {
        PG8_STAGE(PG8_SB(0, 0), cB, voffB); PG8_STAGE(PG8_SB(0, 1), cB + hstep, voffB); PG8_STAGE(PG8_SA(0, 0), cA, voffA); PG8_STAGE(PG8_SA(0, 1), cA + hstep, voffA);
        if (wr == 1) PG8_BAR;
        PG8_WAIT_V(2); PG8_BAR;
        PG8_STAGE(PG8_SB(1, 0), cB + kstep, voffB); PG8_STAGE(PG8_SA(1, 0), cA + kstep, voffA); PG8_STAGE(PG8_SB(1, 1), cB + hstep + kstep, voffB);
        PG8_WAIT_V(6); PG8_BAR;
    } else {
        PG8_STAGE(PG8_SB(0, 0), cB, voffB); PG8_STAGE(PG8_SA(0, 0), cA, voffA); PG8_STAGE(PG8_SB(0, 1), cB + hstep, voffB); PG8_STAGE(PG8_SA(0, 1), cA + hstep, voffA);
        if (wr == 1) PG8_BAR;
        PG8_WAIT_V(4); PG8_BAR;
        PG8_STAGE(PG8_SB(1, 0), cB + kstep, voffB); PG8_STAGE(PG8_SA(1, 0), cA + kstep, voffA); PG8_STAGE(PG8_SB(1, 1), cB + hstep + kstep, voffB);
        PG8_WAIT_V(6); PG8_BAR;
    }
    unsigned long long st_tk = 0, st_ck = 0, st_te = 0;
    for (;;) {
        const bool has_next = S.next(ui + 1, nxt);
        unsigned long long st_r0 = 0, st_c0 = 0; if (stamp) { st_r0 = __builtin_amdgcn_s_memrealtime(); st_c0 = __builtin_readcyclecounter(); }
        const char* nA = has_next ? (const char*)g.A + (size_t)nxt.pm * tstep : cA; const char* nB = has_next ? (const char*)g.Bt + (size_t)nxt.pn * tstep : cB;
        for (int t = 0; t < nt; t += 2) {
            const bool last = (t == nt - 2);
            const char* a1 = cA + (size_t)(t + 1) * kstep;
            const char* a2 = last ? nA : cA + (size_t)(t + 2) * kstep; const char* b2 = last ? nB : cB + (size_t)(t + 2) * kstep;
            const char* a3 = a2 + kstep; const char* b3 = b2 + kstep;
            if (last && has_next) S.a_ready(nxt);
            if constexpr (SP2) {
            PG8_LDB(B0, 0, 0); PG8_LDB(B1, 0, 1); PG8_SCHED; PG8_LDA(At, 0, 0); PG8_STAGE(PG8_SA(1, 1), a1 + hstep, voffA);
            PG8_WAIT_V(8); PG8_WAIT_L(0); PG8_BAR; PG8_MMA(0, 0, At, B0); PG8_MMA(0, 1, At, B1); PG8_BAR; PG8_SCHED;
            PG8_LDA(At, 0, 1); PG8_STAGE(PG8_SB(0, 0), b2, voffB); PG8_STAGE(PG8_SB(0, 1), b2 + hstep, voffB); PG8_STAGE(PG8_SA(0, 0), a2, voffA);
            PG8_WAIT_V(8); PG8_WAIT_L(0); PG8_BAR; PG8_MMA(1, 0, At, B0); PG8_MMA(1, 1, At, B1); PG8_BAR; PG8_SCHED;
            PG8_LDB(B0, 1, 0); PG8_LDB(B1, 1, 1); PG8_SCHED; PG8_LDA(At, 1, 0); PG8_STAGE(PG8_SA(0, 1), a2 + hstep, voffA);
            PG8_WAIT_V(8); PG8_WAIT_L(0); PG8_BAR; PG8_MMA(0, 0, At, B0); PG8_MMA(0, 1, At, B1); PG8_BAR; PG8_SCHED;
            PG8_LDA(At, 1, 1); PG8_STAGE(PG8_SB(1, 0), b3, voffB); PG8_STAGE(PG8_SB(1, 1), b3 + hstep, voffB); PG8_STAGE(PG8_SA(1, 0), a3, voffA);
            PG8_WAIT_V(8); PG8_WAIT_L(0); PG8_BAR; PG8_MMA(1, 0, At, B0); PG8_MMA(1, 1, At, B1); PG8_BAR; PG8_SCHED;
            } else {
            PG8_LDB(B0, 0, 0); PG8_SCHED; PG8_LDA(At, 0, 0); PG8_STAGE(PG8_SA(1, 1), a1 + hstep, voffA);
            PG8_WAIT_L(8); PG8_BAR; PG8_WAIT_L(0); PG8_MMA(0, 0, At, B0); PG8_BAR; PG8_SCHED;
            PG8_LDB(B1, 0, 1); PG8_STAGE(PG8_SB(0, 0), b2, voffB);
            PG8_BAR; PG8_WAIT_L(0); PG8_MMA(0, 1, At, B1); PG8_BAR;
            PG8_LDA(At, 0, 1); PG8_STAGE(PG8_SA(0, 0), a2, voffA);
            PG8_BAR; PG8_WAIT_L(0); PG8_MMA(1, 0, At, B0); PG8_BAR; PG8_SCHED;
            PG8_STAGE(PG8_SB(0, 1), b2 + hstep, voffB);
            PG8_WAIT_V(6); PG8_BAR; PG8_MMA(1, 1, At, B1); PG8_BAR;
            PG8_LDB(B0, 1, 0); PG8_SCHED; PG8_LDA(At, 1, 0); PG8_STAGE(PG8_SA(0, 1), a2 + hstep, voffA);
            PG8_WAIT_L(8); PG8_BAR; PG8_WAIT_L(0); PG8_MMA(0, 0, At, B0); PG8_BAR; PG8_SCHED;
            PG8_LDB(B1, 1, 1); PG8_STAGE(PG8_SB(1, 0), b3, voffB);
            PG8_BAR; PG8_WAIT_L(0); PG8_MMA(0, 1, At, B1); PG8_BAR;
            PG8_LDA(At, 1, 1); PG8_STAGE(PG8_SA(1, 0), a3, voffA);
            PG8_BAR; PG8_WAIT_L(0); PG8_MMA(1, 0, At, B0); PG8_BAR; PG8_SCHED;
            PG8_STAGE(PG8_SB(1, 1), b3 + hstep, voffB);
            PG8_WAIT_V(6); PG8_BAR; PG8_MMA(1, 1, At, B1); PG8_BAR;
            }
        }
        unsigned long long st_r1 = 0; if (stamp) { st_r1 = __builtin_amdgcn_s_memrealtime(); st_tk += st_r1 - st_r0; st_ck += __builtin_readcyclecounter() - st_c0; }
        if constexpr (ALIGN_EPI) { if (wr == 0) PG8_BAR; }
        if constexpr (!Epi::AFTER_DRAIN) { E(acc, cur, wr, wc, fr, fq, lds); S.done(cur); }
        if (stamp) st_te += __builtin_amdgcn_s_memrealtime() - st_r1;
        if (!has_next) break;
#pragma unroll
        for (int a = 0; a < 2; ++a)
#pragma unroll
            for (int b = 0; b < 2; ++b)
#pragma unroll
                for (int m = 0; m < 4; ++m)
#pragma unroll
                    for (int n = 0; n < 2; ++n) acc[a][b][m][n] = (f32x4){0.f, 0.f, 0.f, 0.f};
        cur = nxt; cA = nA; cB = nB; ++ui;
        if constexpr (ALIGN_EPI) { if (wr == 1) PG8_BAR; }
    }
    PG8_WAIT_V(0);
    if constexpr (!ALIGN_EPI) { if (wr == 0) PG8_BAR; }
    PG8_BAR;
    if (stamp && wid == 0 && lane == 0 && blockIdx.x == 0) { atomicAdd(stamp, st_tk); atomicAdd(stamp + 1, st_ck); atomicAdd(stamp + 2, st_te); }
    if constexpr (Epi::AFTER_DRAIN) { E.fused(acc, cur, wr, wc, fr, fq, lds, wid, lane); S.done(cur); }
#undef PG8_SA
#undef PG8_SB
#undef PG8_STAGE
#undef PG8_LDA
#undef PG8_LDB
#undef PG8_MMA
#undef PG8_WAIT_V
#undef PG8_WAIT_L
#undef PG8_BAR
#undef PG8_SCHED
}

template <class Epi, class Sched>
__device__ __forceinline__ void gemm_phase_i(PG8_LAS unsigned char* lds, const Gemm g, const Sched& S, const Epi& E, const int wv, unsigned long long* stamp = nullptr) {
    int wvo_ = wv; asm volatile("" : "+s"(wvo_));
    const int lane = lane_id_opaque(), wid = wvo_, tid = wid * 64 + lane, wr = wid >> 2, wc = wid & 3, fr = lane & 15, fq = lane >> 4;
    const int K = g.K, nt = K / BK;
    unsigned voffA[2], voffB[2];
#pragma unroll
    for (int i = 0; i < 2; ++i) { int R, C; stage_rc(tid * 16 + i * 8192, R, C); const int Rb = Epi::PERM ? ((R & ~31) + perm32(R & 31)) : R;
        voffA[i] = (unsigned)(R * K + C) * 2u; voffB[i] = (unsigned)(Rb * K + C) * 2u; }
    const size_t kstep = (size_t)(BK * 2), hstep = (size_t)HALF * K * 2, tstep = 2 * hstep;
    const unsigned ldsw = (unsigned)wid * 1024u;
    const int aoff = lds_byte(wr * 64 + fr, fq * 8), boff = lds_byte(wc * 32 + fr, fq * 8);
#define PG8_SA(b, h) (((b) * 2 + (h)) * HTB)
#define PG8_SB(b, h) ((4 + (b) * 2 + (h)) * HTB)
#define PG8_STAGE(bufoff, gbase, voff) do { _Pragma("unroll") for (int _i = 0; _i < 2; ++_i) \
        __builtin_amdgcn_global_load_lds((const unsigned*)((const char*)(gbase) + (voff)[_i]), (PG8_LAS unsigned*)(lds + (bufoff) + ldsw + _i * 8192), 16, 0, 0); } while (0)
#define PG8_LDA(dst, b, h) do { _Pragma("unroll") for (int m = 0; m < 4; ++m) _Pragma("unroll") for (int k = 0; k < 2; ++k) dst[m][k] = *(const PG8_LAS bf16x8*)(lds + PG8_SA(b, h) + aoff + m * 2048 + k * 1024); } while (0)
#define PG8_LDB(dst, b, h) do { _Pragma("unroll") for (int n = 0; n < 2; ++n) _Pragma("unroll") for (int k = 0; k < 2; ++k) dst[n][k] = *(const PG8_LAS bf16x8*)(lds + PG8_SB(b, h) + boff + n * 2048 + k * 1024); } while (0)
#define PG8_MMA(ai, bj, At, Bt) do { __builtin_amdgcn_s_setprio(1); _Pragma("unroll") for (int m = 0; m < 4; ++m) _Pragma("unroll") for (int n = 0; n < 2; ++n) _Pragma("unroll") for (int k = 0; k < 2; ++k) \
        acc[ai][bj][m][n] = __builtin_amdgcn_mfma_f32_16x16x32_bf16(Bt[n][k], At[m][k], acc[ai][bj][m][n], 0, 0, 0); __builtin_amdgcn_s_setprio(0); } while (0)
#define PG8_WAIT_V(n) asm volatile("s_waitcnt vmcnt(" #n ")" ::: "memory")
#define PG8_WAIT_L(n) asm volatile("s_waitcnt lgkmcnt(" #n ")" ::: "memory")
#define PG8_BAR __builtin_amdgcn_s_barrier()
#define PG8_SCHED __builtin_amdgcn_sched_barrier(0)
#define PG8_ZERO(ai) do { _Pragma("unroll") for (int b_ = 0; b_ < 2; ++b_) _Pragma("unroll") for (int m_ = 0; m_ < 4; ++m_) _Pragma("unroll") for (int n_ = 0; n_ < 2; ++n_) acc[ai][b_][m_][n_] = (f32x4){0.f, 0.f, 0.f, 0.f}; } while (0)
#define PG8_TRIP(EA, EB, W1, W2, W3, W4) do { \
        PG8_LDB(B0, 0, 0); PG8_LDB(B1, 0, 1); PG8_SCHED; PG8_LDA(At, 0, 0); PG8_STAGE(PG8_SA(1, 1), a1 + hstep, voffA); PG8_SCHED; EA; PG8_SCHED; \
        PG8_WAIT_V(W1); PG8_WAIT_L(0); PG8_BAR; PG8_MMA(0, 0, At, B0); PG8_MMA(0, 1, At, B1); PG8_BAR; PG8_SCHED; \
        PG8_LDA(At, 0, 1); PG8_STAGE(PG8_SB(0, 0), b2, voffB); PG8_STAGE(PG8_SB(0, 1), b2 + hstep, voffB); PG8_STAGE(PG8_SA(0, 0), a2, voffA); PG8_SCHED; EB; PG8_SCHED; \
        PG8_WAIT_V(W2); PG8_WAIT_L(0); PG8_BAR; PG8_MMA(1, 0, At, B0); PG8_MMA(1, 1, At, B1); PG8_BAR; PG8_SCHED; \
        PG8_LDB(B0, 1, 0); PG8_LDB(B1, 1, 1); PG8_SCHED; PG8_LDA(At, 1, 0); PG8_STAGE(PG8_SA(0, 1), a2 + hstep, voffA); \
        PG8_WAIT_V(W3); PG8_WAIT_L(0); PG8_BAR; PG8_MMA(0, 0, At, B0); PG8_MMA(0, 1, At, B1); PG8_BAR; PG8_SCHED; \
        PG8_LDA(At, 1, 1); PG8_STAGE(PG8_SB(1, 0), b3, voffB); PG8_STAGE(PG8_SB(1, 1), b3 + hstep, voffB); PG8_STAGE(PG8_SA(1, 0), a3, voffA); \
        PG8_WAIT_V(W4); PG8_WAIT_L(0); PG8_BAR; PG8_MMA(1, 0, At, B0); PG8_MMA(1, 1, At, B1); PG8_BAR; PG8_SCHED; } while (0)
    Unit cur, nxt, prv; int ui = 0;
    if (!S.next(0, cur)) return;
    prv = cur;
    f32x4 acc[2][2][4][2];
    PG8_ZERO(0); PG8_ZERO(1);
    bf16x8 At[4][2], B0[2][2], B1[2][2];
    const char* cA = (const char*)g.A + (size_t)cur.pm * tstep; const char* cB = (const char*)g.Bt + (size_t)cur.pn * tstep;
    S.a_ready(cur);
    PG8_STAGE(PG8_SB(0, 0), cB, voffB); PG8_STAGE(PG8_SB(0, 1), cB + hstep, voffB); PG8_STAGE(PG8_SA(0, 0), cA, voffA); PG8_STAGE(PG8_SA(0, 1), cA + hstep, voffA);
    if (wr == 1) PG8_BAR;
    PG8_WAIT_V(2); PG8_BAR;
    PG8_STAGE(PG8_SB(1, 0), cB + kstep, voffB); PG8_STAGE(PG8_SA(1, 0), cA + kstep, voffA); PG8_STAGE(PG8_SB(1, 1), cB + hstep + kstep, voffB);
    PG8_WAIT_V(6); PG8_BAR;
    unsigned long long st_tk = 0, st_ck = 0, st_te = 0;
    for (;;) {
        const bool has_next = S.next(ui + 1, nxt);
        unsigned long long st_r0 = 0, st_c0 = 0; if (stamp) { st_r0 = __builtin_amdgcn_s_memrealtime(); st_c0 = __builtin_readcyclecounter(); }
        const char* nA = has_next ? (const char*)g.A + (size_t)nxt.pm * tstep : cA; const char* nB = has_next ? (const char*)g.Bt + (size_t)nxt.pn * tstep : cB;
        {
            const char* a1 = cA + kstep; const char* a2 = cA + 2 * kstep; const char* b2 = cB + 2 * kstep; const char* a3 = a2 + kstep; const char* b3 = b2 + kstep;
            unsigned long long st_f0 = 0; if (stamp) st_f0 = __builtin_amdgcn_s_memrealtime();
            const bool epi = ui > 0;
            PG8_STAGE(PG8_SA(1, 1), a1 + hstep, voffA); PG8_SCHED;
            if (epi) { E.half(acc, prv, 0, wr, wc, fr, fq, lds); PG8_ZERO(0); } PG8_SCHED;
            PG8_LDB(B0, 0, 0); PG8_LDB(B1, 0, 1); PG8_SCHED; PG8_LDA(At, 0, 0);
            if (epi) { PG8_WAIT_V(16); } else { PG8_WAIT_V(8); }
            PG8_WAIT_L(0); PG8_BAR; PG8_MMA(0, 0, At, B0); PG8_MMA(0, 1, At, B1); PG8_BAR; PG8_SCHED;
            PG8_STAGE(PG8_SB(0, 0), b2, voffB); PG8_STAGE(PG8_SB(0, 1), b2 + hstep, voffB); PG8_STAGE(PG8_SA(0, 0), a2, voffA); PG8_SCHED;
            if (epi) { E.half(acc, prv, 1, wr, wc, fr, fq, lds); PG8_ZERO(1); } PG8_SCHED;
            PG8_LDA(At, 0, 1);
            if (epi) { PG8_WAIT_V(24); } else { PG8_WAIT_V(8); }
            PG8_WAIT_L(0); PG8_BAR; PG8_MMA(1, 0, At, B0); PG8_MMA(1, 1, At, B1); PG8_BAR; PG8_SCHED;
            PG8_LDB(B0, 1, 0); PG8_LDB(B1, 1, 1); PG8_SCHED; PG8_LDA(At, 1, 0); PG8_STAGE(PG8_SA(0, 1), a2 + hstep, voffA);
            if (epi) { PG8_WAIT_V(24); } else { PG8_WAIT_V(8); }
            PG8_WAIT_L(0); PG8_BAR; PG8_MMA(0, 0, At, B0); PG8_MMA(0, 1, At, B1); PG8_BAR; PG8_SCHED;
            PG8_LDA(At, 1, 1); PG8_STAGE(PG8_SB(1, 0), b3, voffB); PG8_STAGE(PG8_SB(1, 1), b3 + hstep, voffB); PG8_STAGE(PG8_SA(1, 0), a3, voffA);
            if (epi) { PG8_WAIT_V(16); } else { PG8_WAIT_V(8); }
            PG8_WAIT_L(0); PG8_BAR; PG8_MMA(1, 0, At, B0); PG8_MMA(1, 1, At, B1); PG8_BAR; PG8_SCHED;
            if (stamp && epi) st_te += __builtin_amdgcn_s_memrealtime() - st_f0;
        }
        for (int t = 2; t < nt; t += 2) {
            const bool last = (t == nt - 2);
            const char* a1 = cA + (size_t)(t + 1) * kstep;
            const char* a2 = last ? nA : cA + (size_t)(t + 2) * kstep; const char* b2 = last ? nB : cB + (size_t)(t + 2) * kstep;
            const char* a3 = a2 + kstep; const char* b3 = b2 + kstep;
            if (last && has_next) S.a_ready(nxt);
            if (last) E.prefetch(cur, lds, wid, lane);
            PG8_TRIP((void)0, (void)0, 8, 8, 8, 8);
        }
        if (stamp) { const unsigned long long st_r1 = __builtin_amdgcn_s_memrealtime(); st_tk += st_r1 - st_r0; st_ck += __builtin_readcyclecounter() - st_c0; }
        if (!has_next) break;
        prv = cur; cur = nxt; cA = nA; cB = nB; ++ui;
    }
    { unsigned long long st_r1 = 0; if (stamp) st_r1 = __builtin_amdgcn_s_memrealtime();
      E.half(acc, cur, 0, wr, wc, fr, fq, lds); E.half(acc, cur, 1, wr, wc, fr, fq, lds); S.done(cur);
      (void)st_r1; }
    PG8_WAIT_V(0);
    if (wr == 0) PG8_BAR;
    PG8_BAR;
    if (stamp && wid == 0 && lane == 0) { if (blockIdx.x == 0) { atomicAdd(stamp, st_tk); atomicAdd(stamp + 1, st_ck); atomicAdd(stamp + 2, st_te); } atomicAdd(stamp + 8 + blockIdx.x, st_tk); }
#undef PG8_TRIP
#undef PG8_ZERO
#undef PG8_SA
#undef PG8_SB
#undef PG8_STAGE
#undef PG8_LDA
#undef PG8_LDB
#undef PG8_MMA
#undef PG8_WAIT_V
#undef PG8_WAIT_L
#undef PG8_BAR
#undef PG8_SCHED
}
}

#define GAS __attribute__((address_space(1)))
#define LAS __attribute__((address_space(3)))
typedef unsigned short bf16_t;
typedef short bf16x8 __attribute__((ext_vector_type(8)));
typedef short s16x4 __attribute__((ext_vector_type(4)));
typedef float f32x4 __attribute__((ext_vector_type(4)));
typedef float f32x16 __attribute__((ext_vector_type(16)));
typedef unsigned u32x4 __attribute__((ext_vector_type(4)));
typedef unsigned u32x2 __attribute__((ext_vector_type(2)));
#define SBAR() __builtin_amdgcn_sched_barrier(0)
__device__ __forceinline__ unsigned cvtpk(float lo, float hi) { unsigned r; asm volatile("v_cvt_pk_bf16_f32 %0, %1, %2" : "=v"(r) : "v"(lo), "v"(hi)); return r; }
__device__ __forceinline__ float bf2f(unsigned short b) { return __uint_as_float(((unsigned)b) << 16); }
__device__ __forceinline__ float bflo(unsigned w) { return __uint_as_float(w << 16); }
__device__ __forceinline__ float bfhi(unsigned w) { return __uint_as_float(w & 0xffff0000u); }
__device__ __forceinline__ unsigned short f2bf(float f) { return (unsigned short)(cvtpk(f, 0.f) & 0xffffu); }

namespace att {
constexpr int D = 128, NW = 8, QBLK = 32, KVBLK = 64, LD = 1024;
constexpr float SCALE = 0.088388347648318440f, THR = 8.f;
constexpr int SHM_V = KVBLK * D * 2, SHM_K = KVBLK * D * 2;
constexpr int OFF_V = 0, OFF_K = 2 * SHM_V, OFF_Q = 2 * SHM_V + 2 * SHM_K  , OFF_WS = 134144  , OFF_BIAS = OFF_WS + NW * 64 * 4, LDS_BYTES = OFF_BIAS + 16 * 32 * 4;
#define KSWZ(row, colB) ((row) * 256 + ((colB) ^ (((row) & 7) << 4)))
__device__ __forceinline__ int crow(int r, int hi) { return (r & 3) + 8 * (r >> 2) + 4 * hi; }

__device__ __forceinline__ void partialSM(f32x16& p0, f32x16& p1, float& m_reg, float& mn, float& alpha) {
  constexpr float C = SCALE * 1.4426950408889634f;
  float pmax = p0[0];
#pragma unroll
  for (int r = 1; r < 16; ++r) pmax = fmaxf(pmax, p0[r]);
#pragma unroll
  for (int r = 0; r < 16; ++r) pmax = fmaxf(pmax, p1[r]);
  { auto rr = __builtin_amdgcn_permlane32_swap(__float_as_uint(pmax), __float_as_uint(pmax), false, false);
    pmax = fmaxf(__uint_as_float(rr[0]), __uint_as_float(rr[1])); }
  if (__builtin_expect(__all(pmax - m_reg <= THR / SCALE), 1)) { mn = m_reg; alpha = 1.f; }
  else { mn = fmaxf(m_reg, pmax); alpha = __builtin_amdgcn_exp2f((m_reg - mn) * C); m_reg = mn; }
  float mnC = -mn * C;
#pragma unroll
  for (int r = 0; r < 16; ++r) p0[r] = fmaf(p0[r], C, mnC);
#pragma unroll
  for (int r = 0; r < 16; ++r) p1[r] = fmaf(p1[r], C, mnC);
#pragma unroll
  for (int r = 0; r < 16; ++r) p0[r] = __builtin_amdgcn_exp2f(p0[r]);
}
__device__ __forceinline__ void finishSM(f32x16& p0, f32x16& p1, float alpha, float& l_reg, bf16x8& pa0, bf16x8& pa1, bf16x8& pa2, bf16x8& pa3) {
#pragma unroll
  for (int r = 0; r < 16; ++r) p1[r] = __builtin_amdgcn_exp2f(p1[r]);
  float ps = 0;
#pragma unroll
  for (int r = 0; r < 16; ++r) ps += p0[r];
#pragma unroll
  for (int r = 0; r < 16; ++r) ps += p1[r];
  { auto rr = __builtin_amdgcn_permlane32_swap(__float_as_uint(ps), __float_as_uint(ps), false, false);
    ps = __uint_as_float(rr[0]) + __uint_as_float(rr[1]); }
  l_reg = l_reg * alpha + ps;
#define PK4(P, BASE, OUT) do { unsigned a0 = cvtpk(P[BASE + 0], P[BASE + 1]), a1 = cvtpk(P[BASE + 2], P[BASE + 3]);   \
    unsigned b0 = cvtpk(P[BASE + 4], P[BASE + 5]), b1 = cvtpk(P[BASE + 6], P[BASE + 7]);                              \
    auto r0 = __builtin_amdgcn_permlane32_swap(a0, b0, false, false); auto r1 = __builtin_amdgcn_permlane32_swap(a1, b1, false, false); \
    u32x4 w = {r0[0], r1[0], r0[1], r1[1]}; OUT = *reinterpret_cast<bf16x8*>(&w); } while (0)
  PK4(p0, 0, pa0); PK4(p0, 8, pa1); PK4(p1, 0, pa2); PK4(p1, 8, pa3);
#undef PK4
}
__device__ __forceinline__ void qkt(f32x16& p0, f32x16& p1, const LAS char* Ks, const LAS char* Qs, int r32, int hi) {
  p0 = f32x16{}; p1 = f32x16{};
#pragma unroll
  for (int d0 = 0; d0 < 8; ++d0) { const int cb = (d0 * 16 + hi * 8) * 2;
    const bf16x8 b0 = *(const LAS bf16x8*)(Ks + KSWZ(r32, cb));
    const bf16x8 b1 = *(const LAS bf16x8*)(Ks + KSWZ(32 + r32, cb));
    const bf16x8 q = *(const LAS bf16x8*)(Qs + KSWZ(r32, cb));
    p0 = __builtin_amdgcn_mfma_f32_32x32x16_bf16(b0, q, p0, 0, 0, 0);
    p1 = __builtin_amdgcn_mfma_f32_32x32x16_bf16(b1, q, p1, 0, 0, 0); }
}
__device__ __forceinline__ int v_st(int k, int c) { const int kk = (k & ~0xC) | ((k & 4) << 1) | ((k & 8) >> 1); return ((kk >> 3) * 4 + (c >> 5)) * 512 + ((kk & 7) * 32 + (c & 31)) * 2; }
__device__ __forceinline__ int v_rd_base(int lane) { return ((lane & 3) << 3) | (((lane >> 2) & 3) << 6) | (((lane >> 4) & 1) << 5) | (((lane >> 5) & 1) << 8); }
constexpr int v_rd_off(int d0, int ks, int half) { return d0 * 512 + ks * 4096 + half * 2048; }
template <int OFF> __device__ __forceinline__ s16x4 tr_read(int vb) {
  s16x4 r; asm volatile("ds_read_b64_tr_b16 %0, %1 offset:%2" : "=&v"(r) : "v"(vb), "i"(OFF) : "memory"); return r;
}
template <int D0> __device__ __forceinline__ void pv_one(f32x16& od, int vb, bf16x8 pa0, bf16x8 pa1, bf16x8 pa2, bf16x8 pa3) {
  const s16x4 l0 = tr_read<v_rd_off(D0, 0, 0)>(vb), h0 = tr_read<v_rd_off(D0, 0, 1)>(vb), l1 = tr_read<v_rd_off(D0, 1, 0)>(vb), h1 = tr_read<v_rd_off(D0, 1, 1)>(vb);
  const s16x4 l2 = tr_read<v_rd_off(D0, 2, 0)>(vb), h2 = tr_read<v_rd_off(D0, 2, 1)>(vb), l3 = tr_read<v_rd_off(D0, 3, 0)>(vb), h3 = tr_read<v_rd_off(D0, 3, 1)>(vb);
  asm volatile("s_waitcnt lgkmcnt(0)" ::: "memory"); SBAR();
#define PK(L, H) (bf16x8){L[0], L[1], L[2], L[3], H[0], H[1], H[2], H[3]}
  od = __builtin_amdgcn_mfma_f32_32x32x16_bf16(pa0, PK(l0, h0), od, 0, 0, 0);
  od = __builtin_amdgcn_mfma_f32_32x32x16_bf16(pa1, PK(l1, h1), od, 0, 0, 0);
  od = __builtin_amdgcn_mfma_f32_32x32x16_bf16(pa2, PK(l2, h2), od, 0, 0, 0);
  od = __builtin_amdgcn_mfma_f32_32x32x16_bf16(pa3, PK(l3, h3), od, 0, 0, 0);
#undef PK
}
__device__ __forceinline__ void pv_d0(f32x16* o, int vb, bf16x8 pa0, bf16x8 pa1, bf16x8 pa2, bf16x8 pa3) {
  pv_one<0>(o[0], vb, pa0, pa1, pa2, pa3); pv_one<1>(o[1], vb, pa0, pa1, pa2, pa3); pv_one<2>(o[2], vb, pa0, pa1, pa2, pa3); pv_one<3>(o[3], vb, pa0, pa1, pa2, pa3);
}

__device__ __forceinline__ void na_mask(f32x16& p0, f32x16& p1, int kr, int qrow, int qc, unsigned cmask, int hi, const LAS float* biasL) {
  int r0 = qrow - 4; r0 = r0 < 0 ? 0 : (r0 > 56 ? 56 : r0);
  const bool rowok = (kr >= r0) && (kr < r0 + 8);
  const unsigned em = rowok ? cmask : 0u;
  const int dr = rowok ? (kr - qrow + 7) : 0;
  const LAS float* brow = biasL + dr * 32 + (15 - qc + 4 * hi);
#pragma unroll
  for (int i4 = 0; i4 < 4; ++i4) {
#pragma unroll
    for (int ii = 0; ii < 4; ++ii) { const int i = i4 * 4 + ii, kc = (i & 3) + 8 * (i >> 2);
      const bool ok0 = (em >> i) & 1u, ok1 = (em >> (16 + i)) & 1u;
      const float b0 = brow[kc], b1 = brow[kc + 32];
      p0[i] = ok0 ? p0[i] + b0 : -1e30f; p1[i] = ok1 ? p1[i] + b1 : -1e30f; }
    asm volatile("" ::: "memory"); }
}

template <bool NA, int SDEPTH>
__device__ __forceinline__ void attn_unit(LAS char* lds, const bf16_t* __restrict__ Qb, const bf16_t* __restrict__ K0, const bf16_t* __restrict__ V0, int nt0,
                                          const bf16_t* __restrict__ K1, const bf16_t* __restrict__ V1, int NT, bf16_t* __restrict__ Ob, int ldo, int R, int kr0, const int wv) {
  const int lane = lane_id_opaque(), wid = wv, tid = wv * 64 + lane, r32 = lane & 31, hi = lane >> 5;
  LAS char* V_lds = lds + OFF_V; LAS char* K_lds = lds + OFF_K;
  LAS float* ws = (LAS float*)(lds + OFF_WS) + wid * 64; LAS float* li_l = ws; LAS float* al_l = ws + 32;
  const LAS float* biasL = (const LAS float*)(lds + OFF_BIAS);
  float m_reg = -1e30f, l_reg = 0; f32x16 o[4] = {};
  LAS char* Q_lds = lds + OFF_Q + wid * 8192;
  { const bf16_t* Qw = Qb + (long)(wid * QBLK + r32) * LD + hi * 8; bf16x8 qt[8];
#pragma unroll
    for (int d0 = 0; d0 < 8; ++d0) qt[d0] = *(const bf16x8*)(Qw + d0 * 16);
#pragma unroll
    for (int d0 = 0; d0 < 8; ++d0) *(LAS bf16x8*)(Q_lds + KSWZ(r32, (d0 * 16 + hi * 8) * 2)) = qt[d0]; }
  const int sr = tid >> 4, sc = (tid & 15) * 8, vst0 = v_st(sr, sc), vst1 = v_st(32 + sr, sc);
  const int vb0 = (int)(uintptr_t)V_lds + v_rd_base(lane);
  const int qrow = R + (wid >> 1), qc = 32 * (wid & 1) + r32;
  unsigned cmask = 0;
  if (NA) { int c0 = qc - 8; c0 = c0 < 0 ? 0 : (c0 > 48 ? 48 : c0);
#pragma unroll
    for (int i = 0; i < 16; ++i) { const int kc = crow(i, hi); if ((unsigned)(kc - c0) < 16u) cmask |= 1u << i; if ((unsigned)(kc + 32 - c0) < 16u) cmask |= 1u << (16 + i); } }
  struct { bf16x8 vs0, vs1, ks0, ks1; } sr_[SDEPTH];
#define TILE_K(t) (((t) < nt0 ? K0 + (long)(t) * (KVBLK * LD) : K1 + (long)((t) - nt0) * (KVBLK * LD)))
#define TILE_V(t) (((t) < nt0 ? V0 + (long)(t) * (KVBLK * LD) : V1 + (long)((t) - nt0) * (KVBLK * LD)))
#define SLOAD(i, t) do { const bf16_t* kp_ = TILE_K(t); const bf16_t* vp_ = TILE_V(t); \
    sr_[i].vs0 = *(const bf16x8*)(vp_ + (long)sr * LD + sc); sr_[i].vs1 = *(const bf16x8*)(vp_ + (long)(32 + sr) * LD + sc); \
    sr_[i].ks0 = *(const bf16x8*)(kp_ + (long)sr * LD + sc); sr_[i].ks1 = *(const bf16x8*)(kp_ + (long)(32 + sr) * LD + sc); } while (0)
#define SWRITE(b, i) do { *(LAS bf16x8*)(V_lds + (b) * SHM_V + vst0) = sr_[i].vs0;          \
    *(LAS bf16x8*)(V_lds + (b) * SHM_V + vst1) = sr_[i].vs1; const int kc_ = sc * 2;               \
    *(LAS bf16x8*)(K_lds + (b) * SHM_K + KSWZ(sr, kc_)) = sr_[i].ks0;                       \
    *(LAS bf16x8*)(K_lds + (b) * SHM_K + KSWZ(32 + sr, kc_)) = sr_[i].ks1; } while (0)
#define SWAIT() do { if constexpr (SDEPTH == 2) asm volatile("s_waitcnt vmcnt(4)" ::: "memory"); else asm volatile("s_waitcnt vmcnt(0)" ::: "memory"); } while (0)
#define RESC(a) do { if (__any((a) < 1.f)) { if (hi == 0) al_l[r32] = (a); asm volatile("s_waitcnt lgkmcnt(0)" ::: "memory"); \
    _Pragma("unroll") for (int d = 0; d < 4; ++d) _Pragma("unroll") for (int r = 0; r < 16; ++r) o[d][r] *= al_l[crow(r, hi)]; } } while (0)
#define MASK(P0, P1, t) do { if (NA && (t) >= nt0) na_mask(P0, P1, kr0 + (t) - nt0, qrow, qc, cmask, hi, biasL); } while (0)
  f32x16 pA0, pA1, pB0, pB1; float mnA, mnB, alA, alB; bf16x8 pa0, pa1, pa2, pa3;
  int wr0 = qrow - 4; wr0 = wr0 < 0 ? 0 : (wr0 > 56 ? 56 : wr0);
#define TV(t) (!NA || (t) < nt0 || (unsigned)(kr0 + (t) - nt0 - wr0) < 8u)
#define SCORE(P0, P1, KB, t, V) do { if (V) qkt(P0, P1, KB, Q_lds, r32, hi); } while (0)
#define PSM(P0, P1, t, V, MN, AL) do { if (V) { MASK(P0, P1, t); partialSM(P0, P1, m_reg, MN, AL); } else { AL = 1.f; } } while (0)
#define FSM(P0, P1, AL, V) do { if (V) finishSM(P0, P1, AL, l_reg, pa0, pa1, pa2, pa3); } while (0)
#define PVT(VB, V) do { if (V) pv_d0(o, VB, pa0, pa1, pa2, pa3); } while (0)
  constexpr int SE = 0, SO = SDEPTH - 1;
  bool vA = true, vB = true;
  SLOAD(SE, 0); asm volatile("s_waitcnt vmcnt(0)" ::: "memory"); SWRITE(0, SE); __syncthreads();
  vA = TV(0); SCORE(pA0, pA1, K_lds, 0, vA); PSM(pA0, pA1, 0, vA, mnA, alA);
  SLOAD(SO, 1); if constexpr (SDEPTH == 2) { if (2 < NT) SLOAD(SE, 2); }
  SWAIT(); SWRITE(1, SO); __syncthreads();
  for (int j = 1; j + 1 < NT; j += 2) {
    vB = TV(j);
    SBAR(); SCORE(pB0, pB1, K_lds + SHM_K, j, vB);
    FSM(pA0, pA1, alA, vA); SBAR();
    SLOAD(SO, j + SDEPTH); SBAR();
    PVT(vb0, vA); PSM(pB0, pB1, j, vB, mnB, alB);
    __syncthreads(); SWAIT(); SWRITE(0, SE);
    RESC(alB); __syncthreads();
    vA = TV(j + 1);
    SBAR(); SCORE(pA0, pA1, K_lds, j + 1, vA);
    FSM(pB0, pB1, alB, vB); SBAR();
    if (SDEPTH == 1 || j + 3 < NT) SLOAD(SE, j + 1 + SDEPTH); SBAR();
    PVT(vb0 + SHM_V, vB); PSM(pA0, pA1, j + 1, vA, mnA, alA);
    __syncthreads(); SWAIT(); SWRITE(1, SO);
    RESC(alA); __syncthreads();
  }
  vB = TV(NT - 1);
  SBAR(); SCORE(pB0, pB1, K_lds + SHM_K, NT - 1, vB);
  FSM(pA0, pA1, alA, vA); SBAR();
  PVT(vb0, vA); PSM(pB0, pB1, NT - 1, vB, mnB, alB);
  __syncthreads(); RESC(alB);
  FSM(pB0, pB1, alB, vB); SBAR();
  PVT(vb0 + SHM_V, vB);
#undef TV
#undef SCORE
#undef PSM
#undef FSM
#undef PVT
  if (hi == 0) li_l[r32] = l_reg; asm volatile("s_waitcnt lgkmcnt(0)" ::: "memory");
  float rli[16];
#pragma unroll
  for (int r = 0; r < 16; ++r) rli[r] = __builtin_amdgcn_rcpf(li_l[crow(r, hi)]);
  bf16_t* Ow = Ob + (long)(wid * QBLK) * ldo;
#pragma unroll
  for (int r = 0; r < 16; ++r) { const int orow = crow(r, hi);
#pragma unroll
    for (int d0 = 0; d0 < 4; ++d0) Ow[(long)orow * ldo + d0 * 32 + r32] = f2bf(o[d0][r] * rli[r]); }
#undef SLOAD
#undef SWRITE
#undef SWAIT
#undef RESC
#undef MASK
#undef TILE_K
#undef TILE_V
}
}

constexpr int DM = 2048, NCTX = 8192, NLAT = 32768, MTOK = NCTX + NLAT;
constexpr int CTX_L = 256, LAT_L = 4096, NLAYER = 4, DFF = 8192;
constexpr int ABIN = 3584, ABOUT = 1536, S5W = 512;
constexpr float NORM_EPS = 1e-6f;
constexpr int S5T = 32;
constexpr int NCHUNK = MTOK / S5T;
__device__ __forceinline__ int ada_row_of_token(int m) { return m < NCTX ? 0 : 1 + ((m - NCTX) >> 12); }

#ifndef S5_STAMP
#define S5_STAMP 0
#endif
namespace s5 {
constexpr int XROW = 272;
constexpr int XBYTES = S5T * XROW;
constexpr int GROW = 1040;
constexpr int OFF_X = 0, OFF_G = 8 * XBYTES, LDS_BYTES = OFF_G + S5T * GROW;

struct BFrag { bf16x8 r0, r1, i0, i1; };
__device__ __forceinline__ bf16x8 load_u(const bf16_t* __restrict__ U, int m0, int g, int dir, int lane) {
  const int r = lane & 31, h = lane >> 5, tok = dir ? 31 - r : r;
  return *(const bf16x8*)(U + (size_t)(m0 + tok) * S5W + g * 16 + h * 8);
}
__device__ __forceinline__ BFrag load_bb(const bf16_t* __restrict__ BB, int lane) {
  const int r = lane & 31, h = lane >> 5; BFrag f;
  f.r0 = *(const bf16x8*)(BB + (0 * 64 + r) * 16 + h * 8); f.r1 = *(const bf16x8*)(BB + (0 * 64 + 32 + r) * 16 + h * 8);
  f.i0 = *(const bf16x8*)(BB + (1 * 64 + r) * 16 + h * 8); f.i1 = *(const bf16x8*)(BB + (1 * 64 + 32 + r) * 16 + h * 8);
  return f;
}
__device__ __forceinline__ void bu_compute(const bf16x8 ua, const BFrag& f, float (&bre)[32], float (&bim)[32]) {
  const f32x16 z = {};
  { const f32x16 dr0 = __builtin_amdgcn_mfma_f32_32x32x16_bf16(ua, f.r0, z, 0, 0, 0), dr1 = __builtin_amdgcn_mfma_f32_32x32x16_bf16(ua, f.r1, z, 0, 0, 0);
#pragma unroll
    for (int i = 0; i < 16; ++i) { const int c0 = (i & 3) + 8 * (i >> 2);
      auto a = __builtin_amdgcn_permlane32_swap(__float_as_uint(dr0[i]), __float_as_uint(dr1[i]), false, false);
      bre[c0] = __uint_as_float(a[0]); bre[c0 + 4] = __uint_as_float(a[1]); } }
  asm volatile("" : "+v"(bre[0]), "+v"(bre[31]));
  { const f32x16 di0 = __builtin_amdgcn_mfma_f32_32x32x16_bf16(ua, f.i0, z, 0, 0, 0), di1 = __builtin_amdgcn_mfma_f32_32x32x16_bf16(ua, f.i1, z, 0, 0, 0);
#pragma unroll
    for (int i = 0; i < 16; ++i) { const int c0 = (i & 3) + 8 * (i >> 2);
      auto b = __builtin_amdgcn_permlane32_swap(__float_as_uint(di0[i]), __float_as_uint(di1[i]), false, false);
      bim[c0] = __uint_as_float(b[0]); bim[c0 + 4] = __uint_as_float(b[1]); } }
}

__device__ __forceinline__ void phase_a(int e, const bf16_t* U, const float4* S5A, const bf16_t* S5BB, float* Ef, float* Ec, int G, int vcu, const int wv) {
  const int lane = lane_id_opaque(), wid = wv; (void)wid;
  for (int task = vcu; task < (MTOK / 128) * 4; task += G) {
    const int cc = task >> 2, g = (task & 3) * 8 + wid;
#pragma unroll 1
    for (int dir = 0; dir < 2; ++dir) {
      const int tb = ((e * 2 + dir) * 32 + g);
      const float4 a4 = S5A[tb * 64 + lane];
      float cr = 0.f, ci = 0.f;
      const BFrag bf = load_bb(S5BB + (size_t)tb * 2048, lane);
      bf16x8 ua = load_u(U, (cc * 4 + (dir ? 3 : 0)) * S5T, g, dir, lane);
#pragma unroll 1
      for (int k = 0; k < 4; ++k) { const int f = dir ? 3 - k : k; const int ci_f = cc * 4 + f;
        const int fn = dir ? 2 - k : k + 1;
        const bf16x8 un = load_u(U, (cc * 4 + (k < 3 ? fn : f)) * S5T, g, dir, lane);
        float bre[32], bim[32];
        bu_compute(ua, bf, bre, bim);
        float xr = 0.f, xi = 0.f;
#pragma unroll
        for (int i = 0; i < 32; ++i) { const float nr = fmaf(a4.x, xr, fmaf(-a4.y, xi, bre[i])), ni = fmaf(a4.x, xi, fmaf(a4.y, xr, bim[i])); xr = nr; xi = ni; }
        float* ep = Ef + (((size_t)ci_f * 32 + g) * 2 + dir) * 128;
        ep[lane] = xr; ep[64 + lane] = xi;
        const float nr = fmaf(a4.z, cr, fmaf(-a4.w, ci, xr)), ni = fmaf(a4.z, ci, fmaf(a4.w, cr, xi)); cr = nr; ci = ni;
        ua = un;
      }
      float* ecp = Ec + (((size_t)cc * 32 + g) * 2 + dir) * 128;
      ecp[lane] = cr; ecp[64 + lane] = ci;
    }
  }
}

struct SOps { float4 a4; float2 a128; bf16x8 ua; BFrag bf; float sr, si; float fer[3], fei[3]; float er[16], ei[16]; };
struct SGeo { int m0, ci, c, nC, b; bool isctx; };
__device__ __forceinline__ void s5b_load(SOps& o, const SGeo& t, int e, int g, int dir, int lane, const bf16_t* U, const float4* S5A, const float2* S5A128, const bf16_t* S5BB,
                                         const float* Ef, const float* Ec, const float* h0re, const float* h0im) {
  const int tb = ((e * 2 + dir) * 32 + g);
  o.a4 = S5A[tb * 64 + lane]; o.a128 = S5A128[tb * 64 + lane];
  o.ua = load_u(U, t.m0, g, dir, lane); o.bf = load_bb(S5BB + (size_t)tb * 2048, lane);
  o.sr = 0.f; o.si = 0.f;
  if (!t.isctx) { const int hi_ = (((t.b * 2 + e) * 2 + dir) * 32 + g) * 64 + lane; o.sr = h0re[hi_]; o.si = h0im[hi_]; }
  const int C = t.c >> 2, f = t.c & 3, nCC = t.nC >> 2, cc0 = (t.ci - t.c) >> 2;
  const int n = dir ? (nCC - 1 - C) : C; const int cstart = dir ? (cc0 + nCC - 1) : cc0; const int estep = (dir ? -1 : 1) * 32 * 2 * 128;
  const int e0 = ((cstart * 32 + g) * 2 + dir) * 128 + lane;
  const int nf = dir ? (3 - f) : f; const int fstart = dir ? (t.ci - f + 3) : (t.ci - f);
  const int f0 = ((fstart * 32 + g) * 2 + dir) * 128 + lane;
#pragma unroll
  for (int q = 0; q < 3; ++q) { const int qq = q < nf ? q : 0; o.fer[q] = Ef[f0 + qq * estep]; o.fei[q] = Ef[f0 + qq * estep + 64]; }
#pragma unroll
  for (int j = 0; j < 16; ++j) { const int kk = j < n ? j : 0; o.er[j] = Ec[e0 + kk * estep]; o.ei[j] = Ec[e0 + kk * estep + 64]; }
}
__device__ __forceinline__ void phase_b(LAS char* lds, int e, const bf16_t* U, const float4* S5A, const float2* S5A128, const bf16_t* S5BB, const bf16_t* S5CM, const float* Ef, const float* Ec,
                                        const float* h0re, const float* h0im, const float* dvec, const bf16_t* Wglu, const float* bglu,
                                        bf16_t* AO, float* st_re, float* st_im, int G, int vcu, const int wv, unsigned long long* stampp = nullptr) {
  const int lane = lane_id_opaque(), wid = wv; (void)wid; (void)stampp;
  LAS char* X = lds + OFF_X + wid * XBYTES; LAS char* Gt = lds + OFF_G;
  for (int ci = vcu; ci < NCHUNK; ci += G) {
    SGeo t; t.ci = ci; t.m0 = ci * S5T; t.isctx = t.m0 < NCTX;
    if (t.isctx) { t.b = t.m0 / CTX_L; t.c = (t.m0 % CTX_L) / S5T; t.nC = CTX_L / S5T; } else { t.b = (t.m0 - NCTX) / LAT_L; t.c = ((t.m0 - NCTX) % LAT_L) / S5T; t.nC = LAT_L / S5T; }
    const int m0 = t.m0;
#if S5_STAMP
    const unsigned long long st0_ = __builtin_amdgcn_s_memrealtime();
#endif
    SOps P;
    s5b_load(P, t, e, wid * 4, 0, lane, U, S5A, S5A128, S5BB, Ef, Ec, h0re, h0im);
    f32x4 yacc[2] = {{0.f, 0.f, 0.f, 0.f}, {0.f, 0.f, 0.f, 0.f}};
    float uu[2][4];
#pragma unroll 1
    for (int q = 0; q < 8; ++q) { const int g = wid * 4 + (q >> 1), dir = q & 1;
      const int tb = ((e * 2 + dir) * 32 + g);
      const int nl = lane & 15, col = g * 16 + nl;
      const bf16_t* cm = S5CM + (size_t)tb * 2048 + (lane & 15) * 128 + (lane >> 4) * 8;
      bf16x8 cf[4];
#pragma unroll
      for (int ks = 0; ks < 4; ++ks) cf[ks] = *(const bf16x8*)(cm + ks * 32);
      if (dir == 0) {
#pragma unroll
        for (int rb = 0; rb < 2; ++rb)
#pragma unroll
          for (int i = 0; i < 4; ++i) uu[rb][i] = bf2f(U[(size_t)(m0 + rb * 16 + (lane >> 4) * 4 + i) * S5W + col]); }
      const float4 a4 = P.a4; const float2 a128 = P.a128;
      float sr = P.sr, si = P.si;
      const int C = t.c >> 2, f = t.c & 3, nCC = t.nC >> 2, cc0 = (t.ci - t.c) >> 2;
      const int n = dir ? (nCC - 1 - C) : C; const int cstart = dir ? (cc0 + nCC - 1) : cc0; const int estep = (dir ? -1 : 1) * 32 * 2 * 128;
      const int nf = dir ? (3 - f) : f;
#pragma unroll
      for (int j = 0; j < 16; ++j) if (j < n) { const float nr = fmaf(a128.x, sr, fmaf(-a128.y, si, P.er[j])), ni = fmaf(a128.x, si, fmaf(a128.y, sr, P.ei[j])); sr = nr; si = ni; }
      if (n > 16) { const int e0 = ((cstart * 32 + g) * 2 + dir) * 128 + lane; float er[16], ei[16];
#pragma unroll
        for (int j = 0; j < 16; ++j) { const int kk = 16 + j < n ? 16 + j : 16; er[j] = Ec[e0 + kk * estep]; ei[j] = Ec[e0 + kk * estep + 64]; }
#pragma unroll
        for (int j = 0; j < 16; ++j) if (16 + j < n) { const float nr = fmaf(a128.x, sr, fmaf(-a128.y, si, er[j])), ni = fmaf(a128.x, si, fmaf(a128.y, sr, ei[j])); sr = nr; si = ni; } }
#pragma unroll
      for (int qq = 0; qq < 3; ++qq) if (qq < nf) { const float nr = fmaf(a4.z, sr, fmaf(-a4.w, si, P.fer[qq])), ni = fmaf(a4.z, si, fmaf(a4.w, sr, P.fei[qq])); sr = nr; si = ni; }
      float bre[32], bim[32];
      bu_compute(P.ua, P.bf, bre, bim);
      if (q < 7) s5b_load(P, t, e, wid * 4 + ((q + 1) >> 1), (q + 1) & 1, lane, U, S5A, S5A128, S5BB, Ef, Ec, h0re, h0im);
      float xr = sr, xi = si;
#pragma unroll
      for (int i = 0; i < 32; ++i) { const float nr = fmaf(a4.x, xr, fmaf(-a4.y, xi, bre[i])), ni = fmaf(a4.x, xi, fmaf(a4.y, xr, bim[i])); xr = nr; xi = ni; bre[i] = nr; bim[i] = ni; }
      if (t.isctx && ((dir == 0 && t.c == t.nC - 1) || (dir == 1 && t.c == 0))) { const int so = (((t.b * 2 + e) * 2 + dir) * 32 + g) * 64 + lane; st_re[so] = xr; st_im[so] = xi; }
#pragma unroll
      for (int i = 0; i < 32; ++i) { const int tok = dir ? 31 - i : i;
        *(LAS unsigned*)(X + tok * XROW + lane * 4) = cvtpk(bre[i], bim[i]); }
      asm volatile("s_waitcnt lgkmcnt(0)" ::: "memory");
#pragma unroll
      for (int rb = 0; rb < 2; ++rb)
#pragma unroll
        for (int ks = 0; ks < 4; ++ks) { const bf16x8 af = *(const LAS bf16x8*)(X + (rb * 16 + (lane & 15)) * XROW + (ks * 32 + (lane >> 4) * 8) * 2);
          yacc[rb] = __builtin_amdgcn_mfma_f32_16x16x32_bf16(af, cf[ks], yacc[rb], 0, 0, 0); }
      asm volatile("s_waitcnt lgkmcnt(0)" ::: "memory");
      if (dir == 1) {
        const float dv = dvec[col];
#pragma unroll
        for (int rb = 0; rb < 2; ++rb)
#pragma unroll
          for (int i = 0; i < 4; ++i) { const int tok = rb * 16 + (lane >> 4) * 4 + i;
            const float y = yacc[rb][i] + dv * uu[rb][i];
            const float z2 = 1.5957691216057308f * (y + 0.044715f * y * y * y);
            const float gl = y - y / (1.f + __expf(z2));
            *(LAS unsigned short*)(Gt + tok * GROW + col * 2) = f2bf(gl); }
        yacc[0] = (f32x4){0.f, 0.f, 0.f, 0.f}; yacc[1] = (f32x4){0.f, 0.f, 0.f, 0.f};
      }
    }
#if S5_STAMP
    if (blockIdx.x == 0 && wid == 0 && lane == 0) atomicAdd(stampp, __builtin_amdgcn_s_memrealtime() - st0_);
#endif
    __syncthreads();
    { f32x4 acc[2][4];
#pragma unroll
      for (int rb = 0; rb < 2; ++rb)
#pragma unroll
        for (int cb = 0; cb < 4; ++cb) acc[rb][cb] = (f32x4){0.f, 0.f, 0.f, 0.f};
      const bf16_t* wp = Wglu + (size_t)(wid * 64 + (lane & 15)) * 512 + (lane >> 4) * 8;
#pragma unroll 4
      for (int ks = 0; ks < 16; ++ks) {
        bf16x8 af[2], bfr[4];
#pragma unroll
        for (int cb = 0; cb < 4; ++cb) bfr[cb] = *(const bf16x8*)(wp + (size_t)cb * 16 * 512 + ks * 32);
#pragma unroll
        for (int rb = 0; rb < 2; ++rb) af[rb] = *(const LAS bf16x8*)(Gt + (rb * 16 + (lane & 15)) * GROW + (ks * 32 + (lane >> 4) * 8) * 2);
#pragma unroll
        for (int rb = 0; rb < 2; ++rb)
#pragma unroll
          for (int cb = 0; cb < 4; ++cb) acc[rb][cb] = __builtin_amdgcn_mfma_f32_16x16x32_bf16(af[rb], bfr[cb], acc[rb][cb], 0, 0, 0);
      }
#pragma unroll
      for (int cb = 0; cb < 4; ++cb) { const int col = wid * 64 + cb * 16 + (lane & 15); const float bb = bglu[col];
#pragma unroll
        for (int rb = 0; rb < 2; ++rb)
#pragma unroll
          for (int i = 0; i < 4; ++i) { const int tok = rb * 16 + (lane >> 4) * 4 + i;
            const float gv = bf2f(*(const LAS unsigned short*)(Gt + tok * GROW + col * 2));
            const float zz = acc[rb][cb][i] + bb;
            AO[(size_t)(m0 + tok) * ABOUT + col] = f2bf(gv / (1.f + __expf(-zz))); } }
    }
    __syncthreads();
  }
}
}

constexpr size_t MiB = 1u << 20;
constexpr size_t WS_CTL = 0, CTL_ZERO_BYTES = 3 * MiB;
constexpr size_t WS_SSQ = 1 * MiB;
constexpr size_t WS_ADA = 3 * MiB;
constexpr size_t WS_S5A = 5 * MiB, WS_S5A128 = 5 * MiB + 512 * 1024, WS_S5BB = 6 * MiB, WS_S5CM = 7 * MiB;
constexpr size_t WS_GV = 8 * MiB;
constexpr size_t WS_BIAS = 9 * MiB;
constexpr size_t WS_CK = 14 * MiB, WS_CV = 22 * MiB;
constexpr size_t WS_WGLU = 30 * MiB;
constexpr size_t WS_WABIN = 32 * MiB;
constexpr size_t WS_WABOUT = 60 * MiB;
constexpr size_t WS_WCVIN = 72 * MiB;
constexpr size_t WS_WCVOUT = 120 * MiB;
constexpr size_t WS_WUP = 136 * MiB;
constexpr size_t WS_WDN = 264 * MiB;
constexpr size_t WS_H = 392 * MiB;
constexpr size_t WS_BIG = 552 * MiB;
constexpr size_t WS_U = WS_BIG, WS_Q = WS_BIG + 40 * MiB, WS_K = WS_BIG + 120 * MiB, WS_V = WS_BIG + 200 * MiB, WS_AO = WS_BIG + 280 * MiB, WS_E = WS_BIG + 400 * MiB, WS_EC = WS_BIG + 440 * MiB;
static_assert(WS_V - WS_K == WS_K - WS_Q, "q/k/v equally spaced");
constexpr size_t WS_Z = WS_BIG, WS_GB = WS_BIG + 160 * MiB, WS_A2 = WS_BIG + 320 * MiB;
constexpr size_t WS_END = WS_BIG + 640 * MiB;
constexpr int CW_TMO = 0, CW_BAR = 4096;

constexpr int RING_BYTES = 131072;
constexpr int LDSCTL_OFF = RING_BYTES, MISC_OFF = LDSCTL_OFF + 320;
constexpr int LDS_BYTES = 147456;
static_assert(att::OFF_WS >= RING_BYTES + 1024 + 2048 && att::LDS_BYTES <= LDS_BYTES && s5::LDS_BYTES <= RING_BYTES, "phase scratch fits");
constexpr int NWAVES = 8;

typedef GAS unsigned gu32;
#define RLX_AGENT __ATOMIC_RELAXED, __HIP_MEMORY_SCOPE_AGENT
#define LDS_WAIT() asm volatile("s_waitcnt lgkmcnt(0)" ::: "memory")
#define VM_WAIT() asm volatile("s_waitcnt vmcnt(0)" ::: "memory")

#define XB_TMO      128
#define XB_XCNT(j)  (256  + 64 * (j))
#define XB_XSUB(j)  (1280 + 64 * (j))
#define XB_XGEN(j)  (2304 + 64 * (j))
#define XB_TOP      3328
#define XB_TOPGEN   3392
#define XCD_BAR_WORDS 3456
#define XB_SPIN_CAP (1u << 18)
__device__ __forceinline__ unsigned xb_ld(unsigned* p)              { return __hip_atomic_load(p, __ATOMIC_RELAXED, __HIP_MEMORY_SCOPE_AGENT); }
__device__ __forceinline__ unsigned xb_add(unsigned* p, unsigned v) { return __hip_atomic_fetch_add(p, v, __ATOMIC_RELAXED, __HIP_MEMORY_SCOPE_AGENT); }
__device__ __forceinline__ unsigned xb_xcc_id() { return (unsigned)__builtin_amdgcn_s_getreg((3 << 11) | 20) & 0xFu; }
#define XB_SPIN(cond, bar) do { unsigned _sp = 0; while (cond) { __builtin_amdgcn_s_sleep(1); \
    if ((++_sp & 255u) == 0u) { if (xb_ld(&(bar)[XB_TMO])) break; if (_sp > XB_SPIN_CAP) { atomicAdd(&(bar)[XB_TMO], 1u); break; } } } } while (0)
struct XcdBarrier { unsigned* bar; unsigned x; volatile LAS unsigned* st; };
__device__ __forceinline__ XcdBarrier xcd_barrier_post(unsigned* bar, volatile LAS unsigned* st) {
    XcdBarrier b; b.bar = bar; b.x = xb_xcc_id(); b.st = st;
    if (threadIdx.x == 0) (void)xb_add(&bar[XB_XCNT(b.x)], 1u);
    return b;
}
__device__ __forceinline__ void xcd_barrier_complete(unsigned* bar, unsigned x, unsigned& nloc, unsigned& nx) {
    const unsigned G = gridDim.x * gridDim.y * gridDim.z;
    unsigned sum, cnt, mine, sp = 0u;
    for (;;) {
        sum = 0u; cnt = 0u; mine = 0u;
#pragma unroll
        for (unsigned j = 0; j < 16; ++j) { const unsigned c = xb_ld(&bar[XB_XCNT(j)]); sum += c; cnt += (c > 0u) ? 1u : 0u; mine = (j == x) ? c : mine; }
        if (sum == G) break;
        __builtin_amdgcn_s_sleep(1);
        if ((++sp & 255u) == 0u) { if (xb_ld(&bar[XB_TMO])) break; if (sp > XB_SPIN_CAP) { atomicAdd(&bar[XB_TMO], 1u); break; } }
    }
    nloc = mine > 0u ? mine : 1u; nx = cnt > 0u ? cnt : 1u;
}
__device__ __forceinline__ void xcd_barrier(const XcdBarrier& b, const int wv) {
    asm volatile("s_waitcnt vmcnt(0)" ::: "memory");
    __syncthreads();
    if (wv == 0 && lane_id_opaque() == 0) {
        unsigned* bar = b.bar; asm volatile("" : "+s"(bar));
        __builtin_amdgcn_s_waitcnt(0);
        unsigned nloc = b.st[0], nx = b.st[1];
        if (nloc == 0u) { xcd_barrier_complete(bar, b.x, nloc, nx); b.st[0] = nloc; b.st[1] = nx; }
        const unsigned old = xb_add(&bar[XB_XSUB(b.x)], 1u);
        const unsigned gen = old / nloc;
        if (old + 1u == (gen + 1u) * nloc) {
            __builtin_amdgcn_fence(__ATOMIC_RELEASE, "agent");
            asm volatile("s_waitcnt vmcnt(0)" ::: "memory");
            const unsigned og = xb_add(&bar[XB_TOP], 1u);
            const unsigned tg = og / nx;
            if (og + 1u == (tg + 1u) * nx) xb_add(&bar[XB_TOPGEN], 1u);
            else XB_SPIN(xb_ld(&bar[XB_TOPGEN]) == tg, bar);
            __builtin_amdgcn_fence(__ATOMIC_ACQUIRE, "agent");
            xb_add(&bar[XB_XGEN(b.x)], 1u);
            asm volatile("s_waitcnt vmcnt(0)" ::: "memory");
        } else {
            XB_SPIN(xb_ld(&bar[XB_XGEN(b.x)]) == gen, bar);
            __builtin_amdgcn_fence(__ATOMIC_ACQUIRE, "agent");
            asm volatile("s_waitcnt vmcnt(0)" ::: "memory");
        }
    }
    __syncthreads();
}

struct Args { const float* in[33]; float* out; unsigned char* ws; int ph_lo, ph_hi; };
enum { I_XP = 0, I_XS, I_C, I_CK, I_CV, I_SRE, I_SIM, I_CCTX, I_ADAW, I_ADAB, I_N1G, I_N2G, I_ABWIN, I_ABWOUT, I_LAMRE, I_LAMIM, I_LOGDT, I_BRE, I_BIM, I_CRE, I_CIM, I_S5D,
       I_GLUW, I_GLUB, I_QNG, I_KNG, I_RPB, I_CVWIN, I_CVW, I_CVB, I_CVWOUT, I_W1, I_W2 };
constexpr size_t O_X = 0, O_CK = (size_t)MTOK * DM, O_CV = O_CK + (size_t)32 * 2 * 256 * 1024, O_SRE = O_CV + (size_t)32 * 2 * 256 * 1024, O_SIM = O_SRE + 32 * 2 * 2 * 32 * 64;

__device__ __forceinline__ float lane_xor(float v, int lane, int m) { return __uint_as_float((unsigned)__builtin_amdgcn_ds_bpermute((lane ^ m) << 2, (int)__float_as_uint(v))); }
__device__ __forceinline__ float wave_sum(float v, int lane) {
#pragma unroll
    for (int o = 1; o < 64; o <<= 1) v += lane_xor(v, lane, o);
    return v;
}
__device__ __forceinline__ unsigned pk2(float lo, float hi) { return cvtpk(lo, hi); }
__device__ __forceinline__ float wave_sum_dpp(float v) {
    v += __uint_as_float((unsigned)__builtin_amdgcn_update_dpp(0, (int)__float_as_uint(v), 0x128, 0xf, 0xf, false));
    v += __uint_as_float((unsigned)__builtin_amdgcn_update_dpp(0, (int)__float_as_uint(v), 0x124, 0xf, 0xf, false));
    v += __uint_as_float((unsigned)__builtin_amdgcn_update_dpp(0, (int)__float_as_uint(v), 0x122, 0xf, 0xf, false));
    v += __uint_as_float((unsigned)__builtin_amdgcn_update_dpp(0, (int)__float_as_uint(v), 0x121, 0xf, 0xf, false));
    { auto t = __builtin_amdgcn_permlane16_swap(__float_as_uint(v), __float_as_uint(v), false, false); v = __uint_as_float(t[0]) + __uint_as_float(t[1]); }
    { auto t = __builtin_amdgcn_permlane32_swap(__float_as_uint(v), __float_as_uint(v), false, false); v = __uint_as_float(t[0]) + __uint_as_float(t[1]); }
    return v;
}

__device__ __forceinline__ int dest_row(int n0, int mode) {
    if (mode == 0) return n0;
    if (n0 < 2048) return 4096 + n0;
    if (n0 < 4096) { const int c = n0 - 2048; return (c >> 7) * 256 + (c & 127); }
    const int c = n0 - 4096; return (c >> 7) * 256 + 128 + (c & 127);
}
__device__ __forceinline__ void p0_transpose_item(const float* W, int K, int N, bf16_t* WT, int mode, LAS unsigned* T, int item, int lane) {
    const int nblk = N / 128, kb = item / nblk, nb = item % nblk, k0 = 64 * kb, n0 = 128 * nb;
    const int lr = lane >> 5, lc = lane & 31;
    const float* src = W + (size_t)(k0 + 2 * lr) * N + n0 + 4 * lc;
#pragma unroll 8
    for (int q = 0; q < 16; ++q) { const f32x4 a = __builtin_nontemporal_load((const f32x4*)(src + (size_t)(4 * q) * N)), b = __builtin_nontemporal_load((const f32x4*)(src + (size_t)(4 * q + 1) * N));
        const int kp = 2 * q + lr; u32x4 w; w.x = pk2(a[0], b[0]); w.y = pk2(a[1], b[1]); w.z = pk2(a[2], b[2]); w.w = pk2(a[3], b[3]);
        *(LAS u32x4*)(T + kp * 128 + ((4 * lc) ^ (((kp >> 2) & 7) << 2))) = w; }
    LDS_WAIT(); asm volatile("" ::: "memory");
    const int kq = lane & 7, nl = lane >> 3; const int r0 = dest_row(n0, mode);
#pragma unroll 4
    for (int j = 0; j < 16; ++j) { const int n = nl + 8 * j; u32x4 o;
        o.x = T[(4 * kq + 0) * 128 + (n ^ (kq << 2))]; o.y = T[(4 * kq + 1) * 128 + (n ^ (kq << 2))]; o.z = T[(4 * kq + 2) * 128 + (n ^ (kq << 2))]; o.w = T[(4 * kq + 3) * 128 + (n ^ (kq << 2))];
        *(GAS u32x4*)(WT + (size_t)(r0 + n) * K + k0 + 8 * kq) = o; }
    LDS_WAIT(); asm volatile("" ::: "memory");
}
__device__ __forceinline__ void sincos_d(double x, double& s, double& c) {
    const double k = rint(x * 0.63661977236758134308);
    double r = fma(-k, 1.5707963267948966, x); r = fma(-k, 6.123233995736766e-17, r);
    const double r2 = r * r;
    double ps = 1.0 / 355687428096000.0;
    ps = fma(ps, r2, -1.0 / 1307674368000.0); ps = fma(ps, r2, 1.0 / 6227020800.0); ps = fma(ps, r2, -1.0 / 39916800.0); ps = fma(ps, r2, 1.0 / 362880.0);
    ps = fma(ps, r2, -1.0 / 5040.0); ps = fma(ps, r2, 1.0 / 120.0); ps = fma(ps, r2, -1.0 / 6.0); ps = fma(ps * r2, r, r);
    double pc = 1.0 / 6402373705728000.0;
    pc = fma(pc, r2, -1.0 / 20922789888000.0); pc = fma(pc, r2, 1.0 / 87178291200.0); pc = fma(pc, r2, -1.0 / 479001600.0); pc = fma(pc, r2, 1.0 / 3628800.0);
    pc = fma(pc, r2, -1.0 / 40320.0); pc = fma(pc, r2, 1.0 / 720.0); pc = fma(pc, r2, -1.0 / 24.0); pc = fma(pc, r2, 0.5); pc = fma(-pc, r2, 1.0);
    const int q = ((int)k) & 3;
    s = (q == 0) ? ps : (q == 1) ? pc : (q == 2) ? -ps : -pc;
    c = (q == 0) ? pc : (q == 1) ? -ps : (q == 2) ? -pc : ps;
}
__device__ __forceinline__ double exp_small_d(double x) {
    double p = 1.0 / 87178291200.0;
    p = fma(p, x, 1.0 / 6227020800.0); p = fma(p, x, 1.0 / 479001600.0); p = fma(p, x, 1.0 / 39916800.0); p = fma(p, x, 1.0 / 3628800.0); p = fma(p, x, 1.0 / 362880.0);
    p = fma(p, x, 1.0 / 40320.0); p = fma(p, x, 1.0 / 5040.0); p = fma(p, x, 1.0 / 720.0); p = fma(p, x, 1.0 / 120.0); p = fma(p, x, 1.0 / 24.0); p = fma(p, x, 1.0 / 6.0);
    p = fma(p, x, 0.5); p = fma(p, x, 1.0); p = fma(p, x, 1.0); return p;
}
__device__ __forceinline__ double exp_d(double x) {
    const double k = rint(x * 1.4426950408889634); const double r = fma(-k, 0.6931471805599453, x) ;
    double e = exp_small_d(r * 0.25); e = e * e; e = e * e;
    return ldexp(e, (int)k);
}

__device__ __forceinline__ const float* as_global(const float* x) { const GAS float* p = (const GAS float*)x; asm("" : "+s"(p)); return (const float*)p; }
#define FIN(i) as_global(F.in[i])
struct Frame {
    LAS unsigned char* lds;
    int wave, vcu, G;
    const float* const* in;
    float* out; unsigned char* ws;
};

__device__ __forceinline__ void p0_ada_item(Frame& F, int item) {
    const int lane = lane_id_opaque(), tid = F.wave * 64 + lane; (void)tid;
    const int l = item / 48, cb = item % 48;
    LAS float* sl = (LAS float*)F.lds;
    for (int i = tid; i < 9 * 2048; i += 512) { const int j = i / 2048, k = i % 2048; const float c = j == 0 ? FIN(I_CCTX)[k] : FIN(I_C)[(j - 1) * 2048 + k]; sl[k * 12 + j] = c / (1.f + __expf(-c)); }
    __syncthreads();
    const float* W = FIN(I_ADAW) + (size_t)l * 2048 * 12288 + (size_t)(F.wave * 256) * 12288 + cb * 256 + lane * 4;
    f32x4 acc[9];
#pragma unroll
    for (int j = 0; j < 9; ++j) acc[j] = (f32x4){0.f, 0.f, 0.f, 0.f};
    for (int k0 = 0; k0 < 256; k0 += 8) {
        f32x4 w[8];
#pragma unroll
        for (int u = 0; u < 8; ++u) w[u] = __builtin_nontemporal_load((const f32x4*)(W + (size_t)(k0 + u) * 12288));
#pragma unroll
        for (int u = 0; u < 8; ++u) { const LAS f32x4* sp = (const LAS f32x4*)(sl + (F.wave * 256 + k0 + u) * 12);
            const f32x4 s0 = sp[0], s1 = sp[1], s2 = sp[2];
            acc[0] += w[u] * s0[0]; acc[1] += w[u] * s0[1]; acc[2] += w[u] * s0[2]; acc[3] += w[u] * s0[3];
            acc[4] += w[u] * s1[0]; acc[5] += w[u] * s1[1]; acc[6] += w[u] * s1[2]; acc[7] += w[u] * s1[3]; acc[8] += w[u] * s2[0]; }
    }
    __syncthreads();
    LAS f32x4* pp = (LAS f32x4*)F.lds;
#pragma unroll
    for (int j = 0; j < 9; ++j) pp[(F.wave * 9 + j) * 64 + lane] = acc[j];
    __syncthreads();
    float* ADA = (float*)(F.ws + WS_ADA) + (size_t)l * 9 * 12288;
    const float* bias = FIN(I_ADAB) + (size_t)l * 12288;
    for (int i = tid; i < 9 * 64; i += 512) { const int j = i / 64, q = i % 64; f32x4 s = pp[(0 * 9 + j) * 64 + q];
#pragma unroll
        for (int w = 1; w < 8; ++w) s += pp[(w * 9 + j) * 64 + q];
        const int col = cb * 256 + q * 4; s += *(const f32x4*)(bias + col);
        *(f32x4*)(ADA + (size_t)j * 12288 + col) = s; }
    __syncthreads();
}
__device__ __forceinline__ void p0_s5_tables(Frame& F) {
    const int lane = lane_id_opaque(), tid = F.wave * 64 + lane; (void)tid;
    const int gt = F.vcu * 512 + tid;
    if (gt >= 2 * 2 * 32 * 64) return;
    const int p = gt & 63, g = (gt >> 6) & 31, dir = (gt >> 11) & 1, e = gt >> 12;
    const int gi = (e * 2 + dir) * 32 + g;
    const double lre = (double)FIN(I_LAMRE)[gi * 64 + p], lim = (double)FIN(I_LAMIM)[gi * 64 + p];
    const double dt = exp_d((double)FIN(I_LOGDT)[gi]);
    const double ar = lre * dt, ai = lim * dt;
    double s, c; sincos_d(ai, s, c); const double dec = exp_d(ar);
    const double are = dec * c, aim = dec * s;
    double sT, cT; sincos_d(ai * S5T, sT, cT); const double decT = exp_d(ar * S5T);
    float4* A = (float4*)(F.ws + WS_S5A);
    A[gi * 64 + p] = make_float4((float)are, (float)aim, (float)(decT * cT), (float)(decT * sT));
    { double s4, c4; sincos_d(ai * (4 * S5T), s4, c4); const double dec4 = exp_d(ar * (4 * S5T));
      ((float2*)(F.ws + WS_S5A128))[gi * 64 + p] = make_float2((float)(dec4 * c4), (float)(dec4 * s4)); }
    const double den = lre * lre + lim * lim, nr = are - 1.0;
    const double fre = (nr * lre + aim * lim) / den, fim = (aim * lre - nr * lim) / den;
    bf16_t* BB = (bf16_t*)(F.ws + WS_S5BB) + (size_t)gi * 2048;
    const float* bre = FIN(I_BRE) + ((size_t)gi * 64 + p) * 16; const float* bim = FIN(I_BIM) + ((size_t)gi * 64 + p) * 16;
#pragma unroll
    for (int n = 0; n < 16; ++n) { const double br = bre[n], bi = bim[n];
        BB[(0 * 64 + p) * 16 + n] = f2bf((float)(fre * br - fim * bi)); BB[(1 * 64 + p) * 16 + n] = f2bf((float)(fre * bi + fim * br)); }
    bf16_t* CM = (bf16_t*)(F.ws + WS_S5CM) + (size_t)gi * 2048;
    const float* cre = FIN(I_CRE) + (size_t)gi * 16 * 64; const float* cim = FIN(I_CIM) + (size_t)gi * 16 * 64;
#pragma unroll
    for (int n = 0; n < 16; ++n) { CM[n * 128 + 2 * p] = f2bf(cre[n * 64 + p]); CM[n * 128 + 2 * p + 1] = f2bf(-cim[n * 64 + p]); }
}
__device__ __forceinline__ void p0_prologue(Frame& F) {
    const int lane = lane_id_opaque(), tid = F.wave * 64 + lane; (void)tid;
    if (F.vcu < 192) p0_ada_item(F, F.vcu);
    p0_s5_tables(F);
    { const size_t n8 = (size_t)8 * 2 * 256 * 1024 / 8; const size_t gth = (size_t)F.vcu * 512 + tid, nth = (size_t)F.G * 512;
      for (size_t i = gth; i < 2 * n8; i += nth) { const bool isk = i < n8; const size_t j = isk ? i : i - n8;
        const float* src = (isk ? FIN(I_CK) : FIN(I_CV)) + j * 8; bf16_t* dst = (bf16_t*)(F.ws + (isk ? WS_CK : WS_CV)) + j * 8;
        const f32x4 a = __builtin_nontemporal_load((const f32x4*)src), b = __builtin_nontemporal_load((const f32x4*)(src + 4));
        u32x4 o; o.x = pk2(a[0], a[1]); o.y = pk2(a[2], a[3]); o.z = pk2(b[0], b[1]); o.w = pk2(b[2], b[3]); *(u32x4*)dst = o; } }
    LAS unsigned* scr = (LAS unsigned*)(F.lds + F.wave * 16384);
    const int gw = F.vcu * NWAVES + F.wave, NGW = F.G * NWAVES;
    constexpr int I_ABI = 32 * 28, I_ABO = 24 * 16, I_CVI = 32 * 48, I_CVO = 32 * 16, I_UP = 32 * 64, I_DN = 128 * 16, I_GLU = 8 * 4;
    constexpr int NITEMS = 2 * I_ABI + 2 * I_ABO + 2 * I_CVI + 2 * I_CVO + 4 * I_UP + 4 * I_DN + 2 * I_GLU;
    for (int it = gw; it < NITEMS; it += NGW) {
        int r = it;
        if (r < 2 * I_ABI) { const int e = r / I_ABI; p0_transpose_item(FIN(I_ABWIN) + (size_t)e * DM * ABIN, DM, ABIN, (bf16_t*)(F.ws + WS_WABIN) + (size_t)e * ABIN * DM, 0, scr, r % I_ABI, lane); continue; } r -= 2 * I_ABI;
        if (r < 2 * I_ABO) { const int e = r / I_ABO; p0_transpose_item(FIN(I_ABWOUT) + (size_t)e * ABOUT * DM, ABOUT, DM, (bf16_t*)(F.ws + WS_WABOUT) + (size_t)e * DM * ABOUT, 0, scr, r % I_ABO, lane); continue; } r -= 2 * I_ABO;
        if (r < 2 * I_CVI) { const int e = r / I_CVI; p0_transpose_item(FIN(I_CVWIN) + (size_t)e * DM * 3 * DM, DM, 3 * DM, (bf16_t*)(F.ws + WS_WCVIN) + (size_t)e * 3 * DM * DM, 1, scr, r % I_CVI, lane); continue; } r -= 2 * I_CVI;
        if (r < 2 * I_CVO) { const int e = r / I_CVO; p0_transpose_item(FIN(I_CVWOUT) + (size_t)e * DM * DM, DM, DM, (bf16_t*)(F.ws + WS_WCVOUT) + (size_t)e * DM * DM, 0, scr, r % I_CVO, lane); continue; } r -= 2 * I_CVO;
        if (r < 4 * I_UP) { const int e = r / I_UP; p0_transpose_item(FIN(I_W1) + (size_t)e * DM * DFF, DM, DFF, (bf16_t*)(F.ws + WS_WUP) + (size_t)e * DFF * DM, 0, scr, r % I_UP, lane); continue; } r -= 4 * I_UP;
        if (r < 4 * I_DN) { const int e = r / I_DN; p0_transpose_item(FIN(I_W2) + (size_t)e * DFF * DM, DFF, DM, (bf16_t*)(F.ws + WS_WDN) + (size_t)e * DM * DFF, 0, scr, r % I_DN, lane); continue; } r -= 4 * I_DN;
        { const int e = r / I_GLU; p0_transpose_item(FIN(I_GLUW) + (size_t)e * S5W * S5W, S5W, S5W, (bf16_t*)(F.ws + WS_WGLU) + (size_t)e * S5W * S5W, 0, scr, r % I_GLU, lane); }
    }
}

__device__ __forceinline__ const bf16_t* wt_of_norm(const unsigned char* ws, int s, int& N) {
    const int l = s >> 1;
    if (s & 1) { N = DFF; return (const bf16_t*)(ws + WS_WUP) + (size_t)l * DFF * DM; }
    if (l & 1) { N = 3 * DM; return (const bf16_t*)(ws + WS_WCVIN) + (size_t)(l >> 1) * 3 * DM * DM; }
    N = ABIN; return (const bf16_t*)(ws + WS_WABIN) + (size_t)(l >> 1) * ABIN * DM;
}
__device__ __forceinline__ void pre_phase(Frame& F) {
    const int lane = lane_id_opaque(), wave = F.wave, tid = wave * 64 + lane;
    GAS unsigned char* wsg_ = (GAS unsigned char*)F.ws; asm volatile("" : "+s"(wsg_)); unsigned char* ws = (unsigned char*)wsg_;
    const int gw = F.vcu * NWAVES + wave, NGW = F.G * NWAVES;
    const float* ADA0 = (const float*)(ws + WS_ADA);
    { float* GV = (float*)(ws + WS_GV);
      for (int i = F.vcu * 512 + tid; i < 8 * 9 * DM; i += F.G * 512) { const int s = i / (9 * DM), r = i % (9 * DM), j = r / DM, col = r % DM, l = s >> 1, which = s & 1;
        GV[i] = F.in[which ? I_N2G : I_N1G][l * DM + col] * (1.f + ADA0[((size_t)l * 9 + j) * 12288 + (which ? 4 : 1) * DM + col]); } }
    { bf16_t* H = (bf16_t*)(ws + WS_H); float* SSQ = (float*)(ws + WS_SSQ); const float* gn = FIN(I_N1G);
      for (int m = gw; m < MTOK; m += NGW) {
        const float* xrow = m < NCTX ? FIN(I_XP) + (size_t)m * DM : FIN(I_XS) + (size_t)(m - NCTX) * DM;
        const f32x4* xr = (const f32x4*)xrow + lane;
        const float* ad = ADA0 + (size_t)ada_row_of_token(m) * 12288;
        u32x2* o8 = (u32x2*)(H + (size_t)m * DM) + lane; float sq = 0.f;
#pragma unroll
        for (int j = 0; j < 8; ++j) { const int col = 4 * lane + 256 * j; const f32x4 v = __builtin_nontemporal_load(xr + 64 * j);
            sq += (v[0] * v[0] + v[1] * v[1]) + (v[2] * v[2] + v[3] * v[3]);
            const f32x4 g = *(const f32x4*)(gn + col), sc = *(const f32x4*)(ad + DM + col);
            const f32x4 h = v * g * (sc + 1.f);
            u32x2 w; w.x = pk2(h[0], h[1]); w.y = pk2(h[2], h[3]); o8[64 * j] = w; }
        sq = wave_sum_dpp(sq);
        if (lane == 0) SSQ[m] = sq; } }
    { float* BIAS = (float*)(ws + WS_BIAS);
      constexpr int T_AB = ABIN / 16, T_CV = 3 * DM / 16, T_UP = DFF / 16, T_PAIR = T_AB + T_UP + T_CV + T_UP;
      for (int it = gw; it < 2 * T_PAIR; it += NGW) {
        int r = it % T_PAIR, s = (it / T_PAIR) * 4;
        if (r >= T_AB) { r -= T_AB; ++s; if (r >= T_UP) { r -= T_UP; ++s; if (r >= T_CV) { r -= T_CV; ++s; } } }
        const int l = s >> 1, which = s & 1, n0 = r * 16;
        int N; const bf16_t* Wt = wt_of_norm(ws, s, N);
        const GAS bf16_t* wp = (const GAS bf16_t*)Wt + (size_t)(n0 + (lane & 15)) * DM + (lane >> 4) * 8;
        const int jj = (lane & 15) < 9 ? (lane & 15) : 8;
        const GAS float* sp = (const GAS float*)ADA0 + ((size_t)l * 9 + jj) * 12288 + (which ? 3 : 0) * DM + (lane >> 4) * 8;
        f32x4 acc = {0.f, 0.f, 0.f, 0.f};
#pragma unroll 8
        for (int ks = 0; ks < DM / 32; ++ks) {
            const bf16x8 a = *(const GAS bf16x8*)(wp + ks * 32);
            const f32x4 b0 = *(const GAS f32x4*)(sp + ks * 32), b1 = *(const GAS f32x4*)(sp + ks * 32 + 4);
            u32x4 hw; hw.x = pk2(b0[0], b0[1]); hw.y = pk2(b0[2], b0[3]); hw.z = pk2(b1[0], b1[1]); hw.w = pk2(b1[2], b1[3]);
            u32x4 lw; lw.x = pk2(b0[0] - bflo(hw.x), b0[1] - bfhi(hw.x)); lw.y = pk2(b0[2] - bflo(hw.y), b0[3] - bfhi(hw.y));
            lw.z = pk2(b1[0] - bflo(hw.z), b1[1] - bfhi(hw.z)); lw.w = pk2(b1[2] - bflo(hw.w), b1[3] - bfhi(hw.w));
            acc = __builtin_amdgcn_mfma_f32_16x16x32_bf16(a, *(const bf16x8*)&hw, acc, 0, 0, 0);
            acc = __builtin_amdgcn_mfma_f32_16x16x32_bf16(a, *(const bf16x8*)&lw, acc, 0, 0, 0);
        }
        if ((lane & 15) < 9) *(GAS f32x4*)(BIAS + ((size_t)s * 9 + (lane & 15)) * DFF + n0 + (lane >> 4) * 4) = acc;
      } }
}
__device__ __forceinline__ void qknorm_phase(Frame& F, int e) {
    const int lane = lane_id_opaque(), wave = F.wave, tid = wave * 64 + lane; (void)tid;
    GAS unsigned char* wsg_ = (GAS unsigned char*)F.ws; asm volatile("" : "+s"(wsg_)); unsigned char* ws = (unsigned char*)wsg_;

    const int gw = F.vcu * NWAVES + wave, NGW = F.G * NWAVES;
    bf16_t* Q = (bf16_t*)(ws + WS_Q); bf16_t* Kb = (bf16_t*)(ws + WS_K); const bf16_t* V = (const bf16_t*)(ws + WS_V);
    const int d0 = (lane & 7) * 16;
    float gq[16], gk[16];
#pragma unroll
    for (int i = 0; i < 16; ++i) { gq[i] = FIN(I_QNG)[e * 128 + d0 + i]; gk[i] = FIN(I_KNG)[e * 128 + d0 + i]; }
    for (int m = gw; m < MTOK; m += NGW) {
#pragma unroll
        for (int t = 0; t < 2; ++t) {
            bf16_t* row = (t ? Kb : Q) + (size_t)m * 1024 + lane * 16;
            const u32x4 a = *(const u32x4*)row, b = *(const u32x4*)(row + 8);
            float x[16];
#pragma unroll
            for (int i = 0; i < 4; ++i) { x[2 * i] = bflo(a[i]); x[2 * i + 1] = bfhi(a[i]); x[8 + 2 * i] = bflo(b[i]); x[8 + 2 * i + 1] = bfhi(b[i]); }
            float s = 0.f;
#pragma unroll
            for (int i = 0; i < 16; ++i) s += x[i] * x[i];
            s += lane_xor(s, lane, 1); s += lane_xor(s, lane, 2); s += lane_xor(s, lane, 4);
            const float rstd = 1.f / sqrtf(s * (1.f / 128.f) + NORM_EPS);
#pragma unroll
            for (int i = 0; i < 16; ++i) x[i] = x[i] * rstd * (t ? gk[i] : gq[i]);
            u32x4 oa, ob;
#pragma unroll
            for (int i = 0; i < 4; ++i) { oa[i] = pk2(x[2 * i], x[2 * i + 1]); ob[i] = pk2(x[8 + 2 * i], x[8 + 2 * i + 1]); }
            *(u32x4*)row = oa; *(u32x4*)(row + 8) = ob;
            if (t == 1 && m < NCTX) { const int b_ = m >> 8, tt = m & 255; float* o = F.out + O_CK + (((size_t)b_ * 2 + e) * 256 + tt) * 1024 + lane * 16;
#pragma unroll
                for (int i = 0; i < 4; ++i) __builtin_nontemporal_store((f32x4){x[4 * i], x[4 * i + 1], x[4 * i + 2], x[4 * i + 3]}, (f32x4*)(o + 4 * i)); }
        }
        if (m < NCTX) { const int b_ = m >> 8, tt = m & 255; float* o = F.out + O_CV + (((size_t)b_ * 2 + e) * 256 + tt) * 1024 + lane * 16;
            const bf16_t* row = V + (size_t)m * 1024 + lane * 16; const u32x4 a = *(const u32x4*)row, b = *(const u32x4*)(row + 8);
            *(f32x4*)(o + 0) = (f32x4){bflo(a[0]), bfhi(a[0]), bflo(a[1]), bfhi(a[1])}; *(f32x4*)(o + 4) = (f32x4){bflo(a[2]), bfhi(a[2]), bflo(a[3]), bfhi(a[3])};
            *(f32x4*)(o + 8) = (f32x4){bflo(b[0]), bfhi(b[0]), bflo(b[1]), bfhi(b[1])}; *(f32x4*)(o + 12) = (f32x4){bflo(b[2]), bfhi(b[2]), bflo(b[3]), bfhi(b[3])}; }
    }
}
__device__ __forceinline__ void conv_phase(Frame& F, int o) {
    const int lane = lane_id_opaque(), wave = F.wave, tid = wave * 64 + lane; (void)tid;
    GAS unsigned char* wsg_ = (GAS unsigned char*)F.ws; asm volatile("" : "+s"(wsg_)); unsigned char* ws = (unsigned char*)wsg_;

    const int gw = F.vcu * NWAVES + wave, NGW = F.G * NWAVES;
    const bf16_t* Z = (const bf16_t*)(ws + WS_Z); const bf16_t* GB = (const bf16_t*)(ws + WS_GB); bf16_t* A2 = (bf16_t*)(ws + WS_A2);
    const float* cw = FIN(I_CVW) + (size_t)o * 3 * DM; const float* cb = FIN(I_CVB) + (size_t)o * DM;
    for (int it = gw; it < (MTOK / 16) * 4; it += NGW) {
        const int rc = it >> 2, cq = it & 3, m0 = rc * 16, col = cq * 512 + lane * 8;
        float w0[8], w1[8], w2[8], bb[8];
#pragma unroll
        for (int i = 0; i < 8; ++i) { w0[i] = cw[col + i]; w1[i] = cw[DM + col + i]; w2[i] = cw[2 * DM + col + i]; bb[i] = cb[col + i]; }
        const int L = m0 < NCTX ? CTX_L : LAT_L; const int t0 = (m0 < NCTX ? m0 : m0 - NCTX) % L;
        u32x4 zp = (u32x4){0u, 0u, 0u, 0u}, zc, zn;
        if (t0 > 0) zp = *(const u32x4*)(Z + (size_t)(m0 - 1) * DM + col);
        zc = *(const u32x4*)(Z + (size_t)m0 * DM + col);
#pragma unroll 4
        for (int r = 0; r < 16; ++r) { const int m = m0 + r;
            zn = (u32x4){0u, 0u, 0u, 0u}; if (t0 + r + 1 < L) zn = *(const u32x4*)(Z + (size_t)(m + 1) * DM + col);
            const u32x4 gb = *(const u32x4*)(GB + (size_t)m * DM + col);
            float ov[8];
#pragma unroll
            for (int i = 0; i < 4; ++i) {
                const float c0 = w0[2 * i] * bflo(zp[i]) + w1[2 * i] * bflo(zc[i]) + w2[2 * i] * bflo(zn[i]) + bb[2 * i];
                const float c1 = w0[2 * i + 1] * bfhi(zp[i]) + w1[2 * i + 1] * bfhi(zc[i]) + w2[2 * i + 1] * bfhi(zn[i]) + bb[2 * i + 1];
                ov[2 * i] = bflo(gb[i]) * c0; ov[2 * i + 1] = bfhi(gb[i]) * c1; }
            u32x4 ow; ow.x = pk2(ov[0], ov[1]); ow.y = pk2(ov[2], ov[3]); ow.z = pk2(ov[4], ov[5]); ow.w = pk2(ov[6], ov[7]);
            *(u32x4*)(A2 + (size_t)m * DM + col) = ow;
            zp = zc; zc = zn; }
    }
}
#ifndef ATT_SDEPTH
#define ATT_SDEPTH 2
#endif
__device__ __forceinline__ void attn_phase(Frame& F, int e) {
    const int lane = lane_id_opaque(), wave = F.wave, tid = wave * 64 + lane; (void)tid;
    GAS unsigned char* wsg_ = (GAS unsigned char*)F.ws; asm volatile("" : "+s"(wsg_)); unsigned char* ws = (unsigned char*)wsg_;

    const bf16_t* Q = (const bf16_t*)(ws + WS_Q); const bf16_t* Kb = (const bf16_t*)(ws + WS_K); const bf16_t* V = (const bf16_t*)(ws + WS_V);
    bf16_t* AO = (bf16_t*)(ws + WS_AO);
    const bf16_t* CK = (const bf16_t*)(ws + WS_CK); const bf16_t* CV = (const bf16_t*)(ws + WS_CV);
    LAS char* lds = (LAS char*)F.lds;
    for (int u = F.vcu; u < 1024 + 256; u += F.G) {
        __syncthreads();
        if (u < 1024) {
            const int b = u >> 7, h = (u >> 4) & 7, R = (u & 15) * 4;
            int kr0 = R - 4; kr0 = kr0 < 0 ? 0 : (kr0 > 52 ? 52 : kr0);
            LAS float* bl = (LAS float*)(lds + att::OFF_BIAS);
            { const int t2 = wave * 64 + lane_id_opaque();
              if (t2 < 15 * 32) { const int dr = t2 >> 5, dc = t2 & 31; bl[t2] = dc < 31 ? FIN(I_RPB)[((size_t)(e * 8 + h) * 15 + dr) * 31 + dc] * 11.313708498984761f : 0.f; } }
            const size_t seq0 = (size_t)NCTX + (size_t)b * LAT_L;
            const bf16_t* Qb = Q + (seq0 + (size_t)R * 64) * 1024 + h * 128;
            const bf16_t* K0 = CK + (((size_t)b * 2 + e) * 256) * 1024 + h * 128; const bf16_t* V0 = CV + (((size_t)b * 2 + e) * 256) * 1024 + h * 128;
            const bf16_t* K1 = Kb + (seq0 + (size_t)kr0 * 64) * 1024 + h * 128; const bf16_t* V1 = V + (seq0 + (size_t)kr0 * 64) * 1024 + h * 128;
            bf16_t* Ob = AO + (seq0 + (size_t)R * 64) * ABOUT + S5W + h * 128;
            att::attn_unit<true, ATT_SDEPTH>(lds, Qb, K0, V0, 4, K1, V1, 16, Ob, ABOUT, R, kr0, wave);
        } else {
            const int uc = u - 1024, b = uc >> 3, h = uc & 7;
            const size_t seq0 = (size_t)b * CTX_L;
            const bf16_t* Qb = Q + seq0 * 1024 + h * 128; const bf16_t* K0 = Kb + seq0 * 1024 + h * 128; const bf16_t* V0 = V + seq0 * 1024 + h * 128;
            bf16_t* Ob = AO + seq0 * ABOUT + S5W + h * 128;
            att::attn_unit<false, ATT_SDEPTH>(lds, Qb, K0, V0, 4, K0, V0, 4, Ob, ABOUT, 0, 0, wave);
        }
    }
}

constexpr int NPHASE = 2 + 6 * NLAYER;
#ifndef REP_PRO
#define REP_PRO 1
#endif
#ifndef REP_PRE
#define REP_PRE 1
#endif
#ifndef REP_S5A
#define REP_S5A 1
#endif
#ifndef REP_S5B
#define REP_S5B 1
#endif
#ifndef REP_ATT
#define REP_ATT 1
#endif
#ifndef REP_CONV
#define REP_CONV 1
#endif
#ifndef REP_UP
#define REP_UP 1
#endif
#ifndef GEMM_STAMP
#define GEMM_STAMP 0
#endif
#ifndef PG8_SP2
#define PG8_SP2 true
#endif
#ifndef PG8_ALIGN
#define PG8_ALIGN true
#endif

__global__ void __launch_bounds__(NWAVES * 64, 2) fwd(Args args) {
    extern __shared__ __attribute__((aligned(16))) unsigned char lds[];
    Frame F;
    F.lds = (LAS unsigned char*)lds;
    F.wave = __builtin_amdgcn_readfirstlane((int)threadIdx.x >> 6);
    F.G = gridDim.x; { const int bx = blockIdx.x; F.vcu = (F.G % 8 == 0) ? (bx % 8) * (F.G / 8) + bx / 8 : bx; }
    F.in = args.in; F.out = (float*)(GAS float*)args.out; F.ws = (unsigned char*)(GAS unsigned char*)args.ws;
    for (int u = threadIdx.x; u < (LDS_BYTES - LDSCTL_OFF) / 4; u += NWAVES * 64) ((LAS unsigned*)(F.lds + LDSCTL_OFF))[u] = 0u;
    __syncthreads();
    volatile LAS unsigned* MISC = (volatile LAS unsigned*)(F.lds + MISC_OFF);
    XcdBarrier bar = xcd_barrier_post((unsigned*)(F.ws + WS_CTL) + CW_BAR, MISC + 8);
#if MK_PER_PHASE
    const int lo = args.ph_lo, hi = args.ph_hi;
#else
    constexpr int lo = 0, hi = NPHASE;
#endif
#define IN(k) (lo <= (k) && (k) < hi)
#if GEMM_STAMP == 7
#define SEAM(k) do { if (lo <= (k) && (k) + 1 < hi) { const unsigned long long t0_ = __builtin_amdgcn_s_memrealtime(); xcd_barrier(bar, F.wave); const unsigned long long dt_ = __builtin_amdgcn_s_memrealtime() - t0_; if (blockIdx.x == 0 && threadIdx.x == 0) atomicAdd((unsigned long long*)(F.ws + WS_CTL + 65536) + 3, dt_); } } while (0)
#else
#define SEAM(k) do { if (lo <= (k) && (k) + 1 < hi) xcd_barrier(bar, F.wave); } while (0)
#endif
#define OPAQUE_WS GAS unsigned char* wsg_ = (GAS unsigned char*)F.ws; asm volatile("" : "+s"(wsg_)); unsigned char* ws = (unsigned char*)wsg_; int bxo = bx; asm volatile("" : "+s"(bxo)); (void)bxo
    LAS unsigned char* ring = F.lds;
    const int bx = (int)blockIdx.x;

    if (IN(0)) { for (int rep = 0; rep < REP_PRO; ++rep) { p0_prologue(F); __syncthreads(); } }
    SEAM(0);
    if (IN(1)) { for (int rep = 0; rep < REP_PRE; ++rep) pre_phase(F); }
    SEAM(1);
#pragma unroll 1
    for (int l = 0; l < NLAYER; ++l) {
        const int pb = 2 + 6 * l, e = l >> 1;
        const float* ADA = (const float*)(F.ws + WS_ADA) + (size_t)l * 9 * 12288;
        const float* rb0 = l == 0 ? FIN(I_XP) : F.out; const float* rb1 = l == 0 ? FIN(I_XS) - (size_t)NCTX * DM : F.out;
        if ((l & 1) == 0) {
            if (IN(pb + 0)) { OPAQUE_WS; pg8::Gemm g{(const bf16_t*)(ws + WS_H), (const bf16_t*)(ws + WS_WABIN) + (size_t)e * ABIN * DM, MTOK, ABIN, DM}; pg8::StaticOrder S; S.init(MTOK, ABIN, F.G, bxo);
                pg8::EpiAbIn E{(bf16_t*)(ws + WS_U), (bf16_t*)(ws + WS_Q), (size_t)(WS_K - WS_Q) / 2, pg8::NormIn{(const float*)(ws + WS_SSQ) + (size_t)(2 * l) * MTOK, (const float*)(ws + WS_BIAS) + (size_t)(2 * l) * 9 * DFF, DFF}};
                pg8::gemm_phase_i<pg8::EpiAbIn, pg8::StaticOrder>(ring, g, S, E, F.wave); }
            SEAM(pb + 0);
            if (IN(pb + 1)) { OPAQUE_WS; qknorm_phase(F, e);
                for (int rep = 0; rep < REP_S5A; ++rep) s5::phase_a(e, (const bf16_t*)(ws + WS_U), (const float4*)(ws + WS_S5A), (const bf16_t*)(ws + WS_S5BB), (float*)(ws + WS_E), (float*)(ws + WS_EC), F.G, F.vcu, F.wave); }
            SEAM(pb + 1);
            if (IN(pb + 2)) { OPAQUE_WS;
                for (int rep = 0; rep < REP_S5B; ++rep) s5::phase_b((LAS char*)F.lds, e, (const bf16_t*)(ws + WS_U), (const float4*)(ws + WS_S5A), (const float2*)(ws + WS_S5A128), (const bf16_t*)(ws + WS_S5BB), (const bf16_t*)(ws + WS_S5CM), (const float*)(ws + WS_E), (const float*)(ws + WS_EC),
                            FIN(I_SRE), FIN(I_SIM), FIN(I_S5D) + (size_t)e * S5W, (const bf16_t*)(ws + WS_WGLU) + (size_t)e * S5W * S5W, FIN(I_GLUB) + (size_t)e * S5W,
                            (bf16_t*)(ws + WS_AO), F.out + O_SRE, F.out + O_SIM, F.G, F.vcu, F.wave, (unsigned long long*)(ws + WS_CTL + 65536) + 4);
                for (int rep = 0; rep < REP_ATT; ++rep) attn_phase(F, e); }
            SEAM(pb + 2);
            if (IN(pb + 3)) { OPAQUE_WS; pg8::Gemm g{(const bf16_t*)(ws + WS_AO), (const bf16_t*)(ws + WS_WABOUT) + (size_t)e * DM * ABOUT, MTOK, DM, ABOUT}; pg8::StaticOrder S; S.init(MTOK, DM, F.G, bxo);
                pg8::EpiRes<true> E{rb0, rb1, F.out, ADA + 2 * DM, (const float*)(ws + WS_GV) + (size_t)(2 * l + 1) * 9 * DM, (bf16_t*)(ws + WS_H), (float*)(ws + WS_SSQ) + (size_t)(2 * l + 1) * MTOK};
                pg8::gemm_phase<pg8::EpiRes<true>, pg8::StaticOrder, PG8_ALIGN, PG8_SP2>(ring, g, S, E, F.wave); }
            SEAM(pb + 3);
        } else {
            if (IN(pb + 0)) { OPAQUE_WS; pg8::Gemm g{(const bf16_t*)(ws + WS_H), (const bf16_t*)(ws + WS_WCVIN) + (size_t)e * 3 * DM * DM, MTOK, 3 * DM, DM}; pg8::StaticOrder S; S.init(MTOK, 3 * DM, F.G, bxo);
                pg8::EpiConvIn E{(bf16_t*)(ws + WS_Z), (bf16_t*)(ws + WS_GB), pg8::NormIn{(const float*)(ws + WS_SSQ) + (size_t)(2 * l) * MTOK, (const float*)(ws + WS_BIAS) + (size_t)(2 * l) * 9 * DFF, DFF}};
                pg8::gemm_phase_i<pg8::EpiConvIn, pg8::StaticOrder>(ring, g, S, E, F.wave); }
            SEAM(pb + 0);
            if (IN(pb + 1)) { for (int rep = 0; rep < REP_CONV; ++rep) conv_phase(F, e); }
            SEAM(pb + 2);
            if (IN(pb + 3)) { OPAQUE_WS; pg8::Gemm g{(const bf16_t*)(ws + WS_A2), (const bf16_t*)(ws + WS_WCVOUT) + (size_t)e * DM * DM, MTOK, DM, DM}; pg8::StaticOrder S; S.init(MTOK, DM, F.G, bxo);
                pg8::EpiRes<true> E{rb0, rb1, F.out, ADA + 2 * DM, (const float*)(ws + WS_GV) + (size_t)(2 * l + 1) * 9 * DM, (bf16_t*)(ws + WS_H), (float*)(ws + WS_SSQ) + (size_t)(2 * l + 1) * MTOK};
                pg8::gemm_phase<pg8::EpiRes<true>, pg8::StaticOrder, PG8_ALIGN, PG8_SP2>(ring, g, S, E, F.wave); }
            SEAM(pb + 3);
        }
        if (IN(pb + 4)) { OPAQUE_WS; pg8::Gemm g{(const bf16_t*)(ws + WS_H), (const bf16_t*)(ws + WS_WUP) + (size_t)l * DFF * DM, MTOK, DFF, DM}; pg8::StaticOrder S; S.init(MTOK, DFF, F.G, bxo);
            pg8::EpiRelu2 E{(bf16_t*)(ws + WS_BIG), DFF, pg8::NormIn{(const float*)(ws + WS_SSQ) + (size_t)(2 * l + 1) * MTOK, (const float*)(ws + WS_BIAS) + (size_t)(2 * l + 1) * 9 * DFF, DFF}};
#if GEMM_STAMP
            pg8::gemm_phase_i<pg8::EpiRelu2, pg8::StaticOrder>(ring, g, S, E, F.wave, (unsigned long long*)(ws + WS_CTL + 65536)); }
#else
            for (int rep = 0; rep < REP_UP; ++rep) pg8::gemm_phase_i<pg8::EpiRelu2, pg8::StaticOrder>(ring, g, S, E, F.wave); }
#endif
        SEAM(pb + 4);
        if (IN(pb + 5)) { OPAQUE_WS; pg8::Gemm g{(const bf16_t*)(ws + WS_BIG), (const bf16_t*)(ws + WS_WDN) + (size_t)l * DM * DFF, MTOK, DM, DFF}; pg8::StaticOrder S; S.init(MTOK, DM, F.G, bxo);
            if (l < NLAYER - 1) { pg8::EpiRes<true> E{F.out, F.out, F.out, ADA + 5 * DM, (const float*)(ws + WS_GV) + (size_t)(2 * l + 2) * 9 * DM, (bf16_t*)(ws + WS_H), (float*)(ws + WS_SSQ) + (size_t)(2 * l + 2) * MTOK};
                pg8::gemm_phase<pg8::EpiRes<true>, pg8::StaticOrder, PG8_ALIGN, PG8_SP2>(ring, g, S, E, F.wave); }
            else { pg8::EpiRes<false> E{F.out, F.out, F.out, ADA + 5 * DM, nullptr, nullptr, nullptr};
                pg8::gemm_phase<pg8::EpiRes<false>, pg8::StaticOrder, PG8_ALIGN, PG8_SP2>(ring, g, S, E, F.wave); } }
        SEAM(pb + 5);
    }
#if GEMM_STAMP || S5_STAMP
    if (blockIdx.x == 0 && threadIdx.x == 0) { unsigned long long* st = (unsigned long long*)(F.ws + WS_CTL + 65536);
        const unsigned long long tk = __hip_atomic_load(st, __ATOMIC_RELAXED, __HIP_MEMORY_SCOPE_AGENT), ck = __hip_atomic_load(st + 1, __ATOMIC_RELAXED, __HIP_MEMORY_SCOPE_AGENT), te = __hip_atomic_load(st + 2, __ATOMIC_RELAXED, __HIP_MEMORY_SCOPE_AGENT);
        unsigned long long wait = 0;
#if GEMM_STAMP == 7
        wait = __hip_atomic_load(st + 3, __ATOMIC_RELAXED, __HIP_MEMORY_SCOPE_AGENT);
#endif
        if (S5_STAMP) wait = __hip_atomic_load(st + 4, __ATOMIC_RELAXED, __HIP_MEMORY_SCOPE_AGENT);
        if (GEMM_STAMP == 1) wait = tk ? ck * 10000ull / tk : 0;
        if (GEMM_STAMP == 2) wait = tk / 4;
        if (GEMM_STAMP == 3) wait = te;
        if (GEMM_STAMP >= 4) { unsigned long long mx = 0, mn = ~0ull, sm = 0; for (unsigned i = 0; i < gridDim.x; ++i) { const unsigned long long v = __hip_atomic_load(st + 8 + i, __ATOMIC_RELAXED, __HIP_MEMORY_SCOPE_AGENT); mx = v > mx ? v : mx; mn = v < mn ? v : mn; sm += v; }
            wait = (GEMM_STAMP == 4 ? mx : GEMM_STAMP == 5 ? mn : sm / gridDim.x) / 4; }
        const unsigned long long t0 = __builtin_amdgcn_s_memrealtime(); while (__builtin_amdgcn_s_memrealtime() - t0 < wait) __builtin_amdgcn_s_sleep(32); }
#endif
#undef IN
#undef SEAM
#undef OPAQUE_WS
}

extern "C" void kernel_launch(void* const* d_in, const int* in_sizes, int n_in, void* d_out, int out_size, void* d_ws, size_t ws_size, hipStream_t stream) {
    static int grid = 0;
    if (grid == 0) {
        if (n_in != 33 || ws_size < WS_END) { fprintf(stderr, "kernel_launch: n_in %d ws %zu (need 33, >= %zu)\n", n_in, ws_size, (size_t)WS_END); grid = -1; return; }
        int dev = 0, cus = 0;
        if (hipGetDevice(&dev) != hipSuccess || hipDeviceGetAttribute(&cus, hipDeviceAttributeMultiprocessorCount, dev) != hipSuccess) { grid = -1; return; }
        if (hipFuncSetAttribute((const void*)fwd, hipFuncAttributeMaxDynamicSharedMemorySize, LDS_BYTES) != hipSuccess) { fprintf(stderr, "kernel_launch: hipFuncSetAttribute failed\n"); grid = -1; return; }
        int per_cu = 0;
        if (hipOccupancyMaxActiveBlocksPerMultiprocessor(&per_cu, (const void*)fwd, NWAVES * 64, LDS_BYTES) != hipSuccess || per_cu < 1) fprintf(stderr, "kernel_launch: occupancy query says %d\n", per_cu);
        (void)hipGetLastError();
        grid = cus;
    }
    if (grid < 0) return;
    (void)hipMemsetAsync((char*)d_ws + WS_CTL, 0, CTL_ZERO_BYTES, stream);
    Args a{};
    for (int i = 0; i < 33; ++i) a.in[i] = (const float*)d_in[i];
    a.out = (float*)d_out; a.ws = (unsigned char*)d_ws;
#if MK_PER_PHASE
    for (int p = 0; p < NPHASE; ++p) {
        if (p > 1) { const int l = (p - 2) / 6, k = (p - 2) % 6; if ((l & 1) && k == 2) continue; }
        a.ph_lo = p; a.ph_hi = p + 1;
        hipLaunchKernelGGL(fwd, dim3(grid), dim3(NWAVES * 64), LDS_BYTES, stream, a);
    }
#else
    a.ph_lo = 0; a.ph_hi = NPHASE;
    hipLaunchKernelGGL(fwd, dim3(grid), dim3(NWAVES * 64), LDS_BYTES, stream, a);
#endif
    const hipError_t le = hipPeekAtLastError();
    if (le != hipSuccess) fprintf(stderr, "kernel_launch: launch failed: %s\n", hipGetErrorName(le));
}
```

```cpp
#include <hip/hip_runtime.h>
#include <cstdio>
#include <cstdint>

#ifndef PG8_EARLY
#define PG8_EARLY 0
#endif
#ifndef MK_PER_PHASE
#define MK_PER_PHASE 0
#endif

__device__ __forceinline__ int lane_id_opaque() { int l; asm volatile("v_mbcnt_lo_u32_b32 %0, -1, 0\n\tv_mbcnt_hi_u32_b32 %0, -1, %0" : "=v"(l)); return l; }

namespace pg8 {
#define PG8_LAS __attribute__((address_space(3)))
typedef unsigned short bf16_t;
typedef short bf16x8 __attribute__((ext_vector_type(8)));
typedef float f32x4 __attribute__((ext_vector_type(4)));
typedef unsigned u32x4 __attribute__((ext_vector_type(4)));
constexpr int BM = 256, BK = 64, HALF = 128, HTB = HALF * BK * 2  , STAGE_BYTES = 8 * HTB, NXCD = 8, WGM = 8;

__host__ __device__ __forceinline__ int lds_byte(int r, int c) { const int st = (r >> 4) * 2 + (c >> 5), rr = r & 15, cc = c & 31, ob = rr * 64 + cc * 2; return st * 1024 + (ob ^ (((ob >> 9) & 1) << 5)); }
__host__ __device__ __forceinline__ void stage_rc(int b, int& R, int& C) { const int st = b / 1024, sb = b % 1024, swz = sb ^ (((sb >> 9) & 1) << 5); R = (st >> 1) * 16 + swz / 64; C = (st & 1) * 32 + (swz % 64) / 2; }
__host__ __device__ __forceinline__ int perm32(int rho) { const int n = rho >> 4, i = rho & 15; return 8 * (i >> 2) + 4 * n + (i & 3); }

struct Unit { int pm, pn; };
struct Gemm { const bf16_t* A; const bf16_t* Bt; int M, N, K; };

struct StaticOrder {
    int nM, nN, nwg, G, c;
    __host__ __device__ void init(int M, int N, int G_, int c_) { nM = M / BM; nN = N / BM; nwg = nM * nN; G = G_; c = c_; }
    __host__ __device__ bool next(int i, Unit& u) const {
        const long L = (long)i * G + c; if (L >= nwg) return false;
        int wgid = (int)L; { const int q = nwg / NXCD, r = nwg % NXCD, xcd = wgid % NXCD, off = wgid / NXCD; wgid = (xcd < r ? xcd * (q + 1) : r * (q + 1) + (xcd - r) * q) + off; }
        const int nig = WGM * nN, gid = wgid / nig, fm = gid * WGM, gsz = (nM - fm) < WGM ? (nM - fm) : WGM;
        u.pm = fm + ((wgid % nig) % gsz); u.pn = (wgid % nig) / gsz; return true;
    }
    __device__ __forceinline__ void a_ready(const Unit&) const {}
    __device__ __forceinline__ void done(const Unit&) const {}
};

__device__ __forceinline__ unsigned cvt_pk_bf16(float lo, float hi) { unsigned r; asm volatile("v_cvt_pk_bf16_f32 %0, %1, %2" : "=v"(r) : "v"(lo), "v"(hi)); return r; }

__device__ __forceinline__ void st16(void* p, u32x4 w) { asm volatile("global_store_dwordx4 %0, %1, off\n\ts_nop 1" :: "v"(p), "v"(w) : "memory"); }
typedef unsigned u32x2 __attribute__((ext_vector_type(2)));
__device__ __forceinline__ void st8(void* p, u32x2 w) { asm volatile("global_store_dwordx2 %0, %1, off\n\ts_nop 1" :: "v"(p), "v"(w) : "memory"); }
constexpr int DM = 2048;
__device__ __forceinline__ int ada_row_of_panel(int pm) { return pm < 32 ? 0 : 1 + ((pm - 32) >> 4); }

constexpr int LDSX_OFF = 131072 + 1024;
struct NormIn {
    const float* ssq; const float* bias; int N;
    __device__ __forceinline__ void prefetch(const Unit& u, PG8_LAS unsigned char* lds, int wv, int lane) const {
        const float* src = wv < 4 ? ssq + u.pm * BM + wv * 64 + lane : bias + (size_t)ada_row_of_panel(u.pm) * N + u.pn * BM + (wv - 4) * 64 + lane;
        __builtin_amdgcn_global_load_lds((const unsigned*)src, (PG8_LAS unsigned*)(lds + LDSX_OFF + wv * 256), 4, 0, 0);
    }
    __device__ __forceinline__ void load(PG8_LAS unsigned char* lds, const int ai, int wr, int wc, int fr, int fq, float (&rs)[4], f32x4 (&bv)[2][2]) const {
        const PG8_LAS float* sx = (const PG8_LAS float*)(lds + LDSX_OFF);
#pragma unroll
        for (int m = 0; m < 4; ++m) rs[m] = __builtin_amdgcn_rsqf(sx[ai * HALF + wr * 64 + m * 16 + fr] * (1.0f / DM) + 1e-6f);
#pragma unroll
        for (int bj = 0; bj < 2; ++bj)
#pragma unroll
            for (int n = 0; n < 2; ++n) bv[bj][n] = *(const PG8_LAS f32x4*)(sx + 256 + bj * HALF + wc * 32 + 8 * fq + 4 * n);
    }
};
struct EpiAbIn {
    static constexpr bool PERM = true, AFTER_DRAIN = false, PREFETCH = true;
    bf16_t* U; bf16_t* Q; size_t qkv_stride;
    NormIn nin;
    __device__ __forceinline__ void prefetch(const Unit& u, PG8_LAS unsigned char* lds, int wv, int lane) const { nin.prefetch(u, lds, wv, lane); }
    __device__ __forceinline__ void half(const f32x4 (&acc)[2][2][4][2], const Unit& u, const int ai, int wr, int wc, int, int, PG8_LAS unsigned char* lds) const {
        const int lz = lane_id_opaque(), fr = lz & 15, fq = lz >> 4;
        const int row0 = u.pm * BM + wr * 64 + fr;
        bf16_t* base; int ldc, colt;
        if (u.pn < 2) { base = U; ldc = 512; colt = u.pn * BM; }
        else { const int t = (u.pn - 2) >> 2; base = Q + (size_t)t * qkv_stride; ldc = 1024; colt = ((u.pn - 2) & 3) * BM; }
        const int col0 = colt + wc * 32 + 8 * fq;
        float rs[4]; f32x4 bv[2][2]; nin.load(lds, ai, wr, wc, fr, fq, rs, bv);
#pragma unroll
        for (int m = 0; m < 4; ++m) { bf16_t* rowp = base + (size_t)(row0 + ai * HALF + m * 16) * ldc + col0;
#pragma unroll
            for (int bj = 0; bj < 2; ++bj) { const f32x4 v0 = acc[ai][bj][m][0] * rs[m] + bv[bj][0], v1 = acc[ai][bj][m][1] * rs[m] + bv[bj][1];
                u32x4 w; w.x = cvt_pk_bf16(v0[0], v0[1]); w.y = cvt_pk_bf16(v0[2], v0[3]); w.z = cvt_pk_bf16(v1[0], v1[1]); w.w = cvt_pk_bf16(v1[2], v1[3]);
                st16(rowp + bj * HALF, w); } }
    }
};
struct EpiRelu2 {
    static constexpr bool PERM = true, AFTER_DRAIN = false, PREFETCH = true;
    bf16_t* O; int ldc; NormIn nin;
    __device__ __forceinline__ void prefetch(const Unit& u, PG8_LAS unsigned char* lds, int wv, int lane) const { nin.prefetch(u, lds, wv, lane); }
    __device__ __forceinline__ void half(const f32x4 (&acc)[2][2][4][2], const Unit& u, const int ai, int wr, int wc, int, int, PG8_LAS unsigned char* lds) const {
        const int lz = lane_id_opaque(), fr = lz & 15, fq = lz >> 4;
        const int row0 = u.pm * BM + wr * 64 + fr, col0 = u.pn * BM + wc * 32 + 8 * fq;
        float rs[4]; f32x4 bv[2][2]; nin.load(lds, ai, wr, wc, fr, fq, rs, bv);
#pragma unroll
        for (int m = 0; m < 4; ++m) { bf16_t* rowp = O + (size_t)(row0 + ai * HALF + m * 16) * ldc + col0;
#pragma unroll
            for (int bj = 0; bj < 2; ++bj) { f32x4 v0 = acc[ai][bj][m][0] * rs[m] + bv[bj][0], v1 = acc[ai][bj][m][1] * rs[m] + bv[bj][1];
#pragma unroll
                for (int j = 0; j < 4; ++j) { const float a = fmaxf(v0[j], 0.f), b = fmaxf(v1[j], 0.f); v0[j] = a * a; v1[j] = b * b; }
                u32x4 w; w.x = cvt_pk_bf16(v0[0], v0[1]); w.y = cvt_pk_bf16(v0[2], v0[3]); w.z = cvt_pk_bf16(v1[0], v1[1]); w.w = cvt_pk_bf16(v1[2], v1[3]);
                st16(rowp + bj * HALF, w); } }
    }
};
struct EpiConvIn {
    static constexpr bool PERM = true, AFTER_DRAIN = false, PREFETCH = true;
    bf16_t* Z; bf16_t* GB; NormIn nin;
    __device__ __forceinline__ void prefetch(const Unit& u, PG8_LAS unsigned char* lds, int wv, int lane) const { nin.prefetch(u, lds, wv, lane); }
    __device__ __forceinline__ void half(const f32x4 (&acc)[2][2][4][2], const Unit& u, const int ai, int wr, int wc, int, int, PG8_LAS unsigned char* lds) const {
        const int lz = lane_id_opaque(), fr = lz & 15, fq = lz >> 4;
        const int row0 = u.pm * BM + wr * 64 + fr;
        float rs[4]; f32x4 bv[2][2]; nin.load(lds, ai, wr, wc, fr, fq, rs, bv);
        if (u.pn < 16) {
            const int col0 = u.pn * HALF + wc * 32 + 8 * fq;
#pragma unroll
            for (int m = 0; m < 4; ++m) { bf16_t* rowp = Z + (size_t)(row0 + ai * HALF + m * 16) * DM + col0;
                const f32x4 v0 = (acc[ai][0][m][0] * rs[m] + bv[0][0]) * (acc[ai][1][m][0] * rs[m] + bv[1][0]), v1 = (acc[ai][0][m][1] * rs[m] + bv[0][1]) * (acc[ai][1][m][1] * rs[m] + bv[1][1]);
                u32x2 wa, wb; wa.x = cvt_pk_bf16(v0[0], v0[1]); wa.y = cvt_pk_bf16(v0[2], v0[3]); wb.x = cvt_pk_bf16(v1[0], v1[1]); wb.y = cvt_pk_bf16(v1[2], v1[3]);
                st8(rowp, wa); st8(rowp + 4, wb); }
        } else {
            const int col0 = (u.pn - 16) * BM + wc * 32 + 8 * fq;
#pragma unroll
            for (int m = 0; m < 4; ++m) { bf16_t* rowp = GB + (size_t)(row0 + ai * HALF + m * 16) * DM + col0;
#pragma unroll
                for (int bj = 0; bj < 2; ++bj) { const f32x4 v0 = acc[ai][bj][m][0] * rs[m] + bv[bj][0], v1 = acc[ai][bj][m][1] * rs[m] + bv[bj][1];
                    u32x4 w; w.x = cvt_pk_bf16(v0[0], v0[1]); w.y = cvt_pk_bf16(v0[2], v0[3]); w.z = cvt_pk_bf16(v1[0], v1[1]); w.w = cvt_pk_bf16(v1[2], v1[3]);
                    st16(rowp + bj * HALF, w); } }
        }
    }
};
template <bool NEXT> struct EpiRes {
    static constexpr bool PERM = false, AFTER_DRAIN = false, PREFETCH = false;
    const float* base0; const float* base1; float* out; const float* gate;
    const float* gvn; bf16_t* Hn; float* ssqn;
    __device__ __forceinline__ void operator()(const f32x4 (&acc)[2][2][4][2], const Unit& u, int wr, int wc, int fr, int fq, PG8_LAS unsigned char* lds) const {
        const int row0 = u.pm * BM + wr * 64 + fr, col0 = u.pn * BM + wc * 32 + 4 * fq;
        const int j = ada_row_of_panel(u.pm);
        const float* g = gate + j * 12288 + col0;
        const char* bs = (const char*)(u.pm < 32 ? base0 : base1); char* ob = (char*)out; char* hb = (char*)Hn;
        const unsigned o0 = (unsigned)(row0 * DM + col0) * 4u;
        f32x4 gv[2][2], gn[2][2];
#pragma unroll
        for (int bj = 0; bj < 2; ++bj)
#pragma unroll
            for (int n = 0; n < 2; ++n) { gv[bj][n] = *(const f32x4*)(g + bj * HALF + n * 16); if (NEXT) gn[bj][n] = *(const f32x4*)(gvn + j * DM + col0 + bj * HALF + n * 16); }
#pragma unroll
        for (int am = 0; am < 4; ++am) { const int ai = am >> 1, mh = (am & 1) * 2;
            f32x4 b[2][2][2];
#pragma unroll
            for (int mm = 0; mm < 2; ++mm)
#pragma unroll
                for (int bj = 0; bj < 2; ++bj)
#pragma unroll
                    for (int n = 0; n < 2; ++n) b[mm][bj][n] = *(const f32x4*)(bs + (o0 + (unsigned)(((ai * HALF + (mh + mm) * 16) * DM + bj * HALF + n * 16) * 4)));
#pragma unroll
            for (int mm = 0; mm < 2; ++mm) { const int m = mh + mm; float sq = 0.f;
#pragma unroll
                for (int bj = 0; bj < 2; ++bj)
#pragma unroll
                    for (int n = 0; n < 2; ++n) { const unsigned o = o0 + (unsigned)(((ai * HALF + m * 16) * DM + bj * HALF + n * 16) * 4);
                        const f32x4 x = b[mm][bj][n] + gv[bj][n] * acc[ai][bj][m][n];
                        *(f32x4*)(ob + o) = x;
                        if (NEXT) { sq += (x[0] * x[0] + x[1] * x[1]) + (x[2] * x[2] + x[3] * x[3]); const f32x4 h = x * gn[bj][n];
                            typedef unsigned u32x2v __attribute__((ext_vector_type(2))); u32x2v w; w.x = cvt_pk_bf16(h[0], h[1]); w.y = cvt_pk_bf16(h[2], h[3]);
                            *(u32x2v*)(hb + (o >> 1)) = w; } }
                if (NEXT) {
                    auto t = __builtin_amdgcn_permlane16_swap(__float_as_uint(sq), __float_as_uint(sq), false, false); sq = __uint_as_float(t[0]) + __uint_as_float(t[1]);
                    auto v = __builtin_amdgcn_permlane32_swap(__float_as_uint(sq), __float_as_uint(sq), false, false); sq = __uint_as_float(v[0]) + __uint_as_float(v[1]);
                    if (fq == 0) __hip_atomic_fetch_add(ssqn + row0 + ai * HALF + m * 16, sq, __ATOMIC_RELAXED, __HIP_MEMORY_SCOPE_AGENT); } }
            asm volatile("" ::: "memory"); }
    }
};

template <class Epi, class Sched, bool ALIGN_EPI = false, bool SP2 = false>
__device__ __forceinline__ void gemm_phase(PG8_LAS unsigned char* lds, const Gemm g, const Sched& S, const Epi& E, const int wv  , unsigned long long* stamp = nullptr  ) {
    int wvo_ = wv; asm volatile("" : "+s"(wvo_));
    const int lane = lane_id_opaque(), wid = wvo_, tid = wid * 64 + lane, wr = wid >> 2, wc = wid & 3, fr = lane & 15, fq = lane >> 4;
    const int K = g.K, nt = K / BK;
    unsigned voffA[2], voffB[2];
#pragma unroll
    for (int i = 0; i < 2; ++i) { int R, C; stage_rc(tid * 16 + i * 8192, R, C); const int Rb = Epi::PERM ? ((R & ~31) + perm32(R & 31)) : R;
        voffA[i] = (unsigned)(R * K + C) * 2u; voffB[i] = (unsigned)(Rb * K + C) * 2u; }
    const size_t kstep = (size_t)(BK * 2);
    const size_t hstep = (size_t)HALF * K * 2;
    const size_t tstep = 2 * hstep;
    const unsigned ldsw = (unsigned)wid * 1024u;
    const int aoff = lds_byte(wr * 64 + fr, fq * 8), boff = lds_byte(wc * 32 + fr, fq * 8);
#define PG8_SA(b, h) (((b) * 2 + (h)) * HTB)
#define PG8_SB(b, h) ((4 + (b) * 2 + (h)) * HTB)
#define PG8_STAGE(bufoff, gbase, voff) do { _Pragma("unroll") for (int _i = 0; _i < 2; ++_i) \
        __builtin_amdgcn_global_load_lds((const unsigned*)((const char*)(gbase) + (voff)[_i]), (PG8_LAS unsigned*)(lds + (bufoff) + ldsw + _i * 8192), 16, 0, 0); } while (0)
#define PG8_LDA(dst, b, h) do { _Pragma("unroll") for (int m = 0; m < 4; ++m) _Pragma("unroll") for (int k = 0; k < 2; ++k) dst[m][k] = *(const PG8_LAS bf16x8*)(lds + PG8_SA(b, h) + aoff + m * 2048 + k * 1024); } while (0)
#define PG8_LDB(dst, b, h) do { _Pragma("unroll") for (int n = 0; n < 2; ++n) _Pragma("unroll") for (int k = 0; k < 2; ++k) dst[n][k] = *(const PG8_LAS bf16x8*)(lds + PG8_SB(b, h) + boff + n * 2048 + k * 1024); } while (0)
#define PG8_MMA(ai, bj, At, Bt) do { __builtin_amdgcn_s_setprio(1); _Pragma("unroll") for (int m = 0; m < 4; ++m) _Pragma("unroll") for (int n = 0; n < 2; ++n) _Pragma("unroll") for (int k = 0; k < 2; ++k) \
        acc[ai][bj][m][n] = __builtin_amdgcn_mfma_f32_16x16x32_bf16(Bt[n][k], At[m][k], acc[ai][bj][m][n], 0, 0, 0); __builtin_amdgcn_s_setprio(0); } while (0)
#define PG8_MMA2B(ai, At, B0, B1) do { __builtin_amdgcn_s_setprio(1); \
        _Pragma("unroll") for (int m = 0; m < 4; ++m) _Pragma("unroll") for (int n = 0; n < 2; ++n) _Pragma("unroll") for (int k = 0; k < 2; ++k) acc[ai][0][m][n] = __builtin_amdgcn_mfma_f32_16x16x32_bf16(B0[n][k], At[m][k], acc[ai][0][m][n], 0, 0, 0); \
        _Pragma("unroll") for (int m = 0; m < 4 - PG8_EARLY; ++m) _Pragma("unroll") for (int n = 0; n < 2; ++n) _Pragma("unroll") for (int k = 0; k < 2; ++k) acc[ai][1][m][n] = __builtin_amdgcn_mfma_f32_16x16x32_bf16(B1[n][k], At[m][k], acc[ai][1][m][n], 0, 0, 0); \
        __builtin_amdgcn_sched_barrier(0); __builtin_amdgcn_s_barrier(); __builtin_amdgcn_sched_barrier(0); \
        _Pragma("unroll") for (int m = 4 - PG8_EARLY; m < 4; ++m) _Pragma("unroll") for (int n = 0; n < 2; ++n) _Pragma("unroll") for (int k = 0; k < 2; ++k) acc[ai][1][m][n] = __builtin_amdgcn_mfma_f32_16x16x32_bf16(B1[n][k], At[m][k], acc[ai][1][m][n], 0, 0, 0); \
        __builtin_amdgcn_s_setprio(0); } while (0)
#define PG8_WAIT_V(n) asm volatile("s_waitcnt vmcnt(" #n ")" ::: "memory")
#define PG8_WAIT_L(n) asm volatile("s_waitcnt lgkmcnt(" #n ")" ::: "memory")
#define PG8_BAR __builtin_amdgcn_s_barrier()
#define PG8_SCHED __builtin_amdgcn_sched_barrier(0)
    Unit cur, nxt; int ui = 0;
    if (!S.next(0, cur)) return;
    f32x4 acc[2][2][4][2];
#pragma unroll
    for (int a = 0; a < 2; ++a)
#pragma unroll
        for (int b = 0; b < 2; ++b)
#pragma unroll
            for (int m = 0; m < 4; ++m)
#pragma unroll
                for (int n = 0; n < 2; ++n) acc[a][b][m][n] = (f32x4){0.f, 0.f, 0.f, 0.f};
    bf16x8 At[4][2], B0[2][2], B1[2][2];
    const char* cA = (const char*)g.A + (size_t)cur.pm * tstep; const char* cB = (const char*)g.Bt + (size_t)cur.pn * tstep;
    S.a_ready(cur);
    if constexpr (SP2) {
        PG8_STAGE(PG8_SB(0, 0), cB, voffB); PG8_STAGE(PG8_SB(0, 1), cB + hstep, voffB); PG8_STAGE(PG8_SA(0, 0), cA, voffA); PG8_STAGE(PG8_SA(0, 1), cA + hstep, voffA);
        if (wr == 1) PG8_BAR;
        PG8_WAIT_V(2); PG8_BAR;
        PG8_STAGE(PG8_SB(1, 0), cB + kstep, voffB); PG8_STAGE(PG8_SA(1, 0), cA + kstep, voffA); PG8_STAGE(PG8_SB(1, 1), cB + hstep + kstep, voffB);
        PG8_WAIT_V(6); PG8_BAR;
    } else {
        PG8_STAGE(PG8_SB(0, 0), cB, voffB); PG8_STAGE(PG8_SA(0, 0), cA, voffA); PG8_STAGE(PG8_SB(0, 1), cB + hstep, voffB); PG8_STAGE(PG8_SA(0, 1), cA + hstep, voffA);
        if (wr == 1) PG8_BAR;
        PG8_WAIT_V(4); PG8_BAR;
        PG8_STAGE(PG8_SB(1, 0), cB + kstep, voffB); PG8_STAGE(PG8_SA(1, 0), cA + kstep, voffA); PG8_STAGE(PG8_SB(1, 1), cB + hstep + kstep, voffB);
        PG8_WAIT_V(6); PG8_BAR;
    }
    unsigned long long st_tk = 0, st_ck = 0, st_te = 0;
    for (;;) {
        const bool has_next = S.next(ui + 1, nxt);
        unsigned long long st_r0 = 0, st_c0 = 0; if (stamp) { st_r0 = __builtin_amdgcn_s_memrealtime(); st_c0 = __builtin_readcyclecounter(); }
        const char* nA = has_next ? (const char*)g.A + (size_t)nxt.pm * tstep : cA; const char* nB = has_next ? (const char*)g.Bt + (size_t)nxt.pn * tstep : cB;
        for (int t = 0; t < nt; t += 2) {
            const bool last = (t == nt - 2);
            const char* a1 = cA + (size_t)(t + 1) * kstep;
            const char* a2 = last ? nA : cA + (size_t)(t + 2) * kstep; const char* b2 = last ? nB : cB + (size_t)(t + 2) * kstep;
            const char* a3 = a2 + kstep; const char* b3 = b2 + kstep;
            if (last && has_next) S.a_ready(nxt);
            if constexpr (SP2) {
            PG8_LDB(B0, 0, 0); PG8_LDB(B1, 0, 1); PG8_SCHED; PG8_LDA(At, 0, 0); PG8_STAGE(PG8_SA(1, 1), a1 + hstep, voffA);
            PG8_WAIT_V(8); PG8_WAIT_L(0); PG8_BAR; PG8_MMA2B(0, At, B0, B1); PG8_SCHED;
            PG8_LDA(At, 0, 1); PG8_STAGE(PG8_SB(0, 0), b2, voffB); PG8_STAGE(PG8_SB(0, 1), b2 + hstep, voffB); PG8_STAGE(PG8_SA(0, 0), a2, voffA);
            PG8_WAIT_V(8); PG8_WAIT_L(0); PG8_BAR; PG8_MMA2B(1, At, B0, B1); PG8_SCHED;
            PG8_LDB(B0, 1, 0); PG8_LDB(B1, 1, 1); PG8_SCHED; PG8_LDA(At, 1, 0); PG8_STAGE(PG8_SA(0, 1), a2 + hstep, voffA);
            PG8_WAIT_V(8); PG8_WAIT_L(0); PG8_BAR; PG8_MMA2B(0, At, B0, B1); PG8_SCHED;
            PG8_LDA(At, 1, 1); PG8_STAGE(PG8_SB(1, 0), b3, voffB); PG8_STAGE(PG8_SB(1, 1), b3 + hstep, voffB); PG8_STAGE(PG8_SA(1, 0), a3, voffA);
            PG8_WAIT_V(8); PG8_WAIT_L(0); PG8_BAR; PG8_MMA2B(1, At, B0, B1); PG8_SCHED;
            } else {
            PG8_LDB(B0, 0, 0); PG8_SCHED; PG8_LDA(At, 0, 0); PG8_STAGE(PG8_SA(1, 1), a1 + hstep, voffA);
            PG8_WAIT_L(8); PG8_BAR; PG8_WAIT_L(0); PG8_MMA(0, 0, At, B0); PG8_BAR; PG8_SCHED;
            PG8_LDB(B1, 0, 1); PG8_STAGE(PG8_SB(0, 0), b2, voffB);
            PG8_BAR; PG8_WAIT_L(0); PG8_MMA(0, 1, At, B1); PG8_BAR;
            PG8_LDA(At, 0, 1); PG8_STAGE(PG8_SA(0, 0), a2, voffA);
            PG8_BAR; PG8_WAIT_L(0); PG8_MMA(1, 0, At, B0); PG8_BAR; PG8_SCHED;
            PG8_STAGE(PG8_SB(0, 1), b2 + hstep, voffB);
            PG8_WAIT_V(6); PG8_BAR; PG8_MMA(1, 1, At, B1); PG8_BAR;
            PG8_LDB(B0, 1, 0); PG8_SCHED; PG8_LDA(At, 1, 0); PG8_STAGE(PG8_SA(0, 1), a2 + hstep, voffA);
            PG8_WAIT_L(8); PG8_BAR; PG8_WAIT_L(0); PG8_MMA(0, 0, At, B0); PG8_BAR; PG8_SCHED;
            PG8_LDB(B1, 1, 1); PG8_STAGE(PG8_SB(1, 0), b3, voffB);
            PG8_BAR; PG8_WAIT_L(0); PG8_MMA(0, 1, At, B1); PG8_BAR;
            PG8_LDA(At, 1, 1); PG8_STAGE(PG8_SA(1, 0), a3, voffA);
            PG8_BAR; PG8_WAIT_L(0); PG8_MMA(1, 0, At, B0); PG8_BAR; PG8_SCHED;
            PG8_STAGE(PG8_SB(1, 1), b3 + hstep, voffB);
            PG8_WAIT_V(6); PG8_BAR; PG8_MMA(1, 1, At, B1); PG8_BAR;
            }
        }
        unsigned long long st_r1 = 0; if (stamp) { st_r1 = __builtin_amdgcn_s_memrealtime(); st_tk += st_r1 - st_r0; st_ck += __builtin_readcyclecounter() - st_c0; }
        if constexpr (ALIGN_EPI) { if (wr == 0) PG8_BAR; }
        if constexpr (!Epi::AFTER_DRAIN) { E(acc, cur, wr, wc, fr, fq, lds); S.done(cur); }
        if (stamp) st_te += __builtin_amdgcn_s_memrealtime() - st_r1;
        if (!has_next) break;
#pragma unroll
        for (int a = 0; a < 2; ++a)
#pragma unroll
            for (int b = 0; b < 2; ++b)
#pragma unroll
                for (int m = 0; m < 4; ++m)
#pragma unroll
                    for (int n = 0; n < 2; ++n) acc[a][b][m][n] = (f32x4){0.f, 0.f, 0.f, 0.f};
        cur = nxt; cA = nA; cB = nB; ++ui;
        if constexpr (ALIGN_EPI) { if (wr == 1) PG8_BAR; }
    }
    PG8_WAIT_V(0);
    if constexpr (!ALIGN_EPI) { if (wr == 0) PG8_BAR; }
    PG8_BAR;
    if (stamp && wid == 0 && lane == 0 && blockIdx.x == 0) { atomicAdd(stamp, st_tk); atomicAdd(stamp + 1, st_ck); atomicAdd(stamp + 2, st_te); }
    if constexpr (Epi::AFTER_DRAIN) { E.fused(acc, cur, wr, wc, fr, fq, lds, wid, lane); S.done(cur); }
#undef PG8_SA
#undef PG8_SB
#undef PG8_STAGE
#undef PG8_LDA
#undef PG8_LDB
#undef PG8_MMA
#undef PG8_MMA2B
#undef PG8_WAIT_V
#undef PG8_WAIT_L
#undef PG8_BAR
#undef PG8_SCHED
}

template <class Epi, class Sched>
__device__ __forceinline__ void gemm_phase_i(PG8_LAS unsigned char* lds, const Gemm g, const Sched& S, const Epi& E, const int wv, unsigned long long* stamp = nullptr) {
    int wvo_ = wv; asm volatile("" : "+s"(wvo_));
    const int lane = lane_id_opaque(), wid = wvo_, tid = wid * 64 + lane, wr = wid >> 2, wc = wid & 3, fr = lane & 15, fq = lane >> 4;
    const int K = g.K, nt = K / BK;
    unsigned voffA[2], voffB[2];
#pragma unroll
    for (int i = 0; i < 2; ++i) { int R, C; stage_rc(tid * 16 + i * 8192, R, C); const int Rb = Epi::PERM ? ((R & ~31) + perm32(R & 31)) : R;
        voffA[i] = (unsigned)(R * K + C) * 2u; voffB[i] = (unsigned)(Rb * K + C) * 2u; }
    const size_t kstep = (size_t)(BK * 2), hstep = (size_t)HALF * K * 2, tstep = 2 * hstep;
    const unsigned ldsw = (unsigned)wid * 1024u;
    const int aoff = lds_byte(wr * 64 + fr, fq * 8), boff = lds_byte(wc * 32 + fr, fq * 8);
#define PG8_SA(b, h) (((b) * 2 + (h)) * HTB)
#define PG8_SB(b, h) ((4 + (b) * 2 + (h)) * HTB)
#define PG8_STAGE(bufoff, gbase, voff) do { _Pragma("unroll") for (int _i = 0; _i < 2; ++_i) \
        __builtin_amdgcn_global_load_lds((const unsigned*)((const char*)(gbase) + (voff)[_i]), (PG8_LAS unsigned*)(lds + (bufoff) + ldsw + _i * 8192), 16, 0, 0); } while (0)
#define PG8_LDA(dst, b, h) do { _Pragma("unroll") for (int m = 0; m < 4; ++m) _Pragma("unroll") for (int k = 0; k < 2; ++k) dst[m][k] = *(const PG8_LAS bf16x8*)(lds + PG8_SA(b, h) + aoff + m * 2048 + k * 1024); } while (0)
#define PG8_LDB(dst, b, h) do { _Pragma("unroll") for (int n = 0; n < 2; ++n) _Pragma("unroll") for (int k = 0; k < 2; ++k) dst[n][k] = *(const PG8_LAS bf16x8*)(lds + PG8_SB(b, h) + boff + n * 2048 + k * 1024); } while (0)
#define PG8_MMA(ai, bj, At, Bt) do { __builtin_amdgcn_s_setprio(1); _Pragma("unroll") for (int m = 0; m < 4; ++m) _Pragma("unroll") for (int n = 0; n < 2; ++n) _Pragma("unroll") for (int k = 0; k < 2; ++k) \
        acc[ai][bj][m][n] = __builtin_amdgcn_mfma_f32_16x16x32_bf16(Bt[n][k], At[m][k], acc[ai][bj][m][n], 0, 0, 0); __builtin_amdgcn_s_setprio(0); } while (0)
#define PG8_MMA2B(ai, At, B0, B1) do { __builtin_amdgcn_s_setprio(1); \
        _Pragma("unroll") for (int m = 0; m < 4; ++m) _Pragma("unroll") for (int n = 0; n < 2; ++n) _Pragma("unroll") for (int k = 0; k < 2; ++k) acc[ai][0][m][n] = __builtin_amdgcn_mfma_f32_16x16x32_bf16(B0[n][k], At[m][k], acc[ai][0][m][n], 0, 0, 0); \
        _Pragma("unroll") for (int m = 0; m < 4 - PG8_EARLY; ++m) _Pragma("unroll") for (int n = 0; n < 2; ++n) _Pragma("unroll") for (int k = 0; k < 2; ++k) acc[ai][1][m][n] = __builtin_amdgcn_mfma_f32_16x16x32_bf16(B1[n][k], At[m][k], acc[ai][1][m][n], 0, 0, 0); \
        __builtin_amdgcn_sched_barrier(0); __builtin_amdgcn_s_barrier(); __builtin_amdgcn_sched_barrier(0); \
        _Pragma("unroll") for (int m = 4 - PG8_EARLY; m < 4; ++m) _Pragma("unroll") for (int n = 0; n < 2; ++n) _Pragma("unroll") for (int k = 0; k < 2; ++k) acc[ai][1][m][n] = __builtin_amdgcn_mfma_f32_16x16x32_bf16(B1[n][k], At[m][k], acc[ai][1][m][n], 0, 0, 0); \
        __builtin_amdgcn_s_setprio(0); } while (0)
#define PG8_WAIT_V(n) asm volatile("s_waitcnt vmcnt(" #n ")" ::: "memory")
#define PG8_WAIT_L(n) asm volatile("s_waitcnt lgkmcnt(" #n ")" ::: "memory")
#define PG8_BAR __builtin_amdgcn_s_barrier()
#define PG8_SCHED __builtin_amdgcn_sched_barrier(0)
#define PG8_ZERO(ai) do { _Pragma("unroll") for (int b_ = 0; b_ < 2; ++b_) _Pragma("unroll") for (int m_ = 0; m_ < 4; ++m_) _Pragma("unroll") for (int n_ = 0; n_ < 2; ++n_) acc[ai][b_][m_][n_] = (f32x4){0.f, 0.f, 0.f, 0.f}; } while (0)
#define PG8_TRIP(EA, EB, W1, W2, W3, W4) do { \
        PG8_LDB(B0, 0, 0); PG8_LDB(B1, 0, 1); PG8_SCHED; PG8_LDA(At, 0, 0); PG8_STAGE(PG8_SA(1, 1), a1 + hstep, voffA); PG8_SCHED; EA; PG8_SCHED; \
        PG8_WAIT_V(W1); PG8_WAIT_L(0); PG8_BAR; PG8_MMA2B(0, At, B0, B1); PG8_SCHED; \
        PG8_LDA(At, 0, 1); PG8_STAGE(PG8_SB(0, 0), b2, voffB); PG8_STAGE(PG8_SB(0, 1), b2 + hstep, voffB); PG8_STAGE(PG8_SA(0, 0), a2, voffA); PG8_SCHED; EB; PG8_SCHED; \
        PG8_WAIT_V(W2); PG8_WAIT_L(0); PG8_BAR; PG8_MMA2B(1, At, B0, B1); PG8_SCHED; \
        PG8_LDB(B0, 1, 0); PG8_LDB(B1, 1, 1); PG8_SCHED; PG8_LDA(At, 1, 0); PG8_STAGE(PG8_SA(0, 1), a2 + hstep, voffA); \
        PG8_WAIT_V(W3); PG8_WAIT_L(0); PG8_BAR; PG8_MMA2B(0, At, B0, B1); PG8_SCHED; \
        PG8_LDA(At, 1, 1); PG8_STAGE(PG8_SB(1, 0), b3, voffB); PG8_STAGE(PG8_SB(1, 1), b3 + hstep, voffB); PG8_STAGE(PG8_SA(1, 0), a3, voffA); \
        PG8_WAIT_V(W4); PG8_WAIT_L(0); PG8_BAR; PG8_MMA2B(1, At, B0, B1); PG8_SCHED; } while (0)
    Unit cur, nxt, prv; int ui = 0;
    if (!S.next(0, cur)) return;
    prv = cur;
    f32x4 acc[2][2][4][2];
    PG8_ZERO(0); PG8_ZERO(1);
    bf16x8 At[4][2], B0[2][2], B1[2][2];
    const char* cA = (const char*)g.A + (size_t)cur.pm * tstep; const char* cB = (const char*)g.Bt + (size_t)cur.pn * tstep;
    S.a_ready(cur);
    PG8_STAGE(PG8_SB(0, 0), cB, voffB); PG8_STAGE(PG8_SB(0, 1), cB + hstep, voffB); PG8_STAGE(PG8_SA(0, 0), cA, voffA); PG8_STAGE(PG8_SA(0, 1), cA + hstep, voffA);
    if (wr == 1) PG8_BAR;
    PG8_WAIT_V(2); PG8_BAR;
    PG8_STAGE(PG8_SB(1, 0), cB + kstep, voffB); PG8_STAGE(PG8_SA(1, 0), cA + kstep, voffA); PG8_STAGE(PG8_SB(1, 1), cB + hstep + kstep, voffB);
    PG8_WAIT_V(6); PG8_BAR;
    unsigned long long st_tk = 0, st_ck = 0, st_te = 0;
    for (;;) {
        const bool has_next = S.next(ui + 1, nxt);
        unsigned long long st_r0 = 0, st_c0 = 0; if (stamp) { st_r0 = __builtin_amdgcn_s_memrealtime(); st_c0 = __builtin_readcyclecounter(); }
        const char* nA = has_next ? (const char*)g.A + (size_t)nxt.pm * tstep : cA; const char* nB = has_next ? (const char*)g.Bt + (size_t)nxt.pn * tstep : cB;
        {
            const char* a1 = cA + kstep; const char* a2 = cA + 2 * kstep; const char* b2 = cB + 2 * kstep; const char* a3 = a2 + kstep; const char* b3 = b2 + kstep;
            unsigned long long st_f0 = 0; if (stamp) st_f0 = __builtin_amdgcn_s_memrealtime();
            const bool epi = ui > 0;
            PG8_STAGE(PG8_SA(1, 1), a1 + hstep, voffA); PG8_SCHED;
            if (epi) { E.half(acc, prv, 0, wr, wc, fr, fq, lds); PG8_ZERO(0); } PG8_SCHED;
            PG8_LDB(B0, 0, 0); PG8_LDB(B1, 0, 1); PG8_SCHED; PG8_LDA(At, 0, 0);
            if (epi) { PG8_WAIT_V(16); } else { PG8_WAIT_V(8); }
            PG8_WAIT_L(0); PG8_BAR; PG8_MMA2B(0, At, B0, B1); PG8_SCHED;
            PG8_STAGE(PG8_SB(0, 0), b2, voffB); PG8_STAGE(PG8_SB(0, 1), b2 + hstep, voffB); PG8_STAGE(PG8_SA(0, 0), a2, voffA); PG8_SCHED;
            if (epi) { E.half(acc, prv, 1, wr, wc, fr, fq, lds); PG8_ZERO(1); } PG8_SCHED;
            PG8_LDA(At, 0, 1);
            if (epi) { PG8_WAIT_V(24); } else { PG8_WAIT_V(8); }
            PG8_WAIT_L(0); PG8_BAR; PG8_MMA2B(1, At, B0, B1); PG8_SCHED;
            PG8_LDB(B0, 1, 0); PG8_LDB(B1, 1, 1); PG8_SCHED; PG8_LDA(At, 1, 0); PG8_STAGE(PG8_SA(0, 1), a2 + hstep, voffA);
            if (epi) { PG8_WAIT_V(24); } else { PG8_WAIT_V(8); }
            PG8_WAIT_L(0); PG8_BAR; PG8_MMA2B(0, At, B0, B1); PG8_SCHED;
            PG8_LDA(At, 1, 1); PG8_STAGE(PG8_SB(1, 0), b3, voffB); PG8_STAGE(PG8_SB(1, 1), b3 + hstep, voffB); PG8_STAGE(PG8_SA(1, 0), a3, voffA);
            if (epi) { PG8_WAIT_V(16); } else { PG8_WAIT_V(8); }
            PG8_WAIT_L(0); PG8_BAR; PG8_MMA2B(1, At, B0, B1); PG8_SCHED;
            if (stamp && epi) st_te += __builtin_amdgcn_s_memrealtime() - st_f0;
        }
        for (int t = 2; t < nt; t += 2) {
            const bool last = (t == nt - 2);
            const char* a1 = cA + (size_t)(t + 1) * kstep;
            const char* a2 = last ? nA : cA + (size_t)(t + 2) * kstep; const char* b2 = last ? nB : cB + (size_t)(t + 2) * kstep;
            const char* a3 = a2 + kstep; const char* b3 = b2 + kstep;
            if (last && has_next) S.a_ready(nxt);
            if (last) E.prefetch(cur, lds, wid, lane);
            PG8_TRIP((void)0, (void)0, 8, 8, 8, 8);
        }
        if (stamp) { const unsigned long long st_r1 = __builtin_amdgcn_s_memrealtime(); st_tk += st_r1 - st_r0; st_ck += __builtin_readcyclecounter() - st_c0; }
        if (!has_next) break;
        prv = cur; cur = nxt; cA = nA; cB = nB; ++ui;
    }
    { unsigned long long st_r1 = 0; if (stamp) st_r1 = __builtin_amdgcn_s_memrealtime();
      E.half(acc, cur, 0, wr, wc, fr, fq, lds); E.half(acc, cur, 1, wr, wc, fr, fq, lds); S.done(cur);
      (void)st_r1; }
    PG8_WAIT_V(0);
    if (wr == 0) PG8_BAR;
    PG8_BAR;
    if (stamp && wid == 0 && lane == 0) { if (blockIdx.x == 0) { atomicAdd(stamp, st_tk); atomicAdd(stamp + 1, st_ck); atomicAdd(stamp + 2, st_te); } atomicAdd(stamp + 8 + blockIdx.x, st_tk); }
#undef PG8_TRIP
#undef PG8_ZERO
#undef PG8_SA
#undef PG8_SB
#undef PG8_STAGE
#undef PG8_LDA
#undef PG8_LDB
#undef PG8_MMA
#undef PG8_MMA2B
#undef PG8_WAIT_V
#undef PG8_WAIT_L
#undef PG8_BAR
#undef PG8_SCHED
}
}

#define GAS __attribute__((address_space(1)))
#define LAS __attribute__((address_space(3)))
typedef unsigned short bf16_t;
typedef short bf16x8 __attribute__((ext_vector_type(8)));
typedef short s16x4 __attribute__((ext_vector_type(4)));
typedef float f32x4 __attribute__((ext_vector_type(4)));
typedef float f32x16 __attribute__((ext_vector_type(16)));
typedef unsigned u32x4 __attribute__((ext_vector_type(4)));
typedef unsigned u32x2 __attribute__((ext_vector_type(2)));
#define SBAR() __builtin_amdgcn_sched_barrier(0)
__device__ __forceinline__ unsigned cvtpk(float lo, float hi) { unsigned r; asm volatile("v_cvt_pk_bf16_f32 %0, %1, %2" : "=v"(r) : "v"(lo), "v"(hi)); return r; }
__device__ __forceinline__ float bf2f(unsigned short b) { return __uint_as_float(((unsigned)b) << 16); }
__device__ __forceinline__ float bflo(unsigned w) { return __uint_as_float(w << 16); }
__device__ __forceinline__ float bfhi(unsigned w) { return __uint_as_float(w & 0xffff0000u); }
__device__ __forceinline__ unsigned short f2bf(float f) { return (unsigned short)(cvtpk(f, 0.f) & 0xffffu); }

namespace att {
constexpr int D = 128, NW = 8, QBLK = 32, KVBLK = 64, LD = 1024;
constexpr float SCALE = 0.088388347648318440f, THR = 8.f;
constexpr int SHM_V = KVBLK * D * 2, SHM_K = KVBLK * D * 2;
constexpr int OFF_V = 0, OFF_K = 2 * SHM_V, OFF_Q = 2 * SHM_V + 2 * SHM_K  , OFF_WS = 134144  , OFF_BIAS = OFF_WS + NW * 64 * 4, OFF_GK = OFF_BIAS + 16 * 32 * 4  , LDS_BYTES = OFF_GK + 128 * 4;
#define KSWZ(row, colB) ((row) * 256 + ((colB) ^ (((row) & 7) << 4)))
__device__ __forceinline__ int crow(int r, int hi) { return (r & 3) + 8 * (r >> 2) + 4 * hi; }

__device__ __forceinline__ void partialSM(f32x16& p0, f32x16& p1, float& m_reg, float& mn, float& alpha) {
  constexpr float C = SCALE * 1.4426950408889634f;
  float pmax = p0[0];
#pragma unroll
  for (int r = 1; r < 16; ++r) pmax = fmaxf(pmax, p0[r]);
#pragma unroll
  for (int r = 0; r < 16; ++r) pmax = fmaxf(pmax, p1[r]);
  { auto rr = __builtin_amdgcn_permlane32_swap(__float_as_uint(pmax), __float_as_uint(pmax), false, false);
    pmax = fmaxf(__uint_as_float(rr[0]), __uint_as_float(rr[1])); }
  if (__builtin_expect(__all(pmax - m_reg <= THR / SCALE), 1)) { mn = m_reg; alpha = 1.f; }
  else { mn = fmaxf(m_reg, pmax); alpha = __builtin_amdgcn_exp2f((m_reg - mn) * C); m_reg = mn; }
  float mnC = -mn * C;
#pragma unroll
  for (int r = 0; r < 16; ++r) p0[r] = fmaf(p0[r], C, mnC);
#pragma unroll
  for (int r = 0; r < 16; ++r) p1[r] = fmaf(p1[r], C, mnC);
#pragma unroll
  for (int r = 0; r < 16; ++r) p0[r] = __builtin_amdgcn_exp2f(p0[r]);
}
__device__ __forceinline__ void finishSM(f32x16& p0, f32x16& p1, float alpha, float& l_reg, bf16x8& pa0, bf16x8& pa1, bf16x8& pa2, bf16x8& pa3) {
#pragma unroll
  for (int r = 0; r < 16; ++r) p1[r] = __builtin_amdgcn_exp2f(p1[r]);
  float ps = 0;
#pragma unroll
  for (int r = 0; r < 16; ++r) ps += p0[r];
#pragma unroll
  for (int r = 0; r < 16; ++r) ps += p1[r];
  { auto rr = __builtin_amdgcn_permlane32_swap(__float_as_uint(ps), __float_as_uint(ps), false, false);
    ps = __uint_as_float(rr[0]) + __uint_as_float(rr[1]); }
  l_reg = l_reg * alpha + ps;
#define PK4(P, BASE, OUT) do { unsigned a0 = cvtpk(P[BASE + 0], P[BASE + 1]), a1 = cvtpk(P[BASE + 2], P[BASE + 3]);   \
    unsigned b0 = cvtpk(P[BASE + 4], P[BASE + 5]), b1 = cvtpk(P[BASE + 6], P[BASE + 7]);                              \
    auto r0 = __builtin_amdgcn_permlane32_swap(a0, b0, false, false); auto r1 = __builtin_amdgcn_permlane32_swap(a1, b1, false, false); \
    u32x4 w = {r0[0], r1[0], r0[1], r1[1]}; OUT = *reinterpret_cast<bf16x8*>(&w); } while (0)
  PK4(p0, 0, pa0); PK4(p0, 8, pa1); PK4(p1, 0, pa2); PK4(p1, 8, pa3);
#undef PK4
}
__device__ __forceinline__ void qkt(f32x16& p0, f32x16& p1, const LAS char* Ks, const LAS char* Qs, int r32, int hi) {
  p0 = f32x16{}; p1 = f32x16{};
#pragma unroll
  for (int d0 = 0; d0 < 8; ++d0) { const int cb = (d0 * 16 + hi * 8) * 2;
    const bf16x8 b0 = *(const LAS bf16x8*)(Ks + KSWZ(r32, cb));
    const bf16x8 b1 = *(const LAS bf16x8*)(Ks + KSWZ(32 + r32, cb));
    const bf16x8 q = *(const LAS bf16x8*)(Qs + KSWZ(r32, cb));
    p0 = __builtin_amdgcn_mfma_f32_32x32x16_bf16(b0, q, p0, 0, 0, 0);
    p1 = __builtin_amdgcn_mfma_f32_32x32x16_bf16(b1, q, p1, 0, 0, 0); }
}
__device__ __forceinline__ int v_st(int k, int c) { const int kk = (k & ~0xC) | ((k & 4) << 1) | ((k & 8) >> 1); return ((kk >> 3) * 4 + (c >> 5)) * 512 + ((kk & 7) * 32 + (c & 31)) * 2; }
__device__ __forceinline__ int v_rd_base(int lane) { return ((lane & 3) << 3) | (((lane >> 2) & 3) << 6) | (((lane >> 4) & 1) << 5) | (((lane >> 5) & 1) << 8); }
constexpr int v_rd_off(int d0, int ks, int half) { return d0 * 512 + ks * 4096 + half * 2048; }
template <int OFF> __device__ __forceinline__ s16x4 tr_read(int vb) {
  s16x4 r; asm volatile("ds_read_b64_tr_b16 %0, %1 offset:%2" : "=&v"(r) : "v"(vb), "i"(OFF) : "memory"); return r;
}
template <int D0> __device__ __forceinline__ void pv_one(f32x16& od, int vb, bf16x8 pa0, bf16x8 pa1, bf16x8 pa2, bf16x8 pa3) {
  const s16x4 l0 = tr_read<v_rd_off(D0, 0, 0)>(vb), h0 = tr_read<v_rd_off(D0, 0, 1)>(vb), l1 = tr_read<v_rd_off(D0, 1, 0)>(vb), h1 = tr_read<v_rd_off(D0, 1, 1)>(vb);
  const s16x4 l2 = tr_read<v_rd_off(D0, 2, 0)>(vb), h2 = tr_read<v_rd_off(D0, 2, 1)>(vb), l3 = tr_read<v_rd_off(D0, 3, 0)>(vb), h3 = tr_read<v_rd_off(D0, 3, 1)>(vb);
  asm volatile("s_waitcnt lgkmcnt(0)" ::: "memory"); SBAR();
#define PK(L, H) (bf16x8){L[0], L[1], L[2], L[3], H[0], H[1], H[2], H[3]}
  od = __builtin_amdgcn_mfma_f32_32x32x16_bf16(pa0, PK(l0, h0), od, 0, 0, 0);
  od = __builtin_amdgcn_mfma_f32_32x32x16_bf16(pa1, PK(l1, h1), od, 0, 0, 0);
  od = __builtin_amdgcn_mfma_f32_32x32x16_bf16(pa2, PK(l2, h2), od, 0, 0, 0);
  od = __builtin_amdgcn_mfma_f32_32x32x16_bf16(pa3, PK(l3, h3), od, 0, 0, 0);
#undef PK
}
__device__ __forceinline__ void pv_d0(f32x16* o, int vb, bf16x8 pa0, bf16x8 pa1, bf16x8 pa2, bf16x8 pa3) {
  pv_one<0>(o[0], vb, pa0, pa1, pa2, pa3); pv_one<1>(o[1], vb, pa0, pa1, pa2, pa3); pv_one<2>(o[2], vb, pa0, pa1, pa2, pa3); pv_one<3>(o[3], vb, pa0, pa1, pa2, pa3);
}

__device__ __forceinline__ void na_mask(f32x16& p0, f32x16& p1, int kr, int qrow, int qc, unsigned cmask, int hi, const LAS float* biasL) {
  int r0 = qrow - 4; r0 = r0 < 0 ? 0 : (r0 > 56 ? 56 : r0);
  const bool rowok = (kr >= r0) && (kr < r0 + 8);
  const unsigned em = rowok ? cmask : 0u;
  const int dr = rowok ? (kr - qrow + 7) : 0;
  const LAS float* brow = biasL + dr * 32 + (15 - qc + 4 * hi);
#pragma unroll
  for (int i4 = 0; i4 < 4; ++i4) {
#pragma unroll
    for (int ii = 0; ii < 4; ++ii) { const int i = i4 * 4 + ii, kc = (i & 3) + 8 * (i >> 2);
      const bool ok0 = (em >> i) & 1u, ok1 = (em >> (16 + i)) & 1u;
      const float b0 = brow[kc], b1 = brow[kc + 32];
      p0[i] = ok0 ? p0[i] + b0 : -1e30f; p1[i] = ok1 ? p1[i] + b1 : -1e30f; }
    asm volatile("" ::: "memory"); }
}

template <bool NA, int SDEPTH>
__device__ __forceinline__ void attn_unit(LAS char* lds, const bf16_t* __restrict__ Qb, const bf16_t* __restrict__ K0, const bf16_t* __restrict__ V0, int nt0,
                                          const bf16_t* __restrict__ K1, const bf16_t* __restrict__ V1, int NT, bf16_t* __restrict__ Ob, int ldo, int R, int kr0, const int wv,
                                          const float* __restrict__ gq, float* __restrict__ ck_out, float* __restrict__ cv_out, const bool knorm0) {
  const int lane = lane_id_opaque(), wid = wv, tid = wv * 64 + lane, r32 = lane & 31, hi = lane >> 5;
  LAS char* V_lds = lds + OFF_V; LAS char* K_lds = lds + OFF_K;
  LAS float* ws = (LAS float*)(lds + OFF_WS) + wid * 64; LAS float* li_l = ws; LAS float* al_l = ws + 32;
  const LAS float* biasL = (const LAS float*)(lds + OFF_BIAS); const LAS f32x4* gkL = (const LAS f32x4*)(lds + OFF_GK);
  float m_reg = -1e30f, l_reg = 0; f32x16 o[4] = {};
  LAS char* Q_lds = lds + OFF_Q + wid * 8192;
  { const bf16_t* Qw = Qb + (long)(wid * QBLK + r32) * LD + hi * 8; u32x4 qt[8]; float ss = 0.f;
#pragma unroll
    for (int d0 = 0; d0 < 8; ++d0) { qt[d0] = *(const u32x4*)(Qw + d0 * 16);
#pragma unroll
      for (int i = 0; i < 4; ++i) { const float a = bflo(qt[d0][i]), b = bfhi(qt[d0][i]); ss += a * a + b * b; } }
    { auto rr = __builtin_amdgcn_permlane32_swap(__float_as_uint(ss), __float_as_uint(ss), false, false); ss = __uint_as_float(rr[0]) + __uint_as_float(rr[1]); }
    const float rq = __builtin_amdgcn_rsqf(ss * (1.0f / 128.0f) + 1e-6f);
#pragma unroll
    for (int d0 = 0; d0 < 8; ++d0) { const int d = d0 * 16 + hi * 8;
      const f32x4 g0 = *(const f32x4*)(gq + d), g1 = *(const f32x4*)(gq + d + 4);
      u32x4 w; w.x = cvtpk(bflo(qt[d0].x) * rq * g0[0], bfhi(qt[d0].x) * rq * g0[1]); w.y = cvtpk(bflo(qt[d0].y) * rq * g0[2], bfhi(qt[d0].y) * rq * g0[3]);
      w.z = cvtpk(bflo(qt[d0].z) * rq * g1[0], bfhi(qt[d0].z) * rq * g1[1]); w.w = cvtpk(bflo(qt[d0].w) * rq * g1[2], bfhi(qt[d0].w) * rq * g1[3]);
      *(LAS u32x4*)(Q_lds + KSWZ(r32, d * 2)) = w; } }
  const int sr = tid >> 4, sc = (tid & 15) * 8, vst0 = v_st(sr, sc);
  const int vb0 = (int)(uintptr_t)V_lds + v_rd_base(lane);
  const int qrow = R + (wid >> 1), qc = 32 * (wid & 1) + r32;
  unsigned cmask = 0;
  if (NA) { int c0 = qc - 8; c0 = c0 < 0 ? 0 : (c0 > 48 ? 48 : c0);
#pragma unroll
    for (int i = 0; i < 16; ++i) { const int kc = crow(i, hi); if ((unsigned)(kc - c0) < 16u) cmask |= 1u << i; if ((unsigned)(kc + 32 - c0) < 16u) cmask |= 1u << (16 + i); } }
  struct { bf16x8 vs0, vs1, ks0, ks1; } sr_[SDEPTH];
#define TILE_K(t) (((t) < nt0 ? K0 + (long)(t) * (KVBLK * LD) : K1 + (long)((t) - nt0) * (KVBLK * LD)))
#define TILE_V(t) (((t) < nt0 ? V0 + (long)(t) * (KVBLK * LD) : V1 + (long)((t) - nt0) * (KVBLK * LD)))
#define SLOAD(i, t) do { const bf16_t* kp_ = TILE_K(t); const bf16_t* vp_ = TILE_V(t); \
    sr_[i].vs0 = *(const bf16x8*)(vp_ + (long)sr * LD + sc); sr_[i].vs1 = *(const bf16x8*)(vp_ + (long)(32 + sr) * LD + sc); \
    sr_[i].ks0 = *(const bf16x8*)(kp_ + (long)sr * LD + sc); sr_[i].ks1 = *(const bf16x8*)(kp_ + (long)(32 + sr) * LD + sc); } while (0)
#define KROW(KS, ROW, t, OUT) do { u32x4 kw_ = *(u32x4*)&(KS); float x_[8]; \
    _Pragma("unroll") for (int i_ = 0; i_ < 4; ++i_) { x_[2 * i_] = bflo(kw_[i_]); x_[2 * i_ + 1] = bfhi(kw_[i_]); } \
    if (knorm0 || (t) >= nt0) { float s_ = 0.f; _Pragma("unroll") for (int i_ = 0; i_ < 8; ++i_) s_ += x_[i_] * x_[i_]; \
      s_ += __uint_as_float((unsigned)__builtin_amdgcn_update_dpp(0, (int)__float_as_uint(s_), 0x128, 0xf, 0xf, false)); s_ += __uint_as_float((unsigned)__builtin_amdgcn_update_dpp(0, (int)__float_as_uint(s_), 0x124, 0xf, 0xf, false)); \
      s_ += __uint_as_float((unsigned)__builtin_amdgcn_update_dpp(0, (int)__float_as_uint(s_), 0x122, 0xf, 0xf, false)); s_ += __uint_as_float((unsigned)__builtin_amdgcn_update_dpp(0, (int)__float_as_uint(s_), 0x121, 0xf, 0xf, false)); \
      const float rk_ = __builtin_amdgcn_rsqf(s_ * (1.0f / 128.0f) + 1e-6f); const f32x4 ga_ = gkL[sc >> 2], gb_ = gkL[(sc >> 2) + 1]; \
      x_[0] *= rk_ * ga_[0]; x_[1] *= rk_ * ga_[1]; x_[2] *= rk_ * ga_[2]; x_[3] *= rk_ * ga_[3]; x_[4] *= rk_ * gb_[0]; x_[5] *= rk_ * gb_[1]; x_[6] *= rk_ * gb_[2]; x_[7] *= rk_ * gb_[3]; \
      kw_.x = cvtpk(x_[0], x_[1]); kw_.y = cvtpk(x_[2], x_[3]); kw_.z = cvtpk(x_[4], x_[5]); kw_.w = cvtpk(x_[6], x_[7]); } \
    if (ck_out) { float* o_ = ck_out + (long)((t) * KVBLK + (ROW)) * LD + sc; \
      __builtin_nontemporal_store((f32x4){x_[0], x_[1], x_[2], x_[3]}, (f32x4*)o_); __builtin_nontemporal_store((f32x4){x_[4], x_[5], x_[6], x_[7]}, (f32x4*)(o_ + 4)); } \
    OUT = *(bf16x8*)&kw_; } while (0)
#define VROW(VS, ROW, t) do { if (cv_out) { const u32x4 vw_ = *(const u32x4*)&(VS); float* o_ = cv_out + (long)((t) * KVBLK + (ROW)) * LD + sc; \
      __builtin_nontemporal_store((f32x4){bflo(vw_.x), bfhi(vw_.x), bflo(vw_.y), bfhi(vw_.y)}, (f32x4*)o_); __builtin_nontemporal_store((f32x4){bflo(vw_.z), bfhi(vw_.z), bflo(vw_.w), bfhi(vw_.w)}, (f32x4*)(o_ + 4)); } } while (0)
#define SWRITE(b, i, t) do { *(LAS bf16x8*)(V_lds + (b) * SHM_V + vst0) = sr_[i].vs0;          \
    *(LAS bf16x8*)(V_lds + (b) * SHM_V + vst0 + 8192) = sr_[i].vs1; const int kc_ = sc * 2; VROW(sr_[i].vs0, sr, t); VROW(sr_[i].vs1, 32 + sr, t); \
    bf16x8 k0_, k1_; KROW(sr_[i].ks0, sr, t, k0_); KROW(sr_[i].ks1, 32 + sr, t, k1_); \
    *(LAS bf16x8*)(K_lds + (b) * SHM_K + KSWZ(sr, kc_)) = k0_;                       \
    *(LAS bf16x8*)(K_lds + (b) * SHM_K + KSWZ(sr, kc_) + 8192) = k1_; } while (0)
#define SWAIT() do { if constexpr (SDEPTH == 2) asm volatile("s_waitcnt vmcnt(4)" ::: "memory"); else asm volatile("s_waitcnt vmcnt(0)" ::: "memory"); } while (0)
#define RESC(a) do { if (__any((a) < 1.f)) { if (hi == 0) al_l[r32] = (a); asm volatile("s_waitcnt lgkmcnt(0)" ::: "memory"); \
    _Pragma("unroll") for (int d = 0; d < 4; ++d) _Pragma("unroll") for (int r = 0; r < 16; ++r) o[d][r] *= al_l[crow(r, hi)]; } } while (0)
#define MASK(P0, P1, t) do { if (NA && (t) >= nt0) na_mask(P0, P1, kr0 + (t) - nt0, qrow, qc, cmask, hi, biasL); } while (0)
  f32x16 pA0, pA1, pB0, pB1; float mnA, mnB, alA, alB; bf16x8 pa0, pa1, pa2, pa3;
  int wr0 = qrow - 4; wr0 = wr0 < 0 ? 0 : (wr0 > 56 ? 56 : wr0);
#define TV(t) (!NA || (t) < nt0 || (unsigned)(kr0 + (t) - nt0 - wr0) < 8u)
#define SCORE(P0, P1, KB, t, V) do { if (V) qkt(P0, P1, KB, Q_lds, r32, hi); } while (0)
#define PSM(P0, P1, t, V, MN, AL) do { if (V) { MASK(P0, P1, t); partialSM(P0, P1, m_reg, MN, AL); } else { AL = 1.f; } } while (0)
#define FSM(P0, P1, AL, V) do { if (V) finishSM(P0, P1, AL, l_reg, pa0, pa1, pa2, pa3); } while (0)
#define PVT(VB, V) do { if (V) pv_d0(o, VB, pa0, pa1, pa2, pa3); } while (0)
  constexpr int SE = 0, SO = SDEPTH - 1;
  bool vA = true, vB = true;
  SLOAD(SE, 0); asm volatile("s_waitcnt vmcnt(0)" ::: "memory"); SWRITE(0, SE, 0); __syncthreads();
  vA = TV(0); SCORE(pA0, pA1, K_lds, 0, vA); PSM(pA0, pA1, 0, vA, mnA, alA);
  SLOAD(SO, 1); if constexpr (SDEPTH == 2) { if (2 < NT) SLOAD(SE, 2); }
  SWAIT(); SWRITE(1, SO, 1); __syncthreads();
  for (int j = 1; j + 1 < NT; j += 2) {
    vB = TV(j);
    SBAR(); SCORE(pB0, pB1, K_lds + SHM_K, j, vB);
    FSM(pA0, pA1, alA, vA); SBAR();
    SLOAD(SO, j + SDEPTH); SBAR();
    PVT(vb0, vA); PSM(pB0, pB1, j, vB, mnB, alB);
    __syncthreads(); SWAIT(); SWRITE(0, SE, j + 1);
    RESC(alB); __syncthreads();
    vA = TV(j + 1);
    SBAR(); SCORE(pA0, pA1, K_lds, j + 1, vA);
    FSM(pB0, pB1, alB, vB); SBAR();
    if (SDEPTH == 1 || j + 3 < NT) SLOAD(SE, j + 1 + SDEPTH); SBAR();
    PVT(vb0 + SHM_V, vB); PSM(pA0, pA1, j + 1, vA, mnA, alA);
    __syncthreads(); SWAIT(); SWRITE(1, SO, j + 2);
    RESC(alA); __syncthreads();
  }
  vB = TV(NT - 1);
  SBAR(); SCORE(pB0, pB1, K_lds + SHM_K, NT - 1, vB);
  FSM(pA0, pA1, alA, vA); SBAR();
  PVT(vb0, vA); PSM(pB0, pB1, NT - 1, vB, mnB, alB);
  __syncthreads(); RESC(alB);
  FSM(pB0, pB1, alB, vB); SBAR();
  PVT(vb0 + SHM_V, vB);
#undef TV
#undef SCORE
#undef PSM
#undef FSM
#undef PVT
  if (hi == 0) li_l[r32] = l_reg; asm volatile("s_waitcnt lgkmcnt(0)" ::: "memory");
  float rli[16];
#pragma unroll
  for (int r = 0; r < 16; ++r) rli[r] = __builtin_amdgcn_rcpf(li_l[crow(r, hi)]);
  bf16_t* Ow = Ob + (long)(wid * QBLK) * ldo;
#pragma unroll
  for (int r = 0; r < 16; ++r) { const int orow = crow(r, hi);
#pragma unroll
    for (int d0 = 0; d0 < 4; ++d0) Ow[(long)orow * ldo + d0 * 32 + r32] = f2bf(o[d0][r] * rli[r]); }
#undef SLOAD
#undef SWRITE
#undef KROW
#undef VROW
#undef SWAIT
#undef RESC
#undef MASK
#undef TILE_K
#undef TILE_V
}
}

constexpr int DM = 2048, NCTX = 8192, NLAT = 32768, MTOK = NCTX + NLAT;
constexpr int CTX_L = 256, LAT_L = 4096, NLAYER = 4, DFF = 8192;
constexpr int ABIN = 3584, ABOUT = 1536, S5W = 512;
constexpr float NORM_EPS = 1e-6f;
constexpr int S5T = 32;
constexpr int NCHUNK = MTOK / S5T;
__device__ __forceinline__ int ada_row_of_token(int m) { return m < NCTX ? 0 : 1 + ((m - NCTX) >> 12); }

#ifndef S5_STAMP
#define S5_STAMP 0
#endif
namespace s5 {
constexpr int XROW = 272;
constexpr int XBYTES = S5T * XROW;
constexpr int GROW = 1040;
constexpr int OFF_X = 0, OFF_G = 8 * XBYTES, LDS_BYTES = OFF_G + S5T * GROW;

struct BFrag { bf16x8 r0, r1, i0, i1; };
__device__ __forceinline__ bf16x8 load_u(const bf16_t* __restrict__ U, int m0, int g, int dir, int lane) {
  const int r = lane & 31, h = lane >> 5, tok = dir ? 31 - r : r;
  return *(const bf16x8*)(U + (size_t)(m0 + tok) * S5W + g * 16 + h * 8);
}
__device__ __forceinline__ BFrag load_bb(const bf16_t* __restrict__ BB, int lane) {
  const int r = lane & 31, h = lane >> 5; BFrag f;
  f.r0 = *(const bf16x8*)(BB + (0 * 64 + r) * 16 + h * 8); f.r1 = *(const bf16x8*)(BB + (0 * 64 + 32 + r) * 16 + h * 8);
  f.i0 = *(const bf16x8*)(BB + (1 * 64 + r) * 16 + h * 8); f.i1 = *(const bf16x8*)(BB + (1 * 64 + 32 + r) * 16 + h * 8);
  return f;
}
__device__ __forceinline__ void bu_compute(const bf16x8 ua, const BFrag& f, float (&bre)[32], float (&bim)[32]) {
  const f32x16 z = {};
  { const f32x16 dr0 = __builtin_amdgcn_mfma_f32_32x32x16_bf16(ua, f.r0, z, 0, 0, 0), dr1 = __builtin_amdgcn_mfma_f32_32x32x16_bf16(ua, f.r1, z, 0, 0, 0);
#pragma unroll
    for (int i = 0; i < 16; ++i) { const int c0 = (i & 3) + 8 * (i >> 2);
      auto a = __builtin_amdgcn_permlane32_swap(__float_as_uint(dr0[i]), __float_as_uint(dr1[i]), false, false);
      bre[c0] = __uint_as_float(a[0]); bre[c0 + 4] = __uint_as_float(a[1]); } }
  asm volatile("" : "+v"(bre[0]), "+v"(bre[31]));
  { const f32x16 di0 = __builtin_amdgcn_mfma_f32_32x32x16_bf16(ua, f.i0, z, 0, 0, 0), di1 = __builtin_amdgcn_mfma_f32_32x32x16_bf16(ua, f.i1, z, 0, 0, 0);
#pragma unroll
    for (int i = 0; i < 16; ++i) { const int c0 = (i & 3) + 8 * (i >> 2);
      auto b = __builtin_amdgcn_permlane32_swap(__float_as_uint(di0[i]), __float_as_uint(di1[i]), false, false);
      bim[c0] = __uint_as_float(b[0]); bim[c0 + 4] = __uint_as_float(b[1]); } }
}

__device__ __forceinline__ void phase_a(int e, const bf16_t* U, const float4* S5A, const bf16_t* S5BB, float* Ef, float* Ec, int G, int vcu, const int wv) {
  const int lane = lane_id_opaque(), wid = wv; (void)wid;
  for (int task = vcu; task < (MTOK / 128) * 4; task += G) {
    const int cc = task >> 2, g = (task & 3) * 8 + wid;
#pragma unroll 1
    for (int dir = 0; dir < 2; ++dir) {
      const int tb = ((e * 2 + dir) * 32 + g);
      const float4 a4 = S5A[tb * 64 + lane];
      float cr = 0.f, ci = 0.f;
      const BFrag bf = load_bb(S5BB + (size_t)tb * 2048, lane);
      bf16x8 ua = load_u(U, (cc * 4 + (dir ? 3 : 0)) * S5T, g, dir, lane);
#pragma unroll 1
      for (int k = 0; k < 4; ++k) { const int f = dir ? 3 - k : k; const int ci_f = cc * 4 + f;
        const int fn = dir ? 2 - k : k + 1;
        const bf16x8 un = load_u(U, (cc * 4 + (k < 3 ? fn : f)) * S5T, g, dir, lane);
        float bre[32], bim[32];
        bu_compute(ua, bf, bre, bim);
        float xr = 0.f, xi = 0.f;
#pragma unroll
        for (int i = 0; i < 32; ++i) { const float nr = fmaf(a4.x, xr, fmaf(-a4.y, xi, bre[i])), ni = fmaf(a4.x, xi, fmaf(a4.y, xr, bim[i])); xr = nr; xi = ni; }
        float* ep = Ef + (((size_t)ci_f * 32 + g) * 2 + dir) * 128;
        ep[lane] = xr; ep[64 + lane] = xi;
        const float nr = fmaf(a4.z, cr, fmaf(-a4.w, ci, xr)), ni = fmaf(a4.z, ci, fmaf(a4.w, cr, xi)); cr = nr; ci = ni;
        ua = un;
      }
      float* ecp = Ec + (((size_t)cc * 32 + g) * 2 + dir) * 128;
      ecp[lane] = cr; ecp[64 + lane] = ci;
    }
  }
}

struct SOps { float4 a4; float2 a128; bf16x8 ua; BFrag bf; float sr, si; float fer[3], fei[3]; float er[16], ei[16]; };
struct SGeo { int m0, ci, c, nC, b; bool isctx; };
__device__ __forceinline__ void s5b_load(SOps& o, const SGeo& t, int e, int g, int dir, int lane, const bf16_t* U, const float4* S5A, const float2* S5A128, const bf16_t* S5BB,
                                         const float* Ef, const float* Ec, const float* h0re, const float* h0im) {
  const int tb = ((e * 2 + dir) * 32 + g);
  o.a4 = S5A[tb * 64 + lane]; o.a128 = S5A128[tb * 64 + lane];
  o.ua = load_u(U, t.m0, g, dir, lane); o.bf = load_bb(S5BB + (size_t)tb * 2048, lane);
  o.sr = 0.f; o.si = 0.f;
  if (!t.isctx) { const int hi_ = (((t.b * 2 + e) * 2 + dir) * 32 + g) * 64 + lane; o.sr = h0re[hi_]; o.si = h0im[hi_]; }
  const int C = t.c >> 2, f = t.c & 3, nCC = t.nC >> 2, cc0 = (t.ci - t.c) >> 2;
  const int n = dir ? (nCC - 1 - C) : C; const int cstart = dir ? (cc0 + nCC - 1) : cc0; const int estep = (dir ? -1 : 1) * 32 * 2 * 128;
  const int e0 = ((cstart * 32 + g) * 2 + dir) * 128 + lane;
  const int nf = dir ? (3 - f) : f; const int fstart = dir ? (t.ci - f + 3) : (t.ci - f);
  const int f0 = ((fstart * 32 + g) * 2 + dir) * 128 + lane;
#pragma unroll
  for (int q = 0; q < 3; ++q) { const int qq = q < nf ? q : 0; o.fer[q] = Ef[f0 + qq * estep]; o.fei[q] = Ef[f0 + qq * estep + 64]; }
#pragma unroll
  for (int j = 0; j < 16; ++j) { const int kk = j < n ? j : 0; o.er[j] = Ec[e0 + kk * estep]; o.ei[j] = Ec[e0 + kk * estep + 64]; }
}
__device__ __forceinline__ void phase_b(LAS char* lds, int e, const bf16_t* U, const float4* S5A, const float2* S5A128, const bf16_t* S5BB, const bf16_t* S5CM, const float* Ef, const float* Ec,
                                        const float* h0re, const float* h0im, const float* dvec, const bf16_t* Wglu, const float* bglu,
                                        bf16_t* AO, float* st_re, float* st_im, int G, int vcu, const int wv, unsigned long long* stampp = nullptr) {
  const int lane = lane_id_opaque(), wid = wv; (void)wid; (void)stampp;
  LAS char* X = lds + OFF_X + wid * XBYTES; LAS char* Gt = lds + OFF_G;
  for (int ci = vcu; ci < NCHUNK; ci += G) {
    SGeo t; t.ci = ci; t.m0 = ci * S5T; t.isctx = t.m0 < NCTX;
    if (t.isctx) { t.b = t.m0 / CTX_L; t.c = (t.m0 % CTX_L) / S5T; t.nC = CTX_L / S5T; } else { t.b = (t.m0 - NCTX) / LAT_L; t.c = ((t.m0 - NCTX) % LAT_L) / S5T; t.nC = LAT_L / S5T; }
    const int m0 = t.m0;
#if S5_STAMP
    const unsigned long long st0_ = __builtin_amdgcn_s_memrealtime();
#endif
    SOps P;
    s5b_load(P, t, e, wid * 4, 0, lane, U, S5A, S5A128, S5BB, Ef, Ec, h0re, h0im);
    f32x4 yacc[2] = {{0.f, 0.f, 0.f, 0.f}, {0.f, 0.f, 0.f, 0.f}};
    float uu[2][4];
#pragma unroll 1
    for (int q = 0; q < 8; ++q) { const int g = wid * 4 + (q >> 1), dir = q & 1;
      const int tb = ((e * 2 + dir) * 32 + g);
      const int nl = lane & 15, col = g * 16 + nl;
      const bf16_t* cm = S5CM + (size_t)tb * 2048 + (lane & 15) * 128 + (lane >> 4) * 8;
      bf16x8 cf[4];
#pragma unroll
      for (int ks = 0; ks < 4; ++ks) cf[ks] = *(const bf16x8*)(cm + ks * 32);
      if (dir == 0) {
#pragma unroll
        for (int rb = 0; rb < 2; ++rb)
#pragma unroll
          for (int i = 0; i < 4; ++i) uu[rb][i] = bf2f(U[(size_t)(m0 + rb * 16 + (lane >> 4) * 4 + i) * S5W + col]); }
      const float4 a4 = P.a4; const float2 a128 = P.a128;
      float sr = P.sr, si = P.si;
      const int C = t.c >> 2, f = t.c & 3, nCC = t.nC >> 2, cc0 = (t.ci - t.c) >> 2;
      const int n = dir ? (nCC - 1 - C) : C; const int cstart = dir ? (cc0 + nCC - 1) : cc0; const int estep = (dir ? -1 : 1) * 32 * 2 * 128;
      const int nf = dir ? (3 - f) : f;
#pragma unroll
      for (int j = 0; j < 16; ++j) if (j < n) { const float nr = fmaf(a128.x, sr, fmaf(-a128.y, si, P.er[j])), ni = fmaf(a128.x, si, fmaf(a128.y, sr, P.ei[j])); sr = nr; si = ni; }
      if (n > 16) { const int e0 = ((cstart * 32 + g) * 2 + dir) * 128 + lane; float er[16], ei[16];
#pragma unroll
        for (int j = 0; j < 16; ++j) { const int kk = 16 + j < n ? 16 + j : 16; er[j] = Ec[e0 + kk * estep]; ei[j] = Ec[e0 + kk * estep + 64]; }
#pragma unroll
        for (int j = 0; j < 16; ++j) if (16 + j < n) { const float nr = fmaf(a128.x, sr, fmaf(-a128.y, si, er[j])), ni = fmaf(a128.x, si, fmaf(a128.y, sr, ei[j])); sr = nr; si = ni; } }
#pragma unroll
      for (int qq = 0; qq < 3; ++qq) if (qq < nf) { const float nr = fmaf(a4.z, sr, fmaf(-a4.w, si, P.fer[qq])), ni = fmaf(a4.z, si, fmaf(a4.w, sr, P.fei[qq])); sr = nr; si = ni; }
      float bre[32], bim[32];
      bu_compute(P.ua, P.bf, bre, bim);
      if (q < 7) s5b_load(P, t, e, wid * 4 + ((q + 1) >> 1), (q + 1) & 1, lane, U, S5A, S5A128, S5BB, Ef, Ec, h0re, h0im);
      float xr = sr, xi = si;
#pragma unroll
      for (int i = 0; i < 32; ++i) { const float nr = fmaf(a4.x, xr, fmaf(-a4.y, xi, bre[i])), ni = fmaf(a4.x, xi, fmaf(a4.y, xr, bim[i])); xr = nr; xi = ni; bre[i] = nr; bim[i] = ni; }
      if (t.isctx && ((dir == 0 && t.c == t.nC - 1) || (dir == 1 && t.c == 0))) { const int so = (((t.b * 2 + e) * 2 + dir) * 32 + g) * 64 + lane; st_re[so] = xr; st_im[so] = xi; }
#pragma unroll
      for (int i = 0; i < 32; ++i) { const int tok = dir ? 31 - i : i;
        *(LAS unsigned*)(X + tok * XROW + lane * 4) = cvtpk(bre[i], bim[i]); }
      asm volatile("s_waitcnt lgkmcnt(0)" ::: "memory");
#pragma unroll
      for (int rb = 0; rb < 2; ++rb)
#pragma unroll
        for (int ks = 0; ks < 4; ++ks) { const bf16x8 af = *(const LAS bf16x8*)(X + (rb * 16 + (lane & 15)) * XROW + (ks * 32 + (lane >> 4) * 8) * 2);
          yacc[rb] = __builtin_amdgcn_mfma_f32_16x16x32_bf16(af, cf[ks], yacc[rb], 0, 0, 0); }
      asm volatile("s_waitcnt lgkmcnt(0)" ::: "memory");
      if (dir == 1) {
        const float dv = dvec[col];
#pragma unroll
        for (int rb = 0; rb < 2; ++rb)
#pragma unroll
          for (int i = 0; i < 4; ++i) { const int tok = rb * 16 + (lane >> 4) * 4 + i;
            const float y = yacc[rb][i] + dv * uu[rb][i];
            const float z2 = 1.5957691216057308f * (y + 0.044715f * y * y * y);
            const float gl = y - y / (1.f + __expf(z2));
            *(LAS unsigned short*)(Gt + tok * GROW + col * 2) = f2bf(gl); }
        yacc[0] = (f32x4){0.f, 0.f, 0.f, 0.f}; yacc[1] = (f32x4){0.f, 0.f, 0.f, 0.f};
      }
    }
#if S5_STAMP
    if (blockIdx.x == 0 && wid == 0 && lane == 0) atomicAdd(stampp, __builtin_amdgcn_s_memrealtime() - st0_);
#endif
    __syncthreads();
    { f32x4 acc[2][4];
#pragma unroll
      for (int rb = 0; rb < 2; ++rb)
#pragma unroll
        for (int cb = 0; cb < 4; ++cb) acc[rb][cb] = (f32x4){0.f, 0.f, 0.f, 0.f};
      const bf16_t* wp = Wglu + (size_t)(wid * 64 + (lane & 15)) * 512 + (lane >> 4) * 8;
#pragma unroll 4
      for (int ks = 0; ks < 16; ++ks) {
        bf16x8 af[2], bfr[4];
#pragma unroll
        for (int cb = 0; cb < 4; ++cb) bfr[cb] = *(const bf16x8*)(wp + (size_t)cb * 16 * 512 + ks * 32);
#pragma unroll
        for (int rb = 0; rb < 2; ++rb) af[rb] = *(const LAS bf16x8*)(Gt + (rb * 16 + (lane & 15)) * GROW + (ks * 32 + (lane >> 4) * 8) * 2);
#pragma unroll
        for (int rb = 0; rb < 2; ++rb)
#pragma unroll
          for (int cb = 0; cb < 4; ++cb) acc[rb][cb] = __builtin_amdgcn_mfma_f32_16x16x32_bf16(af[rb], bfr[cb], acc[rb][cb], 0, 0, 0);
      }
#pragma unroll
      for (int cb = 0; cb < 4; ++cb) { const int col = wid * 64 + cb * 16 + (lane & 15); const float bb = bglu[col];
#pragma unroll
        for (int rb = 0; rb < 2; ++rb)
#pragma unroll
          for (int i = 0; i < 4; ++i) { const int tok = rb * 16 + (lane >> 4) * 4 + i;
            const float gv = bf2f(*(const LAS unsigned short*)(Gt + tok * GROW + col * 2));
            const float zz = acc[rb][cb][i] + bb;
            AO[(size_t)(m0 + tok) * ABOUT + col] = f2bf(gv / (1.f + __expf(-zz))); } }
    }
    __syncthreads();
  }
}
}

constexpr size_t MiB = 1u << 20;
constexpr size_t WS_CTL = 0, CTL_ZERO_BYTES = 3 * MiB;
constexpr size_t WS_SSQ = 1 * MiB;
constexpr size_t WS_ADA = 3 * MiB;
constexpr size_t WS_S5A = 5 * MiB, WS_S5A128 = 5 * MiB + 512 * 1024, WS_S5BB = 6 * MiB, WS_S5CM = 7 * MiB;
constexpr size_t WS_GV = 8 * MiB;
constexpr size_t WS_BIAS = 9 * MiB;
constexpr size_t WS_CK = 14 * MiB, WS_CV = 22 * MiB;
constexpr size_t WS_WGLU = 30 * MiB;
constexpr size_t WS_WABIN = 32 * MiB;
constexpr size_t WS_WABOUT = 60 * MiB;
constexpr size_t WS_WCVIN = 72 * MiB;
constexpr size_t WS_WCVOUT = 120 * MiB;
constexpr size_t WS_WUP = 136 * MiB;
constexpr size_t WS_WDN = 264 * MiB;
constexpr size_t WS_H = 392 * MiB;
constexpr size_t WS_BIG = 552 * MiB;
constexpr size_t WS_U = WS_BIG, WS_Q = WS_BIG + 40 * MiB, WS_K = WS_BIG + 120 * MiB, WS_V = WS_BIG + 200 * MiB, WS_AO = WS_BIG + 280 * MiB, WS_E = WS_BIG + 400 * MiB, WS_EC = WS_BIG + 440 * MiB;
static_assert(WS_V - WS_K == WS_K - WS_Q, "q/k/v equally spaced");
constexpr size_t WS_Z = WS_BIG, WS_GB = WS_BIG + 160 * MiB, WS_A2 = WS_BIG + 320 * MiB;
constexpr size_t WS_END = WS_BIG + 640 * MiB;
constexpr int CW_TMO = 0, CW_BAR = 4096;

constexpr int RING_BYTES = 131072;
constexpr int LDSCTL_OFF = RING_BYTES, MISC_OFF = LDSCTL_OFF + 320;
constexpr int LDS_BYTES = 147456;
static_assert(att::OFF_WS >= RING_BYTES + 1024 + 2048 && att::LDS_BYTES <= LDS_BYTES && s5::LDS_BYTES <= RING_BYTES, "phase scratch fits");
constexpr int NWAVES = 8;

typedef GAS unsigned gu32;
#define RLX_AGENT __ATOMIC_RELAXED, __HIP_MEMORY_SCOPE_AGENT
#define LDS_WAIT() asm volatile("s_waitcnt lgkmcnt(0)" ::: "memory")
#define VM_WAIT() asm volatile("s_waitcnt vmcnt(0)" ::: "memory")

#define XB_TMO      128
#define XB_XCNT(j)  (256  + 64 * (j))
#define XB_XSUB(j)  (1280 + 64 * (j))
#define XB_XGEN(j)  (2304 + 64 * (j))
#define XB_TOP      3328
#define XB_TOPGEN   3392
#define XCD_BAR_WORDS 3456
#define XB_SPIN_CAP (1u << 18)
__device__ __forceinline__ unsigned xb_ld(unsigned* p)              { return __hip_atomic_load(p, __ATOMIC_RELAXED, __HIP_MEMORY_SCOPE_AGENT); }
__device__ __forceinline__ unsigned xb_add(unsigned* p, unsigned v) { return __hip_atomic_fetch_add(p, v, __ATOMIC_RELAXED, __HIP_MEMORY_SCOPE_AGENT); }
__device__ __forceinline__ unsigned xb_xcc_id() { return (unsigned)__builtin_amdgcn_s_getreg((3 << 11) | 20) & 0xFu; }
#define XB_SPIN(cond, bar) do { unsigned _sp = 0; while (cond) { __builtin_amdgcn_s_sleep(1); \
    if ((++_sp & 255u) == 0u) { if (xb_ld(&(bar)[XB_TMO])) break; if (_sp > XB_SPIN_CAP) { atomicAdd(&(bar)[XB_TMO], 1u); break; } } } } while (0)
struct XcdBarrier { unsigned* bar; unsigned x; volatile LAS unsigned* st; };
__device__ __forceinline__ XcdBarrier xcd_barrier_post(unsigned* bar, volatile LAS unsigned* st) {
    XcdBarrier b; b.bar = bar; b.x = xb_xcc_id(); b.st = st;
    if (threadIdx.x == 0) (void)xb_add(&bar[XB_XCNT(b.x)], 1u);
    return b;
}
__device__ __forceinline__ void xcd_barrier_complete(unsigned* bar, unsigned x, unsigned& nloc, unsigned& nx) {
    const unsigned G = gridDim.x * gridDim.y * gridDim.z;
    unsigned sum, cnt, mine, sp = 0u;
    for (;;) {
        sum = 0u; cnt = 0u; mine = 0u;
#pragma unroll
        for (unsigned j = 0; j < 16; ++j) { const unsigned c = xb_ld(&bar[XB_XCNT(j)]); sum += c; cnt += (c > 0u) ? 1u : 0u; mine = (j == x) ? c : mine; }
        if (sum == G) break;
        __builtin_amdgcn_s_sleep(1);
        if ((++sp & 255u) == 0u) { if (xb_ld(&bar[XB_TMO])) break; if (sp > XB_SPIN_CAP) { atomicAdd(&bar[XB_TMO], 1u); break; } }
    }
    nloc = mine > 0u ? mine : 1u; nx = cnt > 0u ? cnt : 1u;
}
__device__ __forceinline__ void xcd_barrier(const XcdBarrier& b, const int wv) {
    asm volatile("s_waitcnt vmcnt(0)" ::: "memory");
    __syncthreads();
    if (wv == 0 && lane_id_opaque() == 0) {
        unsigned* bar = b.bar; asm volatile("" : "+s"(bar));
        __builtin_amdgcn_s_waitcnt(0);
        unsigned nloc = b.st[0], nx = b.st[1];
        if (nloc == 0u) { xcd_barrier_complete(bar, b.x, nloc, nx); b.st[0] = nloc; b.st[1] = nx; }
        const unsigned old = xb_add(&bar[XB_XSUB(b.x)], 1u);
        const unsigned gen = old / nloc;
        if (old + 1u == (gen + 1u) * nloc) {
            __builtin_amdgcn_fence(__ATOMIC_RELEASE, "agent");
            asm volatile("s_waitcnt vmcnt(0)" ::: "memory");
            const unsigned og = xb_add(&bar[XB_TOP], 1u);
            const unsigned tg = og / nx;
            if (og + 1u == (tg + 1u) * nx) xb_add(&bar[XB_TOPGEN], 1u);
            else XB_SPIN(xb_ld(&bar[XB_TOPGEN]) == tg, bar);
            __builtin_amdgcn_fence(__ATOMIC_ACQUIRE, "agent");
            xb_add(&bar[XB_XGEN(b.x)], 1u);
            asm volatile("s_waitcnt vmcnt(0)" ::: "memory");
        } else {
            XB_SPIN(xb_ld(&bar[XB_XGEN(b.x)]) == gen, bar);
            __builtin_amdgcn_fence(__ATOMIC_ACQUIRE, "agent");
            asm volatile("s_waitcnt vmcnt(0)" ::: "memory");
        }
    }
    __syncthreads();
}

struct Args { const float* in[33]; float* out; unsigned char* ws; int ph_lo, ph_hi; };
enum { I_XP = 0, I_XS, I_C, I_CK, I_CV, I_SRE, I_SIM, I_CCTX, I_ADAW, I_ADAB, I_N1G, I_N2G, I_ABWIN, I_ABWOUT, I_LAMRE, I_LAMIM, I_LOGDT, I_BRE, I_BIM, I_CRE, I_CIM, I_S5D,
       I_GLUW, I_GLUB, I_QNG, I_KNG, I_RPB, I_CVWIN, I_CVW, I_CVB, I_CVWOUT, I_W1, I_W2 };
constexpr size_t O_X = 0, O_CK = (size_t)MTOK * DM, O_CV = O_CK + (size_t)32 * 2 * 256 * 1024, O_SRE = O_CV + (size_t)32 * 2 * 256 * 1024, O_SIM = O_SRE + 32 * 2 * 2 * 32 * 64;

__device__ __forceinline__ float lane_xor(float v, int lane, int m) { return __uint_as_float((unsigned)__builtin_amdgcn_ds_bpermute((lane ^ m) << 2, (int)__float_as_uint(v))); }
__device__ __forceinline__ float wave_sum(float v, int lane) {
#pragma unroll
    for (int o = 1; o < 64; o <<= 1) v += lane_xor(v, lane, o);
    return v;
}
__device__ __forceinline__ unsigned pk2(float lo, float hi) { return cvtpk(lo, hi); }
__device__ __forceinline__ float wave_sum_dpp(float v) {
    v += __uint_as_float((unsigned)__builtin_amdgcn_update_dpp(0, (int)__float_as_uint(v), 0x128, 0xf, 0xf, false));
    v += __uint_as_float((unsigned)__builtin_amdgcn_update_dpp(0, (int)__float_as_uint(v), 0x124, 0xf, 0xf, false));
    v += __uint_as_float((unsigned)__builtin_amdgcn_update_dpp(0, (int)__float_as_uint(v), 0x122, 0xf, 0xf, false));
    v += __uint_as_float((unsigned)__builtin_amdgcn_update_dpp(0, (int)__float_as_uint(v), 0x121, 0xf, 0xf, false));
    { auto t = __builtin_amdgcn_permlane16_swap(__float_as_uint(v), __float_as_uint(v), false, false); v = __uint_as_float(t[0]) + __uint_as_float(t[1]); }
    { auto t = __builtin_amdgcn_permlane32_swap(__float_as_uint(v), __float_as_uint(v), false, false); v = __uint_as_float(t[0]) + __uint_as_float(t[1]); }
    return v;
}

__device__ __forceinline__ int dest_row(int n0, int mode) {
    if (mode == 0) return n0;
    if (n0 < 2048) return 4096 + n0;
    if (n0 < 4096) { const int c = n0 - 2048; return (c >> 7) * 256 + (c & 127); }
    const int c = n0 - 4096; return (c >> 7) * 256 + 128 + (c & 127);
}
__device__ __forceinline__ void p0_transpose_item(const float* W, int K, int N, bf16_t* WT, int mode, LAS unsigned* T, int item, int lane) {
    const int nblk = N / 128, kb = item / nblk, nb = item % nblk, k0 = 64 * kb, n0 = 128 * nb;
    const int lr = lane >> 5, lc = lane & 31;
    const float* src = W + (size_t)(k0 + 2 * lr) * N + n0 + 4 * lc;
#pragma unroll 8
    for (int q = 0; q < 16; ++q) { const f32x4 a = __builtin_nontemporal_load((const f32x4*)(src + (size_t)(4 * q) * N)), b = __builtin_nontemporal_load((const f32x4*)(src + (size_t)(4 * q + 1) * N));
        const int kp = 2 * q + lr; u32x4 w; w.x = pk2(a[0], b[0]); w.y = pk2(a[1], b[1]); w.z = pk2(a[2], b[2]); w.w = pk2(a[3], b[3]);
        *(LAS u32x4*)(T + kp * 128 + ((4 * lc) ^ (((kp >> 2) & 7) << 2))) = w; }
    LDS_WAIT(); asm volatile("" ::: "memory");
    const int kq = lane & 7, nl = lane >> 3; const int r0 = dest_row(n0, mode);
#pragma unroll 4
    for (int j = 0; j < 16; ++j) { const int n = nl + 8 * j; u32x4 o;
        o.x = T[(4 * kq + 0) * 128 + (n ^ (kq << 2))]; o.y = T[(4 * kq + 1) * 128 + (n ^ (kq << 2))]; o.z = T[(4 * kq + 2) * 128 + (n ^ (kq << 2))]; o.w = T[(4 * kq + 3) * 128 + (n ^ (kq << 2))];
        *(GAS u32x4*)(WT + (size_t)(r0 + n) * K + k0 + 8 * kq) = o; }
    LDS_WAIT(); asm volatile("" ::: "memory");
}
__device__ __forceinline__ void sincos_d(double x, double& s, double& c) {
    const double k = rint(x * 0.63661977236758134308);
    double r = fma(-k, 1.5707963267948966, x); r = fma(-k, 6.123233995736766e-17, r);
    const double r2 = r * r;
    double ps = 1.0 / 355687428096000.0;
    ps = fma(ps, r2, -1.0 / 1307674368000.0); ps = fma(ps, r2, 1.0 / 6227020800.0); ps = fma(ps, r2, -1.0 / 39916800.0); ps = fma(ps, r2, 1.0 / 362880.0);
    ps = fma(ps, r2, -1.0 / 5040.0); ps = fma(ps, r2, 1.0 / 120.0); ps = fma(ps, r2, -1.0 / 6.0); ps = fma(ps * r2, r, r);
    double pc = 1.0 / 6402373705728000.0;
    pc = fma(pc, r2, -1.0 / 20922789888000.0); pc = fma(pc, r2, 1.0 / 87178291200.0); pc = fma(pc, r2, -1.0 / 479001600.0); pc = fma(pc, r2, 1.0 / 3628800.0);
    pc = fma(pc, r2, -1.0 / 40320.0); pc = fma(pc, r2, 1.0 / 720.0); pc = fma(pc, r2, -1.0 / 24.0); pc = fma(pc, r2, 0.5); pc = fma(-pc, r2, 1.0);
    const int q = ((int)k) & 3;
    s = (q == 0) ? ps : (q == 1) ? pc : (q == 2) ? -ps : -pc;
    c = (q == 0) ? pc : (q == 1) ? -ps : (q == 2) ? -pc : ps;
}
__device__ __forceinline__ double exp_small_d(double x) {
    double p = 1.0 / 87178291200.0;
    p = fma(p, x, 1.0 / 6227020800.0); p = fma(p, x, 1.0 / 479001600.0); p = fma(p, x, 1.0 / 39916800.0); p = fma(p, x, 1.0 / 3628800.0); p = fma(p, x, 1.0 / 362880.0);
    p = fma(p, x, 1.0 / 40320.0); p = fma(p, x, 1.0 / 5040.0); p = fma(p, x, 1.0 / 720.0); p = fma(p, x, 1.0 / 120.0); p = fma(p, x, 1.0 / 24.0); p = fma(p, x, 1.0 / 6.0);
    p = fma(p, x, 0.5); p = fma(p, x, 1.0); p = fma(p, x, 1.0); return p;
}
__device__ __forceinline__ double exp_d(double x) {
    const double k = rint(x * 1.4426950408889634); const double r = fma(-k, 0.6931471805599453, x) ;
    double e = exp_small_d(r * 0.25); e = e * e; e = e * e;
    return ldexp(e, (int)k);
}

__device__ __forceinline__ const float* as_global(const float* x) { const GAS float* p = (const GAS float*)x; asm("" : "+s"(p)); return (const float*)p; }
#define FIN(i) as_global(F.in[i])
struct Frame {
    LAS unsigned char* lds;
    int wave, vcu, G;
    const float* const* in;
    float* out; unsigned char* ws;
};

__device__ __forceinline__ void p0_ada_item(Frame& F, int item) {
    const int lane = lane_id_opaque(), tid = F.wave * 64 + lane; (void)tid;
    const int l = item / 48, cb = item % 48;
    LAS float* sl = (LAS float*)F.lds;
    for (int i = tid; i < 9 * 2048; i += 512) { const int j = i / 2048, k = i % 2048; const float c = j == 0 ? FIN(I_CCTX)[k] : FIN(I_C)[(j - 1) * 2048 + k]; sl[k * 12 + j] = c / (1.f + __expf(-c)); }
    __syncthreads();
    const float* W = FIN(I_ADAW) + (size_t)l * 2048 * 12288 + (size_t)(F.wave * 256) * 12288 + cb * 256 + lane * 4;
    f32x4 acc[9];
#pragma unroll
    for (int j = 0; j < 9; ++j) acc[j] = (f32x4){0.f, 0.f, 0.f, 0.f};
    for (int k0 = 0; k0 < 256; k0 += 8) {
        f32x4 w[8];
#pragma unroll
        for (int u = 0; u < 8; ++u) w[u] = __builtin_nontemporal_load((const f32x4*)(W + (size_t)(k0 + u) * 12288));
#pragma unroll
        for (int u = 0; u < 8; ++u) { const LAS f32x4* sp = (const LAS f32x4*)(sl + (F.wave * 256 + k0 + u) * 12);
            const f32x4 s0 = sp[0], s1 = sp[1], s2 = sp[2];
            acc[0] += w[u] * s0[0]; acc[1] += w[u] * s0[1]; acc[2] += w[u] * s0[2]; acc[3] += w[u] * s0[3];
            acc[4] += w[u] * s1[0]; acc[5] += w[u] * s1[1]; acc[6] += w[u] * s1[2]; acc[7] += w[u] * s1[3]; acc[8] += w[u] * s2[0]; }
    }
    __syncthreads();
    LAS f32x4* pp = (LAS f32x4*)F.lds;
#pragma unroll
    for (int j = 0; j < 9; ++j) pp[(F.wave * 9 + j) * 64 + lane] = acc[j];
    __syncthreads();
    float* ADA = (float*)(F.ws + WS_ADA) + (size_t)l * 9 * 12288;
    const float* bias = FIN(I_ADAB) + (size_t)l * 12288;
    for (int i = tid; i < 9 * 64; i += 512) { const int j = i / 64, q = i % 64; f32x4 s = pp[(0 * 9 + j) * 64 + q];
#pragma unroll
        for (int w = 1; w < 8; ++w) s += pp[(w * 9 + j) * 64 + q];
        const int col = cb * 256 + q * 4; s += *(const f32x4*)(bias + col);
        *(f32x4*)(ADA + (size_t)j * 12288 + col) = s; }
    __syncthreads();
}
__device__ __forceinline__ void p0_s5_tables(Frame& F) {
    const int lane = lane_id_opaque(), tid = F.wave * 64 + lane; (void)tid;
    const int gt = F.vcu * 512 + tid;
    if (gt >= 2 * 2 * 32 * 64) return;
    const int p = gt & 63, g = (gt >> 6) & 31, dir = (gt >> 11) & 1, e = gt >> 12;
    const int gi = (e * 2 + dir) * 32 + g;
    const double lre = (double)FIN(I_LAMRE)[gi * 64 + p], lim = (double)FIN(I_LAMIM)[gi * 64 + p];
    const double dt = exp_d((double)FIN(I_LOGDT)[gi]);
    const double ar = lre * dt, ai = lim * dt;
    double s, c; sincos_d(ai, s, c); const double dec = exp_d(ar);
    const double are = dec * c, aim = dec * s;
    double sT, cT; sincos_d(ai * S5T, sT, cT); const double decT = exp_d(ar * S5T);
    float4* A = (float4*)(F.ws + WS_S5A);
    A[gi * 64 + p] = make_float4((float)are, (float)aim, (float)(decT * cT), (float)(decT * sT));
    { double s4, c4; sincos_d(ai * (4 * S5T), s4, c4); const double dec4 = exp_d(ar * (4 * S5T));
      ((float2*)(F.ws + WS_S5A128))[gi * 64 + p] = make_float2((float)(dec4 * c4), (float)(dec4 * s4)); }
    const double den = lre * lre + lim * lim, nr = are - 1.0;
    const double fre = (nr * lre + aim * lim) / den, fim = (aim * lre - nr * lim) / den;
    bf16_t* BB = (bf16_t*)(F.ws + WS_S5BB) + (size_t)gi * 2048;
    const float* bre = FIN(I_BRE) + ((size_t)gi * 64 + p) * 16; const float* bim = FIN(I_BIM) + ((size_t)gi * 64 + p) * 16;
#pragma unroll
    for (int n = 0; n < 16; ++n) { const double br = bre[n], bi = bim[n];
        BB[(0 * 64 + p) * 16 + n] = f2bf((float)(fre * br - fim * bi)); BB[(1 * 64 + p) * 16 + n] = f2bf((float)(fre * bi + fim * br)); }
    bf16_t* CM = (bf16_t*)(F.ws + WS_S5CM) + (size_t)gi * 2048;
    const float* cre = FIN(I_CRE) + (size_t)gi * 16 * 64; const float* cim = FIN(I_CIM) + (size_t)gi * 16 * 64;
#pragma unroll
    for (int n = 0; n < 16; ++n) { CM[n * 128 + 2 * p] = f2bf(cre[n * 64 + p]); CM[n * 128 + 2 * p + 1] = f2bf(-cim[n * 64 + p]); }
}
__device__ __forceinline__ void p0_prologue(Frame& F) {
    const int lane = lane_id_opaque(), tid = F.wave * 64 + lane; (void)tid;
    if (F.vcu < 192) p0_ada_item(F, F.vcu);
    p0_s5_tables(F);
    { const size_t n8 = (size_t)8 * 2 * 256 * 1024 / 8; const size_t gth = (size_t)F.vcu * 512 + tid, nth = (size_t)F.G * 512;
      for (size_t i = gth; i < 2 * n8; i += nth) { const bool isk = i < n8; const size_t j = isk ? i : i - n8;
        const float* src = (isk ? FIN(I_CK) : FIN(I_CV)) + j * 8; bf16_t* dst = (bf16_t*)(F.ws + (isk ? WS_CK : WS_CV)) + j * 8;
        const f32x4 a = __builtin_nontemporal_load((const f32x4*)src), b = __builtin_nontemporal_load((const f32x4*)(src + 4));
        u32x4 o; o.x = pk2(a[0], a[1]); o.y = pk2(a[2], a[3]); o.z = pk2(b[0], b[1]); o.w = pk2(b[2], b[3]); *(u32x4*)dst = o; } }
    LAS unsigned* scr = (LAS unsigned*)(F.lds + F.wave * 16384);
    const int gw = F.vcu * NWAVES + F.wave, NGW = F.G * NWAVES;
    constexpr int I_ABI = 32 * 28, I_ABO = 24 * 16, I_CVI = 32 * 48, I_CVO = 32 * 16, I_UP = 32 * 64, I_DN = 128 * 16, I_GLU = 8 * 4;
    constexpr int NITEMS = 2 * I_ABI + 2 * I_ABO + 2 * I_CVI + 2 * I_CVO + 4 * I_UP + 4 * I_DN + 2 * I_GLU;
    for (int it = gw; it < NITEMS; it += NGW) {
        int r = it;
        if (r < 2 * I_ABI) { const int e = r / I_ABI; p0_transpose_item(FIN(I_ABWIN) + (size_t)e * DM * ABIN, DM, ABIN, (bf16_t*)(F.ws + WS_WABIN) + (size_t)e * ABIN * DM, 0, scr, r % I_ABI, lane); continue; } r -= 2 * I_ABI;
        if (r < 2 * I_ABO) { const int e = r / I_ABO; p0_transpose_item(FIN(I_ABWOUT) + (size_t)e * ABOUT * DM, ABOUT, DM, (bf16_t*)(F.ws + WS_WABOUT) + (size_t)e * DM * ABOUT, 0, scr, r % I_ABO, lane); continue; } r -= 2 * I_ABO;
        if (r < 2 * I_CVI) { const int e = r / I_CVI; p0_transpose_item(FIN(I_CVWIN) + (size_t)e * DM * 3 * DM, DM, 3 * DM, (bf16_t*)(F.ws + WS_WCVIN) + (size_t)e * 3 * DM * DM, 1, scr, r % I_CVI, lane); continue; } r -= 2 * I_CVI;
        if (r < 2 * I_CVO) { const int e = r / I_CVO; p0_transpose_item(FIN(I_CVWOUT) + (size_t)e * DM * DM, DM, DM, (bf16_t*)(F.ws + WS_WCVOUT) + (size_t)e * DM * DM, 0, scr, r % I_CVO, lane); continue; } r -= 2 * I_CVO;
        if (r < 4 * I_UP) { const int e = r / I_UP; p0_transpose_item(FIN(I_W1) + (size_t)e * DM * DFF, DM, DFF, (bf16_t*)(F.ws + WS_WUP) + (size_t)e * DFF * DM, 0, scr, r % I_UP, lane); continue; } r -= 4 * I_UP;
        if (r < 4 * I_DN) { const int e = r / I_DN; p0_transpose_item(FIN(I_W2) + (size_t)e * DFF * DM, DFF, DM, (bf16_t*)(F.ws + WS_WDN) + (size_t)e * DM * DFF, 0, scr, r % I_DN, lane); continue; } r -= 4 * I_DN;
        { const int e = r / I_GLU; p0_transpose_item(FIN(I_GLUW) + (size_t)e * S5W * S5W, S5W, S5W, (bf16_t*)(F.ws + WS_WGLU) + (size_t)e * S5W * S5W, 0, scr, r % I_GLU, lane); }
    }
}

__device__ __forceinline__ const bf16_t* wt_of_norm(const unsigned char* ws, int s, int& N) {
    const int l = s >> 1;
    if (s & 1) { N = DFF; return (const bf16_t*)(ws + WS_WUP) + (size_t)l * DFF * DM; }
    if (l & 1) { N = 3 * DM; return (const bf16_t*)(ws + WS_WCVIN) + (size_t)(l >> 1) * 3 * DM * DM; }
    N = ABIN; return (const bf16_t*)(ws + WS_WABIN) + (size_t)(l >> 1) * ABIN * DM;
}
__device__ __forceinline__ void pre_phase(Frame& F) {
    const int lane = lane_id_opaque(), wave = F.wave, tid = wave * 64 + lane;
    GAS unsigned char* wsg_ = (GAS unsigned char*)F.ws; asm volatile("" : "+s"(wsg_)); unsigned char* ws = (unsigned char*)wsg_;
    const int gw = F.vcu * NWAVES + wave, NGW = F.G * NWAVES;
    const float* ADA0 = (const float*)(ws + WS_ADA);
    { float* GV = (float*)(ws + WS_GV);
      for (int i = F.vcu * 512 + tid; i < 8 * 9 * DM; i += F.G * 512) { const int s = i / (9 * DM), r = i % (9 * DM), j = r / DM, col = r % DM, l = s >> 1, which = s & 1;
        GV[i] = F.in[which ? I_N2G : I_N1G][l * DM + col] * (1.f + ADA0[((size_t)l * 9 + j) * 12288 + (which ? 4 : 1) * DM + col]); } }
    { bf16_t* H = (bf16_t*)(ws + WS_H); float* SSQ = (float*)(ws + WS_SSQ); const float* gn = FIN(I_N1G);
      for (int m = gw; m < MTOK; m += NGW) {
        const float* xrow = m < NCTX ? FIN(I_XP) + (size_t)m * DM : FIN(I_XS) + (size_t)(m - NCTX) * DM;
        const f32x4* xr = (const f32x4*)xrow + lane;
        const float* ad = ADA0 + (size_t)ada_row_of_token(m) * 12288;
        u32x2* o8 = (u32x2*)(H + (size_t)m * DM) + lane; float sq = 0.f;
#pragma unroll
        for (int j = 0; j < 8; ++j) { const int col = 4 * lane + 256 * j; const f32x4 v = __builtin_nontemporal_load(xr + 64 * j);
            sq += (v[0] * v[0] + v[1] * v[1]) + (v[2] * v[2] + v[3] * v[3]);
            const f32x4 g = *(const f32x4*)(gn + col), sc = *(const f32x4*)(ad + DM + col);
            const f32x4 h = v * g * (sc + 1.f);
            u32x2 w; w.x = pk2(h[0], h[1]); w.y = pk2(h[2], h[3]); o8[64 * j] = w; }
        sq = wave_sum_dpp(sq);
        if (lane == 0) SSQ[m] = sq; } }
    { float* BIAS = (float*)(ws + WS_BIAS);
      constexpr int T_AB = ABIN / 16, T_CV = 3 * DM / 16, T_UP = DFF / 16, T_PAIR = T_AB + T_UP + T_CV + T_UP;
      for (int it = gw; it < 2 * T_PAIR; it += NGW) {
        int r = it % T_PAIR, s = (it / T_PAIR) * 4;
        if (r >= T_AB) { r -= T_AB; ++s; if (r >= T_UP) { r -= T_UP; ++s; if (r >= T_CV) { r -= T_CV; ++s; } } }
        const int l = s >> 1, which = s & 1, n0 = r * 16;
        int N; const bf16_t* Wt = wt_of_norm(ws, s, N);
        const GAS bf16_t* wp = (const GAS bf16_t*)Wt + (size_t)(n0 + (lane & 15)) * DM + (lane >> 4) * 8;
        const int jj = (lane & 15) < 9 ? (lane & 15) : 8;
        const GAS float* sp = (const GAS float*)ADA0 + ((size_t)l * 9 + jj) * 12288 + (which ? 3 : 0) * DM + (lane >> 4) * 8;
        f32x4 acc = {0.f, 0.f, 0.f, 0.f};
#pragma unroll 8
        for (int ks = 0; ks < DM / 32; ++ks) {
            const bf16x8 a = *(const GAS bf16x8*)(wp + ks * 32);
            const f32x4 b0 = *(const GAS f32x4*)(sp + ks * 32), b1 = *(const GAS f32x4*)(sp + ks * 32 + 4);
            u32x4 hw; hw.x = pk2(b0[0], b0[1]); hw.y = pk2(b0[2], b0[3]); hw.z = pk2(b1[0], b1[1]); hw.w = pk2(b1[2], b1[3]);
            u32x4 lw; lw.x = pk2(b0[0] - bflo(hw.x), b0[1] - bfhi(hw.x)); lw.y = pk2(b0[2] - bflo(hw.y), b0[3] - bfhi(hw.y));
            lw.z = pk2(b1[0] - bflo(hw.z), b1[1] - bfhi(hw.z)); lw.w = pk2(b1[2] - bflo(hw.w), b1[3] - bfhi(hw.w));
            acc = __builtin_amdgcn_mfma_f32_16x16x32_bf16(a, *(const bf16x8*)&hw, acc, 0, 0, 0);
            acc = __builtin_amdgcn_mfma_f32_16x16x32_bf16(a, *(const bf16x8*)&lw, acc, 0, 0, 0);
        }
        if ((lane & 15) < 9) *(GAS f32x4*)(BIAS + ((size_t)s * 9 + (lane & 15)) * DFF + n0 + (lane >> 4) * 4) = acc;
      } }
}
__device__ __forceinline__ void qknorm_phase(Frame& F, int e) {
    const int lane = lane_id_opaque(), wave = F.wave, tid = wave * 64 + lane; (void)tid;
    GAS unsigned char* wsg_ = (GAS unsigned char*)F.ws; asm volatile("" : "+s"(wsg_)); unsigned char* ws = (unsigned char*)wsg_;

    const int gw = F.vcu * NWAVES + wave, NGW = F.G * NWAVES;
    bf16_t* Q = (bf16_t*)(ws + WS_Q); bf16_t* Kb = (bf16_t*)(ws + WS_K); const bf16_t* V = (const bf16_t*)(ws + WS_V);
    const int d0 = (lane & 7) * 16;
    float gq[16], gk[16];
#pragma unroll
    for (int i = 0; i < 16; ++i) { gq[i] = FIN(I_QNG)[e * 128 + d0 + i]; gk[i] = FIN(I_KNG)[e * 128 + d0 + i]; }
    for (int m = gw; m < MTOK; m += NGW) {
#pragma unroll
        for (int t = 0; t < 2; ++t) {
            bf16_t* row = (t ? Kb : Q) + (size_t)m * 1024 + lane * 16;
            const u32x4 a = *(const u32x4*)row, b = *(const u32x4*)(row + 8);
            float x[16];
#pragma unroll
            for (int i = 0; i < 4; ++i) { x[2 * i] = bflo(a[i]); x[2 * i + 1] = bfhi(a[i]); x[8 + 2 * i] = bflo(b[i]); x[8 + 2 * i + 1] = bfhi(b[i]); }
            float s = 0.f;
#pragma unroll
            for (int i = 0; i < 16; ++i) s += x[i] * x[i];
            s += lane_xor(s, lane, 1); s += lane_xor(s, lane, 2); s += lane_xor(s, lane, 4);
            const float rstd = 1.f / sqrtf(s * (1.f / 128.f) + NORM_EPS);
#pragma unroll
            for (int i = 0; i < 16; ++i) x[i] = x[i] * rstd * (t ? gk[i] : gq[i]);
            u32x4 oa, ob;
#pragma unroll
            for (int i = 0; i < 4; ++i) { oa[i] = pk2(x[2 * i], x[2 * i + 1]); ob[i] = pk2(x[8 + 2 * i], x[8 + 2 * i + 1]); }
            *(u32x4*)row = oa; *(u32x4*)(row + 8) = ob;
            if (t == 1 && m < NCTX) { const int b_ = m >> 8, tt = m & 255; float* o = F.out + O_CK + (((size_t)b_ * 2 + e) * 256 + tt) * 1024 + lane * 16;
#pragma unroll
                for (int i = 0; i < 4; ++i) __builtin_nontemporal_store((f32x4){x[4 * i], x[4 * i + 1], x[4 * i + 2], x[4 * i + 3]}, (f32x4*)(o + 4 * i)); }
        }
        if (m < NCTX) { const int b_ = m >> 8, tt = m & 255; float* o = F.out + O_CV + (((size_t)b_ * 2 + e) * 256 + tt) * 1024 + lane * 16;
            const bf16_t* row = V + (size_t)m * 1024 + lane * 16; const u32x4 a = *(const u32x4*)row, b = *(const u32x4*)(row + 8);
            *(f32x4*)(o + 0) = (f32x4){bflo(a[0]), bfhi(a[0]), bflo(a[1]), bfhi(a[1])}; *(f32x4*)(o + 4) = (f32x4){bflo(a[2]), bfhi(a[2]), bflo(a[3]), bfhi(a[3])};
            *(f32x4*)(o + 8) = (f32x4){bflo(b[0]), bfhi(b[0]), bflo(b[1]), bfhi(b[1])}; *(f32x4*)(o + 12) = (f32x4){bflo(b[2]), bfhi(b[2]), bflo(b[3]), bfhi(b[3])}; }
    }
}
__device__ __forceinline__ void conv_phase(Frame& F, int o) {
    const int lane = lane_id_opaque(), wave = F.wave, tid = wave * 64 + lane; (void)tid;
    GAS unsigned char* wsg_ = (GAS unsigned char*)F.ws; asm volatile("" : "+s"(wsg_)); unsigned char* ws = (unsigned char*)wsg_;

    const int gw = F.vcu * NWAVES + wave, NGW = F.G * NWAVES;
    const bf16_t* Z = (const bf16_t*)(ws + WS_Z); const bf16_t* GB = (const bf16_t*)(ws + WS_GB); bf16_t* A2 = (bf16_t*)(ws + WS_A2);
    const float* cw = FIN(I_CVW) + (size_t)o * 3 * DM; const float* cb = FIN(I_CVB) + (size_t)o * DM;
    for (int it = gw; it < (MTOK / 16) * 4; it += NGW) {
        const int rc = it >> 2, cq = it & 3, m0 = rc * 16, col = cq * 512 + lane * 8;
        float w0[8], w1[8], w2[8], bb[8];
#pragma unroll
        for (int i = 0; i < 8; ++i) { w0[i] = cw[col + i]; w1[i] = cw[DM + col + i]; w2[i] = cw[2 * DM + col + i]; bb[i] = cb[col + i]; }
        const int L = m0 < NCTX ? CTX_L : LAT_L; const int t0 = (m0 < NCTX ? m0 : m0 - NCTX) % L;
        u32x4 zp = (u32x4){0u, 0u, 0u, 0u}, zc, zn;
        if (t0 > 0) zp = *(const u32x4*)(Z + (size_t)(m0 - 1) * DM + col);
        zc = *(const u32x4*)(Z + (size_t)m0 * DM + col);
#pragma unroll 4
        for (int r = 0; r < 16; ++r) { const int m = m0 + r;
            zn = (u32x4){0u, 0u, 0u, 0u}; if (t0 + r + 1 < L) zn = *(const u32x4*)(Z + (size_t)(m + 1) * DM + col);
            const u32x4 gb = *(const u32x4*)(GB + (size_t)m * DM + col);
            float ov[8];
#pragma unroll
            for (int i = 0; i < 4; ++i) {
                const float c0 = w0[2 * i] * bflo(zp[i]) + w1[2 * i] * bflo(zc[i]) + w2[2 * i] * bflo(zn[i]) + bb[2 * i];
                const float c1 = w0[2 * i + 1] * bfhi(zp[i]) + w1[2 * i + 1] * bfhi(zc[i]) + w2[2 * i + 1] * bfhi(zn[i]) + bb[2 * i + 1];
                ov[2 * i] = bflo(gb[i]) * c0; ov[2 * i + 1] = bfhi(gb[i]) * c1; }
            u32x4 ow; ow.x = pk2(ov[0], ov[1]); ow.y = pk2(ov[2], ov[3]); ow.z = pk2(ov[4], ov[5]); ow.w = pk2(ov[6], ov[7]);
            *(u32x4*)(A2 + (size_t)m * DM + col) = ow;
            zp = zc; zc = zn; }
    }
}
#ifndef ATT_SDEPTH
#define ATT_SDEPTH 2
#endif
__device__ __forceinline__ void attn_phase(Frame& F, int e) {
    const int lane = lane_id_opaque(), wave = F.wave, tid = wave * 64 + lane; (void)tid;
    GAS unsigned char* wsg_ = (GAS unsigned char*)F.ws; asm volatile("" : "+s"(wsg_)); unsigned char* ws = (unsigned char*)wsg_;

    const bf16_t* Q = (const bf16_t*)(ws + WS_Q); const bf16_t* Kb = (const bf16_t*)(ws + WS_K); const bf16_t* V = (const bf16_t*)(ws + WS_V);
    bf16_t* AO = (bf16_t*)(ws + WS_AO);
    const bf16_t* CK = (const bf16_t*)(ws + WS_CK); const bf16_t* CV = (const bf16_t*)(ws + WS_CV);
    LAS char* lds = (LAS char*)F.lds;
    const float* gqp = FIN(I_QNG) + e * 128;
    if (tid < 128) ((LAS float*)(lds + att::OFF_GK))[tid] = FIN(I_KNG)[e * 128 + tid];
    for (int u = F.vcu; u < 1024 + 256; u += F.G) {
        __syncthreads();
        if (u < 1024) {
            const int b = u >> 7, h = (u >> 4) & 7, R = (u & 15) * 4;
            int kr0 = R - 4; kr0 = kr0 < 0 ? 0 : (kr0 > 52 ? 52 : kr0);
            LAS float* bl = (LAS float*)(lds + att::OFF_BIAS);
            { const int t2 = wave * 64 + lane_id_opaque();
              if (t2 < 15 * 32) { const int dr = t2 >> 5, dc = t2 & 31; bl[t2] = dc < 31 ? FIN(I_RPB)[((size_t)(e * 8 + h) * 15 + dr) * 31 + dc] * 11.313708498984761f : 0.f; } }
            const size_t seq0 = (size_t)NCTX + (size_t)b * LAT_L;
            const bf16_t* Qb = Q + (seq0 + (size_t)R * 64) * 1024 + h * 128;
            const bf16_t* K0 = CK + (((size_t)b * 2 + e) * 256) * 1024 + h * 128; const bf16_t* V0 = CV + (((size_t)b * 2 + e) * 256) * 1024 + h * 128;
            const bf16_t* K1 = Kb + (seq0 + (size_t)kr0 * 64) * 1024 + h * 128; const bf16_t* V1 = V + (seq0 + (size_t)kr0 * 64) * 1024 + h * 128;
            bf16_t* Ob = AO + (seq0 + (size_t)R * 64) * ABOUT + S5W + h * 128;
            att::attn_unit<true, ATT_SDEPTH>(lds, Qb, K0, V0, 4, K1, V1, 16, Ob, ABOUT, R, kr0, wave, gqp, nullptr, nullptr, false);
        } else {
            const int uc = u - 1024, b = uc >> 3, h = uc & 7;
            const size_t seq0 = (size_t)b * CTX_L;
            const bf16_t* Qb = Q + seq0 * 1024 + h * 128; const bf16_t* K0 = Kb + seq0 * 1024 + h * 128; const bf16_t* V0 = V + seq0 * 1024 + h * 128;
            bf16_t* Ob = AO + seq0 * ABOUT + S5W + h * 128;
            att::attn_unit<false, ATT_SDEPTH>(lds, Qb, K0, V0, 4, K0, V0, 4, Ob, ABOUT, 0, 0, wave, gqp, F.out + O_CK + (((size_t)b * 2 + e) * 256) * 1024 + h * 128, F.out + O_CV + (((size_t)b * 2 + e) * 256) * 1024 + h * 128, true);
        }
    }
}

constexpr int NPHASE = 2 + 6 * NLAYER;
#ifndef REP_PRO
#define REP_PRO 1
#endif
#ifndef REP_PRE
#define REP_PRE 1
#endif
#ifndef REP_S5A
#define REP_S5A 1
#endif
#ifndef REP_S5B
#define REP_S5B 1
#endif
#ifndef REP_ATT
#define REP_ATT 1
#endif
#ifndef REP_CONV
#define REP_CONV 1
#endif
#ifndef REP_UP
#define REP_UP 1
#endif
#ifndef GEMM_STAMP
#define GEMM_STAMP 0
#endif
#ifndef PG8_SP2
#define PG8_SP2 true
#endif
#ifndef PG8_ALIGN
#define PG8_ALIGN true
#endif

__global__ void __launch_bounds__(NWAVES * 64, 2) fwd(Args args) {
    extern __shared__ __attribute__((aligned(16))) unsigned char lds[];
    Frame F;
    F.lds = (LAS unsigned char*)lds;
    F.wave = __builtin_amdgcn_readfirstlane((int)threadIdx.x >> 6);
    F.G = gridDim.x; { const int bx = blockIdx.x; F.vcu = (F.G % 8 == 0) ? (bx % 8) * (F.G / 8) + bx / 8 : bx; }
    F.in = args.in; F.out = (float*)(GAS float*)args.out; F.ws = (unsigned char*)(GAS unsigned char*)args.ws;
    for (int u = threadIdx.x; u < (LDS_BYTES - LDSCTL_OFF) / 4; u += NWAVES * 64) ((LAS unsigned*)(F.lds + LDSCTL_OFF))[u] = 0u;
    __syncthreads();
    volatile LAS unsigned* MISC = (volatile LAS unsigned*)(F.lds + MISC_OFF);
    XcdBarrier bar = xcd_barrier_post((unsigned*)(F.ws + WS_CTL) + CW_BAR, MISC + 8);
#if MK_PER_PHASE
    const int lo = args.ph_lo, hi = args.ph_hi;
#else
    constexpr int lo = 0, hi = NPHASE;
#endif
#define IN(k) (lo <= (k) && (k) < hi)
#if GEMM_STAMP == 7
#define SEAM(k) do { if (lo <= (k) && (k) + 1 < hi) { const unsigned long long t0_ = __builtin_amdgcn_s_memrealtime(); xcd_barrier(bar, F.wave); const unsigned long long dt_ = __builtin_amdgcn_s_memrealtime() - t0_; if (blockIdx.x == 0 && threadIdx.x == 0) atomicAdd((unsigned long long*)(F.ws + WS_CTL + 65536) + 3, dt_); } } while (0)
#else
#define SEAM(k) do { if (lo <= (k) && (k) + 1 < hi) xcd_barrier(bar, F.wave); } while (0)
#endif
#define OPAQUE_WS GAS unsigned char* wsg_ = (GAS unsigned char*)F.ws; asm volatile("" : "+s"(wsg_)); unsigned char* ws = (unsigned char*)wsg_; int bxo = bx; asm volatile("" : "+s"(bxo)); (void)bxo
    LAS unsigned char* ring = F.lds;
    const int bx = (int)blockIdx.x;

    if (IN(0)) { for (int rep = 0; rep < REP_PRO; ++rep) { p0_prologue(F); __syncthreads(); } }
    SEAM(0);
    if (IN(1)) { for (int rep = 0; rep < REP_PRE; ++rep) pre_phase(F); }
    SEAM(1);
#pragma unroll 1
    for (int l = 0; l < NLAYER; ++l) {
        const int pb = 2 + 6 * l, e = l >> 1;
        const float* ADA = (const float*)(F.ws + WS_ADA) + (size_t)l * 9 * 12288;
        const float* rb0 = l == 0 ? FIN(I_XP) : F.out; const float* rb1 = l == 0 ? FIN(I_XS) - (size_t)NCTX * DM : F.out;
        if ((l & 1) == 0) {
            if (IN(pb + 0)) { OPAQUE_WS; pg8::Gemm g{(const bf16_t*)(ws + WS_H), (const bf16_t*)(ws + WS_WABIN) + (size_t)e * ABIN * DM, MTOK, ABIN, DM}; pg8::StaticOrder S; S.init(MTOK, ABIN, F.G, bxo);
                pg8::EpiAbIn E{(bf16_t*)(ws + WS_U), (bf16_t*)(ws + WS_Q), (size_t)(WS_K - WS_Q) / 2, pg8::NormIn{(const float*)(ws + WS_SSQ) + (size_t)(2 * l) * MTOK, (const float*)(ws + WS_BIAS) + (size_t)(2 * l) * 9 * DFF, DFF}};
                pg8::gemm_phase_i<pg8::EpiAbIn, pg8::StaticOrder>(ring, g, S, E, F.wave); }
            SEAM(pb + 0);
            if (IN(pb + 1)) { OPAQUE_WS;
                for (int rep = 0; rep < REP_S5A; ++rep) s5::phase_a(e, (const bf16_t*)(ws + WS_U), (const float4*)(ws + WS_S5A), (const bf16_t*)(ws + WS_S5BB), (float*)(ws + WS_E), (float*)(ws + WS_EC), F.G, F.vcu, F.wave); }
            SEAM(pb + 1);
            if (IN(pb + 2)) { OPAQUE_WS;
                for (int rep = 0; rep < REP_S5B; ++rep) s5::phase_b((LAS char*)F.lds, e, (const bf16_t*)(ws + WS_U), (const float4*)(ws + WS_S5A), (const float2*)(ws + WS_S5A128), (const bf16_t*)(ws + WS_S5BB), (const bf16_t*)(ws + WS_S5CM), (const float*)(ws + WS_E), (const float*)(ws + WS_EC),
                            FIN(I_SRE), FIN(I_SIM), FIN(I_S5D) + (size_t)e * S5W, (const bf16_t*)(ws + WS_WGLU) + (size_t)e * S5W * S5W, FIN(I_GLUB) + (size_t)e * S5W,
                            (bf16_t*)(ws + WS_AO), F.out + O_SRE, F.out + O_SIM, F.G, F.vcu, F.wave, (unsigned long long*)(ws + WS_CTL + 65536) + 4);
                for (int rep = 0; rep < REP_ATT; ++rep) attn_phase(F, e); }
            SEAM(pb + 2);
            if (IN(pb + 3)) { OPAQUE_WS; pg8::Gemm g{(const bf16_t*)(ws + WS_AO), (const bf16_t*)(ws + WS_WABOUT) + (size_t)e * DM * ABOUT, MTOK, DM, ABOUT}; pg8::StaticOrder S; S.init(MTOK, DM, F.G, bxo);
                pg8::EpiRes<true> E{rb0, rb1, F.out, ADA + 2 * DM, (const float*)(ws + WS_GV) + (size_t)(2 * l + 1) * 9 * DM, (bf16_t*)(ws + WS_H), (float*)(ws + WS_SSQ) + (size_t)(2 * l + 1) * MTOK};
                pg8::gemm_phase<pg8::EpiRes<true>, pg8::StaticOrder, PG8_ALIGN, PG8_SP2>(ring, g, S, E, F.wave); }
            SEAM(pb + 3);
        } else {
            if (IN(pb + 0)) { OPAQUE_WS; pg8::Gemm g{(const bf16_t*)(ws + WS_H), (const bf16_t*)(ws + WS_WCVIN) + (size_t)e * 3 * DM * DM, MTOK, 3 * DM, DM}; pg8::StaticOrder S; S.init(MTOK, 3 * DM, F.G, bxo);
                pg8::EpiConvIn E{(bf16_t*)(ws + WS_Z), (bf16_t*)(ws + WS_GB), pg8::NormIn{(const float*)(ws + WS_SSQ) + (size_t)(2 * l) * MTOK, (const float*)(ws + WS_BIAS) + (size_t)(2 * l) * 9 * DFF, DFF}};
                pg8::gemm_phase_i<pg8::EpiConvIn, pg8::StaticOrder>(ring, g, S, E, F.wave); }
            SEAM(pb + 0);
            if (IN(pb + 1)) { for (int rep = 0; rep < REP_CONV; ++rep) conv_phase(F, e); }
            SEAM(pb + 2);
            if (IN(pb + 3)) { OPAQUE_WS; pg8::Gemm g{(const bf16_t*)(ws + WS_A2), (const bf16_t*)(ws + WS_WCVOUT) + (size_t)e * DM * DM, MTOK, DM, DM}; pg8::StaticOrder S; S.init(MTOK, DM, F.G, bxo);
                pg8::EpiRes<true> E{rb0, rb1, F.out, ADA + 2 * DM, (const float*)(ws + WS_GV) + (size_t)(2 * l + 1) * 9 * DM, (bf16_t*)(ws + WS_H), (float*)(ws + WS_SSQ) + (size_t)(2 * l + 1) * MTOK};
                pg8::gemm_phase<pg8::EpiRes<true>, pg8::StaticOrder, PG8_ALIGN, PG8_SP2>(ring, g, S, E, F.wave); }
            SEAM(pb + 3);
        }
        if (IN(pb + 4)) { OPAQUE_WS; pg8::Gemm g{(const bf16_t*)(ws + WS_H), (const bf16_t*)(ws + WS_WUP) + (size_t)l * DFF * DM, MTOK, DFF, DM}; pg8::StaticOrder S; S.init(MTOK, DFF, F.G, bxo);
            pg8::EpiRelu2 E{(bf16_t*)(ws + WS_BIG), DFF, pg8::NormIn{(const float*)(ws + WS_SSQ) + (size_t)(2 * l + 1) * MTOK, (const float*)(ws + WS_BIAS) + (size_t)(2 * l + 1) * 9 * DFF, DFF}};
#if GEMM_STAMP
            pg8::gemm_phase_i<pg8::EpiRelu2, pg8::StaticOrder>(ring, g, S, E, F.wave, (unsigned long long*)(ws + WS_CTL + 65536)); }
#else
            for (int rep = 0; rep < REP_UP; ++rep) pg8::gemm_phase_i<pg8::EpiRelu2, pg8::StaticOrder>(ring, g, S, E, F.wave); }
#endif
        SEAM(pb + 4);
        if (IN(pb + 5)) { OPAQUE_WS; pg8::Gemm g{(const bf16_t*)(ws + WS_BIG), (const bf16_t*)(ws + WS_WDN) + (size_t)l * DM * DFF, MTOK, DM, DFF}; pg8::StaticOrder S; S.init(MTOK, DM, F.G, bxo);
            if (l < NLAYER - 1) { pg8::EpiRes<true> E{F.out, F.out, F.out, ADA + 5 * DM, (const float*)(ws + WS_GV) + (size_t)(2 * l + 2) * 9 * DM, (bf16_t*)(ws + WS_H), (float*)(ws + WS_SSQ) + (size_t)(2 * l + 2) * MTOK};
                pg8::gemm_phase<pg8::EpiRes<true>, pg8::StaticOrder, PG8_ALIGN, PG8_SP2>(ring, g, S, E, F.wave); }
            else { pg8::EpiRes<false> E{F.out, F.out, F.out, ADA + 5 * DM, nullptr, nullptr, nullptr};
                pg8::gemm_phase<pg8::EpiRes<false>, pg8::StaticOrder, PG8_ALIGN, PG8_SP2>(ring, g, S, E, F.wave); } }
        SEAM(pb + 5);
    }
#if GEMM_STAMP || S5_STAMP
    if (blockIdx.x == 0 && threadIdx.x == 0) { unsigned long long* st = (unsigned long long*)(F.ws + WS_CTL + 65536);
        const unsigned long long tk = __hip_atomic_load(st, __ATOMIC_RELAXED, __HIP_MEMORY_SCOPE_AGENT), ck = __hip_atomic_load(st + 1, __ATOMIC_RELAXED, __HIP_MEMORY_SCOPE_AGENT), te = __hip_atomic_load(st + 2, __ATOMIC_RELAXED, __HIP_MEMORY_SCOPE_AGENT);
        unsigned long long wait = 0;
#if GEMM_STAMP == 7
        wait = __hip_atomic_load(st + 3, __ATOMIC_RELAXED, __HIP_MEMORY_SCOPE_AGENT);
#endif
        if (S5_STAMP) wait = __hip_atomic_load(st + 4, __ATOMIC_RELAXED, __HIP_MEMORY_SCOPE_AGENT);
        if (GEMM_STAMP == 1) wait = tk ? ck * 10000ull / tk : 0;
        if (GEMM_STAMP == 2) wait = tk / 4;
        if (GEMM_STAMP == 3) wait = te;
        if (GEMM_STAMP >= 4) { unsigned long long mx = 0, mn = ~0ull, sm = 0; for (unsigned i = 0; i < gridDim.x; ++i) { const unsigned long long v = __hip_atomic_load(st + 8 + i, __ATOMIC_RELAXED, __HIP_MEMORY_SCOPE_AGENT); mx = v > mx ? v : mx; mn = v < mn ? v : mn; sm += v; }
            wait = (GEMM_STAMP == 4 ? mx : GEMM_STAMP == 5 ? mn : sm / gridDim.x) / 4; }
        const unsigned long long t0 = __builtin_amdgcn_s_memrealtime(); while (__builtin_amdgcn_s_memrealtime() - t0 < wait) __builtin_amdgcn_s_sleep(32); }
#endif
#undef IN
#undef SEAM
#undef OPAQUE_WS
}

extern "C" void kernel_launch(void* const* d_in, const int* in_sizes, int n_in, void* d_out, int out_size, void* d_ws, size_t ws_size, hipStream_t stream) {
    static int grid = 0;
    if (grid == 0) {
        if (n_in != 33 || ws_size < WS_END) { fprintf(stderr, "kernel_launch: n_in %d ws %zu (need 33, >= %zu)\n", n_in, ws_size, (size_t)WS_END); grid = -1; return; }
        int dev = 0, cus = 0;
        if (hipGetDevice(&dev) != hipSuccess || hipDeviceGetAttribute(&cus, hipDeviceAttributeMultiprocessorCount, dev) != hipSuccess) { grid = -1; return; }
        if (hipFuncSetAttribute((const void*)fwd, hipFuncAttributeMaxDynamicSharedMemorySize, LDS_BYTES) != hipSuccess) { fprintf(stderr, "kernel_launch: hipFuncSetAttribute failed\n"); grid = -1; return; }
        int per_cu = 0;
        if (hipOccupancyMaxActiveBlocksPerMultiprocessor(&per_cu, (const void*)fwd, NWAVES * 64, LDS_BYTES) != hipSuccess || per_cu < 1) fprintf(stderr, "kernel_launch: occupancy query says %d\n", per_cu);
        (void)hipGetLastError();
        grid = cus;
    }
    if (grid < 0) return;
    (void)hipMemsetAsync((char*)d_ws + WS_CTL, 0, CTL_ZERO_BYTES, stream);
    Args a{};
    for (int i = 0; i < 33; ++i) a.in[i] = (const float*)d_in[i];
    a.out = (float*)d_out; a.ws = (unsigned char*)d_ws;
#if MK_PER_PHASE
    for (int p = 0; p < NPHASE; ++p) {
        if (p > 1) { const int l = (p - 2) / 6, k = (p - 2) % 6; if ((l & 1) && k == 2) continue; }
        a.ph_lo = p; a.ph_hi = p + 1;
        hipLaunchKernelGGL(fwd, dim3(grid), dim3(NWAVES * 64), LDS_BYTES, stream, a);
    }
#else
    a.ph_lo = 0; a.ph_hi = NPHASE;
    hipLaunchKernelGGL(fwd, dim3(grid), dim3(NWAVES * 64), LDS_BYTES, stream, a);
#endif
    const hipError_t le = hipPeekAtLastError();
    if (le != hipSuccess) fprintf(stderr, "kernel_launch: launch failed: %s\n", hipGetErrorName(le));
}
```

```cpp
#include <hip/hip_runtime.h>
#include <cstdio>
#include <cstdint>

#ifndef PG8_EARLY
#define PG8_EARLY 0
#endif
#ifndef MK_PER_PHASE
#define MK_PER_PHASE 0
#endif

__device__ __forceinline__ int lane_id_opaque() { int l; asm volatile("v_mbcnt_lo_u32_b32 %0, -1, 0\n\tv_mbcnt_hi_u32_b32 %0, -1, %0" : "=v"(l)); return l; }

namespace pg8 {
#define PG8_LAS __attribute__((address_space(3)))
typedef unsigned short bf16_t;
typedef short bf16x8 __attribute__((ext_vector_type(8)));
typedef float f32x4 __attribute__((ext_vector_type(4)));
typedef unsigned u32x4 __attribute__((ext_vector_type(4)));
constexpr int BM = 256, BK = 64, HALF = 128, HTB = HALF * BK * 2  , STAGE_BYTES = 8 * HTB, NXCD = 8, WGM = 8;

__host__ __device__ __forceinline__ int lds_byte(int r, int c) { const int st = (r >> 4) * 2 + (c >> 5), rr = r & 15, cc = c & 31, ob = rr * 64 + cc * 2; return st * 1024 + (ob ^ (((ob >> 9) & 1) << 5)); }
__host__ __device__ __forceinline__ void stage_rc(int b, int& R, int& C) { const int st = b / 1024, sb = b % 1024, swz = sb ^ (((sb >> 9) & 1) << 5); R = (st >> 1) * 16 + swz / 64; C = (st & 1) * 32 + (swz % 64) / 2; }
__host__ __device__ __forceinline__ int perm32(int rho) { const int n = rho >> 4, i = rho & 15; return 8 * (i >> 2) + 4 * n + (i & 3); }

struct Unit { int pm, pn; };
struct Gemm { const bf16_t* A; const bf16_t* Bt; int M, N, K; };

struct StaticOrder {
    int nM, nN, nwg, G, c;
    __host__ __device__ void init(int M, int N, int G_, int c_) { nM = M / BM; nN = N / BM; nwg = nM * nN; G = G_; c = c_; }
    __host__ __device__ bool next(int i, Unit& u) const {
        const long L = (long)i * G + c; if (L >= nwg) return false;
        int wgid = (int)L; { const int q = nwg / NXCD, r = nwg % NXCD, xcd = wgid % NXCD, off = wgid / NXCD; wgid = (xcd < r ? xcd * (q + 1) : r * (q + 1) + (xcd - r) * q) + off; }
        const int nig = WGM * nN, gid = wgid / nig, fm = gid * WGM, gsz = (nM - fm) < WGM ? (nM - fm) : WGM;
        u.pm = fm + ((wgid % nig) % gsz); u.pn = (wgid % nig) / gsz; return true;
    }
    __device__ __forceinline__ void a_ready(const Unit&) const {}
    __device__ __forceinline__ void done(const Unit&) const {}
};

__device__ __forceinline__ unsigned cvt_pk_bf16(float lo, float hi) { unsigned r; asm volatile("v_cvt_pk_bf16_f32 %0, %1, %2" : "=v"(r) : "v"(lo), "v"(hi)); return r; }

__device__ __forceinline__ void st16(void* p, u32x4 w) { asm volatile("global_store_dwordx4 %0, %1, off\n\ts_nop 1" :: "v"(p), "v"(w) : "memory"); }
typedef unsigned u32x2 __attribute__((ext_vector_type(2)));
__device__ __forceinline__ void st8(void* p, u32x2 w) { asm volatile("global_store_dwordx2 %0, %1, off\n\ts_nop 1" :: "v"(p), "v"(w) : "memory"); }
constexpr int DM = 2048;
__device__ __forceinline__ int ada_row_of_panel(int pm) { return pm < 32 ? 0 : 1 + ((pm - 32) >> 4); }

constexpr int LDSX_OFF = 131072 + 1024;
struct NormIn {
    const float* ssq; const float* bias; int N;
    __device__ __forceinline__ void prefetch(const Unit& u, PG8_LAS unsigned char* lds, int wv, int lane) const {
        const float* src = wv < 4 ? ssq + u.pm * BM + wv * 64 + lane : bias + (size_t)ada_row_of_panel(u.pm) * N + u.pn * BM + (wv - 4) * 64 + lane;
        __builtin_amdgcn_global_load_lds((const unsigned*)src, (PG8_LAS unsigned*)(lds + LDSX_OFF + wv * 256), 4, 0, 0);
    }
    __device__ __forceinline__ void load(PG8_LAS unsigned char* lds, const int ai, int wr, int wc, int fr, int fq, float (&rs)[4], f32x4 (&bv)[2][2]) const {
        const PG8_LAS float* sx = (const PG8_LAS float*)(lds + LDSX_OFF);
#pragma unroll
        for (int m = 0; m < 4; ++m) rs[m] = __builtin_amdgcn_rsqf(sx[ai * HALF + wr * 64 + m * 16 + fr] * (1.0f / DM) + 1e-6f);
#pragma unroll
        for (int bj = 0; bj < 2; ++bj)
#pragma unroll
            for (int n = 0; n < 2; ++n) bv[bj][n] = *(const PG8_LAS f32x4*)(sx + 256 + bj * HALF + wc * 32 + 8 * fq + 4 * n);
    }
};
struct EpiAbIn {
    static constexpr bool PERM = true, AFTER_DRAIN = false, PREFETCH = true;
    bf16_t* U; bf16_t* Q; size_t qkv_stride;
    NormIn nin;
    __device__ __forceinline__ void prefetch(const Unit& u, PG8_LAS unsigned char* lds, int wv, int lane) const { nin.prefetch(u, lds, wv, lane); }
    __device__ __forceinline__ void half(const f32x4 (&acc)[2][2][4][2], const Unit& u, const int ai, int wr, int wc, int, int, PG8_LAS unsigned char* lds) const {
        const int lz = lane_id_opaque(), fr = lz & 15, fq = lz >> 4;
        const int row0 = u.pm * BM + wr * 64 + fr;
        bf16_t* base; int ldc, colt;
        if (u.pn < 2) { base = U; ldc = 512; colt = u.pn * BM; }
        else { const int t = (u.pn - 2) >> 2; base = Q + (size_t)t * qkv_stride; ldc = 1024; colt = ((u.pn - 2) & 3) * BM; }
        const int col0 = colt + wc * 32 + 8 * fq;
        float rs[4]; f32x4 bv[2][2]; nin.load(lds, ai, wr, wc, fr, fq, rs, bv);
#pragma unroll
        for (int m = 0; m < 4; ++m) { bf16_t* rowp = base + (size_t)(row0 + ai * HALF + m * 16) * ldc + col0;
#pragma unroll
            for (int bj = 0; bj < 2; ++bj) { const f32x4 v0 = acc[ai][bj][m][0] * rs[m] + bv[bj][0], v1 = acc[ai][bj][m][1] * rs[m] + bv[bj][1];
                u32x4 w; w.x = cvt_pk_bf16(v0[0], v0[1]); w.y = cvt_pk_bf16(v0[2], v0[3]); w.z = cvt_pk_bf16(v1[0], v1[1]); w.w = cvt_pk_bf16(v1[2], v1[3]);
                st16(rowp + bj * HALF, w); } }
    }
};
struct EpiRelu2 {
    static constexpr bool PERM = true, AFTER_DRAIN = false, PREFETCH = true;
    bf16_t* O; int ldc; NormIn nin;
    __device__ __forceinline__ void prefetch(const Unit& u, PG8_LAS unsigned char* lds, int wv, int lane) const { nin.prefetch(u, lds, wv, lane); }
    __device__ __forceinline__ void half(const f32x4 (&acc)[2][2][4][2], const Unit& u, const int ai, int wr, int wc, int, int, PG8_LAS unsigned char* lds) const {
        const int lz = lane_id_opaque(), fr = lz & 15, fq = lz >> 4;
        const int row0 = u.pm * BM + wr * 64 + fr, col0 = u.pn * BM + wc * 32 + 8 * fq;
        float rs[4]; f32x4 bv[2][2]; nin.load(lds, ai, wr, wc, fr, fq, rs, bv);
#pragma unroll
        for (int m = 0; m < 4; ++m) { bf16_t* rowp = O + (size_t)(row0 + ai * HALF + m * 16) * ldc + col0;
#pragma unroll
            for (int bj = 0; bj < 2; ++bj) { f32x4 v0 = acc[ai][bj][m][0] * rs[m] + bv[bj][0], v1 = acc[ai][bj][m][1] * rs[m] + bv[bj][1];
#pragma unroll
                for (int j = 0; j < 4; ++j) { const float a = fmaxf(v0[j], 0.f), b = fmaxf(v1[j], 0.f); v0[j] = a * a; v1[j] = b * b; }
                u32x4 w; w.x = cvt_pk_bf16(v0[0], v0[1]); w.y = cvt_pk_bf16(v0[2], v0[3]); w.z = cvt_pk_bf16(v1[0], v1[1]); w.w = cvt_pk_bf16(v1[2], v1[3]);
                st16(rowp + bj * HALF, w); } }
    }
};
struct EpiConvIn {
    static constexpr bool PERM = true, AFTER_DRAIN = false, PREFETCH = true;
    bf16_t* Z; bf16_t* GB; NormIn nin;
    __device__ __forceinline__ void prefetch(const Unit& u, PG8_LAS unsigned char* lds, int wv, int lane) const { nin.prefetch(u, lds, wv, lane); }
    __device__ __forceinline__ void half(const f32x4 (&acc)[2][2][4][2], const Unit& u, const int ai, int wr, int wc, int, int, PG8_LAS unsigned char* lds) const {
        const int lz = lane_id_opaque(), fr = lz & 15, fq = lz >> 4;
        const int row0 = u.pm * BM + wr * 64 + fr;
        float rs[4]; f32x4 bv[2][2]; nin.load(lds, ai, wr, wc, fr, fq, rs, bv);
        if (u.pn < 16) {
            const int col0 = u.pn * HALF + wc * 32 + 8 * fq;
#pragma unroll
            for (int m = 0; m < 4; ++m) { bf16_t* rowp = Z + (size_t)(row0 + ai * HALF + m * 16) * DM + col0;
                const f32x4 v0 = (acc[ai][0][m][0] * rs[m] + bv[0][0]) * (acc[ai][1][m][0] * rs[m] + bv[1][0]), v1 = (acc[ai][0][m][1] * rs[m] + bv[0][1]) * (acc[ai][1][m][1] * rs[m] + bv[1][1]);
                u32x2 wa, wb; wa.x = cvt_pk_bf16(v0[0], v0[1]); wa.y = cvt_pk_bf16(v0[2], v0[3]); wb.x = cvt_pk_bf16(v1[0], v1[1]); wb.y = cvt_pk_bf16(v1[2], v1[3]);
                st8(rowp, wa); st8(rowp + 4, wb); }
        } else {
            const int col0 = (u.pn - 16) * BM + wc * 32 + 8 * fq;
#pragma unroll
            for (int m = 0; m < 4; ++m) { bf16_t* rowp = GB + (size_t)(row0 + ai * HALF + m * 16) * DM + col0;
#pragma unroll
                for (int bj = 0; bj < 2; ++bj) { const f32x4 v0 = acc[ai][bj][m][0] * rs[m] + bv[bj][0], v1 = acc[ai][bj][m][1] * rs[m] + bv[bj][1];
                    u32x4 w; w.x = cvt_pk_bf16(v0[0], v0[1]); w.y = cvt_pk_bf16(v0[2], v0[3]); w.z = cvt_pk_bf16(v1[0], v1[1]); w.w = cvt_pk_bf16(v1[2], v1[3]);
                    st16(rowp + bj * HALF, w); } }
        }
    }
};
template <bool NEXT> struct EpiRes {
    static constexpr bool PERM = false, AFTER_DRAIN = false, PREFETCH = false;
    const float* base0; const float* base1; float* out; const float* gate;
    const float* gvn; bf16_t* Hn; float* ssqn;
    __device__ __forceinline__ void operator()(const f32x4 (&acc)[2][2][4][2], const Unit& u, int wr, int wc, int fr, int fq, PG8_LAS unsigned char* lds) const {
        const int row0 = u.pm * BM + wr * 64 + fr, col0 = u.pn * BM + wc * 32 + 4 * fq;
        const int j = ada_row_of_panel(u.pm);
        const float* g = gate + j * 12288 + col0;
        const char* bs = (const char*)(u.pm < 32 ? base0 : base1); char* ob = (char*)out; char* hb = (char*)Hn;
        const unsigned o0 = (unsigned)(row0 * DM + col0) * 4u;
        f32x4 gv[2][2], gn[2][2];
#pragma unroll
        for (int bj = 0; bj < 2; ++bj)
#pragma unroll
            for (int n = 0; n < 2; ++n) { gv[bj][n] = *(const f32x4*)(g + bj * HALF + n * 16); if (NEXT) gn[bj][n] = *(const f32x4*)(gvn + j * DM + col0 + bj * HALF + n * 16); }
#pragma unroll
        for (int am = 0; am < 4; ++am) { const int ai = am >> 1, mh = (am & 1) * 2;
            f32x4 b[2][2][2];
#pragma unroll
            for (int mm = 0; mm < 2; ++mm)
#pragma unroll
                for (int bj = 0; bj < 2; ++bj)
#pragma unroll
                    for (int n = 0; n < 2; ++n) b[mm][bj][n] = *(const f32x4*)(bs + (o0 + (unsigned)(((ai * HALF + (mh + mm) * 16) * DM + bj * HALF + n * 16) * 4)));
#pragma unroll
            for (int mm = 0; mm < 2; ++mm) { const int m = mh + mm; float sq = 0.f;
#pragma unroll
                for (int bj = 0; bj < 2; ++bj)
#pragma unroll
                    for (int n = 0; n < 2; ++n) { const unsigned o = o0 + (unsigned)(((ai * HALF + m * 16) * DM + bj * HALF + n * 16) * 4);
                        const f32x4 x = b[mm][bj][n] + gv[bj][n] * acc[ai][bj][m][n];
                        *(f32x4*)(ob + o) = x;
                        if (NEXT) { sq += (x[0] * x[0] + x[1] * x[1]) + (x[2] * x[2] + x[3] * x[3]); const f32x4 h = x * gn[bj][n];
                            typedef unsigned u32x2v __attribute__((ext_vector_type(2))); u32x2v w; w.x = cvt_pk_bf16(h[0], h[1]); w.y = cvt_pk_bf16(h[2], h[3]);
                            *(u32x2v*)(hb + (o >> 1)) = w; } }
                if (NEXT) {
                    auto t = __builtin_amdgcn_permlane16_swap(__float_as_uint(sq), __float_as_uint(sq), false, false); sq = __uint_as_float(t[0]) + __uint_as_float(t[1]);
                    auto v = __builtin_amdgcn_permlane32_swap(__float_as_uint(sq), __float_as_uint(sq), false, false); sq = __uint_as_float(v[0]) + __uint_as_float(v[1]);
                    if (fq == 0) __hip_atomic_fetch_add(ssqn + row0 + ai * HALF + m * 16, sq, __ATOMIC_RELAXED, __HIP_MEMORY_SCOPE_AGENT); } }
            asm volatile("" ::: "memory"); }
    }
};

template <class Epi, class Sched, bool ALIGN_EPI = false, bool SP2 = false>
__device__ __forceinline__ void gemm_phase(PG8_LAS unsigned char* lds, const Gemm g, const Sched& S, const Epi& E, const int wv  , unsigned long long* stamp = nullptr  ) {
    int wvo_ = wv; asm volatile("" : "+s"(wvo_));
    const int lane = lane_id_opaque(), wid = wvo_, tid = wid * 64 + lane, wr = wid >> 2, wc = wid & 3, fr = lane & 15, fq = lane >> 4;
    const int K = g.K, nt = K / BK;
    unsigned voffA[2], voffB[2];
#pragma unroll
    for (int i = 0; i < 2; ++i) { int R, C; stage_rc(tid * 16 + i * 8192, R, C); const int Rb = Epi::PERM ? ((R & ~31) + perm32(R & 31)) : R;
        voffA[i] = (unsigned)(R * K + C) * 2u; voffB[i] = (unsigned)(Rb * K + C) * 2u; }
    const size_t kstep = (size_t)(BK * 2);
    const size_t hstep = (size_t)HALF * K * 2;
    const size_t tstep = 2 * hstep;
    const unsigned ldsw = (unsigned)wid * 1024u;
    const int aoff = lds_byte(wr * 64 + fr, fq * 8), boff = lds_byte(wc * 32 + fr, fq * 8);
#define PG8_SA(b, h) (((b) * 2 + (h)) * HTB)
#define PG8_SB(b, h) ((4 + (b) * 2 + (h)) * HTB)
#define PG8_STAGE(bufoff, gbase, voff) do { _Pragma("unroll") for (int _i = 0; _i < 2; ++_i) \
        __builtin_amdgcn_global_load_lds((const unsigned*)((const char*)(gbase) + (voff)[_i]), (PG8_LAS unsigned*)(lds + (bufoff) + ldsw + _i * 8192), 16, 0, 0); } while (0)
#define PG8_LDA(dst, b, h) do { _Pragma("unroll") for (int m = 0; m < 4; ++m) _Pragma("unroll") for (int k = 0; k < 2; ++k) dst[m][k] = *(const PG8_LAS bf16x8*)(lds + PG8_SA(b, h) + aoff + m * 2048 + k * 1024); } while (0)
#define PG8_LDB(dst, b, h) do { _Pragma("unroll") for (int n = 0; n < 2; ++n) _Pragma("unroll") for (int k = 0; k < 2; ++k) dst[n][k] = *(const PG8_LAS bf16x8*)(lds + PG8_SB(b, h) + boff + n * 2048 + k * 1024); } while (0)
#define PG8_MMA(ai, bj, At, Bt) do { __builtin_amdgcn_s_setprio(1); _Pragma("unroll") for (int m = 0; m < 4; ++m) _Pragma("unroll") for (int n = 0; n < 2; ++n) _Pragma("unroll") for (int k = 0; k < 2; ++k) \
        acc[ai][bj][m][n] = __builtin_amdgcn_mfma_f32_16x16x32_bf16(Bt[n][k], At[m][k], acc[ai][bj][m][n], 0, 0, 0); __builtin_amdgcn_s_setprio(0); } while (0)
#define PG8_MMA2B(ai, At, B0, B1) do { __builtin_amdgcn_s_setprio(1); \
        _Pragma("unroll") for (int m = 0; m < 4; ++m) _Pragma("unroll") for (int n = 0; n < 2; ++n) _Pragma("unroll") for (int k = 0; k < 2; ++k) acc[ai][0][m][n] = __builtin_amdgcn_mfma_f32_16x16x32_bf16(B0[n][k], At[m][k], acc[ai][0][m][n], 0, 0, 0); \
        _Pragma("unroll") for (int m = 0; m < 4 - PG8_EARLY; ++m) _Pragma("unroll") for (int n = 0; n < 2; ++n) _Pragma("unroll") for (int k = 0; k < 2; ++k) acc[ai][1][m][n] = __builtin_amdgcn_mfma_f32_16x16x32_bf16(B1[n][k], At[m][k], acc[ai][1][m][n], 0, 0, 0); \
        __builtin_amdgcn_sched_barrier(0); __builtin_amdgcn_s_barrier(); __builtin_amdgcn_sched_barrier(0); \
        _Pragma("unroll") for (int m = 4 - PG8_EARLY; m < 4; ++m) _Pragma("unroll") for (int n = 0; n < 2; ++n) _Pragma("unroll") for (int k = 0; k < 2; ++k) acc[ai][1][m][n] = __builtin_amdgcn_mfma_f32_16x16x32_bf16(B1[n][k], At[m][k], acc[ai][1][m][n], 0, 0, 0); \
        __builtin_amdgcn_s_setprio(0); } while (0)
#define PG8_WAIT_V(n) asm volatile("s_waitcnt vmcnt(" #n ")" ::: "memory")
#define PG8_WAIT_L(n) asm volatile("s_waitcnt lgkmcnt(" #n ")" ::: "memory")
#define PG8_BAR __builtin_amdgcn_s_barrier()
#define PG8_SCHED __builtin_amdgcn_sched_barrier(0)
    Unit cur, nxt; int ui = 0;
    if (!S.next(0, cur)) return;
    f32x4 acc[2][2][4][2];
#pragma unroll
    for (int a = 0; a < 2; ++a)
#pragma unroll
        for (int b = 0; b < 2; ++b)
#pragma unroll
            for (int m = 0; m < 4; ++m)
#pragma unroll
                for (int n = 0; n < 2; ++n) acc[a][b][m][n] = (f32x4){0.f, 0.f, 0.f, 0.f};
    bf16x8 At[4][2], B0[2][2], B1[2][2];
    const char* cA = (const char*)g.A + (size_t)cur.pm * tstep; const char* cB = (const char*)g.Bt + (size_t)cur.pn * tstep;
    S.a_ready(cur);
    if constexpr (SP2) {
        PG8_STAGE(PG8_SB(0, 0), cB, voffB); PG8_STAGE(PG8_SB(0, 1), cB + hstep, voffB); PG8_STAGE(PG8_SA(0, 0), cA, voffA); PG8_STAGE(PG8_SA(0, 1), cA + hstep, voffA);
        if (wr == 1) PG8_BAR;
        PG8_WAIT_V(2); PG8_BAR;
        PG8_STAGE(PG8_SB(1, 0), cB + kstep, voffB); PG8_STAGE(PG8_SA(1, 0), cA + kstep, voffA); PG8_STAGE(PG8_SB(1, 1), cB + hstep + kstep, voffB);
        PG8_WAIT_V(6); PG8_BAR;
    } else {
        PG8_STAGE(PG8_SB(0, 0), cB, voffB); PG8_STAGE(PG8_SA(0, 0), cA, voffA); PG8_STAGE(PG8_SB(0, 1), cB + hstep, voffB); PG8_STAGE(PG8_SA(0, 1), cA + hstep, voffA);
        if (wr == 1) PG8_BAR;
        PG8_WAIT_V(4); PG8_BAR;
        PG8_STAGE(PG8_SB(1, 0), cB + kstep, voffB); PG8_STAGE(PG8_SA(1, 0), cA + kstep, voffA); PG8_STAGE(PG8_SB(1, 1), cB + hstep + kstep, voffB);
        PG8_WAIT_V(6); PG8_BAR;
    }
    unsigned long long st_tk = 0, st_ck = 0, st_te = 0;
    for (;;) {
        const bool has_next = S.next(ui + 1, nxt);
        unsigned long long st_r0 = 0, st_c0 = 0; if (stamp) { st_r0 = __builtin_amdgcn_s_memrealtime(); st_c0 = __builtin_readcyclecounter(); }
        const char* nA = has_next ? (const char*)g.A + (size_t)nxt.pm * tstep : cA; const char* nB = has_next ? (const char*)g.Bt + (size_t)nxt.pn * tstep : cB;
        for (int t = 0; t < nt; t += 2) {
            const bool last = (t == nt - 2);
            const char* a1 = cA + (size_t)(t + 1) * kstep;
            const char* a2 = last ? nA : cA + (size_t)(t + 2) * kstep; const char* b2 = last ? nB : cB + (size_t)(t + 2) * kstep;
            const char* a3 = a2 + kstep; const char* b3 = b2 + kstep;
            if (last && has_next) S.a_ready(nxt);
            if constexpr (SP2) {
            PG8_LDB(B0, 0, 0); PG8_LDB(B1, 0, 1); PG8_SCHED; PG8_LDA(At, 0, 0); PG8_STAGE(PG8_SA(1, 1), a1 + hstep, voffA);
            PG8_WAIT_V(8); PG8_WAIT_L(0); PG8_BAR; PG8_MMA2B(0, At, B0, B1); PG8_SCHED;
            PG8_LDA(At, 0, 1); PG8_STAGE(PG8_SB(0, 0), b2, voffB); PG8_STAGE(PG8_SB(0, 1), b2 + hstep, voffB); PG8_STAGE(PG8_SA(0, 0), a2, voffA);
            PG8_WAIT_V(8); PG8_WAIT_L(0); PG8_BAR; PG8_MMA2B(1, At, B0, B1); PG8_SCHED;
            PG8_LDB(B0, 1, 0); PG8_LDB(B1, 1, 1); PG8_SCHED; PG8_LDA(At, 1, 0); PG8_STAGE(PG8_SA(0, 1), a2 + hstep, voffA);
            PG8_WAIT_V(8); PG8_WAIT_L(0); PG8_BAR; PG8_MMA2B(0, At, B0, B1); PG8_SCHED;
            PG8_LDA(At, 1, 1); PG8_STAGE(PG8_SB(1, 0), b3, voffB); PG8_STAGE(PG8_SB(1, 1), b3 + hstep, voffB); PG8_STAGE(PG8_SA(1, 0), a3, voffA);
            PG8_WAIT_V(8); PG8_WAIT_L(0); PG8_BAR; PG8_MMA2B(1, At, B0, B1); PG8_SCHED;
            } else {
            PG8_LDB(B0, 0, 0); PG8_SCHED; PG8_LDA(At, 0, 0); PG8_STAGE(PG8_SA(1, 1), a1 + hstep, voffA);
            PG8_WAIT_L(8); PG8_BAR; PG8_WAIT_L(0); PG8_MMA(0, 0, At, B0); PG8_BAR; PG8_SCHED;
            PG8_LDB(B1, 0, 1); PG8_STAGE(PG8_SB(0, 0), b2, voffB);
            PG8_BAR; PG8_WAIT_L(0); PG8_MMA(0, 1, At, B1); PG8_BAR;
            PG8_LDA(At, 0, 1); PG8_STAGE(PG8_SA(0, 0), a2, voffA);
            PG8_BAR; PG8_WAIT_L(0); PG8_MMA(1, 0, At, B0); PG8_BAR; PG8_SCHED;
            PG8_STAGE(PG8_SB(0, 1), b2 + hstep, voffB);
            PG8_WAIT_V(6); PG8_BAR; PG8_MMA(1, 1, At, B1); PG8_BAR;
            PG8_LDB(B0, 1, 0); PG8_SCHED; PG8_LDA(At, 1, 0); PG8_STAGE(PG8_SA(0, 1), a2 + hstep, voffA);
            PG8_WAIT_L(8); PG8_BAR; PG8_WAIT_L(0); PG8_MMA(0, 0, At, B0); PG8_BAR; PG8_SCHED;
            PG8_LDB(B1, 1, 1); PG8_STAGE(PG8_SB(1, 0), b3, voffB);
            PG8_BAR; PG8_WAIT_L(0); PG8_MMA(0, 1, At, B1); PG8_BAR;
            PG8_LDA(At, 1, 1); PG8_STAGE(PG8_SA(1, 0), a3, voffA);
            PG8_BAR; PG8_WAIT_L(0); PG8_MMA(1, 0, At, B0); PG8_BAR; PG8_SCHED;
            PG8_STAGE(PG8_SB(1, 1), b3 + hstep, voffB);
            PG8_WAIT_V(6); PG8_BAR; PG8_MMA(1, 1, At, B1); PG8_BAR;
            }
        }
        unsigned long long st_r1 = 0; if (stamp) { st_r1 = __builtin_amdgcn_s_memrealtime(); st_tk += st_r1 - st_r0; st_ck += __builtin_readcyclecounter() - st_c0; }
        if constexpr (ALIGN_EPI) { if (wr == 0) PG8_BAR; }
        if constexpr (!Epi::AFTER_DRAIN) { E(acc, cur, wr, wc, fr, fq, lds); S.done(cur); }
        if (stamp) st_te += __builtin_amdgcn_s_memrealtime() - st_r1;
        if (!has_next) break;
#pragma unroll
        for (int a = 0; a < 2; ++a)
#pragma unroll
            for (int b = 0; b < 2; ++b)
#pragma unroll
                for (int m = 0; m < 4; ++m)
#pragma unroll
                    for (int n = 0; n < 2; ++n) acc[a][b][m][n] = (f32x4){0.f, 0.f, 0.f, 0.f};
        cur = nxt; cA = nA; cB = nB; ++ui;
        if constexpr (ALIGN_EPI) { if (wr == 1) PG8_BAR; }
    }
    PG8_WAIT_V(0);
    if constexpr (!ALIGN_EPI) { if (wr == 0) PG8_BAR; }
    PG8_BAR;
    if (stamp && wid == 0 && lane == 0 && blockIdx.x == 0) { atomicAdd(stamp, st_tk); atomicAdd(stamp + 1, st_ck); atomicAdd(stamp + 2, st_te); }
    if constexpr (Epi::AFTER_DRAIN) { E.fused(acc, cur, wr, wc, fr, fq, lds, wid, lane); S.done(cur); }
#undef PG8_SA
#undef PG8_SB
#undef PG8_STAGE
#undef PG8_LDA
#undef PG8_LDB
#undef PG8_MMA
#undef PG8_MMA2B
#undef PG8_WAIT_V
#undef PG8_WAIT_L
#undef PG8_BAR
#undef PG8_SCHED
}

template <class Epi, class Sched>
__device__ __forceinline__ void gemm_phase_i(PG8_LAS unsigned char* lds, const Gemm g, const Sched& S, const Epi& E, const int wv, unsigned long long* stamp = nullptr) {
    int wvo_ = wv; asm volatile("" : "+s"(wvo_));
    const int lane = lane_id_opaque(), wid = wvo_, tid = wid * 64 + lane, wr = wid >> 2, wc = wid & 3, fr = lane & 15, fq = lane >> 4;
    const int K = g.K, nt = K / BK;
    unsigned voffA[2], voffB[2];
#pragma unroll
    for (int i = 0; i < 2; ++i) { int R, C; stage_rc(tid * 16 + i * 8192, R, C); const int Rb = Epi::PERM ? ((R & ~31) + perm32(R & 31)) : R;
        voffA[i] = (unsigned)(R * K + C) * 2u; voffB[i] = (unsigned)(Rb * K + C) * 2u; }
    const size_t kstep = (size_t)(BK * 2), hstep = (size_t)HALF * K * 2, tstep = 2 * hstep;
    const unsigned ldsw = (unsigned)wid * 1024u;
    const int aoff = lds_byte(wr * 64 + fr, fq * 8), boff = lds_byte(wc * 32 + fr, fq * 8);
#define PG8_SA(b, h) (((b) * 2 + (h)) * HTB)
#define PG8_SB(b, h) ((4 + (b) * 2 + (h)) * HTB)
#define PG8_STAGE(bufoff, gbase, voff) do { _Pragma("unroll") for (int _i = 0; _i < 2; ++_i) \
        __builtin_amdgcn_global_load_lds((const unsigned*)((const char*)(gbase) + (voff)[_i]), (PG8_LAS unsigned*)(lds + (bufoff) + ldsw + _i * 8192), 16, 0, 0); } while (0)
#define PG8_LDA(dst, b, h) do { _Pragma("unroll") for (int m = 0; m < 4; ++m) _Pragma("unroll") for (int k = 0; k < 2; ++k) dst[m][k] = *(const PG8_LAS bf16x8*)(lds + PG8_SA(b, h) + aoff + m * 2048 + k * 1024); } while (0)
#define PG8_LDB(dst, b, h) do { _Pragma("unroll") for (int n = 0; n < 2; ++n) _Pragma("unroll") for (int k = 0; k < 2; ++k) dst[n][k] = *(const PG8_LAS bf16x8*)(lds + PG8_SB(b, h) + boff + n * 2048 + k * 1024); } while (0)
#define PG8_MMA(ai, bj, At, Bt) do { __builtin_amdgcn_s_setprio(1); _Pragma("unroll") for (int m = 0; m < 4; ++m) _Pragma("unroll") for (int n = 0; n < 2; ++n) _Pragma("unroll") for (int k = 0; k < 2; ++k) \
        acc[ai][bj][m][n] = __builtin_amdgcn_mfma_f32_16x16x32_bf16(Bt[n][k], At[m][k], acc[ai][bj][m][n], 0, 0, 0); __builtin_amdgcn_s_setprio(0); } while (0)
#define PG8_MMA2B(ai, At, B0, B1) do { __builtin_amdgcn_s_setprio(1); \
        _Pragma("unroll") for (int m = 0; m < 4; ++m) _Pragma("unroll") for (int n = 0; n < 2; ++n) _Pragma("unroll") for (int k = 0; k < 2; ++k) acc[ai][0][m][n] = __builtin_amdgcn_mfma_f32_16x16x32_bf16(B0[n][k], At[m][k], acc[ai][0][m][n], 0, 0, 0); \
        _Pragma("unroll") for (int m = 0; m < 4 - PG8_EARLY; ++m) _Pragma("unroll") for (int n = 0; n < 2; ++n) _Pragma("unroll") for (int k = 0; k < 2; ++k) acc[ai][1][m][n] = __builtin_amdgcn_mfma_f32_16x16x32_bf16(B1[n][k], At[m][k], acc[ai][1][m][n], 0, 0, 0); \
        __builtin_amdgcn_sched_barrier(0); __builtin_amdgcn_s_barrier(); __builtin_amdgcn_sched_barrier(0); \
        _Pragma("unroll") for (int m = 4 - PG8_EARLY; m < 4; ++m) _Pragma("unroll") for (int n = 0; n < 2; ++n) _Pragma("unroll") for (int k = 0; k < 2; ++k) acc[ai][1][m][n] = __builtin_amdgcn_mfma_f32_16x16x32_bf16(B1[n][k], At[m][k], acc[ai][1][m][n], 0, 0, 0); \
        __builtin_amdgcn_s_setprio(0); } while (0)
#define PG8_WAIT_V(n) asm volatile("s_waitcnt vmcnt(" #n ")" ::: "memory")
#define PG8_WAIT_L(n) asm volatile("s_waitcnt lgkmcnt(" #n ")" ::: "memory")
#define PG8_BAR __builtin_amdgcn_s_barrier()
#define PG8_SCHED __builtin_amdgcn_sched_barrier(0)
#define PG8_ZERO(ai) do { _Pragma("unroll") for (int b_ = 0; b_ < 2; ++b_) _Pragma("unroll") for (int m_ = 0; m_ < 4; ++m_) _Pragma("unroll") for (int n_ = 0; n_ < 2; ++n_) acc[ai][b_][m_][n_] = (f32x4){0.f, 0.f, 0.f, 0.f}; } while (0)
#define PG8_TRIP(EA, EB, W1, W2, W3, W4) do { \
        PG8_LDB(B0, 0, 0); PG8_LDB(B1, 0, 1); PG8_SCHED; PG8_LDA(At, 0, 0); PG8_STAGE(PG8_SA(1, 1), a1 + hstep, voffA); PG8_SCHED; EA; PG8_SCHED; \
        PG8_WAIT_V(W1); PG8_WAIT_L(0); PG8_BAR; PG8_MMA2B(0, At, B0, B1); PG8_SCHED; \
        PG8_LDA(At, 0, 1); PG8_STAGE(PG8_SB(0, 0), b2, voffB); PG8_STAGE(PG8_SB(0, 1), b2 + hstep, voffB); PG8_STAGE(PG8_SA(0, 0), a2, voffA); PG8_SCHED; EB; PG8_SCHED; \
        PG8_WAIT_V(W2); PG8_WAIT_L(0); PG8_BAR; PG8_MMA2B(1, At, B0, B1); PG8_SCHED; \
        PG8_LDB(B0, 1, 0); PG8_LDB(B1, 1, 1); PG8_SCHED; PG8_LDA(At, 1, 0); PG8_STAGE(PG8_SA(0, 1), a2 + hstep, voffA); \
        PG8_WAIT_V(W3); PG8_WAIT_L(0); PG8_BAR; PG8_MMA2B(0, At, B0, B1); PG8_SCHED; \
        PG8_LDA(At, 1, 1); PG8_STAGE(PG8_SB(1, 0), b3, voffB); PG8_STAGE(PG8_SB(1, 1), b3 + hstep, voffB); PG8_STAGE(PG8_SA(1, 0), a3, voffA); \
        PG8_WAIT_V(W4); PG8_WAIT_L(0); PG8_BAR; PG8_MMA2B(1, At, B0, B1); PG8_SCHED; } while (0)
    Unit cur, nxt, prv; int ui = 0;
    if (!S.next(0, cur)) return;
    prv = cur;
    f32x4 acc[2][2][4][2];
    PG8_ZERO(0); PG8_ZERO(1);
    bf16x8 At[4][2], B0[2][2], B1[2][2];
    const char* cA = (const char*)g.A + (size_t)cur.pm * tstep; const char* cB = (const char*)g.Bt + (size_t)cur.pn * tstep;
    S.a_ready(cur);
    PG8_STAGE(PG8_SB(0, 0), cB, voffB); PG8_STAGE(PG8_SB(0, 1), cB + hstep, voffB); PG8_STAGE(PG8_SA(0, 0), cA, voffA); PG8_STAGE(PG8_SA(0, 1), cA + hstep, voffA);
    if (wr == 1) PG8_BAR;
    PG8_WAIT_V(2); PG8_BAR;
    PG8_STAGE(PG8_SB(1, 0), cB + kstep, voffB); PG8_STAGE(PG8_SA(1, 0), cA + kstep, voffA); PG8_STAGE(PG8_SB(1, 1), cB + hstep + kstep, voffB);
    PG8_WAIT_V(6); PG8_BAR;
    unsigned long long st_tk = 0, st_ck = 0, st_te = 0;
    for (;;) {
        const bool has_next = S.next(ui + 1, nxt);
        unsigned long long st_r0 = 0, st_c0 = 0; if (stamp) { st_r0 = __builtin_amdgcn_s_memrealtime(); st_c0 = __builtin_readcyclecounter(); }
        const char* nA = has_next ? (const char*)g.A + (size_t)nxt.pm * tstep : cA; const char* nB = has_next ? (const char*)g.Bt + (size_t)nxt.pn * tstep : cB;
        {
            const char* a1 = cA + kstep; const char* a2 = cA + 2 * kstep; const char* b2 = cB + 2 * kstep; const char* a3 = a2 + kstep; const char* b3 = b2 + kstep;
            unsigned long long st_f0 = 0; if (stamp) st_f0 = __builtin_amdgcn_s_memrealtime();
            const bool epi = ui > 0;
            PG8_STAGE(PG8_SA(1, 1), a1 + hstep, voffA); PG8_SCHED;
            if (epi) { E.half(acc, prv, 0, wr, wc, fr, fq, lds); PG8_ZERO(0); } PG8_SCHED;
            PG8_LDB(B0, 0, 0); PG8_LDB(B1, 0, 1); PG8_SCHED; PG8_LDA(At, 0, 0);
            if (epi) { PG8_WAIT_V(16); } else { PG8_WAIT_V(8); }
            PG8_WAIT_L(0); PG8_BAR; PG8_MMA2B(0, At, B0, B1); PG8_SCHED;
            PG8_STAGE(PG8_SB(0, 0), b2, voffB); PG8_STAGE(PG8_SB(0, 1), b2 + hstep, voffB); PG8_STAGE(PG8_SA(0, 0), a2, voffA); PG8_SCHED;
            if (epi) { E.half(acc, prv, 1, wr, wc, fr, fq, lds); PG8_ZERO(1); } PG8_SCHED;
            PG8_LDA(At, 0, 1);
            if (epi) { PG8_WAIT_V(24); } else { PG8_WAIT_V(8); }
            PG8_WAIT_L(0); PG8_BAR; PG8_MMA2B(1, At, B0, B1); PG8_SCHED;
            PG8_LDB(B0, 1, 0); PG8_LDB(B1, 1, 1); PG8_SCHED; PG8_LDA(At, 1, 0); PG8_STAGE(PG8_SA(0, 1), a2 + hstep, voffA);
            if (epi) { PG8_WAIT_V(24); } else { PG8_WAIT_V(8); }
            PG8_WAIT_L(0); PG8_BAR; PG8_MMA2B(0, At, B0, B1); PG8_SCHED;
            PG8_LDA(At, 1, 1); PG8_STAGE(PG8_SB(1, 0), b3, voffB); PG8_STAGE(PG8_SB(1, 1), b3 + hstep, voffB); PG8_STAGE(PG8_SA(1, 0), a3, voffA);
            if (epi) { PG8_WAIT_V(16); } else { PG8_WAIT_V(8); }
            PG8_WAIT_L(0); PG8_BAR; PG8_MMA2B(1, At, B0, B1); PG8_SCHED;
            if (stamp && epi) st_te += __builtin_amdgcn_s_memrealtime() - st_f0;
        }
        for (int t = 2; t < nt; t += 2) {
            const bool last = (t == nt - 2);
            const char* a1 = cA + (size_t)(t + 1) * kstep;
            const char* a2 = last ? nA : cA + (size_t)(t + 2) * kstep; const char* b2 = last ? nB : cB + (size_t)(t + 2) * kstep;
            const char* a3 = a2 + kstep; const char* b3 = b2 + kstep;
            if (last && has_next) S.a_ready(nxt);
            if (last) E.prefetch(cur, lds, wid, lane);
            PG8_TRIP((void)0, (void)0, 8, 8, 8, 8);
        }
        if (stamp) { const unsigned long long st_r1 = __builtin_amdgcn_s_memrealtime(); st_tk += st_r1 - st_r0; st_ck += __builtin_readcyclecounter() - st_c0; }
        if (!has_next) break;
        prv = cur; cur = nxt; cA = nA; cB = nB; ++ui;
    }
    { unsigned long long st_r1 = 0; if (stamp) st_r1 = __builtin_amdgcn_s_memrealtime();
      E.half(acc, cur, 0, wr, wc, fr, fq, lds); E.half(acc, cur, 1, wr, wc, fr, fq, lds); S.done(cur);
      (void)st_r1; }
    PG8_WAIT_V(0);
    if (wr == 0) PG8_BAR;
    PG8_BAR;
    if (stamp && wid == 0 && lane == 0) { if (blockIdx.x == 0) { atomicAdd(stamp, st_tk); atomicAdd(stamp + 1, st_ck); atomicAdd(stamp + 2, st_te); } atomicAdd(stamp + 8 + blockIdx.x, st_tk); }
#undef PG8_TRIP
#undef PG8_ZERO
#undef PG8_SA
#undef PG8_SB
#undef PG8_STAGE
#undef PG8_LDA
#undef PG8_LDB
#undef PG8_MMA
#undef PG8_MMA2B
#undef PG8_WAIT_V
#undef PG8_WAIT_L
#undef PG8_BAR
#undef PG8_SCHED
}
}

#define GAS __attribute__((address_space(1)))
#define LAS __attribute__((address_space(3)))
typedef unsigned short bf16_t;
typedef short bf16x8 __attribute__((ext_vector_type(8)));
typedef short s16x4 __attribute__((ext_vector_type(4)));
typedef float f32x4 __attribute__((ext_vector_type(4)));
typedef float f32x16 __attribute__((ext_vector_type(16)));
typedef unsigned u32x4 __attribute__((ext_vector_type(4)));
typedef unsigned u32x2 __attribute__((ext_vector_type(2)));
#define SBAR() __builtin_amdgcn_sched_barrier(0)
__device__ __forceinline__ unsigned cvtpk(float lo, float hi) { unsigned r; asm volatile("v_cvt_pk_bf16_f32 %0, %1, %2" : "=v"(r) : "v"(lo), "v"(hi)); return r; }
__device__ __forceinline__ float bf2f(unsigned short b) { return __uint_as_float(((unsigned)b) << 16); }
__device__ __forceinline__ float bflo(unsigned w) { return __uint_as_float(w << 16); }
__device__ __forceinline__ float bfhi(unsigned w) { return __uint_as_float(w & 0xffff0000u); }
__device__ __forceinline__ unsigned short f2bf(float f) { return (unsigned short)(cvtpk(f, 0.f) & 0xffffu); }

namespace att {
constexpr int D = 128, NW = 8, QBLK = 32, KVBLK = 64, LD = 1024;
constexpr float SCALE = 0.088388347648318440f, THR = 8.f;
constexpr int SHM_V = KVBLK * D * 2, SHM_K = KVBLK * D * 2;
constexpr int OFF_V = 0, OFF_K = 2 * SHM_V, OFF_Q = 2 * SHM_V + 2 * SHM_K  , OFF_WS = 134144  , OFF_BIAS = OFF_WS + NW * 64 * 4, OFF_GK = OFF_BIAS + 16 * 32 * 4  , LDS_BYTES = OFF_GK + 128 * 4;
#define KSWZ(row, colB) ((row) * 256 + ((colB) ^ (((row) & 7) << 4)))
__device__ __forceinline__ int crow(int r, int hi) { return (r & 3) + 8 * (r >> 2) + 4 * hi; }

__device__ __forceinline__ void partialSM(f32x16& p0, f32x16& p1, float& m_reg, float& mn, float& alpha) {
  constexpr float C = SCALE * 1.4426950408889634f;
  float pmax = p0[0];
#pragma unroll
  for (int r = 1; r < 16; ++r) pmax = fmaxf(pmax, p0[r]);
#pragma unroll
  for (int r = 0; r < 16; ++r) pmax = fmaxf(pmax, p1[r]);
  { auto rr = __builtin_amdgcn_permlane32_swap(__float_as_uint(pmax), __float_as_uint(pmax), false, false);
    pmax = fmaxf(__uint_as_float(rr[0]), __uint_as_float(rr[1])); }
  if (__builtin_expect(__all(pmax - m_reg <= THR / SCALE), 1)) { mn = m_reg; alpha = 1.f; }
  else { mn = fmaxf(m_reg, pmax); alpha = __builtin_amdgcn_exp2f((m_reg - mn) * C); m_reg = mn; }
  float mnC = -mn * C;
#pragma unroll
  for (int r = 0; r < 16; ++r) p0[r] = fmaf(p0[r], C, mnC);
#pragma unroll
  for (int r = 0; r < 16; ++r) p1[r] = fmaf(p1[r], C, mnC);
#pragma unroll
  for (int r = 0; r < 16; ++r) p0[r] = __builtin_amdgcn_exp2f(p0[r]);
}
__device__ __forceinline__ void finishSM(f32x16& p0, f32x16& p1, float alpha, float& l_reg, bf16x8& pa0, bf16x8& pa1, bf16x8& pa2, bf16x8& pa3) {
#pragma unroll
  for (int r = 0; r < 16; ++r) p1[r] = __builtin_amdgcn_exp2f(p1[r]);
  float ps = 0;
#pragma unroll
  for (int r = 0; r < 16; ++r) ps += p0[r];
#pragma unroll
  for (int r = 0; r < 16; ++r) ps += p1[r];
  { auto rr = __builtin_amdgcn_permlane32_swap(__float_as_uint(ps), __float_as_uint(ps), false, false);
    ps = __uint_as_float(rr[0]) + __uint_as_float(rr[1]); }
  l_reg = l_reg * alpha + ps;
#define PK4(P, BASE, OUT) do { unsigned a0 = cvtpk(P[BASE + 0], P[BASE + 1]), a1 = cvtpk(P[BASE + 2], P[BASE + 3]);   \
    unsigned b0 = cvtpk(P[BASE + 4], P[BASE + 5]), b1 = cvtpk(P[BASE + 6], P[BASE + 7]);                              \
    auto r0 = __builtin_amdgcn_permlane32_swap(a0, b0, false, false); auto r1 = __builtin_amdgcn_permlane32_swap(a1, b1, false, false); \
    u32x4 w = {r0[0], r1[0], r0[1], r1[1]}; OUT = *reinterpret_cast<bf16x8*>(&w); } while (0)
  PK4(p0, 0, pa0); PK4(p0, 8, pa1); PK4(p1, 0, pa2); PK4(p1, 8, pa3);
#undef PK4
}
__device__ __forceinline__ void qkt(f32x16& p0, f32x16& p1, const LAS char* Ks, const LAS char* Qs, int r32, int hi) {
  p0 = f32x16{}; p1 = f32x16{};
#pragma unroll
  for (int d0 = 0; d0 < 8; ++d0) { const int cb = (d0 * 16 + hi * 8) * 2;
    const bf16x8 b0 = *(const LAS bf16x8*)(Ks + KSWZ(r32, cb));
    const bf16x8 b1 = *(const LAS bf16x8*)(Ks + KSWZ(32 + r32, cb));
    const bf16x8 q = *(const LAS bf16x8*)(Qs + KSWZ(r32, cb));
    p0 = __builtin_amdgcn_mfma_f32_32x32x16_bf16(b0, q, p0, 0, 0, 0);
    p1 = __builtin_amdgcn_mfma_f32_32x32x16_bf16(b1, q, p1, 0, 0, 0); }
}
__device__ __forceinline__ int v_st(int k, int c) { const int kk = (k & ~0xC) | ((k & 4) << 1) | ((k & 8) >> 1); return ((kk >> 3) * 4 + (c >> 5)) * 512 + ((kk & 7) * 32 + (c & 31)) * 2; }
__device__ __forceinline__ int v_rd_base(int lane) { return ((lane & 3) << 3) | (((lane >> 2) & 3) << 6) | (((lane >> 4) & 1) << 5) | (((lane >> 5) & 1) << 8); }
constexpr int v_rd_off(int d0, int ks, int half) { return d0 * 512 + ks * 4096 + half * 2048; }
template <int OFF> __device__ __forceinline__ s16x4 tr_read(int vb) {
  s16x4 r; asm volatile("ds_read_b64_tr_b16 %0, %1 offset:%2" : "=&v"(r) : "v"(vb), "i"(OFF) : "memory"); return r;
}
template <int D0> __device__ __forceinline__ void pv_one(f32x16& od, int vb, bf16x8 pa0, bf16x8 pa1, bf16x8 pa2, bf16x8 pa3) {
  const s16x4 l0 = tr_read<v_rd_off(D0, 0, 0)>(vb), h0 = tr_read<v_rd_off(D0, 0, 1)>(vb), l1 = tr_read<v_rd_off(D0, 1, 0)>(vb), h1 = tr_read<v_rd_off(D0, 1, 1)>(vb);
  const s16x4 l2 = tr_read<v_rd_off(D0, 2, 0)>(vb), h2 = tr_read<v_rd_off(D0, 2, 1)>(vb), l3 = tr_read<v_rd_off(D0, 3, 0)>(vb), h3 = tr_read<v_rd_off(D0, 3, 1)>(vb);
  asm volatile("s_waitcnt lgkmcnt(0)" ::: "memory"); SBAR();
#define PK(L, H) (bf16x8){L[0], L[1], L[2], L[3], H[0], H[1], H[2], H[3]}
  od = __builtin_amdgcn_mfma_f32_32x32x16_bf16(pa0, PK(l0, h0), od, 0, 0, 0);
  od = __builtin_amdgcn_mfma_f32_32x32x16_bf16(pa1, PK(l1, h1), od, 0, 0, 0);
  od = __builtin_amdgcn_mfma_f32_32x32x16_bf16(pa2, PK(l2, h2), od, 0, 0, 0);
  od = __builtin_amdgcn_mfma_f32_32x32x16_bf16(pa3, PK(l3, h3), od, 0, 0, 0);
#undef PK
}
__device__ __forceinline__ void pv_d0(f32x16* o, int vb, bf16x8 pa0, bf16x8 pa1, bf16x8 pa2, bf16x8 pa3) {
  pv_one<0>(o[0], vb, pa0, pa1, pa2, pa3); pv_one<1>(o[1], vb, pa0, pa1, pa2, pa3); pv_one<2>(o[2], vb, pa0, pa1, pa2, pa3); pv_one<3>(o[3], vb, pa0, pa1, pa2, pa3);
}

__device__ __forceinline__ void na_mask(f32x16& p0, f32x16& p1, int kr, int qrow, int qc, unsigned cmask, int hi, const LAS float* biasL) {
  int r0 = qrow - 4; r0 = r0 < 0 ? 0 : (r0 > 56 ? 56 : r0);
  const bool rowok = (kr >= r0) && (kr < r0 + 8);
  const unsigned em = rowok ? cmask : 0u;
  const int dr = rowok ? (kr - qrow + 7) : 0;
  const LAS float* brow = biasL + dr * 32 + (15 - qc + 4 * hi);
#pragma unroll
  for (int i4 = 0; i4 < 4; ++i4) {
#pragma unroll
    for (int ii = 0; ii < 4; ++ii) { const int i = i4 * 4 + ii, kc = (i & 3) + 8 * (i >> 2);
      const bool ok0 = (em >> i) & 1u, ok1 = (em >> (16 + i)) & 1u;
      const float b0 = brow[kc], b1 = brow[kc + 32];
      p0[i] = ok0 ? p0[i] + b0 : -1e30f; p1[i] = ok1 ? p1[i] + b1 : -1e30f; }
    asm volatile("" ::: "memory"); }
}

template <bool NA, int SDEPTH>
__device__ __forceinline__ void attn_unit(LAS char* lds, const bf16_t* __restrict__ Qb, const bf16_t* __restrict__ K0, const bf16_t* __restrict__ V0, int nt0,
                                          const bf16_t* __restrict__ K1, const bf16_t* __restrict__ V1, int NT, bf16_t* __restrict__ Ob, int ldo, int R, int kr0, const int wv,
                                          const float* __restrict__ gq, float* __restrict__ ck_out, float* __restrict__ cv_out, const bool knorm0) {
  const int lane = lane_id_opaque(), wid = wv, tid = wv * 64 + lane, r32 = lane & 31, hi = lane >> 5;
  LAS char* V_lds = lds + OFF_V; LAS char* K_lds = lds + OFF_K;
  LAS float* ws = (LAS float*)(lds + OFF_WS) + wid * 64; LAS float* li_l = ws; LAS float* al_l = ws + 32;
  const LAS float* biasL = (const LAS float*)(lds + OFF_BIAS); const LAS f32x4* gkL = (const LAS f32x4*)(lds + OFF_GK);
  float m_reg = -1e30f, l_reg = 0; f32x16 o[4] = {};
  LAS char* Q_lds = lds + OFF_Q + wid * 8192;
  { const bf16_t* Qw = Qb + (long)(wid * QBLK + r32) * LD + hi * 8; u32x4 qt[8]; float ss = 0.f;
#pragma unroll
    for (int d0 = 0; d0 < 8; ++d0) { qt[d0] = *(const u32x4*)(Qw + d0 * 16);
#pragma unroll
      for (int i = 0; i < 4; ++i) { const float a = bflo(qt[d0][i]), b = bfhi(qt[d0][i]); ss += a * a + b * b; } }
    { auto rr = __builtin_amdgcn_permlane32_swap(__float_as_uint(ss), __float_as_uint(ss), false, false); ss = __uint_as_float(rr[0]) + __uint_as_float(rr[1]); }
    const float rq = __builtin_amdgcn_rsqf(ss * (1.0f / 128.0f) + 1e-6f);
#pragma unroll
    for (int d0 = 0; d0 < 8; ++d0) { const int d = d0 * 16 + hi * 8;
      const f32x4 g0 = *(const f32x4*)(gq + d), g1 = *(const f32x4*)(gq + d + 4);
      u32x4 w; w.x = cvtpk(bflo(qt[d0].x) * rq * g0[0], bfhi(qt[d0].x) * rq * g0[1]); w.y = cvtpk(bflo(qt[d0].y) * rq * g0[2], bfhi(qt[d0].y) * rq * g0[3]);
      w.z = cvtpk(bflo(qt[d0].z) * rq * g1[0], bfhi(qt[d0].z) * rq * g1[1]); w.w = cvtpk(bflo(qt[d0].w) * rq * g1[2], bfhi(qt[d0].w) * rq * g1[3]);
      *(LAS u32x4*)(Q_lds + KSWZ(r32, d * 2)) = w; } }
  const int sr = tid >> 4, sc = (tid & 15) * 8, vst0 = v_st(sr, sc);
  const int vb0 = (int)(uintptr_t)V_lds + v_rd_base(lane);
  const int qrow = R + (wid >> 1), qc = 32 * (wid & 1) + r32;
  unsigned cmask = 0;
  if (NA) { int c0 = qc - 8; c0 = c0 < 0 ? 0 : (c0 > 48 ? 48 : c0);
#pragma unroll
    for (int i = 0; i < 16; ++i) { const int kc = crow(i, hi); if ((unsigned)(kc - c0) < 16u) cmask |= 1u << i; if ((unsigned)(kc + 32 - c0) < 16u) cmask |= 1u << (16 + i); } }
  struct { bf16x8 vs0, vs1, ks0, ks1; } sr_[SDEPTH];
#define TILE_K(t) (((t) < nt0 ? K0 + (long)(t) * (KVBLK * LD) : K1 + (long)((t) - nt0) * (KVBLK * LD)))
#define TILE_V(t) (((t) < nt0 ? V0 + (long)(t) * (KVBLK * LD) : V1 + (long)((t) - nt0) * (KVBLK * LD)))
#define SLOAD(i, t) do { const bf16_t* kp_ = TILE_K(t); const bf16_t* vp_ = TILE_V(t); \
    sr_[i].vs0 = *(const bf16x8*)(vp_ + (long)sr * LD + sc); sr_[i].vs1 = *(const bf16x8*)(vp_ + (long)(32 + sr) * LD + sc); \
    sr_[i].ks0 = *(const bf16x8*)(kp_ + (long)sr * LD + sc); sr_[i].ks1 = *(const bf16x8*)(kp_ + (long)(32 + sr) * LD + sc); } while (0)
#define KROW(KS, ROW, t, OUT) do { u32x4 kw_ = *(u32x4*)&(KS); float x_[8]; \
    _Pragma("unroll") for (int i_ = 0; i_ < 4; ++i_) { x_[2 * i_] = bflo(kw_[i_]); x_[2 * i_ + 1] = bfhi(kw_[i_]); } \
    if (knorm0 || (t) >= nt0) { float s_ = 0.f; _Pragma("unroll") for (int i_ = 0; i_ < 8; ++i_) s_ += x_[i_] * x_[i_]; \
      s_ += __uint_as_float((unsigned)__builtin_amdgcn_update_dpp(0, (int)__float_as_uint(s_), 0x128, 0xf, 0xf, false)); s_ += __uint_as_float((unsigned)__builtin_amdgcn_update_dpp(0, (int)__float_as_uint(s_), 0x124, 0xf, 0xf, false)); \
      s_ += __uint_as_float((unsigned)__builtin_amdgcn_update_dpp(0, (int)__float_as_uint(s_), 0x122, 0xf, 0xf, false)); s_ += __uint_as_float((unsigned)__builtin_amdgcn_update_dpp(0, (int)__float_as_uint(s_), 0x121, 0xf, 0xf, false)); \
      const float rk_ = __builtin_amdgcn_rsqf(s_ * (1.0f / 128.0f) + 1e-6f); const f32x4 ga_ = gkL[sc >> 2], gb_ = gkL[(sc >> 2) + 1]; \
      x_[0] *= rk_ * ga_[0]; x_[1] *= rk_ * ga_[1]; x_[2] *= rk_ * ga_[2]; x_[3] *= rk_ * ga_[3]; x_[4] *= rk_ * gb_[0]; x_[5] *= rk_ * gb_[1]; x_[6] *= rk_ * gb_[2]; x_[7] *= rk_ * gb_[3]; \
      kw_.x = cvtpk(x_[0], x_[1]); kw_.y = cvtpk(x_[2], x_[3]); kw_.z = cvtpk(x_[4], x_[5]); kw_.w = cvtpk(x_[6], x_[7]); } \
    if (ck_out) { float* o_ = ck_out + (long)((t) * KVBLK + (ROW)) * LD + sc; \
      __builtin_nontemporal_store((f32x4){x_[0], x_[1], x_[2], x_[3]}, (f32x4*)o_); __builtin_nontemporal_store((f32x4){x_[4], x_[5], x_[6], x_[7]}, (f32x4*)(o_ + 4)); } \
    OUT = *(bf16x8*)&kw_; } while (0)
#define VROW(VS, ROW, t) do { if (cv_out) { const u32x4 vw_ = *(const u32x4*)&(VS); float* o_ = cv_out + (long)((t) * KVBLK + (ROW)) * LD + sc; \
      __builtin_nontemporal_store((f32x4){bflo(vw_.x), bfhi(vw_.x), bflo(vw_.y), bfhi(vw_.y)}, (f32x4*)o_); __builtin_nontemporal_store((f32x4){bflo(vw_.z), bfhi(vw_.z), bflo(vw_.w), bfhi(vw_.w)}, (f32x4*)(o_ + 4)); } } while (0)
#define SWRITE(b, i, t) do { *(LAS bf16x8*)(V_lds + (b) * SHM_V + vst0) = sr_[i].vs0;          \
    *(LAS bf16x8*)(V_lds + (b) * SHM_V + vst0 + 8192) = sr_[i].vs1; const int kc_ = sc * 2; VROW(sr_[i].vs0, sr, t); VROW(sr_[i].vs1, 32 + sr, t); \
    bf16x8 k0_, k1_; KROW(sr_[i].ks0, sr, t, k0_); KROW(sr_[i].ks1, 32 + sr, t, k1_); \
    *(LAS bf16x8*)(K_lds + (b) * SHM_K + KSWZ(sr, kc_)) = k0_;                       \
    *(LAS bf16x8*)(K_lds + (b) * SHM_K + KSWZ(sr, kc_) + 8192) = k1_; } while (0)
#define SWAIT() do { if constexpr (SDEPTH == 2) asm volatile("s_waitcnt vmcnt(4)" ::: "memory"); else asm volatile("s_waitcnt vmcnt(0)" ::: "memory"); } while (0)
#define RESC(a) do { if (__any((a) < 1.f)) { if (hi == 0) al_l[r32] = (a); asm volatile("s_waitcnt lgkmcnt(0)" ::: "memory"); \
    _Pragma("unroll") for (int d = 0; d < 4; ++d) _Pragma("unroll") for (int r = 0; r < 16; ++r) o[d][r] *= al_l[crow(r, hi)]; } } while (0)
#define MASK(P0, P1, t) do { if (NA && (t) >= nt0) na_mask(P0, P1, kr0 + (t) - nt0, qrow, qc, cmask, hi, biasL); } while (0)
  f32x16 pA0, pA1, pB0, pB1; float mnA, mnB, alA, alB; bf16x8 pa0, pa1, pa2, pa3;
  int wr0 = qrow - 4; wr0 = wr0 < 0 ? 0 : (wr0 > 56 ? 56 : wr0);
#define TV(t) (!NA || (t) < nt0 || (unsigned)(kr0 + (t) - nt0 - wr0) < 8u)
#define SCORE(P0, P1, KB, t, V) do { if (V) qkt(P0, P1, KB, Q_lds, r32, hi); } while (0)
#define PSM(P0, P1, t, V, MN, AL) do { if (V) { MASK(P0, P1, t); partialSM(P0, P1, m_reg, MN, AL); } else { AL = 1.f; } } while (0)
#define FSM(P0, P1, AL, V) do { if (V) finishSM(P0, P1, AL, l_reg, pa0, pa1, pa2, pa3); } while (0)
#define PVT(VB, V) do { if (V) pv_d0(o, VB, pa0, pa1, pa2, pa3); } while (0)
  constexpr int SE = 0, SO = SDEPTH - 1;
  bool vA = true, vB = true;
  SLOAD(SE, 0); asm volatile("s_waitcnt vmcnt(0)" ::: "memory"); SWRITE(0, SE, 0); __syncthreads();
  vA = TV(0); SCORE(pA0, pA1, K_lds, 0, vA); PSM(pA0, pA1, 0, vA, mnA, alA);
  SLOAD(SO, 1); if constexpr (SDEPTH == 2) { if (2 < NT) SLOAD(SE, 2); }
  SWAIT(); SWRITE(1, SO, 1); __syncthreads();
  for (int j = 1; j + 1 < NT; j += 2) {
    vB = TV(j);
    SBAR(); SCORE(pB0, pB1, K_lds + SHM_K, j, vB);
    FSM(pA0, pA1, alA, vA); SBAR();
    SLOAD(SO, j + SDEPTH); SBAR();
    PVT(vb0, vA); PSM(pB0, pB1, j, vB, mnB, alB);
    __syncthreads(); SWAIT(); SWRITE(0, SE, j + 1);
    RESC(alB); __syncthreads();
    vA = TV(j + 1);
    SBAR(); SCORE(pA0, pA1, K_lds, j + 1, vA);
    FSM(pB0, pB1, alB, vB); SBAR();
    if (SDEPTH == 1 || j + 3 < NT) SLOAD(SE, j + 1 + SDEPTH); SBAR();
    PVT(vb0 + SHM_V, vB); PSM(pA0, pA1, j + 1, vA, mnA, alA);
    __syncthreads(); SWAIT(); SWRITE(1, SO, j + 2);
    RESC(alA); __syncthreads();
  }
  vB = TV(NT - 1);
  SBAR(); SCORE(pB0, pB1, K_lds + SHM_K, NT - 1, vB);
  FSM(pA0, pA1, alA, vA); SBAR();
  PVT(vb0, vA); PSM(pB0, pB1, NT - 1, vB, mnB, alB);
  __syncthreads(); RESC(alB);
  FSM(pB0, pB1, alB, vB); SBAR();
  PVT(vb0 + SHM_V, vB);
#undef TV
#undef SCORE
#undef PSM
#undef FSM
#undef PVT
  if (hi == 0) li_l[r32] = l_reg; asm volatile("s_waitcnt lgkmcnt(0)" ::: "memory");
  float rli[16];
#pragma unroll
  for (int r = 0; r < 16; ++r) rli[r] = __builtin_amdgcn_rcpf(li_l[crow(r, hi)]);
  bf16_t* Ow = Ob + (long)(wid * QBLK) * ldo;
#pragma unroll
  for (int r = 0; r < 16; ++r) { const int orow = crow(r, hi);
#pragma unroll
    for (int d0 = 0; d0 < 4; ++d0) Ow[(long)orow * ldo + d0 * 32 + r32] = f2bf(o[d0][r] * rli[r]); }
#undef SLOAD
#undef SWRITE
#undef KROW
#undef VROW
#undef SWAIT
#undef RESC
#undef MASK
#undef TILE_K
#undef TILE_V
}
}

constexpr int DM = 2048, NCTX = 8192, NLAT = 32768, MTOK = NCTX + NLAT;
constexpr int CTX_L = 256, LAT_L = 4096, NLAYER = 4, DFF = 8192;
constexpr int ABIN = 3584, ABOUT = 1536, S5W = 512;
constexpr float NORM_EPS = 1e-6f;
constexpr int S5T = 32;
constexpr int NCHUNK = MTOK / S5T;
__device__ __forceinline__ int ada_row_of_token(int m) { return m < NCTX ? 0 : 1 + ((m - NCTX) >> 12); }

namespace s5 {
constexpr int XROW = 272;
constexpr int XBYTES = S5T * XROW;
constexpr int GROW = 1040;
constexpr int OFF_X = 0, OFF_G = 8 * XBYTES, LDS_BYTES = OFF_G + S5T * GROW;

struct BFrag { bf16x8 r0, r1, i0, i1; };
__device__ __forceinline__ bf16x8 load_u(const bf16_t* __restrict__ U, int m0, int g, int dir, int lane) {
  const int r = lane & 31, h = lane >> 5, tok = dir ? 31 - r : r;
  return *(const bf16x8*)(U + (size_t)(m0 + tok) * S5W + g * 16 + h * 8);
}
__device__ __forceinline__ BFrag load_bb(const bf16_t* __restrict__ BB, int lane) {
  const int r = lane & 31, h = lane >> 5; BFrag f;
  f.r0 = *(const bf16x8*)(BB + (0 * 64 + r) * 16 + h * 8); f.r1 = *(const bf16x8*)(BB + (0 * 64 + 32 + r) * 16 + h * 8);
  f.i0 = *(const bf16x8*)(BB + (1 * 64 + r) * 16 + h * 8); f.i1 = *(const bf16x8*)(BB + (1 * 64 + 32 + r) * 16 + h * 8);
  return f;
}
__device__ __forceinline__ void bu_compute(const bf16x8 ua, const BFrag& f, float (&bre)[32], float (&bim)[32]) {
  const f32x16 z = {};
  { const f32x16 dr0 = __builtin_amdgcn_mfma_f32_32x32x16_bf16(ua, f.r0, z, 0, 0, 0), dr1 = __builtin_amdgcn_mfma_f32_32x32x16_bf16(ua, f.r1, z, 0, 0, 0);
#pragma unroll
    for (int i = 0; i < 16; ++i) { const int c0 = (i & 3) + 8 * (i >> 2);
      auto a = __builtin_amdgcn_permlane32_swap(__float_as_uint(dr0[i]), __float_as_uint(dr1[i]), false, false);
      bre[c0] = __uint_as_float(a[0]); bre[c0 + 4] = __uint_as_float(a[1]); } }
  asm volatile("" : "+v"(bre[0]), "+v"(bre[31]));
  { const f32x16 di0 = __builtin_amdgcn_mfma_f32_32x32x16_bf16(ua, f.i0, z, 0, 0, 0), di1 = __builtin_amdgcn_mfma_f32_32x32x16_bf16(ua, f.i1, z, 0, 0, 0);
#pragma unroll
    for (int i = 0; i < 16; ++i) { const int c0 = (i & 3) + 8 * (i >> 2);
      auto b = __builtin_amdgcn_permlane32_swap(__float_as_uint(di0[i]), __float_as_uint(di1[i]), false, false);
      bim[c0] = __uint_as_float(b[0]); bim[c0 + 4] = __uint_as_float(b[1]); } }
}

__device__ __forceinline__ void phase_a(int e, const bf16_t* U, const float4* S5A, const bf16_t* S5BB, float* Ef, float* Ec, int G, int vcu, const int wv) {
  const int lane = lane_id_opaque(), wid = wv; (void)wid;
  for (int task = vcu; task < (MTOK / 128) * 4; task += G) {
    const int cc = task >> 2, g = (task & 3) * 8 + wid;
#pragma unroll 1
    for (int dir = 0; dir < 2; ++dir) {
      const int tb = ((e * 2 + dir) * 32 + g);
      const float4 a4 = S5A[tb * 64 + lane];
      float cr = 0.f, ci = 0.f;
      const BFrag bf = load_bb(S5BB + (size_t)tb * 2048, lane);
      bf16x8 ua = load_u(U, (cc * 4 + (dir ? 3 : 0)) * S5T, g, dir, lane);
#pragma unroll 1
      for (int k = 0; k < 4; ++k) { const int f = dir ? 3 - k : k; const int ci_f = cc * 4 + f;
        const int fn = dir ? 2 - k : k + 1;
        const bf16x8 un = load_u(U, (cc * 4 + (k < 3 ? fn : f)) * S5T, g, dir, lane);
        float bre[32], bim[32];
        bu_compute(ua, bf, bre, bim);
        float xr = 0.f, xi = 0.f;
#pragma unroll
        for (int i = 0; i < 32; ++i) { const float nr = fmaf(a4.x, xr, fmaf(-a4.y, xi, bre[i])), ni = fmaf(a4.x, xi, fmaf(a4.y, xr, bim[i])); xr = nr; xi = ni; }
        float* ep = Ef + (((size_t)ci_f * 32 + g) * 2 + dir) * 128;
        ep[lane] = xr; ep[64 + lane] = xi;
        const float nr = fmaf(a4.z, cr, fmaf(-a4.w, ci, xr)), ni = fmaf(a4.z, ci, fmaf(a4.w, cr, xi)); cr = nr; ci = ni;
        ua = un;
      }
      float* ecp = Ec + (((size_t)cc * 32 + g) * 2 + dir) * 128;
      ecp[lane] = cr; ecp[64 + lane] = ci;
    }
  }
}

struct SOps { float4 a4; float2 a128; bf16x8 ua; BFrag bf; float sr, si; float fer[3], fei[3]; float er[16], ei[16]; };
struct SGeo { int m0, ci, c, nC, b; bool isctx; };
__device__ __forceinline__ void s5b_load(SOps& o, const SGeo& t, int e, int g, int dir, int lane, const bf16_t* U, const float4* S5A, const float2* S5A128, const bf16_t* S5BB,
                                         const float* Ef, const float* Ec, const float* h0re, const float* h0im) {
  const int tb = ((e * 2 + dir) * 32 + g);
  o.a4 = S5A[tb * 64 + lane]; o.a128 = S5A128[tb * 64 + lane];
  o.ua = load_u(U, t.m0, g, dir, lane); o.bf = load_bb(S5BB + (size_t)tb * 2048, lane);
  o.sr = 0.f; o.si = 0.f;
  if (!t.isctx) { const int hi_ = (((t.b * 2 + e) * 2 + dir) * 32 + g) * 64 + lane; o.sr = h0re[hi_]; o.si = h0im[hi_]; }
  const int C = t.c >> 2, f = t.c & 3, nCC = t.nC >> 2, cc0 = (t.ci - t.c) >> 2;
  const int n = dir ? (nCC - 1 - C) : C; const int cstart = dir ? (cc0 + nCC - 1) : cc0; const int estep = (dir ? -1 : 1) * 32 * 2 * 128;
  const int e0 = ((cstart * 32 + g) * 2 + dir) * 128 + lane;
  const int nf = dir ? (3 - f) : f; const int fstart = dir ? (t.ci - f + 3) : (t.ci - f);
  const int f0 = ((fstart * 32 + g) * 2 + dir) * 128 + lane;
#pragma unroll
  for (int q = 0; q < 3; ++q) { const int qq = q < nf ? q : 0; o.fer[q] = Ef[f0 + qq * estep]; o.fei[q] = Ef[f0 + qq * estep + 64]; }
#pragma unroll
  for (int j = 0; j < 16; ++j) { const int kk = j < n ? j : 0; o.er[j] = Ec[e0 + kk * estep]; o.ei[j] = Ec[e0 + kk * estep + 64]; }
}
__device__ __forceinline__ void phase_b(LAS char* lds, int e, const bf16_t* U, const float4* S5A, const float2* S5A128, const bf16_t* S5BB, const bf16_t* S5CM, const float* Ef, const float* Ec,
                                        const float* h0re, const float* h0im, const float* dvec, const bf16_t* Wglu, const float* bglu,
                                        bf16_t* AO, float* st_re, float* st_im, int G, int vcu, const int wv) {
  const int lane = lane_id_opaque(), wid = wv; (void)wid;
  LAS char* X = lds + OFF_X + wid * XBYTES; LAS char* Gt = lds + OFF_G;
  for (int ci = vcu; ci < NCHUNK; ci += G) {
    SGeo t; t.ci = ci; t.m0 = ci * S5T; t.isctx = t.m0 < NCTX;
    if (t.isctx) { t.b = t.m0 / CTX_L; t.c = (t.m0 % CTX_L) / S5T; t.nC = CTX_L / S5T; } else { t.b = (t.m0 - NCTX) / LAT_L; t.c = ((t.m0 - NCTX) % LAT_L) / S5T; t.nC = LAT_L / S5T; }
    const int m0 = t.m0;
    SOps P;
    s5b_load(P, t, e, wid * 4, 0, lane, U, S5A, S5A128, S5BB, Ef, Ec, h0re, h0im);
    f32x4 yacc[2] = {{0.f, 0.f, 0.f, 0.f}, {0.f, 0.f, 0.f, 0.f}};
    float uu[2][4];
#pragma unroll 1
    for (int q = 0; q < 8; ++q) { const int g = wid * 4 + (q >> 1), dir = q & 1;
      const int tb = ((e * 2 + dir) * 32 + g);
      const int nl = lane & 15, col = g * 16 + nl;
      const bf16_t* cm = S5CM + (size_t)tb * 2048 + (lane & 15) * 128 + (lane >> 4) * 8;
      bf16x8 cf[4];
#pragma unroll
      for (int ks = 0; ks < 4; ++ks) cf[ks] = *(const bf16x8*)(cm + ks * 32);
      if (dir == 0) {
#pragma unroll
        for (int rb = 0; rb < 2; ++rb)
#pragma unroll
          for (int i = 0; i < 4; ++i) uu[rb][i] = bf2f(U[(size_t)(m0 + rb * 16 + (lane >> 4) * 4 + i) * S5W + col]); }
      const float4 a4 = P.a4; const float2 a128 = P.a128;
      float sr = P.sr, si = P.si;
      const int C = t.c >> 2, f = t.c & 3, nCC = t.nC >> 2, cc0 = (t.ci - t.c) >> 2;
      const int n = dir ? (nCC - 1 - C) : C; const int cstart = dir ? (cc0 + nCC - 1) : cc0; const int estep = (dir ? -1 : 1) * 32 * 2 * 128;
      const int nf = dir ? (3 - f) : f;
#pragma unroll
      for (int j = 0; j < 16; ++j) if (j < n) { const float nr = fmaf(a128.x, sr, fmaf(-a128.y, si, P.er[j])), ni = fmaf(a128.x, si, fmaf(a128.y, sr, P.ei[j])); sr = nr; si = ni; }
      if (n > 16) { const int e0 = ((cstart * 32 + g) * 2 + dir) * 128 + lane; float er[16], ei[16];
#pragma unroll
        for (int j = 0; j < 16; ++j) { const int kk = 16 + j < n ? 16 + j : 16; er[j] = Ec[e0 + kk * estep]; ei[j] = Ec[e0 + kk * estep + 64]; }
#pragma unroll
        for (int j = 0; j < 16; ++j) if (16 + j < n) { const float nr = fmaf(a128.x, sr, fmaf(-a128.y, si, er[j])), ni = fmaf(a128.x, si, fmaf(a128.y, sr, ei[j])); sr = nr; si = ni; } }
#pragma unroll
      for (int qq = 0; qq < 3; ++qq) if (qq < nf) { const float nr = fmaf(a4.z, sr, fmaf(-a4.w, si, P.fer[qq])), ni = fmaf(a4.z, si, fmaf(a4.w, sr, P.fei[qq])); sr = nr; si = ni; }
      float bre[32], bim[32];
      bu_compute(P.ua, P.bf, bre, bim);
      if (q < 7) s5b_load(P, t, e, wid * 4 + ((q + 1) >> 1), (q + 1) & 1, lane, U, S5A, S5A128, S5BB, Ef, Ec, h0re, h0im);
      float xr = sr, xi = si;
#pragma unroll
      for (int i = 0; i < 32; ++i) { const float nr = fmaf(a4.x, xr, fmaf(-a4.y, xi, bre[i])), ni = fmaf(a4.x, xi, fmaf(a4.y, xr, bim[i])); xr = nr; xi = ni; bre[i] = nr; bim[i] = ni; }
      if (t.isctx && ((dir == 0 && t.c == t.nC - 1) || (dir == 1 && t.c == 0))) { const int so = (((t.b * 2 + e) * 2 + dir) * 32 + g) * 64 + lane; st_re[so] = xr; st_im[so] = xi; }
#pragma unroll
      for (int i = 0; i < 32; ++i) { const int tok = dir ? 31 - i : i;
        *(LAS unsigned*)(X + tok * XROW + lane * 4) = cvtpk(bre[i], bim[i]); }
      asm volatile("s_waitcnt lgkmcnt(0)" ::: "memory");
#pragma unroll
      for (int rb = 0; rb < 2; ++rb)
#pragma unroll
        for (int ks = 0; ks < 4; ++ks) { const bf16x8 af = *(const LAS bf16x8*)(X + (rb * 16 + (lane & 15)) * XROW + (ks * 32 + (lane >> 4) * 8) * 2);
          yacc[rb] = __builtin_amdgcn_mfma_f32_16x16x32_bf16(af, cf[ks], yacc[rb], 0, 0, 0); }
      asm volatile("s_waitcnt lgkmcnt(0)" ::: "memory");
      if (dir == 1) {
        const float dv = dvec[col];
#pragma unroll
        for (int rb = 0; rb < 2; ++rb)
#pragma unroll
          for (int i = 0; i < 4; ++i) { const int tok = rb * 16 + (lane >> 4) * 4 + i;
            const float y = yacc[rb][i] + dv * uu[rb][i];
            const float z2 = 1.5957691216057308f * (y + 0.044715f * y * y * y);
            const float gl = y - y / (1.f + __expf(z2));
            *(LAS unsigned short*)(Gt + tok * GROW + col * 2) = f2bf(gl); }
        yacc[0] = (f32x4){0.f, 0.f, 0.f, 0.f}; yacc[1] = (f32x4){0.f, 0.f, 0.f, 0.f};
      }
    }
    __syncthreads();
    { f32x4 acc[2][4];
#pragma unroll
      for (int rb = 0; rb < 2; ++rb)
#pragma unroll
        for (int cb = 0; cb < 4; ++cb) acc[rb][cb] = (f32x4){0.f, 0.f, 0.f, 0.f};
      const bf16_t* wp = Wglu + (size_t)(wid * 64 + (lane & 15)) * 512 + (lane >> 4) * 8;
#pragma unroll 4
      for (int ks = 0; ks < 16; ++ks) {
        bf16x8 af[2], bfr[4];
#pragma unroll
        for (int cb = 0; cb < 4; ++cb) bfr[cb] = *(const bf16x8*)(wp + (size_t)cb * 16 * 512 + ks * 32);
#pragma unroll
        for (int rb = 0; rb < 2; ++rb) af[rb] = *(const LAS bf16x8*)(Gt + (rb * 16 + (lane & 15)) * GROW + (ks * 32 + (lane >> 4) * 8) * 2);
#pragma unroll
        for (int rb = 0; rb < 2; ++rb)
#pragma unroll
          for (int cb = 0; cb < 4; ++cb) acc[rb][cb] = __builtin_amdgcn_mfma_f32_16x16x32_bf16(af[rb], bfr[cb], acc[rb][cb], 0, 0, 0);
      }
#pragma unroll
      for (int cb = 0; cb < 4; ++cb) { const int col = wid * 64 + cb * 16 + (lane & 15); const float bb = bglu[col];
#pragma unroll
        for (int rb = 0; rb < 2; ++rb)
#pragma unroll
          for (int i = 0; i < 4; ++i) { const int tok = rb * 16 + (lane >> 4) * 4 + i;
            const float gv = bf2f(*(const LAS unsigned short*)(Gt + tok * GROW + col * 2));
            const float zz = acc[rb][cb][i] + bb;
            AO[(size_t)(m0 + tok) * ABOUT + col] = f2bf(gv / (1.f + __expf(-zz))); } }
    }
    __syncthreads();
  }
}
}

constexpr size_t MiB = 1u << 20;
constexpr size_t WS_CTL = 0, CTL_ZERO_BYTES = 3 * MiB;
constexpr size_t WS_SSQ = 1 * MiB;
constexpr size_t WS_ADA = 3 * MiB;
constexpr size_t WS_S5A = 5 * MiB, WS_S5A128 = 5 * MiB + 512 * 1024, WS_S5BB = 6 * MiB, WS_S5CM = 7 * MiB;
constexpr size_t WS_GV = 8 * MiB;
constexpr size_t WS_BIAS = 9 * MiB;
constexpr size_t WS_CK = 14 * MiB, WS_CV = 22 * MiB;
constexpr size_t WS_WGLU = 30 * MiB;
constexpr size_t WS_WABIN = 32 * MiB;
constexpr size_t WS_WABOUT = 60 * MiB;
constexpr size_t WS_WCVIN = 72 * MiB;
constexpr size_t WS_WCVOUT = 120 * MiB;
constexpr size_t WS_WUP = 136 * MiB;
constexpr size_t WS_WDN = 264 * MiB;
constexpr size_t WS_H = 392 * MiB;
constexpr size_t WS_BIG = 552 * MiB;
constexpr size_t WS_U = WS_BIG, WS_Q = WS_BIG + 40 * MiB, WS_K = WS_BIG + 120 * MiB, WS_V = WS_BIG + 200 * MiB, WS_AO = WS_BIG + 280 * MiB, WS_E = WS_BIG + 400 * MiB, WS_EC = WS_BIG + 440 * MiB;
static_assert(WS_V - WS_K == WS_K - WS_Q, "q/k/v equally spaced");
constexpr size_t WS_Z = WS_BIG, WS_GB = WS_BIG + 160 * MiB, WS_A2 = WS_BIG + 320 * MiB;
constexpr size_t WS_END = WS_BIG + 640 * MiB;
constexpr int CW_TMO = 0, CW_BAR = 4096;

constexpr int RING_BYTES = 131072;
constexpr int LDSCTL_OFF = RING_BYTES, MISC_OFF = LDSCTL_OFF + 320;
constexpr int LDS_BYTES = 147456;
static_assert(att::OFF_WS >= RING_BYTES + 1024 + 2048 && att::LDS_BYTES <= LDS_BYTES && s5::LDS_BYTES <= RING_BYTES, "phase scratch fits");
constexpr int NWAVES = 8;

typedef GAS unsigned gu32;
#define RLX_AGENT __ATOMIC_RELAXED, __HIP_MEMORY_SCOPE_AGENT
#define LDS_WAIT() asm volatile("s_waitcnt lgkmcnt(0)" ::: "memory")
#define VM_WAIT() asm volatile("s_waitcnt vmcnt(0)" ::: "memory")

#define XB_TMO      128
#define XB_XCNT(j)  (256  + 64 * (j))
#define XB_XSUB(j)  (1280 + 64 * (j))
#define XB_XGEN(j)  (2304 + 64 * (j))
#define XB_TOP      3328
#define XB_TOPGEN   3392
#define XCD_BAR_WORDS 3456
#define XB_SPIN_CAP (1u << 18)
__device__ __forceinline__ unsigned xb_ld(unsigned* p)              { return __hip_atomic_load(p, __ATOMIC_RELAXED, __HIP_MEMORY_SCOPE_AGENT); }
__device__ __forceinline__ unsigned xb_add(unsigned* p, unsigned v) { return __hip_atomic_fetch_add(p, v, __ATOMIC_RELAXED, __HIP_MEMORY_SCOPE_AGENT); }
__device__ __forceinline__ unsigned xb_xcc_id() { return (unsigned)__builtin_amdgcn_s_getreg((3 << 11) | 20) & 0xFu; }
#define XB_SPIN(cond, bar) do { unsigned _sp = 0; while (cond) { __builtin_amdgcn_s_sleep(1); \
    if ((++_sp & 255u) == 0u) { if (xb_ld(&(bar)[XB_TMO])) break; if (_sp > XB_SPIN_CAP) { atomicAdd(&(bar)[XB_TMO], 1u); break; } } } } while (0)
struct XcdBarrier { unsigned* bar; unsigned x; volatile LAS unsigned* st; };
__device__ __forceinline__ XcdBarrier xcd_barrier_post(unsigned* bar, volatile LAS unsigned* st) {
    XcdBarrier b; b.bar = bar; b.x = xb_xcc_id(); b.st = st;
    if (threadIdx.x == 0) (void)xb_add(&bar[XB_XCNT(b.x)], 1u);
    return b;
}
__device__ __forceinline__ void xcd_barrier_complete(unsigned* bar, unsigned x, unsigned& nloc, unsigned& nx) {
    const unsigned G = gridDim.x * gridDim.y * gridDim.z;
    unsigned sum, cnt, mine, sp = 0u;
    for (;;) {
        sum = 0u; cnt = 0u; mine = 0u;
#pragma unroll
        for (unsigned j = 0; j < 16; ++j) { const unsigned c = xb_ld(&bar[XB_XCNT(j)]); sum += c; cnt += (c > 0u) ? 1u : 0u; mine = (j == x) ? c : mine; }
        if (sum == G) break;
        __builtin_amdgcn_s_sleep(1);
        if ((++sp & 255u) == 0u) { if (xb_ld(&bar[XB_TMO])) break; if (sp > XB_SPIN_CAP) { atomicAdd(&bar[XB_TMO], 1u); break; } }
    }
    nloc = mine > 0u ? mine : 1u; nx = cnt > 0u ? cnt : 1u;
}
__device__ __forceinline__ void xcd_barrier(const XcdBarrier& b, const int wv) {
    asm volatile("s_waitcnt vmcnt(0)" ::: "memory");
    __syncthreads();
    if (wv == 0 && lane_id_opaque() == 0) {
        unsigned* bar = b.bar; asm volatile("" : "+s"(bar));
        __builtin_amdgcn_s_waitcnt(0);
        unsigned nloc = b.st[0], nx = b.st[1];
        if (nloc == 0u) { xcd_barrier_complete(bar, b.x, nloc, nx); b.st[0] = nloc; b.st[1] = nx; }
        const unsigned old = xb_add(&bar[XB_XSUB(b.x)], 1u);
        const unsigned gen = old / nloc;
        if (old + 1u == (gen + 1u) * nloc) {
            __builtin_amdgcn_fence(__ATOMIC_RELEASE, "agent");
            asm volatile("s_waitcnt vmcnt(0)" ::: "memory");
            const unsigned og = xb_add(&bar[XB_TOP], 1u);
            const unsigned tg = og / nx;
            if (og + 1u == (tg + 1u) * nx) xb_add(&bar[XB_TOPGEN], 1u);
            else XB_SPIN(xb_ld(&bar[XB_TOPGEN]) == tg, bar);
            __builtin_amdgcn_fence(__ATOMIC_ACQUIRE, "agent");
            xb_add(&bar[XB_XGEN(b.x)], 1u);
            asm volatile("s_waitcnt vmcnt(0)" ::: "memory");
        } else {
            XB_SPIN(xb_ld(&bar[XB_XGEN(b.x)]) == gen, bar);
            __builtin_amdgcn_fence(__ATOMIC_ACQUIRE, "agent");
            asm volatile("s_waitcnt vmcnt(0)" ::: "memory");
        }
    }
    __syncthreads();
}

struct Args { const float* in[33]; float* out; unsigned char* ws; int ph_lo, ph_hi; };
enum { I_XP = 0, I_XS, I_C, I_CK, I_CV, I_SRE, I_SIM, I_CCTX, I_ADAW, I_ADAB, I_N1G, I_N2G, I_ABWIN, I_ABWOUT, I_LAMRE, I_LAMIM, I_LOGDT, I_BRE, I_BIM, I_CRE, I_CIM, I_S5D,
       I_GLUW, I_GLUB, I_QNG, I_KNG, I_RPB, I_CVWIN, I_CVW, I_CVB, I_CVWOUT, I_W1, I_W2 };
constexpr size_t O_X = 0, O_CK = (size_t)MTOK * DM, O_CV = O_CK + (size_t)32 * 2 * 256 * 1024, O_SRE = O_CV + (size_t)32 * 2 * 256 * 1024, O_SIM = O_SRE + 32 * 2 * 2 * 32 * 64;

__device__ __forceinline__ float lane_xor(float v, int lane, int m) { return __uint_as_float((unsigned)__builtin_amdgcn_ds_bpermute((lane ^ m) << 2, (int)__float_as_uint(v))); }
__device__ __forceinline__ float wave_sum(float v, int lane) {
#pragma unroll
    for (int o = 1; o < 64; o <<= 1) v += lane_xor(v, lane, o);
    return v;
}
__device__ __forceinline__ unsigned pk2(float lo, float hi) { return cvtpk(lo, hi); }
__device__ __forceinline__ float wave_sum_dpp(float v) {
    v += __uint_as_float((unsigned)__builtin_amdgcn_update_dpp(0, (int)__float_as_uint(v), 0x128, 0xf, 0xf, false));
    v += __uint_as_float((unsigned)__builtin_amdgcn_update_dpp(0, (int)__float_as_uint(v), 0x124, 0xf, 0xf, false));
    v += __uint_as_float((unsigned)__builtin_amdgcn_update_dpp(0, (int)__float_as_uint(v), 0x122, 0xf, 0xf, false));
    v += __uint_as_float((unsigned)__builtin_amdgcn_update_dpp(0, (int)__float_as_uint(v), 0x121, 0xf, 0xf, false));
    { auto t = __builtin_amdgcn_permlane16_swap(__float_as_uint(v), __float_as_uint(v), false, false); v = __uint_as_float(t[0]) + __uint_as_float(t[1]); }
    { auto t = __builtin_amdgcn_permlane32_swap(__float_as_uint(v), __float_as_uint(v), false, false); v = __uint_as_float(t[0]) + __uint_as_float(t[1]); }
    return v;
}

__device__ __forceinline__ int dest_row(int n0, int mode) {
    if (mode == 0) return n0;
    if (n0 < 2048) return 4096 + n0;
    if (n0 < 4096) { const int c = n0 - 2048; return (c >> 7) * 256 + (c & 127); }
    const int c = n0 - 4096; return (c >> 7) * 256 + 128 + (c & 127);
}
__device__ __forceinline__ void p0_transpose_item(const float* W, int K, int N, bf16_t* WT, int mode, LAS unsigned* T, int item, int lane) {
    const int nblk = N / 128, kb = item / nblk, nb = item % nblk, k0 = 64 * kb, n0 = 128 * nb;
    const int lr = lane >> 5, lc = lane & 31;
    const float* src = W + (size_t)(k0 + 2 * lr) * N + n0 + 4 * lc;
#pragma unroll 8
    for (int q = 0; q < 16; ++q) { const f32x4 a = __builtin_nontemporal_load((const f32x4*)(src + (size_t)(4 * q) * N)), b = __builtin_nontemporal_load((const f32x4*)(src + (size_t)(4 * q + 1) * N));
        const int kp = 2 * q + lr; u32x4 w; w.x = pk2(a[0], b[0]); w.y = pk2(a[1], b[1]); w.z = pk2(a[2], b[2]); w.w = pk2(a[3], b[3]);
        *(LAS u32x4*)(T + kp * 128 + ((4 * lc) ^ (((kp >> 2) & 7) << 2))) = w; }
    LDS_WAIT(); asm volatile("" ::: "memory");
    const int kq = lane & 7, nl = lane >> 3; const int r0 = dest_row(n0, mode);
#pragma unroll 4
    for (int j = 0; j < 16; ++j) { const int n = nl + 8 * j; u32x4 o;
        o.x = T[(4 * kq + 0) * 128 + (n ^ (kq << 2))]; o.y = T[(4 * kq + 1) * 128 + (n ^ (kq << 2))]; o.z = T[(4 * kq + 2) * 128 + (n ^ (kq << 2))]; o.w = T[(4 * kq + 3) * 128 + (n ^ (kq << 2))];
        *(GAS u32x4*)(WT + (size_t)(r0 + n) * K + k0 + 8 * kq) = o; }
    LDS_WAIT(); asm volatile("" ::: "memory");
}
__device__ __forceinline__ void sincos_d(double x, double& s, double& c) {
    const double k = rint(x * 0.63661977236758134308);
    double r = fma(-k, 1.5707963267948966, x); r = fma(-k, 6.123233995736766e-17, r);
    const double r2 = r * r;
    double ps = 1.0 / 355687428096000.0;
    ps = fma(ps, r2, -1.0 / 1307674368000.0); ps = fma(ps, r2, 1.0 / 6227020800.0); ps = fma(ps, r2, -1.0 / 39916800.0); ps = fma(ps, r2, 1.0 / 362880.0);
    ps = fma(ps, r2, -1.0 / 5040.0); ps = fma(ps, r2, 1.0 / 120.0); ps = fma(ps, r2, -1.0 / 6.0); ps = fma(ps * r2, r, r);
    double pc = 1.0 / 6402373705728000.0;
    pc = fma(pc, r2, -1.0 / 20922789888000.0); pc = fma(pc, r2, 1.0 / 87178291200.0); pc = fma(pc, r2, -1.0 / 479001600.0); pc = fma(pc, r2, 1.0 / 3628800.0);
    pc = fma(pc, r2, -1.0 / 40320.0); pc = fma(pc, r2, 1.0 / 720.0); pc = fma(pc, r2, -1.0 / 24.0); pc = fma(pc, r2, 0.5); pc = fma(-pc, r2, 1.0);
    const int q = ((int)k) & 3;
    s = (q == 0) ? ps : (q == 1) ? pc : (q == 2) ? -ps : -pc;
    c = (q == 0) ? pc : (q == 1) ? -ps : (q == 2) ? -pc : ps;
}
__device__ __forceinline__ double exp_small_d(double x) {
    double p = 1.0 / 87178291200.0;
    p = fma(p, x, 1.0 / 6227020800.0); p = fma(p, x, 1.0 / 479001600.0); p = fma(p, x, 1.0 / 39916800.0); p = fma(p, x, 1.0 / 3628800.0); p = fma(p, x, 1.0 / 362880.0);
    p = fma(p, x, 1.0 / 40320.0); p = fma(p, x, 1.0 / 5040.0); p = fma(p, x, 1.0 / 720.0); p = fma(p, x, 1.0 / 120.0); p = fma(p, x, 1.0 / 24.0); p = fma(p, x, 1.0 / 6.0);
    p = fma(p, x, 0.5); p = fma(p, x, 1.0); p = fma(p, x, 1.0); return p;
}
__device__ __forceinline__ double exp_d(double x) {
    const double k = rint(x * 1.4426950408889634); const double r = fma(-k, 0.6931471805599453, x) ;
    double e = exp_small_d(r * 0.25); e = e * e; e = e * e;
    return ldexp(e, (int)k);
}

__device__ __forceinline__ const float* as_global(const float* x) { const GAS float* p = (const GAS float*)x; asm("" : "+s"(p)); return (const float*)p; }
#define FIN(i) as_global(F.in[i])
struct Frame {
    LAS unsigned char* lds;
    int wave, vcu, G;
    const float* const* in;
    float* out; unsigned char* ws;
};

__device__ __forceinline__ void p0_ada_item(Frame& F, int item) {
    const int lane = lane_id_opaque(), tid = F.wave * 64 + lane; (void)tid;
    const int l = item / 48, cb = item % 48;
    LAS float* sl = (LAS float*)F.lds;
    for (int i = tid; i < 9 * 2048; i += 512) { const int j = i / 2048, k = i % 2048; const float c = j == 0 ? FIN(I_CCTX)[k] : FIN(I_C)[(j - 1) * 2048 + k]; sl[k * 12 + j] = c / (1.f + __expf(-c)); }
    __syncthreads();
    const float* W = FIN(I_ADAW) + (size_t)l * 2048 * 12288 + (size_t)(F.wave * 256) * 12288 + cb * 256 + lane * 4;
    f32x4 acc[9];
#pragma unroll
    for (int j = 0; j < 9; ++j) acc[j] = (f32x4){0.f, 0.f, 0.f, 0.f};
    for (int k0 = 0; k0 < 256; k0 += 8) {
        f32x4 w[8];
#pragma unroll
        for (int u = 0; u < 8; ++u) w[u] = __builtin_nontemporal_load((const f32x4*)(W + (size_t)(k0 + u) * 12288));
#pragma unroll
        for (int u = 0; u < 8; ++u) { const LAS f32x4* sp = (const LAS f32x4*)(sl + (F.wave * 256 + k0 + u) * 12);
            const f32x4 s0 = sp[0], s1 = sp[1], s2 = sp[2];
            acc[0] += w[u] * s0[0]; acc[1] += w[u] * s0[1]; acc[2] += w[u] * s0[2]; acc[3] += w[u] * s0[3];
            acc[4] += w[u] * s1[0]; acc[5] += w[u] * s1[1]; acc[6] += w[u] * s1[2]; acc[7] += w[u] * s1[3]; acc[8] += w[u] * s2[0]; }
    }
    __syncthreads();
    LAS f32x4* pp = (LAS f32x4*)F.lds;
#pragma unroll
    for (int j = 0; j < 9; ++j) pp[(F.wave * 9 + j) * 64 + lane] = acc[j];
    __syncthreads();
    float* ADA = (float*)(F.ws + WS_ADA) + (size_t)l * 9 * 12288;
    const float* bias = FIN(I_ADAB) + (size_t)l * 12288;
    for (int i = tid; i < 9 * 64; i += 512) { const int j = i / 64, q = i % 64; f32x4 s = pp[(0 * 9 + j) * 64 + q];
#pragma unroll
        for (int w = 1; w < 8; ++w) s += pp[(w * 9 + j) * 64 + q];
        const int col = cb * 256 + q * 4; s += *(const f32x4*)(bias + col);
        *(f32x4*)(ADA + (size_t)j * 12288 + col) = s; }
    __syncthreads();
}
__device__ __forceinline__ void p0_s5_tables(Frame& F) {
    const int lane = lane_id_opaque(), tid = F.wave * 64 + lane; (void)tid;
    const int gt = F.vcu * 512 + tid;
    if (gt >= 2 * 2 * 32 * 64) return;
    const int p = gt & 63, g = (gt >> 6) & 31, dir = (gt >> 11) & 1, e = gt >> 12;
    const int gi = (e * 2 + dir) * 32 + g;
    const double lre = (double)FIN(I_LAMRE)[gi * 64 + p], lim = (double)FIN(I_LAMIM)[gi * 64 + p];
    const double dt = exp_d((double)FIN(I_LOGDT)[gi]);
    const double ar = lre * dt, ai = lim * dt;
    double s, c; sincos_d(ai, s, c); const double dec = exp_d(ar);
    const double are = dec * c, aim = dec * s;
    double sT, cT; sincos_d(ai * S5T, sT, cT); const double decT = exp_d(ar * S5T);
    float4* A = (float4*)(F.ws + WS_S5A);
    A[gi * 64 + p] = make_float4((float)are, (float)aim, (float)(decT * cT), (float)(decT * sT));
    { double s4, c4; sincos_d(ai * (4 * S5T), s4, c4); const double dec4 = exp_d(ar * (4 * S5T));
      ((float2*)(F.ws + WS_S5A128))[gi * 64 + p] = make_float2((float)(dec4 * c4), (float)(dec4 * s4)); }
    const double den = lre * lre + lim * lim, nr = are - 1.0;
    const double fre = (nr * lre + aim * lim) / den, fim = (aim * lre - nr * lim) / den;
    bf16_t* BB = (bf16_t*)(F.ws + WS_S5BB) + (size_t)gi * 2048;
    const float* bre = FIN(I_BRE) + ((size_t)gi * 64 + p) * 16; const float* bim = FIN(I_BIM) + ((size_t)gi * 64 + p) * 16;
#pragma unroll
    for (int n = 0; n < 16; ++n) { const double br = bre[n], bi = bim[n];
        BB[(0 * 64 + p) * 16 + n] = f2bf((float)(fre * br - fim * bi)); BB[(1 * 64 + p) * 16 + n] = f2bf((float)(fre * bi + fim * br)); }
    bf16_t* CM = (bf16_t*)(F.ws + WS_S5CM) + (size_t)gi * 2048;
    const float* cre = FIN(I_CRE) + (size_t)gi * 16 * 64; const float* cim = FIN(I_CIM) + (size_t)gi * 16 * 64;
#pragma unroll
    for (int n = 0; n < 16; ++n) { CM[n * 128 + 2 * p] = f2bf(cre[n * 64 + p]); CM[n * 128 + 2 * p + 1] = f2bf(-cim[n * 64 + p]); }
}
__device__ __forceinline__ void p0_prologue(Frame& F) {
    const int lane = lane_id_opaque(), tid = F.wave * 64 + lane; (void)tid;
    if (F.vcu < 192) p0_ada_item(F, F.vcu);
    p0_s5_tables(F);
    { const size_t n8 = (size_t)8 * 2 * 256 * 1024 / 8; const size_t gth = (size_t)F.vcu * 512 + tid, nth = (size_t)F.G * 512;
      for (size_t i = gth; i < 2 * n8; i += nth) { const bool isk = i < n8; const size_t j = isk ? i : i - n8;
        const float* src = (isk ? FIN(I_CK) : FIN(I_CV)) + j * 8; bf16_t* dst = (bf16_t*)(F.ws + (isk ? WS_CK : WS_CV)) + j * 8;
        const f32x4 a = __builtin_nontemporal_load((const f32x4*)src), b = __builtin_nontemporal_load((const f32x4*)(src + 4));
        u32x4 o; o.x = pk2(a[0], a[1]); o.y = pk2(a[2], a[3]); o.z = pk2(b[0], b[1]); o.w = pk2(b[2], b[3]); *(u32x4*)dst = o; } }
    LAS unsigned* scr = (LAS unsigned*)(F.lds + F.wave * 16384);
    const int gw = F.vcu * NWAVES + F.wave, NGW = F.G * NWAVES;
    constexpr int I_ABI = 32 * 28, I_ABO = 24 * 16, I_CVI = 32 * 48, I_CVO = 32 * 16, I_UP = 32 * 64, I_DN = 128 * 16, I_GLU = 8 * 4;
    constexpr int NITEMS = 2 * I_ABI + 2 * I_ABO + 2 * I_CVI + 2 * I_CVO + 4 * I_UP + 4 * I_DN + 2 * I_GLU;
    for (int it = gw; it < NITEMS; it += NGW) {
        int r = it;
        if (r < 2 * I_ABI) { const int e = r / I_ABI; p0_transpose_item(FIN(I_ABWIN) + (size_t)e * DM * ABIN, DM, ABIN, (bf16_t*)(F.ws + WS_WABIN) + (size_t)e * ABIN * DM, 0, scr, r % I_ABI, lane); continue; } r -= 2 * I_ABI;
        if (r < 2 * I_ABO) { const int e = r / I_ABO; p0_transpose_item(FIN(I_ABWOUT) + (size_t)e * ABOUT * DM, ABOUT, DM, (bf16_t*)(F.ws + WS_WABOUT) + (size_t)e * DM * ABOUT, 0, scr, r % I_ABO, lane); continue; } r -= 2 * I_ABO;
        if (r < 2 * I_CVI) { const int e = r / I_CVI; p0_transpose_item(FIN(I_CVWIN) + (size_t)e * DM * 3 * DM, DM, 3 * DM, (bf16_t*)(F.ws + WS_WCVIN) + (size_t)e * 3 * DM * DM, 1, scr, r % I_CVI, lane); continue; } r -= 2 * I_CVI;
        if (r < 2 * I_CVO) { const int e = r / I_CVO; p0_transpose_item(FIN(I_CVWOUT) + (size_t)e * DM * DM, DM, DM, (bf16_t*)(F.ws + WS_WCVOUT) + (size_t)e * DM * DM, 0, scr, r % I_CVO, lane); continue; } r -= 2 * I_CVO;
        if (r < 4 * I_UP) { const int e = r / I_UP; p0_transpose_item(FIN(I_W1) + (size_t)e * DM * DFF, DM, DFF, (bf16_t*)(F.ws + WS_WUP) + (size_t)e * DFF * DM, 0, scr, r % I_UP, lane); continue; } r -= 4 * I_UP;
        if (r < 4 * I_DN) { const int e = r / I_DN; p0_transpose_item(FIN(I_W2) + (size_t)e * DFF * DM, DFF, DM, (bf16_t*)(F.ws + WS_WDN) + (size_t)e * DM * DFF, 0, scr, r % I_DN, lane); continue; } r -= 4 * I_DN;
        { const int e = r / I_GLU; p0_transpose_item(FIN(I_GLUW) + (size_t)e * S5W * S5W, S5W, S5W, (bf16_t*)(F.ws + WS_WGLU) + (size_t)e * S5W * S5W, 0, scr, r % I_GLU, lane); }
    }
}

__device__ __forceinline__ const bf16_t* wt_of_norm(const unsigned char* ws, int s, int& N) {
    const int l = s >> 1;
    if (s & 1) { N = DFF; return (const bf16_t*)(ws + WS_WUP) + (size_t)l * DFF * DM; }
    if (l & 1) { N = 3 * DM; return (const bf16_t*)(ws + WS_WCVIN) + (size_t)(l >> 1) * 3 * DM * DM; }
    N = ABIN; return (const bf16_t*)(ws + WS_WABIN) + (size_t)(l >> 1) * ABIN * DM;
}
__device__ __forceinline__ void pre_phase(Frame& F) {
    const int lane = lane_id_opaque(), wave = F.wave, tid = wave * 64 + lane;
    GAS unsigned char* wsg_ = (GAS unsigned char*)F.ws; asm volatile("" : "+s"(wsg_)); unsigned char* ws = (unsigned char*)wsg_;
    const int gw = F.vcu * NWAVES + wave, NGW = F.G * NWAVES;
    const float* ADA0 = (const float*)(ws + WS_ADA);
    { float* GV = (float*)(ws + WS_GV);
      for (int i = F.vcu * 512 + tid; i < 8 * 9 * DM; i += F.G * 512) { const int s = i / (9 * DM), r = i % (9 * DM), j = r / DM, col = r % DM, l = s >> 1, which = s & 1;
        GV[i] = F.in[which ? I_N2G : I_N1G][l * DM + col] * (1.f + ADA0[((size_t)l * 9 + j) * 12288 + (which ? 4 : 1) * DM + col]); } }
    { bf16_t* H = (bf16_t*)(ws + WS_H); float* SSQ = (float*)(ws + WS_SSQ); const float* gn = FIN(I_N1G);
      for (int m = gw; m < MTOK; m += NGW) {
        const float* xrow = m < NCTX ? FIN(I_XP) + (size_t)m * DM : FIN(I_XS) + (size_t)(m - NCTX) * DM;
        const f32x4* xr = (const f32x4*)xrow + lane;
        const float* ad = ADA0 + (size_t)ada_row_of_token(m) * 12288;
        u32x2* o8 = (u32x2*)(H + (size_t)m * DM) + lane; float sq = 0.f;
#pragma unroll
        for (int j = 0; j < 8; ++j) { const int col = 4 * lane + 256 * j; const f32x4 v = __builtin_nontemporal_load(xr + 64 * j);
            sq += (v[0] * v[0] + v[1] * v[1]) + (v[2] * v[2] + v[3] * v[3]);
            const f32x4 g = *(const f32x4*)(gn + col), sc = *(const f32x4*)(ad + DM + col);
            const f32x4 h = v * g * (sc + 1.f);
            u32x2 w; w.x = pk2(h[0], h[1]); w.y = pk2(h[2], h[3]); o8[64 * j] = w; }
        sq = wave_sum_dpp(sq);
        if (lane == 0) SSQ[m] = sq; } }
    { float* BIAS = (float*)(ws + WS_BIAS);
      constexpr int T_AB = ABIN / 16, T_CV = 3 * DM / 16, T_UP = DFF / 16, T_PAIR = T_AB + T_UP + T_CV + T_UP;
      for (int it = gw; it < 2 * T_PAIR; it += NGW) {
        int r = it % T_PAIR, s = (it / T_PAIR) * 4;
        if (r >= T_AB) { r -= T_AB; ++s; if (r >= T_UP) { r -= T_UP; ++s; if (r >= T_CV) { r -= T_CV; ++s; } } }
        const int l = s >> 1, which = s & 1, n0 = r * 16;
        int N; const bf16_t* Wt = wt_of_norm(ws, s, N);
        const GAS bf16_t* wp = (const GAS bf16_t*)Wt + (size_t)(n0 + (lane & 15)) * DM + (lane >> 4) * 8;
        const int jj = (lane & 15) < 9 ? (lane & 15) : 8;
        const GAS float* sp = (const GAS float*)ADA0 + ((size_t)l * 9 + jj) * 12288 + (which ? 3 : 0) * DM + (lane >> 4) * 8;
        f32x4 acc = {0.f, 0.f, 0.f, 0.f};
#pragma unroll 8
        for (int ks = 0; ks < DM / 32; ++ks) {
            const bf16x8 a = *(const GAS bf16x8*)(wp + ks * 32);
            const f32x4 b0 = *(const GAS f32x4*)(sp + ks * 32), b1 = *(const GAS f32x4*)(sp + ks * 32 + 4);
            u32x4 hw; hw.x = pk2(b0[0], b0[1]); hw.y = pk2(b0[2], b0[3]); hw.z = pk2(b1[0], b1[1]); hw.w = pk2(b1[2], b1[3]);
            u32x4 lw; lw.x = pk2(b0[0] - bflo(hw.x), b0[1] - bfhi(hw.x)); lw.y = pk2(b0[2] - bflo(hw.y), b0[3] - bfhi(hw.y));
            lw.z = pk2(b1[0] - bflo(hw.z), b1[1] - bfhi(hw.z)); lw.w = pk2(b1[2] - bflo(hw.w), b1[3] - bfhi(hw.w));
            acc = __builtin_amdgcn_mfma_f32_16x16x32_bf16(a, *(const bf16x8*)&hw, acc, 0, 0, 0);
            acc = __builtin_amdgcn_mfma_f32_16x16x32_bf16(a, *(const bf16x8*)&lw, acc, 0, 0, 0);
        }
        if ((lane & 15) < 9) *(GAS f32x4*)(BIAS + ((size_t)s * 9 + (lane & 15)) * DFF + n0 + (lane >> 4) * 4) = acc;
      } }
}
__device__ __forceinline__ void conv_phase(Frame& F, int o) {
    const int lane = lane_id_opaque(), wave = F.wave, tid = wave * 64 + lane; (void)tid;
    GAS unsigned char* wsg_ = (GAS unsigned char*)F.ws; asm volatile("" : "+s"(wsg_)); unsigned char* ws = (unsigned char*)wsg_;

    const int gw = F.vcu * NWAVES + wave, NGW = F.G * NWAVES;
    const bf16_t* Z = (const bf16_t*)(ws + WS_Z); const bf16_t* GB = (const bf16_t*)(ws + WS_GB); bf16_t* A2 = (bf16_t*)(ws + WS_A2);
    const float* cw = FIN(I_CVW) + (size_t)o * 3 * DM; const float* cb = FIN(I_CVB) + (size_t)o * DM;
    for (int it = gw; it < (MTOK / 16) * 4; it += NGW) {
        const int rc = it >> 2, cq = it & 3, m0 = rc * 16, col = cq * 512 + lane * 8;
        float w0[8], w1[8], w2[8], bb[8];
#pragma unroll
        for (int i = 0; i < 8; ++i) { w0[i] = cw[col + i]; w1[i] = cw[DM + col + i]; w2[i] = cw[2 * DM + col + i]; bb[i] = cb[col + i]; }
        const int L = m0 < NCTX ? CTX_L : LAT_L; const int t0 = (m0 < NCTX ? m0 : m0 - NCTX) % L;
        u32x4 zp = (u32x4){0u, 0u, 0u, 0u}, zc, zn;
        if (t0 > 0) zp = *(const u32x4*)(Z + (size_t)(m0 - 1) * DM + col);
        zc = *(const u32x4*)(Z + (size_t)m0 * DM + col);
#pragma unroll 4
        for (int r = 0; r < 16; ++r) { const int m = m0 + r;
            zn = (u32x4){0u, 0u, 0u, 0u}; if (t0 + r + 1 < L) zn = *(const u32x4*)(Z + (size_t)(m + 1) * DM + col);
            const u32x4 gb = *(const u32x4*)(GB + (size_t)m * DM + col);
            float ov[8];
#pragma unroll
            for (int i = 0; i < 4; ++i) {
                const float c0 = w0[2 * i] * bflo(zp[i]) + w1[2 * i] * bflo(zc[i]) + w2[2 * i] * bflo(zn[i]) + bb[2 * i];
                const float c1 = w0[2 * i + 1] * bfhi(zp[i]) + w1[2 * i + 1] * bfhi(zc[i]) + w2[2 * i + 1] * bfhi(zn[i]) + bb[2 * i + 1];
                ov[2 * i] = bflo(gb[i]) * c0; ov[2 * i + 1] = bfhi(gb[i]) * c1; }
            u32x4 ow; ow.x = pk2(ov[0], ov[1]); ow.y = pk2(ov[2], ov[3]); ow.z = pk2(ov[4], ov[5]); ow.w = pk2(ov[6], ov[7]);
            *(u32x4*)(A2 + (size_t)m * DM + col) = ow;
            zp = zc; zc = zn; }
    }
}
#ifndef ATT_SDEPTH
#define ATT_SDEPTH 2
#endif
__device__ __forceinline__ void attn_phase(Frame& F, int e) {
    const int lane = lane_id_opaque(), wave = F.wave, tid = wave * 64 + lane; (void)tid;
    GAS unsigned char* wsg_ = (GAS unsigned char*)F.ws; asm volatile("" : "+s"(wsg_)); unsigned char* ws = (unsigned char*)wsg_;

    const bf16_t* Q = (const bf16_t*)(ws + WS_Q); const bf16_t* Kb = (const bf16_t*)(ws + WS_K); const bf16_t* V = (const bf16_t*)(ws + WS_V);
    bf16_t* AO = (bf16_t*)(ws + WS_AO);
    const bf16_t* CK = (const bf16_t*)(ws + WS_CK); const bf16_t* CV = (const bf16_t*)(ws + WS_CV);
    LAS char* lds = (LAS char*)F.lds;
    const float* gqp = FIN(I_QNG) + e * 128;
    if (tid < 128) ((LAS float*)(lds + att::OFF_GK))[tid] = FIN(I_KNG)[e * 128 + tid];
    for (int u = F.vcu; u < 1024 + 256; u += F.G) {
        __syncthreads();
        if (u < 1024) {
            const int b = u >> 7, h = (u >> 4) & 7, R = (u & 15) * 4;
            int kr0 = R - 4; kr0 = kr0 < 0 ? 0 : (kr0 > 52 ? 52 : kr0);
            LAS float* bl = (LAS float*)(lds + att::OFF_BIAS);
            { const int t2 = wave * 64 + lane_id_opaque();
              if (t2 < 15 * 32) { const int dr = t2 >> 5, dc = t2 & 31; bl[t2] = dc < 31 ? FIN(I_RPB)[((size_t)(e * 8 + h) * 15 + dr) * 31 + dc] * 11.313708498984761f : 0.f; } }
            const size_t seq0 = (size_t)NCTX + (size_t)b * LAT_L;
            const bf16_t* Qb = Q + (seq0 + (size_t)R * 64) * 1024 + h * 128;
            const bf16_t* K0 = CK + (((size_t)b * 2 + e) * 256) * 1024 + h * 128; const bf16_t* V0 = CV + (((size_t)b * 2 + e) * 256) * 1024 + h * 128;
            const bf16_t* K1 = Kb + (seq0 + (size_t)kr0 * 64) * 1024 + h * 128; const bf16_t* V1 = V + (seq0 + (size_t)kr0 * 64) * 1024 + h * 128;
            bf16_t* Ob = AO + (seq0 + (size_t)R * 64) * ABOUT + S5W + h * 128;
            att::attn_unit<true, ATT_SDEPTH>(lds, Qb, K0, V0, 4, K1, V1, 16, Ob, ABOUT, R, kr0, wave, gqp, nullptr, nullptr, false);
        } else {
            const int uc = u - 1024, b = uc >> 3, h = uc & 7;
            const size_t seq0 = (size_t)b * CTX_L;
            const bf16_t* Qb = Q + seq0 * 1024 + h * 128; const bf16_t* K0 = Kb + seq0 * 1024 + h * 128; const bf16_t* V0 = V + seq0 * 1024 + h * 128;
            bf16_t* Ob = AO + seq0 * ABOUT + S5W + h * 128;
            att::attn_unit<false, ATT_SDEPTH>(lds, Qb, K0, V0, 4, K0, V0, 4, Ob, ABOUT, 0, 0, wave, gqp, F.out + O_CK + (((size_t)b * 2 + e) * 256) * 1024 + h * 128, F.out + O_CV + (((size_t)b * 2 + e) * 256) * 1024 + h * 128, true);
        }
    }
}

constexpr int NPHASE = 2 + 6 * NLAYER;
#ifndef REP_PRO
#define REP_PRO 1
#endif
#ifndef REP_PRE
#define REP_PRE 1
#endif
#ifndef REP_S5A
#define REP_S5A 1
#endif
#ifndef REP_S5B
#define REP_S5B 1
#endif
#ifndef REP_ATT
#define REP_ATT 1
#endif
#ifndef REP_CONV
#define REP_CONV 1
#endif
#ifndef REP_UP
#define REP_UP 1
#endif
#ifndef GEMM_STAMP
#define GEMM_STAMP 0
#endif
#ifndef PG8_SP2
#define PG8_SP2 true
#endif
#ifndef PG8_ALIGN
#define PG8_ALIGN true
#endif

__global__ void __launch_bounds__(NWAVES * 64, 2) fwd(Args args) {
    extern __shared__ __attribute__((aligned(16))) unsigned char lds[];
    Frame F;
    F.lds = (LAS unsigned char*)lds;
    F.wave = __builtin_amdgcn_readfirstlane((int)threadIdx.x >> 6);
    F.G = gridDim.x; { const int bx = blockIdx.x; F.vcu = (F.G % 8 == 0) ? (bx % 8) * (F.G / 8) + bx / 8 : bx; }
    F.in = args.in; F.out = (float*)(GAS float*)args.out; F.ws = (unsigned char*)(GAS unsigned char*)args.ws;
    for (int u = threadIdx.x; u < (LDS_BYTES - LDSCTL_OFF) / 4; u += NWAVES * 64) ((LAS unsigned*)(F.lds + LDSCTL_OFF))[u] = 0u;
    __syncthreads();
    volatile LAS unsigned* MISC = (volatile LAS unsigned*)(F.lds + MISC_OFF);
    XcdBarrier bar = xcd_barrier_post((unsigned*)(F.ws + WS_CTL) + CW_BAR, MISC + 8);
#if MK_PER_PHASE
    const int lo = args.ph_lo, hi = args.ph_hi;
#else
    constexpr int lo = 0, hi = NPHASE;
#endif
#define IN(k) (lo <= (k) && (k) < hi)
#if GEMM_STAMP == 7
#define SEAM(k) do { if (lo <= (k) && (k) + 1 < hi) { const unsigned long long t0_ = __builtin_amdgcn_s_memrealtime(); xcd_barrier(bar, F.wave); const unsigned long long dt_ = __builtin_amdgcn_s_memrealtime() - t0_; if (blockIdx.x == 0 && threadIdx.x == 0) atomicAdd((unsigned long long*)(F.ws + WS_CTL + 65536) + 3, dt_); } } while (0)
#else
#define SEAM(k) do { if (lo <= (k) && (k) + 1 < hi) xcd_barrier(bar, F.wave); } while (0)
#endif
#define OPAQUE_WS GAS unsigned char* wsg_ = (GAS unsigned char*)F.ws; asm volatile("" : "+s"(wsg_)); unsigned char* ws = (unsigned char*)wsg_; int bxo = bx; asm volatile("" : "+s"(bxo)); (void)bxo
    LAS unsigned char* ring = F.lds;
    const int bx = (int)blockIdx.x;

    if (IN(0)) { for (int rep = 0; rep < REP_PRO; ++rep) { p0_prologue(F); __syncthreads(); } }
    SEAM(0);
    if (IN(1)) { for (int rep = 0; rep < REP_PRE; ++rep) pre_phase(F); }
    SEAM(1);
#pragma unroll 1
    for (int l = 0; l < NLAYER; ++l) {
        const int pb = 2 + 6 * l, e = l >> 1;
        const float* ADA = (const float*)(F.ws + WS_ADA) + (size_t)l * 9 * 12288;
        const float* rb0 = l == 0 ? FIN(I_XP) : F.out; const float* rb1 = l == 0 ? FIN(I_XS) - (size_t)NCTX * DM : F.out;
        if ((l & 1) == 0) {
            if (IN(pb + 0)) { OPAQUE_WS; pg8::Gemm g{(const bf16_t*)(ws + WS_H), (const bf16_t*)(ws + WS_WABIN) + (size_t)e * ABIN * DM, MTOK, ABIN, DM}; pg8::StaticOrder S; S.init(MTOK, ABIN, F.G, bxo);
                pg8::EpiAbIn E{(bf16_t*)(ws + WS_U), (bf16_t*)(ws + WS_Q), (size_t)(WS_K - WS_Q) / 2, pg8::NormIn{(const float*)(ws + WS_SSQ) + (size_t)(2 * l) * MTOK, (const float*)(ws + WS_BIAS) + (size_t)(2 * l) * 9 * DFF, DFF}};
                pg8::gemm_phase_i<pg8::EpiAbIn, pg8::StaticOrder>(ring, g, S, E, F.wave); }
            SEAM(pb + 0);
            if (IN(pb + 1)) { OPAQUE_WS;
                for (int rep = 0; rep < REP_S5A; ++rep) s5::phase_a(e, (const bf16_t*)(ws + WS_U), (const float4*)(ws + WS_S5A), (const bf16_t*)(ws + WS_S5BB), (float*)(ws + WS_E), (float*)(ws + WS_EC), F.G, F.vcu, F.wave); }
            SEAM(pb + 1);
            if (IN(pb + 2)) { OPAQUE_WS;
                for (int rep = 0; rep < REP_S5B; ++rep) s5::phase_b((LAS char*)F.lds, e, (const bf16_t*)(ws + WS_U), (const float4*)(ws + WS_S5A), (const float2*)(ws + WS_S5A128), (const bf16_t*)(ws + WS_S5BB), (const bf16_t*)(ws + WS_S5CM), (const float*)(ws + WS_E), (const float*)(ws + WS_EC),
                            FIN(I_SRE), FIN(I_SIM), FIN(I_S5D) + (size_t)e * S5W, (const bf16_t*)(ws + WS_WGLU) + (size_t)e * S5W * S5W, FIN(I_GLUB) + (size_t)e * S5W,
                            (bf16_t*)(ws + WS_AO), F.out + O_SRE, F.out + O_SIM, F.G, F.vcu, F.wave);
                for (int rep = 0; rep < REP_ATT; ++rep) attn_phase(F, e); }
            SEAM(pb + 2);
            if (IN(pb + 3)) { OPAQUE_WS; pg8::Gemm g{(const bf16_t*)(ws + WS_AO), (const bf16_t*)(ws + WS_WABOUT) + (size_t)e * DM * ABOUT, MTOK, DM, ABOUT}; pg8::StaticOrder S; S.init(MTOK, DM, F.G, bxo);
                pg8::EpiRes<true> E{rb0, rb1, F.out, ADA + 2 * DM, (const float*)(ws + WS_GV) + (size_t)(2 * l + 1) * 9 * DM, (bf16_t*)(ws + WS_H), (float*)(ws + WS_SSQ) + (size_t)(2 * l + 1) * MTOK};
                pg8::gemm_phase<pg8::EpiRes<true>, pg8::StaticOrder, PG8_ALIGN, PG8_SP2>(ring, g, S, E, F.wave); }
            SEAM(pb + 3);
        } else {
            if (IN(pb + 0)) { OPAQUE_WS; pg8::Gemm g{(const bf16_t*)(ws + WS_H), (const bf16_t*)(ws + WS_WCVIN) + (size_t)e * 3 * DM * DM, MTOK, 3 * DM, DM}; pg8::StaticOrder S; S.init(MTOK, 3 * DM, F.G, bxo);
                pg8::EpiConvIn E{(bf16_t*)(ws + WS_Z), (bf16_t*)(ws + WS_GB), pg8::NormIn{(const float*)(ws + WS_SSQ) + (size_t)(2 * l) * MTOK, (const float*)(ws + WS_BIAS) + (size_t)(2 * l) * 9 * DFF, DFF}};
                pg8::gemm_phase_i<pg8::EpiConvIn, pg8::StaticOrder>(ring, g, S, E, F.wave); }
            SEAM(pb + 0);
            if (IN(pb + 1)) { for (int rep = 0; rep < REP_CONV; ++rep) conv_phase(F, e); }
            SEAM(pb + 2);
            if (IN(pb + 3)) { OPAQUE_WS; pg8::Gemm g{(const bf16_t*)(ws + WS_A2), (const bf16_t*)(ws + WS_WCVOUT) + (size_t)e * DM * DM, MTOK, DM, DM}; pg8::StaticOrder S; S.init(MTOK, DM, F.G, bxo);
                pg8::EpiRes<true> E{rb0, rb1, F.out, ADA + 2 * DM, (const float*)(ws + WS_GV) + (size_t)(2 * l + 1) * 9 * DM, (bf16_t*)(ws + WS_H), (float*)(ws + WS_SSQ) + (size_t)(2 * l + 1) * MTOK};
                pg8::gemm_phase<pg8::EpiRes<true>, pg8::StaticOrder, PG8_ALIGN, PG8_SP2>(ring, g, S, E, F.wave); }
            SEAM(pb + 3);
        }
        if (IN(pb + 4)) { OPAQUE_WS; pg8::Gemm g{(const bf16_t*)(ws + WS_H), (const bf16_t*)(ws + WS_WUP) + (size_t)l * DFF * DM, MTOK, DFF, DM}; pg8::StaticOrder S; S.init(MTOK, DFF, F.G, bxo);
            pg8::EpiRelu2 E{(bf16_t*)(ws + WS_BIG), DFF, pg8::NormIn{(const float*)(ws + WS_SSQ) + (size_t)(2 * l + 1) * MTOK, (const float*)(ws + WS_BIAS) + (size_t)(2 * l + 1) * 9 * DFF, DFF}};
#if GEMM_STAMP
            pg8::gemm_phase_i<pg8::EpiRelu2, pg8::StaticOrder>(ring, g, S, E, F.wave, (unsigned long long*)(ws + WS_CTL + 65536)); }
#else
            for (int rep = 0; rep < REP_UP; ++rep) pg8::gemm_phase_i<pg8::EpiRelu2, pg8::StaticOrder>(ring, g, S, E, F.wave); }
#endif
        SEAM(pb + 4);
        if (IN(pb + 5)) { OPAQUE_WS; pg8::Gemm g{(const bf16_t*)(ws + WS_BIG), (const bf16_t*)(ws + WS_WDN) + (size_t)l * DM * DFF, MTOK, DM, DFF}; pg8::StaticOrder S; S.init(MTOK, DM, F.G, bxo);
            if (l < NLAYER - 1) { pg8::EpiRes<true> E{F.out, F.out, F.out, ADA + 5 * DM, (const float*)(ws + WS_GV) + (size_t)(2 * l + 2) * 9 * DM, (bf16_t*)(ws + WS_H), (float*)(ws + WS_SSQ) + (size_t)(2 * l + 2) * MTOK};
                pg8::gemm_phase<pg8::EpiRes<true>, pg8::StaticOrder, PG8_ALIGN, PG8_SP2>(ring, g, S, E, F.wave); }
            else { pg8::EpiRes<false> E{F.out, F.out, F.out, ADA + 5 * DM, nullptr, nullptr, nullptr};
                pg8::gemm_phase<pg8::EpiRes<false>, pg8::StaticOrder, PG8_ALIGN, PG8_SP2>(ring, g, S, E, F.wave); } }
        SEAM(pb + 5);
    }
#if GEMM_STAMP
    if (blockIdx.x == 0 && threadIdx.x == 0) { unsigned long long* st = (unsigned long long*)(F.ws + WS_CTL + 65536);
        const unsigned long long tk = __hip_atomic_load(st, __ATOMIC_RELAXED, __HIP_MEMORY_SCOPE_AGENT), ck = __hip_atomic_load(st + 1, __ATOMIC_RELAXED, __HIP_MEMORY_SCOPE_AGENT), te = __hip_atomic_load(st + 2, __ATOMIC_RELAXED, __HIP_MEMORY_SCOPE_AGENT);
        unsigned long long wait = 0;
#if GEMM_STAMP == 7
        wait = __hip_atomic_load(st + 3, __ATOMIC_RELAXED, __HIP_MEMORY_SCOPE_AGENT);
#endif
        if (GEMM_STAMP == 1) wait = tk ? ck * 10000ull / tk : 0;
        if (GEMM_STAMP == 2) wait = tk / 4;
        if (GEMM_STAMP == 3) wait = te;
        if (GEMM_STAMP >= 4) { unsigned long long mx = 0, mn = ~0ull, sm = 0; for (unsigned i = 0; i < gridDim.x; ++i) { const unsigned long long v = __hip_atomic_load(st + 8 + i, __ATOMIC_RELAXED, __HIP_MEMORY_SCOPE_AGENT); mx = v > mx ? v : mx; mn = v < mn ? v : mn; sm += v; }
            wait = (GEMM_STAMP == 4 ? mx : GEMM_STAMP == 5 ? mn : sm / gridDim.x) / 4; }
        const unsigned long long t0 = __builtin_amdgcn_s_memrealtime(); while (__builtin_amdgcn_s_memrealtime() - t0 < wait) __builtin_amdgcn_s_sleep(32); }
#endif
#undef IN
#undef SEAM
#undef OPAQUE_WS
}

extern "C" void kernel_launch(void* const* d_in, const int* in_sizes, int n_in, void* d_out, int out_size, void* d_ws, size_t ws_size, hipStream_t stream) {
    static int grid = 0;
    if (grid == 0) {
        if (n_in != 33 || ws_size < WS_END) { fprintf(stderr, "kernel_launch: n_in %d ws %zu (need 33, >= %zu)\n", n_in, ws_size, (size_t)WS_END); grid = -1; return; }
        int dev = 0, cus = 0;
        if (hipGetDevice(&dev) != hipSuccess || hipDeviceGetAttribute(&cus, hipDeviceAttributeMultiprocessorCount, dev) != hipSuccess) { grid = -1; return; }
        if (hipFuncSetAttribute((const void*)fwd, hipFuncAttributeMaxDynamicSharedMemorySize, LDS_BYTES) != hipSuccess) { fprintf(stderr, "kernel_launch: hipFuncSetAttribute failed\n"); grid = -1; return; }
        int per_cu = 0;
        if (hipOccupancyMaxActiveBlocksPerMultiprocessor(&per_cu, (const void*)fwd, NWAVES * 64, LDS_BYTES) != hipSuccess || per_cu < 1) fprintf(stderr, "kernel_launch: occupancy query says %d\n", per_cu);
        (void)hipGetLastError();
        grid = cus;
    }
    if (grid < 0) return;
    (void)hipMemsetAsync((char*)d_ws + WS_CTL, 0, CTL_ZERO_BYTES, stream);
    Args a{};
    for (int i = 0; i < 33; ++i) a.in[i] = (const float*)d_in[i];
    a.out = (float*)d_out; a.ws = (unsigned char*)d_ws;
#if MK_PER_PHASE
    for (int p = 0; p < NPHASE; ++p) {
        if (p > 1) { const int l = (p - 2) / 6, k = (p - 2) % 6; if ((l & 1) && k == 2) continue; }
        a.ph_lo = p; a.ph_hi = p + 1;
        hipLaunchKernelGGL(fwd, dim3(grid), dim3(NWAVES * 64), LDS_BYTES, stream, a);
    }
#else
    a.ph_lo = 0; a.ph_hi = NPHASE;
    hipLaunchKernelGGL(fwd, dim3(grid), dim3(NWAVES * 64), LDS_BYTES, stream, a);
#endif
    const hipError_t le = hipPeekAtLastError();
    if (le != hipSuccess) fprintf(stderr, "kernel_launch: launch failed: %s\n", hipGetErrorName(le));
}
```

```cpp
#include <hip/hip_runtime.h>
#include <cstdio>
#include <cstdint>

#ifndef PG8_WGM
#define PG8_WGM 4
#endif
#ifndef PG8_EARLY
#define PG8_EARLY 0
#endif
#ifndef MK_PER_PHASE
#define MK_PER_PHASE 0
#endif

__device__ __forceinline__ int lane_id_opaque() { int l; asm volatile("v_mbcnt_lo_u32_b32 %0, -1, 0\n\tv_mbcnt_hi_u32_b32 %0, -1, %0" : "=v"(l)); return l; }

namespace pg8 {
#define PG8_LAS __attribute__((address_space(3)))
typedef unsigned short bf16_t;
typedef short bf16x8 __attribute__((ext_vector_type(8)));
typedef float f32x4 __attribute__((ext_vector_type(4)));
typedef unsigned u32x4 __attribute__((ext_vector_type(4)));
constexpr int BM = 256, BK = 64, HALF = 128, HTB = HALF * BK * 2  , STAGE_BYTES = 8 * HTB, NXCD = 8, WGM = PG8_WGM;

__host__ __device__ __forceinline__ int lds_byte(int r, int c) { const int st = (r >> 4) * 2 + (c >> 5), rr = r & 15, cc = c & 31, ob = rr * 64 + cc * 2; return st * 1024 + (ob ^ (((ob >> 9) & 1) << 5)); }
__host__ __device__ __forceinline__ void stage_rc(int b, int& R, int& C) { const int st = b / 1024, sb = b % 1024, swz = sb ^ (((sb >> 9) & 1) << 5); R = (st >> 1) * 16 + swz / 64; C = (st & 1) * 32 + (swz % 64) / 2; }
__host__ __device__ __forceinline__ int perm32(int rho) { const int n = rho >> 4, i = rho & 15; return 8 * (i >> 2) + 4 * n + (i & 3); }

struct Unit { int pm, pn; };
struct Gemm { const bf16_t* A; const bf16_t* Bt; int M, N, K; };

struct StaticOrder {
    int nM, nN, nwg, G, c;
    __host__ __device__ void init(int M, int N, int G_, int c_) { nM = M / BM; nN = N / BM; nwg = nM * nN; G = G_; c = c_; }
    __host__ __device__ bool next(int i, Unit& u) const {
        const long L = (long)i * G + c; if (L >= nwg) return false;
        int wgid = (int)L; { const int q = nwg / NXCD, r = nwg % NXCD, xcd = wgid % NXCD, off = wgid / NXCD; wgid = (xcd < r ? xcd * (q + 1) : r * (q + 1) + (xcd - r) * q) + off; }
        const int nig = WGM * nN, gid = wgid / nig, fm = gid * WGM, gsz = (nM - fm) < WGM ? (nM - fm) : WGM;
        u.pm = fm + ((wgid % nig) % gsz); u.pn = (wgid % nig) / gsz; return true;
    }
    __device__ __forceinline__ void a_ready(const Unit&) const {}
    __device__ __forceinline__ void done(const Unit&) const {}
};

__device__ __forceinline__ unsigned cvt_pk_bf16(float lo, float hi) { unsigned r; asm volatile("v_cvt_pk_bf16_f32 %0, %1, %2" : "=v"(r) : "v"(lo), "v"(hi)); return r; }

__device__ __forceinline__ void st16(void* p, u32x4 w) { asm volatile("global_store_dwordx4 %0, %1, off\n\ts_nop 1" :: "v"(p), "v"(w) : "memory"); }
typedef unsigned u32x2 __attribute__((ext_vector_type(2)));
__device__ __forceinline__ void st8(void* p, u32x2 w) { asm volatile("global_store_dwordx2 %0, %1, off\n\ts_nop 1" :: "v"(p), "v"(w) : "memory"); }
constexpr int DM = 2048;
__device__ __forceinline__ int ada_row_of_panel(int pm) { return pm < 32 ? 0 : 1 + ((pm - 32) >> 4); }

constexpr int LDSX_OFF = 131072 + 1024;
struct NormIn {
    const float* ssq; const float* bias; int N;
    __device__ __forceinline__ void prefetch(const Unit& u, PG8_LAS unsigned char* lds, int wv, int lane) const {
        const float* src = wv < 4 ? ssq + u.pm * BM + wv * 64 + lane : bias + (size_t)ada_row_of_panel(u.pm) * N + u.pn * BM + (wv - 4) * 64 + lane;
        __builtin_amdgcn_global_load_lds((const unsigned*)src, (PG8_LAS unsigned*)(lds + LDSX_OFF + wv * 256), 4, 0, 0);
    }
    __device__ __forceinline__ void load(PG8_LAS unsigned char* lds, const int ai, int wr, int wc, int fr, int fq, float (&rs)[4], f32x4 (&bv)[2][2]) const {
        const PG8_LAS float* sx = (const PG8_LAS float*)(lds + LDSX_OFF);
#pragma unroll
        for (int m = 0; m < 4; ++m) rs[m] = __builtin_amdgcn_rsqf(sx[ai * HALF + wr * 64 + m * 16 + fr] * (1.0f / DM) + 1e-6f);
#pragma unroll
        for (int bj = 0; bj < 2; ++bj)
#pragma unroll
            for (int n = 0; n < 2; ++n) bv[bj][n] = *(const PG8_LAS f32x4*)(sx + 256 + bj * HALF + wc * 32 + 8 * fq + 4 * n);
    }
};
struct EpiAbIn {
    static constexpr bool PERM = true, AFTER_DRAIN = false, PREFETCH = true;
    bf16_t* U; bf16_t* Q; size_t qkv_stride;
    NormIn nin;
    __device__ __forceinline__ void prefetch(const Unit& u, PG8_LAS unsigned char* lds, int wv, int lane) const { nin.prefetch(u, lds, wv, lane); }
    __device__ __forceinline__ void half(const f32x4 (&acc)[2][2][4][2], const Unit& u, const int ai, int wr, int wc, int, int, PG8_LAS unsigned char* lds) const {
        const int lz = lane_id_opaque(), fr = lz & 15, fq = lz >> 4;
        const int row0 = u.pm * BM + wr * 64 + fr;
        bf16_t* base; int ldc, colt;
        if (u.pn < 2) { base = U; ldc = 512; colt = u.pn * BM; }
        else { const int t = (u.pn - 2) >> 2; base = Q + (size_t)t * qkv_stride; ldc = 1024; colt = ((u.pn - 2) & 3) * BM; }
        const int col0 = colt + wc * 32 + 8 * fq;
        float rs[4]; f32x4 bv[2][2]; nin.load(lds, ai, wr, wc, fr, fq, rs, bv);
#pragma unroll
        for (int m = 0; m < 4; ++m) { bf16_t* rowp = base + (size_t)(row0 + ai * HALF + m * 16) * ldc + col0;
#pragma unroll
            for (int bj = 0; bj < 2; ++bj) { const f32x4 v0 = acc[ai][bj][m][0] * rs[m] + bv[bj][0], v1 = acc[ai][bj][m][1] * rs[m] + bv[bj][1];
                u32x4 w; w.x = cvt_pk_bf16(v0[0], v0[1]); w.y = cvt_pk_bf16(v0[2], v0[3]); w.z = cvt_pk_bf16(v1[0], v1[1]); w.w = cvt_pk_bf16(v1[2], v1[3]);
                st16(rowp + bj * HALF, w); } }
    }
};
struct EpiRelu2 {
    static constexpr bool PERM = true, AFTER_DRAIN = false, PREFETCH = true;
    bf16_t* O; int ldc; NormIn nin;
    __device__ __forceinline__ void prefetch(const Unit& u, PG8_LAS unsigned char* lds, int wv, int lane) const { nin.prefetch(u, lds, wv, lane); }
    __device__ __forceinline__ void half(const f32x4 (&acc)[2][2][4][2], const Unit& u, const int ai, int wr, int wc, int, int, PG8_LAS unsigned char* lds) const {
        const int lz = lane_id_opaque(), fr = lz & 15, fq = lz >> 4;
        const int row0 = u.pm * BM + wr * 64 + fr, col0 = u.pn * BM + wc * 32 + 8 * fq;
        float rs[4]; f32x4 bv[2][2]; nin.load(lds, ai, wr, wc, fr, fq, rs, bv);
#pragma unroll
        for (int m = 0; m < 4; ++m) { bf16_t* rowp = O + (size_t)(row0 + ai * HALF + m * 16) * ldc + col0;
#pragma unroll
            for (int bj = 0; bj < 2; ++bj) { f32x4 v0 = acc[ai][bj][m][0] * rs[m] + bv[bj][0], v1 = acc[ai][bj][m][1] * rs[m] + bv[bj][1];
#pragma unroll
                for (int j = 0; j < 4; ++j) { const float a = fmaxf(v0[j], 0.f), b = fmaxf(v1[j], 0.f); v0[j] = a * a; v1[j] = b * b; }
                u32x4 w; w.x = cvt_pk_bf16(v0[0], v0[1]); w.y = cvt_pk_bf16(v0[2], v0[3]); w.z = cvt_pk_bf16(v1[0], v1[1]); w.w = cvt_pk_bf16(v1[2], v1[3]);
                st16(rowp + bj * HALF, w); } }
    }
};
struct EpiConvIn {
    static constexpr bool PERM = true, AFTER_DRAIN = false, PREFETCH = true;
    bf16_t* Z; bf16_t* GB; NormIn nin;
    __device__ __forceinline__ void prefetch(const Unit& u, PG8_LAS unsigned char* lds, int wv, int lane) const { nin.prefetch(u, lds, wv, lane); }
    __device__ __forceinline__ void half(const f32x4 (&acc)[2][2][4][2], const Unit& u, const int ai, int wr, int wc, int, int, PG8_LAS unsigned char* lds) const {
        const int lz = lane_id_opaque(), fr = lz & 15, fq = lz >> 4;
        const int row0 = u.pm * BM + wr * 64 + fr;
        float rs[4]; f32x4 bv[2][2]; nin.load(lds, ai, wr, wc, fr, fq, rs, bv);
        if (u.pn < 16) {
            const int col0 = u.pn * HALF + wc * 32 + 8 * fq;
#pragma unroll
            for (int m = 0; m < 4; ++m) { bf16_t* rowp = Z + (size_t)(row0 + ai * HALF + m * 16) * DM + col0;
                const f32x4 v0 = (acc[ai][0][m][0] * rs[m] + bv[0][0]) * (acc[ai][1][m][0] * rs[m] + bv[1][0]), v1 = (acc[ai][0][m][1] * rs[m] + bv[0][1]) * (acc[ai][1][m][1] * rs[m] + bv[1][1]);
                u32x2 wa, wb; wa.x = cvt_pk_bf16(v0[0], v0[1]); wa.y = cvt_pk_bf16(v0[2], v0[3]); wb.x = cvt_pk_bf16(v1[0], v1[1]); wb.y = cvt_pk_bf16(v1[2], v1[3]);
                st8(rowp, wa); st8(rowp + 4, wb); }
        } else {
            const int col0 = (u.pn - 16) * BM + wc * 32 + 8 * fq;
#pragma unroll
            for (int m = 0; m < 4; ++m) { bf16_t* rowp = GB + (size_t)(row0 + ai * HALF + m * 16) * DM + col0;
#pragma unroll
                for (int bj = 0; bj < 2; ++bj) { const f32x4 v0 = acc[ai][bj][m][0] * rs[m] + bv[bj][0], v1 = acc[ai][bj][m][1] * rs[m] + bv[bj][1];
                    u32x4 w; w.x = cvt_pk_bf16(v0[0], v0[1]); w.y = cvt_pk_bf16(v0[2], v0[3]); w.z = cvt_pk_bf16(v1[0], v1[1]); w.w = cvt_pk_bf16(v1[2], v1[3]);
                    st16(rowp + bj * HALF, w); } }
        }
    }
};
template <bool NEXT> struct EpiRes {
    static constexpr bool PERM = false, AFTER_DRAIN = false, PREFETCH = false;
    const float* base0; const float* base1; float* out; const float* gate;
    const float* gvn; bf16_t* Hn; float* ssqn;
    __device__ __forceinline__ void operator()(const f32x4 (&acc)[2][2][4][2], const Unit& u, int wr, int wc, int fr, int fq, PG8_LAS unsigned char* lds) const {
        const int row0 = u.pm * BM + wr * 64 + fr, col0 = u.pn * BM + wc * 32 + 4 * fq;
        const int j = ada_row_of_panel(u.pm);
        const float* g = gate + j * 12288 + col0;
        const char* bs = (const char*)(u.pm < 32 ? base0 : base1); char* ob = (char*)out; char* hb = (char*)Hn;
        const unsigned o0 = (unsigned)(row0 * DM + col0) * 4u;
        f32x4 gv[2][2], gn[2][2];
#pragma unroll
        for (int bj = 0; bj < 2; ++bj)
#pragma unroll
            for (int n = 0; n < 2; ++n) { gv[bj][n] = *(const f32x4*)(g + bj * HALF + n * 16); if (NEXT) gn[bj][n] = *(const f32x4*)(gvn + j * DM + col0 + bj * HALF + n * 16); }
#pragma unroll
        for (int am = 0; am < 4; ++am) { const int ai = am >> 1, mh = (am & 1) * 2;
            f32x4 b[2][2][2];
#pragma unroll
            for (int mm = 0; mm < 2; ++mm)
#pragma unroll
                for (int bj = 0; bj < 2; ++bj)
#pragma unroll
                    for (int n = 0; n < 2; ++n) b[mm][bj][n] = *(const f32x4*)(bs + (o0 + (unsigned)(((ai * HALF + (mh + mm) * 16) * DM + bj * HALF + n * 16) * 4)));
#pragma unroll
            for (int mm = 0; mm < 2; ++mm) { const int m = mh + mm; float sq = 0.f;
#pragma unroll
                for (int bj = 0; bj < 2; ++bj)
#pragma unroll
                    for (int n = 0; n < 2; ++n) { const unsigned o = o0 + (unsigned)(((ai * HALF + m * 16) * DM + bj * HALF + n * 16) * 4);
                        const f32x4 x = b[mm][bj][n] + gv[bj][n] * acc[ai][bj][m][n];
                        *(f32x4*)(ob + o) = x;
                        if (NEXT) { sq += (x[0] * x[0] + x[1] * x[1]) + (x[2] * x[2] + x[3] * x[3]); const f32x4 h = x * gn[bj][n];
                            typedef unsigned u32x2v __attribute__((ext_vector_type(2))); u32x2v w; w.x = cvt_pk_bf16(h[0], h[1]); w.y = cvt_pk_bf16(h[2], h[3]);
                            *(u32x2v*)(hb + (o >> 1)) = w; } }
                if (NEXT) {
                    auto t = __builtin_amdgcn_permlane16_swap(__float_as_uint(sq), __float_as_uint(sq), false, false); sq = __uint_as_float(t[0]) + __uint_as_float(t[1]);
                    auto v = __builtin_amdgcn_permlane32_swap(__float_as_uint(sq), __float_as_uint(sq), false, false); sq = __uint_as_float(v[0]) + __uint_as_float(v[1]);
                    if (fq == 0) __hip_atomic_fetch_add(ssqn + row0 + ai * HALF + m * 16, sq, __ATOMIC_RELAXED, __HIP_MEMORY_SCOPE_AGENT); } }
            asm volatile("" ::: "memory"); }
    }
};

template <class Epi, class Sched, bool ALIGN_EPI = false, bool SP2 = false>
__device__ __forceinline__ void gemm_phase(PG8_LAS unsigned char* lds, const Gemm g, const Sched& S, const Epi& E, const int wv  , unsigned long long* stamp = nullptr  ) {
    int wvo_ = wv; asm volatile("" : "+s"(wvo_));
    const int lane = lane_id_opaque(), wid = wvo_, tid = wid * 64 + lane, wr = wid >> 2, wc = wid & 3, fr = lane & 15, fq = lane >> 4;
    const int K = g.K, nt = K / BK;
    unsigned voffA[2], voffB[2];
#pragma unroll
    for (int i = 0; i < 2; ++i) { int R, C; stage_rc(tid * 16 + i * 8192, R, C); const int Rb = Epi::PERM ? ((R & ~31) + perm32(R & 31)) : R;
        voffA[i] = (unsigned)(R * K + C) * 2u; voffB[i] = (unsigned)(Rb * K + C) * 2u; }
    const size_t kstep = (size_t)(BK * 2);
    const size_t hstep = (size_t)HALF * K * 2;
    const size_t tstep = 2 * hstep;
    const unsigned ldsw = (unsigned)wid * 1024u;
    const int aoff = lds_byte(wr * 64 + fr, fq * 8), boff = lds_byte(wc * 32 + fr, fq * 8);
#define PG8_SA(b, h) (((b) * 2 + (h)) * HTB)
#define PG8_SB(b, h) ((4 + (b) * 2 + (h)) * HTB)
#define PG8_STAGE(bufoff, gbase, voff) do { _Pragma("unroll") for (int _i = 0; _i < 2; ++_i) \
        __builtin_amdgcn_global_load_lds((const unsigned*)((const char*)(gbase) + (voff)[_i]), (PG8_LAS unsigned*)(lds + (bufoff) + ldsw + _i * 8192), 16, 0, 0); } while (0)
#define PG8_LDA(dst, b, h) do { _Pragma("unroll") for (int m = 0; m < 4; ++m) _Pragma("unroll") for (int k = 0; k < 2; ++k) dst[m][k] = *(const PG8_LAS bf16x8*)(lds + PG8_SA(b, h) + aoff + m * 2048 + k * 1024); } while (0)
#define PG8_LDB(dst, b, h) do { _Pragma("unroll") for (int n = 0; n < 2; ++n) _Pragma("unroll") for (int k = 0; k < 2; ++k) dst[n][k] = *(const PG8_LAS bf16x8*)(lds + PG8_SB(b, h) + boff + n * 2048 + k * 1024); } while (0)
#define PG8_MMA(ai, bj, At, Bt) do { __builtin_amdgcn_s_setprio(1); _Pragma("unroll") for (int m = 0; m < 4; ++m) _Pragma("unroll") for (int n = 0; n < 2; ++n) _Pragma("unroll") for (int k = 0; k < 2; ++k) \
        acc[ai][bj][m][n] = __builtin_amdgcn_mfma_f32_16x16x32_bf16(Bt[n][k], At[m][k], acc[ai][bj][m][n], 0, 0, 0); __builtin_amdgcn_s_setprio(0); } while (0)
#define PG8_MMA2B(ai, At, B0, B1) do { __builtin_amdgcn_s_setprio(1); \
        _Pragma("unroll") for (int m = 0; m < 4; ++m) _Pragma("unroll") for (int n = 0; n < 2; ++n) _Pragma("unroll") for (int k = 0; k < 2; ++k) acc[ai][0][m][n] = __builtin_amdgcn_mfma_f32_16x16x32_bf16(B0[n][k], At[m][k], acc[ai][0][m][n], 0, 0, 0); \
        _Pragma("unroll") for (int m = 0; m < 4 - PG8_EARLY; ++m) _Pragma("unroll") for (int n = 0; n < 2; ++n) _Pragma("unroll") for (int k = 0; k < 2; ++k) acc[ai][1][m][n] = __builtin_amdgcn_mfma_f32_16x16x32_bf16(B1[n][k], At[m][k], acc[ai][1][m][n], 0, 0, 0); \
        __builtin_amdgcn_sched_barrier(0); __builtin_amdgcn_s_barrier(); __builtin_amdgcn_sched_barrier(0); \
        _Pragma("unroll") for (int m = 4 - PG8_EARLY; m < 4; ++m) _Pragma("unroll") for (int n = 0; n < 2; ++n) _Pragma("unroll") for (int k = 0; k < 2; ++k) acc[ai][1][m][n] = __builtin_amdgcn_mfma_f32_16x16x32_bf16(B1[n][k], At[m][k], acc[ai][1][m][n], 0, 0, 0); \
        __builtin_amdgcn_s_setprio(0); } while (0)
#define PG8_WAIT_V(n) asm volatile("s_waitcnt vmcnt(" #n ")" ::: "memory")
#define PG8_WAIT_L(n) asm volatile("s_waitcnt lgkmcnt(" #n ")" ::: "memory")
#define PG8_BAR __builtin_amdgcn_s_barrier()
#define PG8_SCHED __builtin_amdgcn_sched_barrier(0)
    Unit cur, nxt; int ui = 0;
    if (!S.next(0, cur)) return;
    f32x4 acc[2][2][4][2];
#pragma unroll
    for (int a = 0; a < 2; ++a)
#pragma unroll
        for (int b = 0; b < 2; ++b)
#pragma unroll
            for (int m = 0; m < 4; ++m)
#pragma unroll
                for (int n = 0; n < 2; ++n) acc[a][b][m][n] = (f32x4){0.f, 0.f, 0.f, 0.f};
    bf16x8 At[4][2], B0[2][2], B1[2][2];
    const char* cA = (const char*)g.A + (size_t)cur.pm * tstep; const char* cB = (const char*)g.Bt + (size_t)cur.pn * tstep;
    S.a_ready(cur);
    if constexpr (SP2) {
        PG8_STAGE(PG8_SB(0, 0), cB, voffB); PG8_STAGE(PG8_SB(0, 1), cB + hstep, voffB); PG8_STAGE(PG8_SA(0, 0), cA, voffA); PG8_STAGE(PG8_SA(0, 1), cA + hstep, voffA);
        if (wr == 1) PG8_BAR;
        PG8_WAIT_V(2); PG8_BAR;
        PG8_STAGE(PG8_SB(1, 0), cB + kstep, voffB); PG8_STAGE(PG8_SA(1, 0), cA + kstep, voffA); PG8_STAGE(PG8_SB(1, 1), cB + hstep + kstep, voffB);
        PG8_WAIT_V(6); PG8_BAR;
    } else {
        PG8_STAGE(PG8_SB(0, 0), cB, voffB); PG8_STAGE(PG8_SA(0, 0), cA, voffA); PG8_STAGE(PG8_SB(0, 1), cB + hstep, voffB); PG8_STAGE(PG8_SA(0, 1), cA + hstep, voffA);
        if (wr == 1) PG8_BAR;
        PG8_WAIT_V(4); PG8_BAR;
        PG8_STAGE(PG8_SB(1, 0), cB + kstep, voffB); PG8_STAGE(PG8_SA(1, 0), cA + kstep, voffA); PG8_STAGE(PG8_SB(1, 1), cB + hstep + kstep, voffB);
        PG8_WAIT_V(6); PG8_BAR;
    }
    unsigned long long st_tk = 0, st_ck = 0, st_te = 0;
    for (;;) {
        const bool has_next = S.next(ui + 1, nxt);
        unsigned long long st_r0 = 0, st_c0 = 0; if (stamp) { st_r0 = __builtin_amdgcn_s_memrealtime(); st_c0 = __builtin_readcyclecounter(); }
        const char* nA = has_next ? (const char*)g.A + (size_t)nxt.pm * tstep : cA; const char* nB = has_next ? (const char*)g.Bt + (size_t)nxt.pn * tstep : cB;
        for (int t = 0; t < nt; t += 2) {
            const bool last = (t == nt - 2);
            const char* a1 = cA + (size_t)(t + 1) * kstep;
            const char* a2 = last ? nA : cA + (size_t)(t + 2) * kstep; const char* b2 = last ? nB : cB + (size_t)(t + 2) * kstep;
            const char* a3 = a2 + kstep; const char* b3 = b2 + kstep;
            if (last && has_next) S.a_ready(nxt);
            if constexpr (SP2) {
            PG8_LDB(B0, 0, 0); PG8_LDB(B1, 0, 1); PG8_SCHED; PG8_LDA(At, 0, 0); PG8_STAGE(PG8_SA(1, 1), a1 + hstep, voffA);
            PG8_WAIT_V(8); PG8_WAIT_L(0); PG8_BAR; PG8_MMA2B(0, At, B0, B1); PG8_SCHED;
            PG8_LDA(At, 0, 1); PG8_STAGE(PG8_SB(0, 0), b2, voffB); PG8_STAGE(PG8_SB(0, 1), b2 + hstep, voffB); PG8_STAGE(PG8_SA(0, 0), a2, voffA);
            PG8_WAIT_V(8); PG8_WAIT_L(0); PG8_BAR; PG8_MMA2B(1, At, B0, B1); PG8_SCHED;
            PG8_LDB(B0, 1, 0); PG8_LDB(B1, 1, 1); PG8_SCHED; PG8_LDA(At, 1, 0); PG8_STAGE(PG8_SA(0, 1), a2 + hstep, voffA);
            PG8_WAIT_V(8); PG8_WAIT_L(0); PG8_BAR; PG8_MMA2B(0, At, B0, B1); PG8_SCHED;
            PG8_LDA(At, 1, 1); PG8_STAGE(PG8_SB(1, 0), b3, voffB); PG8_STAGE(PG8_SB(1, 1), b3 + hstep, voffB); PG8_STAGE(PG8_SA(1, 0), a3, voffA);
            PG8_WAIT_V(8); PG8_WAIT_L(0); PG8_BAR; PG8_MMA2B(1, At, B0, B1); PG8_SCHED;
            } else {
            PG8_LDB(B0, 0, 0); PG8_SCHED; PG8_LDA(At, 0, 0); PG8_STAGE(PG8_SA(1, 1), a1 + hstep, voffA);
            PG8_WAIT_L(8); PG8_BAR; PG8_WAIT_L(0); PG8_MMA(0, 0, At, B0); PG8_BAR; PG8_SCHED;
            PG8_LDB(B1, 0, 1); PG8_STAGE(PG8_SB(0, 0), b2, voffB);
            PG8_BAR; PG8_WAIT_L(0); PG8_MMA(0, 1, At, B1); PG8_BAR;
            PG8_LDA(At, 0, 1); PG8_STAGE(PG8_SA(0, 0), a2, voffA);
            PG8_BAR; PG8_WAIT_L(0); PG8_MMA(1, 0, At, B0); PG8_BAR; PG8_SCHED;
            PG8_STAGE(PG8_SB(0, 1), b2 + hstep, voffB);
            PG8_WAIT_V(6); PG8_BAR; PG8_MMA(1, 1, At, B1); PG8_BAR;
            PG8_LDB(B0, 1, 0); PG8_SCHED; PG8_LDA(At, 1, 0); PG8_STAGE(PG8_SA(0, 1), a2 + hstep, voffA);
            PG8_WAIT_L(8); PG8_BAR; PG8_WAIT_L(0); PG8_MMA(0, 0, At, B0); PG8_BAR; PG8_SCHED;
            PG8_LDB(B1, 1, 1); PG8_STAGE(PG8_SB(1, 0), b3, voffB);
            PG8_BAR; PG8_WAIT_L(0); PG8_MMA(0, 1, At, B1); PG8_BAR;
            PG8_LDA(At, 1, 1); PG8_STAGE(PG8_SA(1, 0), a3, voffA);
            PG8_BAR; PG8_WAIT_L(0); PG8_MMA(1, 0, At, B0); PG8_BAR; PG8_SCHED;
            PG8_STAGE(PG8_SB(1, 1), b3 + hstep, voffB);
            PG8_WAIT_V(6); PG8_BAR; PG8_MMA(1, 1, At, B1); PG8_BAR;
            }
        }
        unsigned long long st_r1 = 0; if (stamp) { st_r1 = __builtin_amdgcn_s_memrealtime(); st_tk += st_r1 - st_r0; st_ck += __builtin_readcyclecounter() - st_c0; }
        if constexpr (ALIGN_EPI) { if (wr == 0) PG8_BAR; }
        if constexpr (!Epi::AFTER_DRAIN) { E(acc, cur, wr, wc, fr, fq, lds); S.done(cur); }
        if (stamp) st_te += __builtin_amdgcn_s_memrealtime() - st_r1;
        if (!has_next) break;
#pragma unroll
        for (int a = 0; a < 2; ++a)
#pragma unroll
            for (int b = 0; b < 2; ++b)
#pragma unroll
                for (int m = 0; m < 4; ++m)
#pragma unroll
                    for (int n = 0; n < 2; ++n) acc[a][b][m][n] = (f32x4){0.f, 0.f, 0.f, 0.f};
        cur = nxt; cA = nA; cB = nB; ++ui;
        if constexpr (ALIGN_EPI) { if (wr == 1) PG8_BAR; }
    }
    PG8_WAIT_V(0);
    if constexpr (!ALIGN_EPI) { if (wr == 0) PG8_BAR; }
    PG8_BAR;
    if (stamp && wid == 0 && lane == 0 && blockIdx.x == 0) { atomicAdd(stamp, st_tk); atomicAdd(stamp + 1, st_ck); atomicAdd(stamp + 2, st_te); }
    if constexpr (Epi::AFTER_DRAIN) { E.fused(acc, cur, wr, wc, fr, fq, lds, wid, lane); S.done(cur); }
#undef PG8_SA
#undef PG8_SB
#undef PG8_STAGE
#undef PG8_LDA
#undef PG8_LDB
#undef PG8_MMA
#undef PG8_MMA2B
#undef PG8_WAIT_V
#undef PG8_WAIT_L
#undef PG8_BAR
#undef PG8_SCHED
}

template <class Epi, class Sched>
__device__ __forceinline__ void gemm_phase_i(PG8_LAS unsigned char* lds, const Gemm g, const Sched& S, const Epi& E, const int wv, unsigned long long* stamp = nullptr) {
    int wvo_ = wv; asm volatile("" : "+s"(wvo_));
    const int lane = lane_id_opaque(), wid = wvo_, tid = wid * 64 + lane, wr = wid >> 2, wc = wid & 3, fr = lane & 15, fq = lane >> 4;
    const int K = g.K, nt = K / BK;
    unsigned voffA[2], voffB[2];
#pragma unroll
    for (int i = 0; i < 2; ++i) { int R, C; stage_rc(tid * 16 + i * 8192, R, C); const int Rb = Epi::PERM ? ((R & ~31) + perm32(R & 31)) : R;
        voffA[i] = (unsigned)(R * K + C) * 2u; voffB[i] = (unsigned)(Rb * K + C) * 2u; }
    const size_t kstep = (size_t)(BK * 2), hstep = (size_t)HALF * K * 2, tstep = 2 * hstep;
    const unsigned ldsw = (unsigned)wid * 1024u;
    const int aoff = lds_byte(wr * 64 + fr, fq * 8), boff = lds_byte(wc * 32 + fr, fq * 8);
#define PG8_SA(b, h) (((b) * 2 + (h)) * HTB)
#define PG8_SB(b, h) ((4 + (b) * 2 + (h)) * HTB)
#define PG8_STAGE(bufoff, gbase, voff) do { _Pragma("unroll") for (int _i = 0; _i < 2; ++_i) \
        __builtin_amdgcn_global_load_lds((const unsigned*)((const char*)(gbase) + (voff)[_i]), (PG8_LAS unsigned*)(lds + (bufoff) + ldsw + _i * 8192), 16, 0, 0); } while (0)
#define PG8_LDA(dst, b, h) do { _Pragma("unroll") for (int m = 0; m < 4; ++m) _Pragma("unroll") for (int k = 0; k < 2; ++k) dst[m][k] = *(const PG8_LAS bf16x8*)(lds + PG8_SA(b, h) + aoff + m * 2048 + k * 1024); } while (0)
#define PG8_LDB(dst, b, h) do { _Pragma("unroll") for (int n = 0; n < 2; ++n) _Pragma("unroll") for (int k = 0; k < 2; ++k) dst[n][k] = *(const PG8_LAS bf16x8*)(lds + PG8_SB(b, h) + boff + n * 2048 + k * 1024); } while (0)
#define PG8_MMA(ai, bj, At, Bt) do { __builtin_amdgcn_s_setprio(1); _Pragma("unroll") for (int m = 0; m < 4; ++m) _Pragma("unroll") for (int n = 0; n < 2; ++n) _Pragma("unroll") for (int k = 0; k < 2; ++k) \
        acc[ai][bj][m][n] = __builtin_amdgcn_mfma_f32_16x16x32_bf16(Bt[n][k], At[m][k], acc[ai][bj][m][n], 0, 0, 0); __builtin_amdgcn_s_setprio(0); } while (0)
#define PG8_MMA2B(ai, At, B0, B1) do { __builtin_amdgcn_s_setprio(1); \
        _Pragma("unroll") for (int m = 0; m < 4; ++m) _Pragma("unroll") for (int n = 0; n < 2; ++n) _Pragma("unroll") for (int k = 0; k < 2; ++k) acc[ai][0][m][n] = __builtin_amdgcn_mfma_f32_16x16x32_bf16(B0[n][k], At[m][k], acc[ai][0][m][n], 0, 0, 0); \
        _Pragma("unroll") for (int m = 0; m < 4 - PG8_EARLY; ++m) _Pragma("unroll") for (int n = 0; n < 2; ++n) _Pragma("unroll") for (int k = 0; k < 2; ++k) acc[ai][1][m][n] = __builtin_amdgcn_mfma_f32_16x16x32_bf16(B1[n][k], At[m][k], acc[ai][1][m][n], 0, 0, 0); \
        __builtin_amdgcn_sched_barrier(0); __builtin_amdgcn_s_barrier(); __builtin_amdgcn_sched_barrier(0); \
        _Pragma("unroll") for (int m = 4 - PG8_EARLY; m < 4; ++m) _Pragma("unroll") for (int n = 0; n < 2; ++n) _Pragma("unroll") for (int k = 0; k < 2; ++k) acc[ai][1][m][n] = __builtin_amdgcn_mfma_f32_16x16x32_bf16(B1[n][k], At[m][k], acc[ai][1][m][n], 0, 0, 0); \
        __builtin_amdgcn_s_setprio(0); } while (0)
#define PG8_WAIT_V(n) asm volatile("s_waitcnt vmcnt(" #n ")" ::: "memory")
#define PG8_WAIT_L(n) asm volatile("s_waitcnt lgkmcnt(" #n ")" ::: "memory")
#define PG8_BAR __builtin_amdgcn_s_barrier()
#define PG8_SCHED __builtin_amdgcn_sched_barrier(0)
#define PG8_ZERO(ai) do { _Pragma("unroll") for (int b_ = 0; b_ < 2; ++b_) _Pragma("unroll") for (int m_ = 0; m_ < 4; ++m_) _Pragma("unroll") for (int n_ = 0; n_ < 2; ++n_) acc[ai][b_][m_][n_] = (f32x4){0.f, 0.f, 0.f, 0.f}; } while (0)
#define PG8_TRIP(EA, EB, W1, W2, W3, W4) do { \
        PG8_LDB(B0, 0, 0); PG8_LDB(B1, 0, 1); PG8_SCHED; PG8_LDA(At, 0, 0); PG8_STAGE(PG8_SA(1, 1), a1 + hstep, voffA); PG8_SCHED; EA; PG8_SCHED; \
        PG8_WAIT_V(W1); PG8_WAIT_L(0); PG8_BAR; PG8_MMA2B(0, At, B0, B1); PG8_SCHED; \
        PG8_LDA(At, 0, 1); PG8_STAGE(PG8_SB(0, 0), b2, voffB); PG8_STAGE(PG8_SB(0, 1), b2 + hstep, voffB); PG8_STAGE(PG8_SA(0, 0), a2, voffA); PG8_SCHED; EB; PG8_SCHED; \
        PG8_WAIT_V(W2); PG8_WAIT_L(0); PG8_BAR; PG8_MMA2B(1, At, B0, B1); PG8_SCHED; \
        PG8_LDB(B0, 1, 0); PG8_LDB(B1, 1, 1); PG8_SCHED; PG8_LDA(At, 1, 0); PG8_STAGE(PG8_SA(0, 1), a2 + hstep, voffA); \
        PG8_WAIT_V(W3); PG8_WAIT_L(0); PG8_BAR; PG8_MMA2B(0, At, B0, B1); PG8_SCHED; \
        PG8_LDA(At, 1, 1); PG8_STAGE(PG8_SB(1, 0), b3, voffB); PG8_STAGE(PG8_SB(1, 1), b3 + hstep, voffB); PG8_STAGE(PG8_SA(1, 0), a3, voffA); \
        PG8_WAIT_V(W4); PG8_WAIT_L(0); PG8_BAR; PG8_MMA2B(1, At, B0, B1); PG8_SCHED; } while (0)
    Unit cur, nxt, prv; int ui = 0;
    if (!S.next(0, cur)) return;
    prv = cur;
    f32x4 acc[2][2][4][2];
    PG8_ZERO(0); PG8_ZERO(1);
    bf16x8 At[4][2], B0[2][2], B1[2][2];
    const char* cA = (const char*)g.A + (size_t)cur.pm * tstep; const char* cB = (const char*)g.Bt + (size_t)cur.pn * tstep;
    S.a_ready(cur);
    PG8_STAGE(PG8_SB(0, 0), cB, voffB); PG8_STAGE(PG8_SB(0, 1), cB + hstep, voffB); PG8_STAGE(PG8_SA(0, 0), cA, voffA); PG8_STAGE(PG8_SA(0, 1), cA + hstep, voffA);
    if (wr == 1) PG8_BAR;
    PG8_WAIT_V(2); PG8_BAR;
    PG8_STAGE(PG8_SB(1, 0), cB + kstep, voffB); PG8_STAGE(PG8_SA(1, 0), cA + kstep, voffA); PG8_STAGE(PG8_SB(1, 1), cB + hstep + kstep, voffB);
    PG8_WAIT_V(6); PG8_BAR;
    unsigned long long st_tk = 0, st_ck = 0, st_te = 0;
    for (;;) {
        const bool has_next = S.next(ui + 1, nxt);
        unsigned long long st_r0 = 0, st_c0 = 0; if (stamp) { st_r0 = __builtin_amdgcn_s_memrealtime(); st_c0 = __builtin_readcyclecounter(); }
        const char* nA = has_next ? (const char*)g.A + (size_t)nxt.pm * tstep : cA; const char* nB = has_next ? (const char*)g.Bt + (size_t)nxt.pn * tstep : cB;
        {
            const char* a1 = cA + kstep; const char* a2 = cA + 2 * kstep; const char* b2 = cB + 2 * kstep; const char* a3 = a2 + kstep; const char* b3 = b2 + kstep;
            unsigned long long st_f0 = 0; if (stamp) st_f0 = __builtin_amdgcn_s_memrealtime();
            const bool epi = ui > 0;
            PG8_STAGE(PG8_SA(1, 1), a1 + hstep, voffA); PG8_SCHED;
            if (epi) { E.half(acc, prv, 0, wr, wc, fr, fq, lds); PG8_ZERO(0); } PG8_SCHED;
            PG8_LDB(B0, 0, 0); PG8_LDB(B1, 0, 1); PG8_SCHED; PG8_LDA(At, 0, 0);
            if (epi) { PG8_WAIT_V(16); } else { PG8_WAIT_V(8); }
            PG8_WAIT_L(0); PG8_BAR; PG8_MMA2B(0, At, B0, B1); PG8_SCHED;
            PG8_STAGE(PG8_SB(0, 0), b2, voffB); PG8_STAGE(PG8_SB(0, 1), b2 + hstep, voffB); PG8_STAGE(PG8_SA(0, 0), a2, voffA); PG8_SCHED;
            if (epi) { E.half(acc, prv, 1, wr, wc, fr, fq, lds); PG8_ZERO(1); } PG8_SCHED;
            PG8_LDA(At, 0, 1);
            if (epi) { PG8_WAIT_V(24); } else { PG8_WAIT_V(8); }
            PG8_WAIT_L(0); PG8_BAR; PG8_MMA2B(1, At, B0, B1); PG8_SCHED;
            PG8_LDB(B0, 1, 0); PG8_LDB(B1, 1, 1); PG8_SCHED; PG8_LDA(At, 1, 0); PG8_STAGE(PG8_SA(0, 1), a2 + hstep, voffA);
            if (epi) { PG8_WAIT_V(24); } else { PG8_WAIT_V(8); }
            PG8_WAIT_L(0); PG8_BAR; PG8_MMA2B(0, At, B0, B1); PG8_SCHED;
            PG8_LDA(At, 1, 1); PG8_STAGE(PG8_SB(1, 0), b3, voffB); PG8_STAGE(PG8_SB(1, 1), b3 + hstep, voffB); PG8_STAGE(PG8_SA(1, 0), a3, voffA);
            if (epi) { PG8_WAIT_V(16); } else { PG8_WAIT_V(8); }
            PG8_WAIT_L(0); PG8_BAR; PG8_MMA2B(1, At, B0, B1); PG8_SCHED;
            if (stamp && epi) st_te += __builtin_amdgcn_s_memrealtime() - st_f0;
        }
        for (int t = 2; t < nt; t += 2) {
            const bool last = (t == nt - 2);
            const char* a1 = cA + (size_t)(t + 1) * kstep;
            const char* a2 = last ? nA : cA + (size_t)(t + 2) * kstep; const char* b2 = last ? nB : cB + (size_t)(t + 2) * kstep;
            const char* a3 = a2 + kstep; const char* b3 = b2 + kstep;
            if (last && has_next) S.a_ready(nxt);
            if (last) E.prefetch(cur, lds, wid, lane);
            PG8_TRIP((void)0, (void)0, 8, 8, 8, 8);
        }
        if (stamp) { const unsigned long long st_r1 = __builtin_amdgcn_s_memrealtime(); st_tk += st_r1 - st_r0; st_ck += __builtin_readcyclecounter() - st_c0; }
        if (!has_next) break;
        prv = cur; cur = nxt; cA = nA; cB = nB; ++ui;
    }
    { unsigned long long st_r1 = 0; if (stamp) st_r1 = __builtin_amdgcn_s_memrealtime();
      E.half(acc, cur, 0, wr, wc, fr, fq, lds); E.half(acc, cur, 1, wr, wc, fr, fq, lds); S.done(cur);
      (void)st_r1; }
    PG8_WAIT_V(0);
    if (wr == 0) PG8_BAR;
    PG8_BAR;
    if (stamp && wid == 0 && lane == 0) { if (blockIdx.x == 0) { atomicAdd(stamp, st_tk); atomicAdd(stamp + 1, st_ck); atomicAdd(stamp + 2, st_te); } atomicAdd(stamp + 8 + blockIdx.x, st_tk); }
#undef PG8_TRIP
#undef PG8_ZERO
#undef PG8_SA
#undef PG8_SB
#undef PG8_STAGE
#undef PG8_LDA
#undef PG8_LDB
#undef PG8_MMA
#undef PG8_MMA2B
#undef PG8_WAIT_V
#undef PG8_WAIT_L
#undef PG8_BAR
#undef PG8_SCHED
}
}

#define GAS __attribute__((address_space(1)))
#define LAS __attribute__((address_space(3)))
typedef unsigned short bf16_t;
typedef short bf16x8 __attribute__((ext_vector_type(8)));
typedef short s16x4 __attribute__((ext_vector_type(4)));
typedef float f32x4 __attribute__((ext_vector_type(4)));
typedef float f32x16 __attribute__((ext_vector_type(16)));
typedef unsigned u32x4 __attribute__((ext_vector_type(4)));
typedef unsigned u32x2 __attribute__((ext_vector_type(2)));
#define SBAR() __builtin_amdgcn_sched_barrier(0)
__device__ __forceinline__ unsigned cvtpk(float lo, float hi) { unsigned r; asm volatile("v_cvt_pk_bf16_f32 %0, %1, %2" : "=v"(r) : "v"(lo), "v"(hi)); return r; }
__device__ __forceinline__ float bf2f(unsigned short b) { return __uint_as_float(((unsigned)b) << 16); }
__device__ __forceinline__ float bflo(unsigned w) { return __uint_as_float(w << 16); }
__device__ __forceinline__ float bfhi(unsigned w) { return __uint_as_float(w & 0xffff0000u); }
__device__ __forceinline__ unsigned short f2bf(float f) { return (unsigned short)(cvtpk(f, 0.f) & 0xffffu); }

namespace att {
constexpr int D = 128, NW = 8, QBLK = 32, KVBLK = 64, LD = 1024;
constexpr float SCALE = 0.088388347648318440f, THR = 8.f;
constexpr int SHM_V = KVBLK * D * 2, SHM_K = KVBLK * D * 2;
constexpr int OFF_V = 0, OFF_K = 2 * SHM_V, OFF_Q = 2 * SHM_V + 2 * SHM_K  , OFF_WS = 134144  , OFF_BIAS = OFF_WS + NW * 64 * 4, OFF_GK = OFF_BIAS + 16 * 32 * 4  , LDS_BYTES = OFF_GK + 128 * 4;
#define KSWZ(row, colB) ((row) * 256 + ((colB) ^ (((row) & 7) << 4)))
__device__ __forceinline__ int crow(int r, int hi) { return (r & 3) + 8 * (r >> 2) + 4 * hi; }

__device__ __forceinline__ void partialSM(f32x16& p0, f32x16& p1, float& m_reg, float& mn, float& alpha) {
  constexpr float C = SCALE * 1.4426950408889634f;
  float pmax = p0[0];
#pragma unroll
  for (int r = 1; r < 16; ++r) pmax = fmaxf(pmax, p0[r]);
#pragma unroll
  for (int r = 0; r < 16; ++r) pmax = fmaxf(pmax, p1[r]);
  { auto rr = __builtin_amdgcn_permlane32_swap(__float_as_uint(pmax), __float_as_uint(pmax), false, false);
    pmax = fmaxf(__uint_as_float(rr[0]), __uint_as_float(rr[1])); }
  if (__builtin_expect(__all(pmax - m_reg <= THR / SCALE), 1)) { mn = m_reg; alpha = 1.f; }
  else { mn = fmaxf(m_reg, pmax); alpha = __builtin_amdgcn_exp2f((m_reg - mn) * C); m_reg = mn; }
  float mnC = -mn * C;
#pragma unroll
  for (int r = 0; r < 16; ++r) p0[r] = fmaf(p0[r], C, mnC);
#pragma unroll
  for (int r = 0; r < 16; ++r) p1[r] = fmaf(p1[r], C, mnC);
#pragma unroll
  for (int r = 0; r < 16; ++r) p0[r] = __builtin_amdgcn_exp2f(p0[r]);
}
__device__ __forceinline__ void finishSM(f32x16& p0, f32x16& p1, float alpha, float& l_reg, bf16x8& pa0, bf16x8& pa1, bf16x8& pa2, bf16x8& pa3) {
#pragma unroll
  for (int r = 0; r < 16; ++r) p1[r] = __builtin_amdgcn_exp2f(p1[r]);
  float ps = 0;
#pragma unroll
  for (int r = 0; r < 16; ++r) ps += p0[r];
#pragma unroll
  for (int r = 0; r < 16; ++r) ps += p1[r];
  { auto rr = __builtin_amdgcn_permlane32_swap(__float_as_uint(ps), __float_as_uint(ps), false, false);
    ps = __uint_as_float(rr[0]) + __uint_as_float(rr[1]); }
  l_reg = l_reg * alpha + ps;
#define PK4(P, BASE, OUT) do { unsigned a0 = cvtpk(P[BASE + 0], P[BASE + 1]), a1 = cvtpk(P[BASE + 2], P[BASE + 3]);   \
    unsigned b0 = cvtpk(P[BASE + 4], P[BASE + 5]), b1 = cvtpk(P[BASE + 6], P[BASE + 7]);                              \
    auto r0 = __builtin_amdgcn_permlane32_swap(a0, b0, false, false); auto r1 = __builtin_amdgcn_permlane32_swap(a1, b1, false, false); \
    u32x4 w = {r0[0], r1[0], r0[1], r1[1]}; OUT = *reinterpret_cast<bf16x8*>(&w); } while (0)
  PK4(p0, 0, pa0); PK4(p0, 8, pa1); PK4(p1, 0, pa2); PK4(p1, 8, pa3);
#undef PK4
}
__device__ __forceinline__ void qkt(f32x16& p0, f32x16& p1, const LAS char* Ks, const LAS char* Qs, int r32, int hi) {
  p0 = f32x16{}; p1 = f32x16{};
#pragma unroll
  for (int d0 = 0; d0 < 8; ++d0) { const int cb = (d0 * 16 + hi * 8) * 2;
    const bf16x8 b0 = *(const LAS bf16x8*)(Ks + KSWZ(r32, cb));
    const bf16x8 b1 = *(const LAS bf16x8*)(Ks + KSWZ(32 + r32, cb));
    const bf16x8 q = *(const LAS bf16x8*)(Qs + KSWZ(r32, cb));
    p0 = __builtin_amdgcn_mfma_f32_32x32x16_bf16(b0, q, p0, 0, 0, 0);
    p1 = __builtin_amdgcn_mfma_f32_32x32x16_bf16(b1, q, p1, 0, 0, 0); }
}
__device__ __forceinline__ int v_st(int k, int c) { const int kk = (k & ~0xC) | ((k & 4) << 1) | ((k & 8) >> 1); return ((kk >> 3) * 4 + (c >> 5)) * 512 + ((kk & 7) * 32 + (c & 31)) * 2; }
__device__ __forceinline__ int v_rd_base(int lane) { return ((lane & 3) << 3) | (((lane >> 2) & 3) << 6) | (((lane >> 4) & 1) << 5) | (((lane >> 5) & 1) << 8); }
constexpr int v_rd_off(int d0, int ks, int half) { return d0 * 512 + ks * 4096 + half * 2048; }
template <int OFF> __device__ __forceinline__ s16x4 tr_read(int vb) {
  s16x4 r; asm volatile("ds_read_b64_tr_b16 %0, %1 offset:%2" : "=&v"(r) : "v"(vb), "i"(OFF) : "memory"); return r;
}
template <int D0> __device__ __forceinline__ void pv_one(f32x16& od, int vb, bf16x8 pa0, bf16x8 pa1, bf16x8 pa2, bf16x8 pa3) {
  const s16x4 l0 = tr_read<v_rd_off(D0, 0, 0)>(vb), h0 = tr_read<v_rd_off(D0, 0, 1)>(vb), l1 = tr_read<v_rd_off(D0, 1, 0)>(vb), h1 = tr_read<v_rd_off(D0, 1, 1)>(vb);
  const s16x4 l2 = tr_read<v_rd_off(D0, 2, 0)>(vb), h2 = tr_read<v_rd_off(D0, 2, 1)>(vb), l3 = tr_read<v_rd_off(D0, 3, 0)>(vb), h3 = tr_read<v_rd_off(D0, 3, 1)>(vb);
  asm volatile("s_waitcnt lgkmcnt(0)" ::: "memory"); SBAR();
#define PK(L, H) (bf16x8){L[0], L[1], L[2], L[3], H[0], H[1], H[2], H[3]}
  od = __builtin_amdgcn_mfma_f32_32x32x16_bf16(pa0, PK(l0, h0), od, 0, 0, 0);
  od = __builtin_amdgcn_mfma_f32_32x32x16_bf16(pa1, PK(l1, h1), od, 0, 0, 0);
  od = __builtin_amdgcn_mfma_f32_32x32x16_bf16(pa2, PK(l2, h2), od, 0, 0, 0);
  od = __builtin_amdgcn_mfma_f32_32x32x16_bf16(pa3, PK(l3, h3), od, 0, 0, 0);
#undef PK
}
__device__ __forceinline__ void pv_d0(f32x16* o, int vb, bf16x8 pa0, bf16x8 pa1, bf16x8 pa2, bf16x8 pa3) {
  pv_one<0>(o[0], vb, pa0, pa1, pa2, pa3); pv_one<1>(o[1], vb, pa0, pa1, pa2, pa3); pv_one<2>(o[2], vb, pa0, pa1, pa2, pa3); pv_one<3>(o[3], vb, pa0, pa1, pa2, pa3);
}

__device__ __forceinline__ void na_mask(f32x16& p0, f32x16& p1, int kr, int qrow, int qc, unsigned cmask, int hi, const LAS float* biasL) {
  int r0 = qrow - 4; r0 = r0 < 0 ? 0 : (r0 > 56 ? 56 : r0);
  const bool rowok = (kr >= r0) && (kr < r0 + 8);
  const unsigned em = rowok ? cmask : 0u;
  const int dr = rowok ? (kr - qrow + 7) : 0;
  const LAS float* brow = biasL + dr * 32 + (15 - qc + 4 * hi);
#pragma unroll
  for (int i4 = 0; i4 < 4; ++i4) {
#pragma unroll
    for (int ii = 0; ii < 4; ++ii) { const int i = i4 * 4 + ii, kc = (i & 3) + 8 * (i >> 2);
      const bool ok0 = (em >> i) & 1u, ok1 = (em >> (16 + i)) & 1u;
      const float b0 = brow[kc], b1 = brow[kc + 32];
      p0[i] = ok0 ? p0[i] + b0 : -1e30f; p1[i] = ok1 ? p1[i] + b1 : -1e30f; }
    asm volatile("" ::: "memory"); }
}

template <bool NA, int SDEPTH>
__device__ __forceinline__ void attn_unit(LAS char* lds, const bf16_t* __restrict__ Qb, const bf16_t* __restrict__ K0, const bf16_t* __restrict__ V0, int nt0,
                                          const bf16_t* __restrict__ K1, const bf16_t* __restrict__ V1, int NT, bf16_t* __restrict__ Ob, int ldo, int R, int kr0, const int wv,
                                          const float* __restrict__ gq, float* __restrict__ ck_out, float* __restrict__ cv_out, const bool knorm0) {
  const int lane = lane_id_opaque(), wid = wv, tid = wv * 64 + lane, r32 = lane & 31, hi = lane >> 5;
  LAS char* V_lds = lds + OFF_V; LAS char* K_lds = lds + OFF_K;
  LAS float* ws = (LAS float*)(lds + OFF_WS) + wid * 64; LAS float* li_l = ws; LAS float* al_l = ws + 32;
  const LAS float* biasL = (const LAS float*)(lds + OFF_BIAS); const LAS f32x4* gkL = (const LAS f32x4*)(lds + OFF_GK);
  float m_reg = -1e30f, l_reg = 0; f32x16 o[4] = {};
  LAS char* Q_lds = lds + OFF_Q + wid * 8192;
  { const bf16_t* Qw = Qb + (long)(wid * QBLK + r32) * LD + hi * 8; u32x4 qt[8]; float ss = 0.f;
#pragma unroll
    for (int d0 = 0; d0 < 8; ++d0) { qt[d0] = *(const u32x4*)(Qw + d0 * 16);
#pragma unroll
      for (int i = 0; i < 4; ++i) { const float a = bflo(qt[d0][i]), b = bfhi(qt[d0][i]); ss += a * a + b * b; } }
    { auto rr = __builtin_amdgcn_permlane32_swap(__float_as_uint(ss), __float_as_uint(ss), false, false); ss = __uint_as_float(rr[0]) + __uint_as_float(rr[1]); }
    const float rq = __builtin_amdgcn_rsqf(ss * (1.0f / 128.0f) + 1e-6f);
#pragma unroll
    for (int d0 = 0; d0 < 8; ++d0) { const int d = d0 * 16 + hi * 8;
      const f32x4 g0 = *(const f32x4*)(gq + d), g1 = *(const f32x4*)(gq + d + 4);
      u32x4 w; w.x = cvtpk(bflo(qt[d0].x) * rq * g0[0], bfhi(qt[d0].x) * rq * g0[1]); w.y = cvtpk(bflo(qt[d0].y) * rq * g0[2], bfhi(qt[d0].y) * rq * g0[3]);
      w.z = cvtpk(bflo(qt[d0].z) * rq * g1[0], bfhi(qt[d0].z) * rq * g1[1]); w.w = cvtpk(bflo(qt[d0].w) * rq * g1[2], bfhi(qt[d0].w) * rq * g1[3]);
      *(LAS u32x4*)(Q_lds + KSWZ(r32, d * 2)) = w; } }
  const int sr = tid >> 4, sc = (tid & 15) * 8, vst0 = v_st(sr, sc);
  const int vb0 = (int)(uintptr_t)V_lds + v_rd_base(lane);
  const int qrow = R + (wid >> 1), qc = 32 * (wid & 1) + r32;
  unsigned cmask = 0;
  if (NA) { int c0 = qc - 8; c0 = c0 < 0 ? 0 : (c0 > 48 ? 48 : c0);
#pragma unroll
    for (int i = 0; i < 16; ++i) { const int kc = crow(i, hi); if ((unsigned)(kc - c0) < 16u) cmask |= 1u << i; if ((unsigned)(kc + 32 - c0) < 16u) cmask |= 1u << (16 + i); } }
  struct { bf16x8 vs0, vs1, ks0, ks1; } sr_[SDEPTH];
#define TILE_K(t) (((t) < nt0 ? K0 + (long)(t) * (KVBLK * LD) : K1 + (long)((t) - nt0) * (KVBLK * LD)))
#define TILE_V(t) (((t) < nt0 ? V0 + (long)(t) * (KVBLK * LD) : V1 + (long)((t) - nt0) * (KVBLK * LD)))
#define SLOAD(i, t) do { const bf16_t* kp_ = TILE_K(t); const bf16_t* vp_ = TILE_V(t); \
    sr_[i].vs0 = *(const bf16x8*)(vp_ + (long)sr * LD + sc); sr_[i].vs1 = *(const bf16x8*)(vp_ + (long)(32 + sr) * LD + sc); \
    sr_[i].ks0 = *(const bf16x8*)(kp_ + (long)sr * LD + sc); sr_[i].ks1 = *(const bf16x8*)(kp_ + (long)(32 + sr) * LD + sc); } while (0)
#define KROW(KS, ROW, t, OUT) do { u32x4 kw_ = *(u32x4*)&(KS); float x_[8]; \
    _Pragma("unroll") for (int i_ = 0; i_ < 4; ++i_) { x_[2 * i_] = bflo(kw_[i_]); x_[2 * i_ + 1] = bfhi(kw_[i_]); } \
    if (knorm0 || (t) >= nt0) { float s_ = 0.f; _Pragma("unroll") for (int i_ = 0; i_ < 8; ++i_) s_ += x_[i_] * x_[i_]; \
      s_ += __uint_as_float((unsigned)__builtin_amdgcn_update_dpp(0, (int)__float_as_uint(s_), 0x128, 0xf, 0xf, false)); s_ += __uint_as_float((unsigned)__builtin_amdgcn_update_dpp(0, (int)__float_as_uint(s_), 0x124, 0xf, 0xf, false)); \
      s_ += __uint_as_float((unsigned)__builtin_amdgcn_update_dpp(0, (int)__float_as_uint(s_), 0x122, 0xf, 0xf, false)); s_ += __uint_as_float((unsigned)__builtin_amdgcn_update_dpp(0, (int)__float_as_uint(s_), 0x121, 0xf, 0xf, false)); \
      const float rk_ = __builtin_amdgcn_rsqf(s_ * (1.0f / 128.0f) + 1e-6f); const f32x4 ga_ = gkL[sc >> 2], gb_ = gkL[(sc >> 2) + 1]; \
      x_[0] *= rk_ * ga_[0]; x_[1] *= rk_ * ga_[1]; x_[2] *= rk_ * ga_[2]; x_[3] *= rk_ * ga_[3]; x_[4] *= rk_ * gb_[0]; x_[5] *= rk_ * gb_[1]; x_[6] *= rk_ * gb_[2]; x_[7] *= rk_ * gb_[3]; \
      kw_.x = cvtpk(x_[0], x_[1]); kw_.y = cvtpk(x_[2], x_[3]); kw_.z = cvtpk(x_[4], x_[5]); kw_.w = cvtpk(x_[6], x_[7]); } \
    if (ck_out) { float* o_ = ck_out + (long)((t) * KVBLK + (ROW)) * LD + sc; \
      __builtin_nontemporal_store((f32x4){x_[0], x_[1], x_[2], x_[3]}, (f32x4*)o_); __builtin_nontemporal_store((f32x4){x_[4], x_[5], x_[6], x_[7]}, (f32x4*)(o_ + 4)); } \
    OUT = *(bf16x8*)&kw_; } while (0)
#define VROW(VS, ROW, t) do { if (cv_out) { const u32x4 vw_ = *(const u32x4*)&(VS); float* o_ = cv_out + (long)((t) * KVBLK + (ROW)) * LD + sc; \
      __builtin_nontemporal_store((f32x4){bflo(vw_.x), bfhi(vw_.x), bflo(vw_.y), bfhi(vw_.y)}, (f32x4*)o_); __builtin_nontemporal_store((f32x4){bflo(vw_.z), bfhi(vw_.z), bflo(vw_.w), bfhi(vw_.w)}, (f32x4*)(o_ + 4)); } } while (0)
#define SWRITE(b, i, t) do { *(LAS bf16x8*)(V_lds + (b) * SHM_V + vst0) = sr_[i].vs0;          \
    *(LAS bf16x8*)(V_lds + (b) * SHM_V + vst0 + 8192) = sr_[i].vs1; const int kc_ = sc * 2; VROW(sr_[i].vs0, sr, t); VROW(sr_[i].vs1, 32 + sr, t); \
    bf16x8 k0_, k1_; KROW(sr_[i].ks0, sr, t, k0_); KROW(sr_[i].ks1, 32 + sr, t, k1_); \
    *(LAS bf16x8*)(K_lds + (b) * SHM_K + KSWZ(sr, kc_)) = k0_;                       \
    *(LAS bf16x8*)(K_lds + (b) * SHM_K + KSWZ(sr, kc_) + 8192) = k1_; } while (0)
#define SWAIT() do { if constexpr (SDEPTH == 2) asm volatile("s_waitcnt vmcnt(4)" ::: "memory"); else asm volatile("s_waitcnt vmcnt(0)" ::: "memory"); } while (0)
#define RESC(a) do { if (__any((a) < 1.f)) { if (hi == 0) al_l[r32] = (a); asm volatile("s_waitcnt lgkmcnt(0)" ::: "memory"); \
    _Pragma("unroll") for (int d = 0; d < 4; ++d) _Pragma("unroll") for (int r = 0; r < 16; ++r) o[d][r] *= al_l[crow(r, hi)]; } } while (0)
#define MASK(P0, P1, t) do { if (NA && (t) >= nt0) na_mask(P0, P1, kr0 + (t) - nt0, qrow, qc, cmask, hi, biasL); } while (0)
  f32x16 pA0, pA1, pB0, pB1; float mnA, mnB, alA, alB; bf16x8 pa0, pa1, pa2, pa3;
  int wr0 = qrow - 4; wr0 = wr0 < 0 ? 0 : (wr0 > 56 ? 56 : wr0);
#define TV(t) (!NA || (t) < nt0 || (unsigned)(kr0 + (t) - nt0 - wr0) < 8u)
#define SCORE(P0, P1, KB, t, V) do { if (V) qkt(P0, P1, KB, Q_lds, r32, hi); } while (0)
#define PSM(P0, P1, t, V, MN, AL) do { if (V) { MASK(P0, P1, t); partialSM(P0, P1, m_reg, MN, AL); } else { AL = 1.f; } } while (0)
#define FSM(P0, P1, AL, V) do { if (V) finishSM(P0, P1, AL, l_reg, pa0, pa1, pa2, pa3); } while (0)
#define PVT(VB, V) do { if (V) pv_d0(o, VB, pa0, pa1, pa2, pa3); } while (0)
  constexpr int SE = 0, SO = SDEPTH - 1;
  bool vA = true, vB = true;
  SLOAD(SE, 0); asm volatile("s_waitcnt vmcnt(0)" ::: "memory"); SWRITE(0, SE, 0); __syncthreads();
  vA = TV(0); SCORE(pA0, pA1, K_lds, 0, vA); PSM(pA0, pA1, 0, vA, mnA, alA);
  SLOAD(SO, 1); if constexpr (SDEPTH == 2) { if (2 < NT) SLOAD(SE, 2); }
  SWAIT(); SWRITE(1, SO, 1); __syncthreads();
  for (int j = 1; j + 1 < NT; j += 2) {
    vB = TV(j);
    SBAR(); SCORE(pB0, pB1, K_lds + SHM_K, j, vB);
    FSM(pA0, pA1, alA, vA); SBAR();
    SLOAD(SO, j + SDEPTH); SBAR();
    PVT(vb0, vA); PSM(pB0, pB1, j, vB, mnB, alB);
    __syncthreads(); SWAIT(); SWRITE(0, SE, j + 1);
    RESC(alB); __syncthreads();
    vA = TV(j + 1);
    SBAR(); SCORE(pA0, pA1, K_lds, j + 1, vA);
    FSM(pB0, pB1, alB, vB); SBAR();
    if (SDEPTH == 1 || j + 3 < NT) SLOAD(SE, j + 1 + SDEPTH); SBAR();
    PVT(vb0 + SHM_V, vB); PSM(pA0, pA1, j + 1, vA, mnA, alA);
    __syncthreads(); SWAIT(); SWRITE(1, SO, j + 2);
    RESC(alA); __syncthreads();
  }
  vB = TV(NT - 1);
  SBAR(); SCORE(pB0, pB1, K_lds + SHM_K, NT - 1, vB);
  FSM(pA0, pA1, alA, vA); SBAR();
  PVT(vb0, vA); PSM(pB0, pB1, NT - 1, vB, mnB, alB);
  __syncthreads(); RESC(alB);
  FSM(pB0, pB1, alB, vB); SBAR();
  PVT(vb0 + SHM_V, vB);
#undef TV
#undef SCORE
#undef PSM
#undef FSM
#undef PVT
  if (hi == 0) li_l[r32] = l_reg; asm volatile("s_waitcnt lgkmcnt(0)" ::: "memory");
  float rli[16];
#pragma unroll
  for (int r = 0; r < 16; ++r) rli[r] = __builtin_amdgcn_rcpf(li_l[crow(r, hi)]);
  bf16_t* Ow = Ob + (long)(wid * QBLK) * ldo;
#pragma unroll
  for (int r = 0; r < 16; ++r) { const int orow = crow(r, hi);
#pragma unroll
    for (int d0 = 0; d0 < 4; ++d0) Ow[(long)orow * ldo + d0 * 32 + r32] = f2bf(o[d0][r] * rli[r]); }
#undef SLOAD
#undef SWRITE
#undef KROW
#undef VROW
#undef SWAIT
#undef RESC
#undef MASK
#undef TILE_K
#undef TILE_V
}
}

constexpr int DM = 2048, NCTX = 8192, NLAT = 32768, MTOK = NCTX + NLAT;
constexpr int CTX_L = 256, LAT_L = 4096, NLAYER = 4, DFF = 8192;
constexpr int ABIN = 3584, ABOUT = 1536, S5W = 512;
constexpr float NORM_EPS = 1e-6f;
constexpr int S5T = 32;
constexpr int NCHUNK = MTOK / S5T;
__device__ __forceinline__ int ada_row_of_token(int m) { return m < NCTX ? 0 : 1 + ((m - NCTX) >> 12); }

namespace s5 {
constexpr int XROW = 272;
constexpr int XBYTES = S5T * XROW;
constexpr int GROW = 1040;
constexpr int OFF_X = 0, OFF_G = 8 * XBYTES, LDS_BYTES = OFF_G + S5T * GROW;

struct BFrag { bf16x8 r0, r1, i0, i1; };
__device__ __forceinline__ bf16x8 load_u(const bf16_t* __restrict__ U, int m0, int g, int dir, int lane) {
  const int r = lane & 31, h = lane >> 5, tok = dir ? 31 - r : r;
  return *(const bf16x8*)(U + (size_t)(m0 + tok) * S5W + g * 16 + h * 8);
}
__device__ __forceinline__ BFrag load_bb(const bf16_t* __restrict__ BB, int lane) {
  const int r = lane & 31, h = lane >> 5; BFrag f;
  f.r0 = *(const bf16x8*)(BB + (0 * 64 + r) * 16 + h * 8); f.r1 = *(const bf16x8*)(BB + (0 * 64 + 32 + r) * 16 + h * 8);
  f.i0 = *(const bf16x8*)(BB + (1 * 64 + r) * 16 + h * 8); f.i1 = *(const bf16x8*)(BB + (1 * 64 + 32 + r) * 16 + h * 8);
  return f;
}
__device__ __forceinline__ void bu_compute(const bf16x8 ua, const BFrag& f, float (&bre)[32], float (&bim)[32]) {
  const f32x16 z = {};
  { const f32x16 dr0 = __builtin_amdgcn_mfma_f32_32x32x16_bf16(ua, f.r0, z, 0, 0, 0), dr1 = __builtin_amdgcn_mfma_f32_32x32x16_bf16(ua, f.r1, z, 0, 0, 0);
#pragma unroll
    for (int i = 0; i < 16; ++i) { const int c0 = (i & 3) + 8 * (i >> 2);
      auto a = __builtin_amdgcn_permlane32_swap(__float_as_uint(dr0[i]), __float_as_uint(dr1[i]), false, false);
      bre[c0] = __uint_as_float(a[0]); bre[c0 + 4] = __uint_as_float(a[1]); } }
  asm volatile("" : "+v"(bre[0]), "+v"(bre[31]));
  { const f32x16 di0 = __builtin_amdgcn_mfma_f32_32x32x16_bf16(ua, f.i0, z, 0, 0, 0), di1 = __builtin_amdgcn_mfma_f32_32x32x16_bf16(ua, f.i1, z, 0, 0, 0);
#pragma unroll
    for (int i = 0; i < 16; ++i) { const int c0 = (i & 3) + 8 * (i >> 2);
      auto b = __builtin_amdgcn_permlane32_swap(__float_as_uint(di0[i]), __float_as_uint(di1[i]), false, false);
      bim[c0] = __uint_as_float(b[0]); bim[c0 + 4] = __uint_as_float(b[1]); } }
}

__device__ __forceinline__ void phase_a(int e, const bf16_t* U, const float4* S5A, const bf16_t* S5BB, float* Ef, float* Ec, int G, int vcu, const int wv) {
  const int lane = lane_id_opaque(), wid = wv; (void)wid;
  for (int task = vcu; task < (MTOK / 128) * 4; task += G) {
    const int cc = task >> 2, g = (task & 3) * 8 + wid;
#pragma unroll 1
    for (int dir = 0; dir < 2; ++dir) {
      const int tb = ((e * 2 + dir) * 32 + g);
      const float4 a4 = S5A[tb * 64 + lane];
      float cr = 0.f, ci = 0.f;
      const BFrag bf = load_bb(S5BB + (size_t)tb * 2048, lane);
      bf16x8 ua = load_u(U, (cc * 4 + (dir ? 3 : 0)) * S5T, g, dir, lane);
#pragma unroll 1
      for (int k = 0; k < 4; ++k) { const int f = dir ? 3 - k : k; const int ci_f = cc * 4 + f;
        const int fn = dir ? 2 - k : k + 1;
        const bf16x8 un = load_u(U, (cc * 4 + (k < 3 ? fn : f)) * S5T, g, dir, lane);
        float bre[32], bim[32];
        bu_compute(ua, bf, bre, bim);
        float xr = 0.f, xi = 0.f;
#pragma unroll
        for (int i = 0; i < 32; ++i) { const float nr = fmaf(a4.x, xr, fmaf(-a4.y, xi, bre[i])), ni = fmaf(a4.x, xi, fmaf(a4.y, xr, bim[i])); xr = nr; xi = ni; }
        float* ep = Ef + (((size_t)ci_f * 32 + g) * 2 + dir) * 128;
        ep[lane] = xr; ep[64 + lane] = xi;
        const float nr = fmaf(a4.z, cr, fmaf(-a4.w, ci, xr)), ni = fmaf(a4.z, ci, fmaf(a4.w, cr, xi)); cr = nr; ci = ni;
        ua = un;
      }
      float* ecp = Ec + (((size_t)cc * 32 + g) * 2 + dir) * 128;
      ecp[lane] = cr; ecp[64 + lane] = ci;
    }
  }
}

struct SOps { float4 a4; float2 a128; bf16x8 ua; BFrag bf; float sr, si; float fer[3], fei[3]; float er[16], ei[16]; };
struct SGeo { int m0, ci, c, nC, b; bool isctx; };
__device__ __forceinline__ void s5b_load(SOps& o, const SGeo& t, int e, int g, int dir, int lane, const bf16_t* U, const float4* S5A, const float2* S5A128, const bf16_t* S5BB,
                                         const float* Ef, const float* Ec, const float* h0re, const float* h0im) {
  const int tb = ((e * 2 + dir) * 32 + g);
  o.a4 = S5A[tb * 64 + lane]; o.a128 = S5A128[tb * 64 + lane];
  o.ua = load_u(U, t.m0, g, dir, lane); o.bf = load_bb(S5BB + (size_t)tb * 2048, lane);
  o.sr = 0.f; o.si = 0.f;
  if (!t.isctx) { const int hi_ = (((t.b * 2 + e) * 2 + dir) * 32 + g) * 64 + lane; o.sr = h0re[hi_]; o.si = h0im[hi_]; }
  const int C = t.c >> 2, f = t.c & 3, nCC = t.nC >> 2, cc0 = (t.ci - t.c) >> 2;
  const int n = dir ? (nCC - 1 - C) : C; const int cstart = dir ? (cc0 + nCC - 1) : cc0; const int estep = (dir ? -1 : 1) * 32 * 2 * 128;
  const int e0 = ((cstart * 32 + g) * 2 + dir) * 128 + lane;
  const int nf = dir ? (3 - f) : f; const int fstart = dir ? (t.ci - f + 3) : (t.ci - f);
  const int f0 = ((fstart * 32 + g) * 2 + dir) * 128 + lane;
#pragma unroll
  for (int q = 0; q < 3; ++q) { const int qq = q < nf ? q : 0; o.fer[q] = Ef[f0 + qq * estep]; o.fei[q] = Ef[f0 + qq * estep + 64]; }
#pragma unroll
  for (int j = 0; j < 16; ++j) { const int kk = j < n ? j : 0; o.er[j] = Ec[e0 + kk * estep]; o.ei[j] = Ec[e0 + kk * estep + 64]; }
}
__device__ __forceinline__ void phase_b(LAS char* lds, int e, const bf16_t* U, const float4* S5A, const float2* S5A128, const bf16_t* S5BB, const bf16_t* S5CM, const float* Ef, const float* Ec,
                                        const float* h0re, const float* h0im, const float* dvec, const bf16_t* Wglu, const float* bglu,
                                        bf16_t* AO, float* st_re, float* st_im, int G, int vcu, const int wv) {
  const int lane = lane_id_opaque(), wid = wv; (void)wid;
  LAS char* X = lds + OFF_X + wid * XBYTES; LAS char* Gt = lds + OFF_G;
  for (int ci = vcu; ci < NCHUNK; ci += G) {
    SGeo t; t.ci = ci; t.m0 = ci * S5T; t.isctx = t.m0 < NCTX;
    if (t.isctx) { t.b = t.m0 / CTX_L; t.c = (t.m0 % CTX_L) / S5T; t.nC = CTX_L / S5T; } else { t.b = (t.m0 - NCTX) / LAT_L; t.c = ((t.m0 - NCTX) % LAT_L) / S5T; t.nC = LAT_L / S5T; }
    const int m0 = t.m0;
    SOps P;
    s5b_load(P, t, e, wid * 4, 0, lane, U, S5A, S5A128, S5BB, Ef, Ec, h0re, h0im);
    f32x4 yacc[2] = {{0.f, 0.f, 0.f, 0.f}, {0.f, 0.f, 0.f, 0.f}};
    float uu[2][4];
#pragma unroll 1
    for (int q = 0; q < 8; ++q) { const int g = wid * 4 + (q >> 1), dir = q & 1;
      const int tb = ((e * 2 + dir) * 32 + g);
      const int nl = lane & 15, col = g * 16 + nl;
      const bf16_t* cm = S5CM + (size_t)tb * 2048 + (lane & 15) * 128 + (lane >> 4) * 8;
      bf16x8 cf[4];
#pragma unroll
      for (int ks = 0; ks < 4; ++ks) cf[ks] = *(const bf16x8*)(cm + ks * 32);
      if (dir == 0) {
#pragma unroll
        for (int rb = 0; rb < 2; ++rb)
#pragma unroll
          for (int i = 0; i < 4; ++i) uu[rb][i] = bf2f(U[(size_t)(m0 + rb * 16 + (lane >> 4) * 4 + i) * S5W + col]); }
      const float4 a4 = P.a4; const float2 a128 = P.a128;
      float sr = P.sr, si = P.si;
      const int C = t.c >> 2, f = t.c & 3, nCC = t.nC >> 2, cc0 = (t.ci - t.c) >> 2;
      const int n = dir ? (nCC - 1 - C) : C; const int cstart = dir ? (cc0 + nCC - 1) : cc0; const int estep = (dir ? -1 : 1) * 32 * 2 * 128;
      const int nf = dir ? (3 - f) : f;
#pragma unroll
      for (int j = 0; j < 16; ++j) if (j < n) { const float nr = fmaf(a128.x, sr, fmaf(-a128.y, si, P.er[j])), ni = fmaf(a128.x, si, fmaf(a128.y, sr, P.ei[j])); sr = nr; si = ni; }
      if (n > 16) { const int e0 = ((cstart * 32 + g) * 2 + dir) * 128 + lane; float er[16], ei[16];
#pragma unroll
        for (int j = 0; j < 16; ++j) { const int kk = 16 + j < n ? 16 + j : 16; er[j] = Ec[e0 + kk * estep]; ei[j] = Ec[e0 + kk * estep + 64]; }
#pragma unroll
        for (int j = 0; j < 16; ++j) if (16 + j < n) { const float nr = fmaf(a128.x, sr, fmaf(-a128.y, si, er[j])), ni = fmaf(a128.x, si, fmaf(a128.y, sr, ei[j])); sr = nr; si = ni; } }
#pragma unroll
      for (int qq = 0; qq < 3; ++qq) if (qq < nf) { const float nr = fmaf(a4.z, sr, fmaf(-a4.w, si, P.fer[qq])), ni = fmaf(a4.z, si, fmaf(a4.w, sr, P.fei[qq])); sr = nr; si = ni; }
      float bre[32], bim[32];
      bu_compute(P.ua, P.bf, bre, bim);
      if (q < 7) s5b_load(P, t, e, wid * 4 + ((q + 1) >> 1), (q + 1) & 1, lane, U, S5A, S5A128, S5BB, Ef, Ec, h0re, h0im);
      float xr = sr, xi = si;
#pragma unroll
      for (int i = 0; i < 32; ++i) { const float nr = fmaf(a4.x, xr, fmaf(-a4.y, xi, bre[i])), ni = fmaf(a4.x, xi, fmaf(a4.y, xr, bim[i])); xr = nr; xi = ni; bre[i] = nr; bim[i] = ni; }
      if (t.isctx && ((dir == 0 && t.c == t.nC - 1) || (dir == 1 && t.c == 0))) { const int so = (((t.b * 2 + e) * 2 + dir) * 32 + g) * 64 + lane; st_re[so] = xr; st_im[so] = xi; }
#pragma unroll
      for (int i = 0; i < 32; ++i) { const int tok = dir ? 31 - i : i;
        *(LAS unsigned*)(X + tok * XROW + lane * 4) = cvtpk(bre[i], bim[i]); }
      asm volatile("s_waitcnt lgkmcnt(0)" ::: "memory");
#pragma unroll
      for (int rb = 0; rb < 2; ++rb)
#pragma unroll
        for (int ks = 0; ks < 4; ++ks) { const bf16x8 af = *(const LAS bf16x8*)(X + (rb * 16 + (lane & 15)) * XROW + (ks * 32 + (lane >> 4) * 8) * 2);
          yacc[rb] = __builtin_amdgcn_mfma_f32_16x16x32_bf16(af, cf[ks], yacc[rb], 0, 0, 0); }
      asm volatile("s_waitcnt lgkmcnt(0)" ::: "memory");
      if (dir == 1) {
        const float dv = dvec[col];
#pragma unroll
        for (int rb = 0; rb < 2; ++rb)
#pragma unroll
          for (int i = 0; i < 4; ++i) { const int tok = rb * 16 + (lane >> 4) * 4 + i;
            const float y = yacc[rb][i] + dv * uu[rb][i];
            const float z2 = 1.5957691216057308f * (y + 0.044715f * y * y * y);
            const float gl = y - y / (1.f + __expf(z2));
            *(LAS unsigned short*)(Gt + tok * GROW + col * 2) = f2bf(gl); }
        yacc[0] = (f32x4){0.f, 0.f, 0.f, 0.f}; yacc[1] = (f32x4){0.f, 0.f, 0.f, 0.f};
      }
    }
    __syncthreads();
    { f32x4 acc[2][4];
#pragma unroll
      for (int rb = 0; rb < 2; ++rb)
#pragma unroll
        for (int cb = 0; cb < 4; ++cb) acc[rb][cb] = (f32x4){0.f, 0.f, 0.f, 0.f};
      const bf16_t* wp = Wglu + (size_t)(wid * 64 + (lane & 15)) * 512 + (lane >> 4) * 8;
#pragma unroll 4
      for (int ks = 0; ks < 16; ++ks) {
        bf16x8 af[2], bfr[4];
#pragma unroll
        for (int cb = 0; cb < 4; ++cb) bfr[cb] = *(const bf16x8*)(wp + (size_t)cb * 16 * 512 + ks * 32);
#pragma unroll
        for (int rb = 0; rb < 2; ++rb) af[rb] = *(const LAS bf16x8*)(Gt + (rb * 16 + (lane & 15)) * GROW + (ks * 32 + (lane >> 4) * 8) * 2);
#pragma unroll
        for (int rb = 0; rb < 2; ++rb)
#pragma unroll
          for (int cb = 0; cb < 4; ++cb) acc[rb][cb] = __builtin_amdgcn_mfma_f32_16x16x32_bf16(af[rb], bfr[cb], acc[rb][cb], 0, 0, 0);
      }
#pragma unroll
      for (int cb = 0; cb < 4; ++cb) { const int col = wid * 64 + cb * 16 + (lane & 15); const float bb = bglu[col];
#pragma unroll
        for (int rb = 0; rb < 2; ++rb)
#pragma unroll
          for (int i = 0; i < 4; ++i) { const int tok = rb * 16 + (lane >> 4) * 4 + i;
            const float gv = bf2f(*(const LAS unsigned short*)(Gt + tok * GROW + col * 2));
            const float zz = acc[rb][cb][i] + bb;
            AO[(size_t)(m0 + tok) * ABOUT + col] = f2bf(gv / (1.f + __expf(-zz))); } }
    }
    __syncthreads();
  }
}
}

constexpr size_t MiB = 1u << 20;
constexpr size_t WS_CTL = 0, CTL_ZERO_BYTES = 3 * MiB;
constexpr size_t WS_SSQ = 1 * MiB;
constexpr size_t WS_ADA = 3 * MiB;
constexpr size_t WS_S5A = 5 * MiB, WS_S5A128 = 5 * MiB + 512 * 1024, WS_S5BB = 6 * MiB, WS_S5CM = 7 * MiB;
constexpr size_t WS_GV = 8 * MiB;
constexpr size_t WS_BIAS = 9 * MiB;
constexpr size_t WS_CK = 14 * MiB, WS_CV = 22 * MiB;
constexpr size_t WS_WGLU = 30 * MiB;
constexpr size_t WS_WABIN = 32 * MiB;
constexpr size_t WS_WABOUT = 60 * MiB;
constexpr size_t WS_WCVIN = 72 * MiB;
constexpr size_t WS_WCVOUT = 120 * MiB;
constexpr size_t WS_WUP = 136 * MiB;
constexpr size_t WS_WDN = 264 * MiB;
constexpr size_t WS_H = 392 * MiB;
constexpr size_t WS_BIG = 552 * MiB;
constexpr size_t WS_U = WS_BIG, WS_Q = WS_BIG + 40 * MiB, WS_K = WS_BIG + 120 * MiB, WS_V = WS_BIG + 200 * MiB, WS_AO = WS_BIG + 280 * MiB, WS_E = WS_BIG + 400 * MiB, WS_EC = WS_BIG + 440 * MiB;
static_assert(WS_V - WS_K == WS_K - WS_Q, "q/k/v equally spaced");
constexpr size_t WS_Z = WS_BIG, WS_GB = WS_BIG + 160 * MiB, WS_A2 = WS_BIG + 320 * MiB;
constexpr size_t WS_END = WS_BIG + 640 * MiB;
constexpr int CW_TMO = 0, CW_BAR = 4096;

constexpr int RING_BYTES = 131072;
constexpr int LDSCTL_OFF = RING_BYTES, MISC_OFF = LDSCTL_OFF + 320;
constexpr int LDS_BYTES = 147456;
static_assert(att::OFF_WS >= RING_BYTES + 1024 + 2048 && att::LDS_BYTES <= LDS_BYTES && s5::LDS_BYTES <= RING_BYTES, "phase scratch fits");
constexpr int NWAVES = 8;

typedef GAS unsigned gu32;
#define RLX_AGENT __ATOMIC_RELAXED, __HIP_MEMORY_SCOPE_AGENT
#define LDS_WAIT() asm volatile("s_waitcnt lgkmcnt(0)" ::: "memory")
#define VM_WAIT() asm volatile("s_waitcnt vmcnt(0)" ::: "memory")

#define XB_TMO      128
#define XB_XCNT(j)  (256  + 64 * (j))
#define XB_XSUB(j)  (1280 + 64 * (j))
#define XB_XGEN(j)  (2304 + 64 * (j))
#define XB_TOP      3328
#define XB_TOPGEN   3392
#define XCD_BAR_WORDS 3456
#define XB_SPIN_CAP (1u << 18)
__device__ __forceinline__ unsigned xb_ld(unsigned* p)              { return __hip_atomic_load(p, __ATOMIC_RELAXED, __HIP_MEMORY_SCOPE_AGENT); }
__device__ __forceinline__ unsigned xb_add(unsigned* p, unsigned v) { return __hip_atomic_fetch_add(p, v, __ATOMIC_RELAXED, __HIP_MEMORY_SCOPE_AGENT); }
__device__ __forceinline__ unsigned xb_xcc_id() { return (unsigned)__builtin_amdgcn_s_getreg((3 << 11) | 20) & 0xFu; }
#define XB_SPIN(cond, bar) do { unsigned _sp = 0; while (cond) { __builtin_amdgcn_s_sleep(1); \
    if ((++_sp & 255u) == 0u) { if (xb_ld(&(bar)[XB_TMO])) break; if (_sp > XB_SPIN_CAP) { atomicAdd(&(bar)[XB_TMO], 1u); break; } } } } while (0)
struct XcdBarrier { unsigned* bar; unsigned x; volatile LAS unsigned* st; };
__device__ __forceinline__ XcdBarrier xcd_barrier_post(unsigned* bar, volatile LAS unsigned* st) {
    XcdBarrier b; b.bar = bar; b.x = xb_xcc_id(); b.st = st;
    if (threadIdx.x == 0) (void)xb_add(&bar[XB_XCNT(b.x)], 1u);
    return b;
}
__device__ __forceinline__ void xcd_barrier_complete(unsigned* bar, unsigned x, unsigned& nloc, unsigned& nx) {
    const unsigned G = gridDim.x * gridDim.y * gridDim.z;
    unsigned sum, cnt, mine, sp = 0u;
    for (;;) {
        sum = 0u; cnt = 0u; mine = 0u;
#pragma unroll
        for (unsigned j = 0; j < 16; ++j) { const unsigned c = xb_ld(&bar[XB_XCNT(j)]); sum += c; cnt += (c > 0u) ? 1u : 0u; mine = (j == x) ? c : mine; }
        if (sum == G) break;
        __builtin_amdgcn_s_sleep(1);
        if ((++sp & 255u) == 0u) { if (xb_ld(&bar[XB_TMO])) break; if (sp > XB_SPIN_CAP) { atomicAdd(&bar[XB_TMO], 1u); break; } }
    }
    nloc = mine > 0u ? mine : 1u; nx = cnt > 0u ? cnt : 1u;
}
__device__ __forceinline__ void xcd_barrier(const XcdBarrier& b, const int wv) {
    asm volatile("s_waitcnt vmcnt(0)" ::: "memory");
    __syncthreads();
    if (wv == 0 && lane_id_opaque() == 0) {
        unsigned* bar = b.bar; asm volatile("" : "+s"(bar));
        __builtin_amdgcn_s_waitcnt(0);
        unsigned nloc = b.st[0], nx = b.st[1];
        if (nloc == 0u) { xcd_barrier_complete(bar, b.x, nloc, nx); b.st[0] = nloc; b.st[1] = nx; }
        const unsigned old = xb_add(&bar[XB_XSUB(b.x)], 1u);
        const unsigned gen = old / nloc;
        if (old + 1u == (gen + 1u) * nloc) {
            __builtin_amdgcn_fence(__ATOMIC_RELEASE, "agent");
            asm volatile("s_waitcnt vmcnt(0)" ::: "memory");
            const unsigned og = xb_add(&bar[XB_TOP], 1u);
            const unsigned tg = og / nx;
            if (og + 1u == (tg + 1u) * nx) xb_add(&bar[XB_TOPGEN], 1u);
            else XB_SPIN(xb_ld(&bar[XB_TOPGEN]) == tg, bar);
            __builtin_amdgcn_fence(__ATOMIC_ACQUIRE, "agent");
            xb_add(&bar[XB_XGEN(b.x)], 1u);
            asm volatile("s_waitcnt vmcnt(0)" ::: "memory");
        } else {
            XB_SPIN(xb_ld(&bar[XB_XGEN(b.x)]) == gen, bar);
            __builtin_amdgcn_fence(__ATOMIC_ACQUIRE, "agent");
            asm volatile("s_waitcnt vmcnt(0)" ::: "memory");
        }
    }
    __syncthreads();
}

struct Args { const float* in[33]; float* out; unsigned char* ws; int ph_lo, ph_hi; };
enum { I_XP = 0, I_XS, I_C, I_CK, I_CV, I_SRE, I_SIM, I_CCTX, I_ADAW, I_ADAB, I_N1G, I_N2G, I_ABWIN, I_ABWOUT, I_LAMRE, I_LAMIM, I_LOGDT, I_BRE, I_BIM, I_CRE, I_CIM, I_S5D,
       I_GLUW, I_GLUB, I_QNG, I_KNG, I_RPB, I_CVWIN, I_CVW, I_CVB, I_CVWOUT, I_W1, I_W2 };
constexpr size_t O_X = 0, O_CK = (size_t)MTOK * DM, O_CV = O_CK + (size_t)32 * 2 * 256 * 1024, O_SRE = O_CV + (size_t)32 * 2 * 256 * 1024, O_SIM = O_SRE + 32 * 2 * 2 * 32 * 64;

__device__ __forceinline__ float lane_xor(float v, int lane, int m) { return __uint_as_float((unsigned)__builtin_amdgcn_ds_bpermute((lane ^ m) << 2, (int)__float_as_uint(v))); }
__device__ __forceinline__ float wave_sum(float v, int lane) {
#pragma unroll
    for (int o = 1; o < 64; o <<= 1) v += lane_xor(v, lane, o);
    return v;
}
__device__ __forceinline__ unsigned pk2(float lo, float hi) { return cvtpk(lo, hi); }
__device__ __forceinline__ float wave_sum_dpp(float v) {
    v += __uint_as_float((unsigned)__builtin_amdgcn_update_dpp(0, (int)__float_as_uint(v), 0x128, 0xf, 0xf, false));
    v += __uint_as_float((unsigned)__builtin_amdgcn_update_dpp(0, (int)__float_as_uint(v), 0x124, 0xf, 0xf, false));
    v += __uint_as_float((unsigned)__builtin_amdgcn_update_dpp(0, (int)__float_as_uint(v), 0x122, 0xf, 0xf, false));
    v += __uint_as_float((unsigned)__builtin_amdgcn_update_dpp(0, (int)__float_as_uint(v), 0x121, 0xf, 0xf, false));
    { auto t = __builtin_amdgcn_permlane16_swap(__float_as_uint(v), __float_as_uint(v), false, false); v = __uint_as_float(t[0]) + __uint_as_float(t[1]); }
    { auto t = __builtin_amdgcn_permlane32_swap(__float_as_uint(v), __float_as_uint(v), false, false); v = __uint_as_float(t[0]) + __uint_as_float(t[1]); }
    return v;
}

__device__ __forceinline__ int dest_row(int n0, int mode) {
    if (mode == 0) return n0;
    if (n0 < 2048) return 4096 + n0;
    if (n0 < 4096) { const int c = n0 - 2048; return (c >> 7) * 256 + (c & 127); }
    const int c = n0 - 4096; return (c >> 7) * 256 + 128 + (c & 127);
}
__device__ __forceinline__ void p0_transpose_item(const float* W, int K, int N, bf16_t* WT, int mode, LAS unsigned* T, int item, int lane) {
    const int nblk = N / 128, kb = item / nblk, nb = item % nblk, k0 = 64 * kb, n0 = 128 * nb;
    const int lr = lane >> 5, lc = lane & 31;
    const float* src = W + (size_t)(k0 + 2 * lr) * N + n0 + 4 * lc;
#pragma unroll 8
    for (int q = 0; q < 16; ++q) { const f32x4 a = __builtin_nontemporal_load((const f32x4*)(src + (size_t)(4 * q) * N)), b = __builtin_nontemporal_load((const f32x4*)(src + (size_t)(4 * q + 1) * N));
        const int kp = 2 * q + lr; u32x4 w; w.x = pk2(a[0], b[0]); w.y = pk2(a[1], b[1]); w.z = pk2(a[2], b[2]); w.w = pk2(a[3], b[3]);
        *(LAS u32x4*)(T + kp * 128 + ((4 * lc) ^ (((kp >> 2) & 7) << 2))) = w; }
    LDS_WAIT(); asm volatile("" ::: "memory");
    const int kq = lane & 7, nl = lane >> 3; const int r0 = dest_row(n0, mode);
#pragma unroll 4
    for (int j = 0; j < 16; ++j) { const int n = nl + 8 * j; u32x4 o;
        o.x = T[(4 * kq + 0) * 128 + (n ^ (kq << 2))]; o.y = T[(4 * kq + 1) * 128 + (n ^ (kq << 2))]; o.z = T[(4 * kq + 2) * 128 + (n ^ (kq << 2))]; o.w = T[(4 * kq + 3) * 128 + (n ^ (kq << 2))];
        *(GAS u32x4*)(WT + (size_t)(r0 + n) * K + k0 + 8 * kq) = o; }
    LDS_WAIT(); asm volatile("" ::: "memory");
}
__device__ __forceinline__ void sincos_d(double x, double& s, double& c) {
    const double k = rint(x * 0.63661977236758134308);
    double r = fma(-k, 1.5707963267948966, x); r = fma(-k, 6.123233995736766e-17, r);
    const double r2 = r * r;
    double ps = 1.0 / 355687428096000.0;
    ps = fma(ps, r2, -1.0 / 1307674368000.0); ps = fma(ps, r2, 1.0 / 6227020800.0); ps = fma(ps, r2, -1.0 / 39916800.0); ps = fma(ps, r2, 1.0 / 362880.0);
    ps = fma(ps, r2, -1.0 / 5040.0); ps = fma(ps, r2, 1.0 / 120.0); ps = fma(ps, r2, -1.0 / 6.0); ps = fma(ps * r2, r, r);
    double pc = 1.0 / 6402373705728000.0;
    pc = fma(pc, r2, -1.0 / 20922789888000.0); pc = fma(pc, r2, 1.0 / 87178291200.0); pc = fma(pc, r2, -1.0 / 479001600.0); pc = fma(pc, r2, 1.0 / 3628800.0);
    pc = fma(pc, r2, -1.0 / 40320.0); pc = fma(pc, r2, 1.0 / 720.0); pc = fma(pc, r2, -1.0 / 24.0); pc = fma(pc, r2, 0.5); pc = fma(-pc, r2, 1.0);
    const int q = ((int)k) & 3;
    s = (q == 0) ? ps : (q == 1) ? pc : (q == 2) ? -ps : -pc;
    c = (q == 0) ? pc : (q == 1) ? -ps : (q == 2) ? -pc : ps;
}
__device__ __forceinline__ double exp_small_d(double x) {
    double p = 1.0 / 87178291200.0;
    p = fma(p, x, 1.0 / 6227020800.0); p = fma(p, x, 1.0 / 479001600.0); p = fma(p, x, 1.0 / 39916800.0); p = fma(p, x, 1.0 / 3628800.0); p = fma(p, x, 1.0 / 362880.0);
    p = fma(p, x, 1.0 / 40320.0); p = fma(p, x, 1.0 / 5040.0); p = fma(p, x, 1.0 / 720.0); p = fma(p, x, 1.0 / 120.0); p = fma(p, x, 1.0 / 24.0); p = fma(p, x, 1.0 / 6.0);
    p = fma(p, x, 0.5); p = fma(p, x, 1.0); p = fma(p, x, 1.0); return p;
}
__device__ __forceinline__ double exp_d(double x) {
    const double k = rint(x * 1.4426950408889634); const double r = fma(-k, 0.6931471805599453, x) ;
    double e = exp_small_d(r * 0.25); e = e * e; e = e * e;
    return ldexp(e, (int)k);
}

__device__ __forceinline__ const float* as_global(const float* x) { const GAS float* p = (const GAS float*)x; asm("" : "+s"(p)); return (const float*)p; }
#define FIN(i) as_global(F.in[i])
struct Frame {
    LAS unsigned char* lds;
    int wave, vcu, G;
    const float* const* in;
    float* out; unsigned char* ws;
};

__device__ __forceinline__ void p0_ada_item(Frame& F, int item) {
    const int lane = lane_id_opaque(), tid = F.wave * 64 + lane; (void)tid;
    const int l = item / 48, cb = item % 48;
    LAS float* sl = (LAS float*)F.lds;
    for (int i = tid; i < 9 * 2048; i += 512) { const int j = i / 2048, k = i % 2048; const float c = j == 0 ? FIN(I_CCTX)[k] : FIN(I_C)[(j - 1) * 2048 + k]; sl[k * 12 + j] = c / (1.f + __expf(-c)); }
    __syncthreads();
    const float* W = FIN(I_ADAW) + (size_t)l * 2048 * 12288 + (size_t)(F.wave * 256) * 12288 + cb * 256 + lane * 4;
    f32x4 acc[9];
#pragma unroll
    for (int j = 0; j < 9; ++j) acc[j] = (f32x4){0.f, 0.f, 0.f, 0.f};
    for (int k0 = 0; k0 < 256; k0 += 8) {
        f32x4 w[8];
#pragma unroll
        for (int u = 0; u < 8; ++u) w[u] = __builtin_nontemporal_load((const f32x4*)(W + (size_t)(k0 + u) * 12288));
#pragma unroll
        for (int u = 0; u < 8; ++u) { const LAS f32x4* sp = (const LAS f32x4*)(sl + (F.wave * 256 + k0 + u) * 12);
            const f32x4 s0 = sp[0], s1 = sp[1], s2 = sp[2];
            acc[0] += w[u] * s0[0]; acc[1] += w[u] * s0[1]; acc[2] += w[u] * s0[2]; acc[3] += w[u] * s0[3];
            acc[4] += w[u] * s1[0]; acc[5] += w[u] * s1[1]; acc[6] += w[u] * s1[2]; acc[7] += w[u] * s1[3]; acc[8] += w[u] * s2[0]; }
    }
    __syncthreads();
    LAS f32x4* pp = (LAS f32x4*)F.lds;
#pragma unroll
    for (int j = 0; j < 9; ++j) pp[(F.wave * 9 + j) * 64 + lane] = acc[j];
    __syncthreads();
    float* ADA = (float*)(F.ws + WS_ADA) + (size_t)l * 9 * 12288;
    const float* bias = FIN(I_ADAB) + (size_t)l * 12288;
    for (int i = tid; i < 9 * 64; i += 512) { const int j = i / 64, q = i % 64; f32x4 s = pp[(0 * 9 + j) * 64 + q];
#pragma unroll
        for (int w = 1; w < 8; ++w) s += pp[(w * 9 + j) * 64 + q];
        const int col = cb * 256 + q * 4; s += *(const f32x4*)(bias + col);
        *(f32x4*)(ADA + (size_t)j * 12288 + col) = s; }
    __syncthreads();
}
__device__ __forceinline__ void p0_s5_tables(Frame& F) {
    const int lane = lane_id_opaque(), tid = F.wave * 64 + lane; (void)tid;
    const int gt = F.vcu * 512 + tid;
    if (gt >= 2 * 2 * 32 * 64) return;
    const int p = gt & 63, g = (gt >> 6) & 31, dir = (gt >> 11) & 1, e = gt >> 12;
    const int gi = (e * 2 + dir) * 32 + g;
    const double lre = (double)FIN(I_LAMRE)[gi * 64 + p], lim = (double)FIN(I_LAMIM)[gi * 64 + p];
    const double dt = exp_d((double)FIN(I_LOGDT)[gi]);
    const double ar = lre * dt, ai = lim * dt;
    double s, c; sincos_d(ai, s, c); const double dec = exp_d(ar);
    const double are = dec * c, aim = dec * s;
    double sT, cT; sincos_d(ai * S5T, sT, cT); const double decT = exp_d(ar * S5T);
    float4* A = (float4*)(F.ws + WS_S5A);
    A[gi * 64 + p] = make_float4((float)are, (float)aim, (float)(decT * cT), (float)(decT * sT));
    { double s4, c4; sincos_d(ai * (4 * S5T), s4, c4); const double dec4 = exp_d(ar * (4 * S5T));
      ((float2*)(F.ws + WS_S5A128))[gi * 64 + p] = make_float2((float)(dec4 * c4), (float)(dec4 * s4)); }
    const double den = lre * lre + lim * lim, nr = are - 1.0;
    const double fre = (nr * lre + aim * lim) / den, fim = (aim * lre - nr * lim) / den;
    bf16_t* BB = (bf16_t*)(F.ws + WS_S5BB) + (size_t)gi * 2048;
    const float* bre = FIN(I_BRE) + ((size_t)gi * 64 + p) * 16; const float* bim = FIN(I_BIM) + ((size_t)gi * 64 + p) * 16;
#pragma unroll
    for (int n = 0; n < 16; ++n) { const double br = bre[n], bi = bim[n];
        BB[(0 * 64 + p) * 16 + n] = f2bf((float)(fre * br - fim * bi)); BB[(1 * 64 + p) * 16 + n] = f2bf((float)(fre * bi + fim * br)); }
    bf16_t* CM = (bf16_t*)(F.ws + WS_S5CM) + (size_t)gi * 2048;
    const float* cre = FIN(I_CRE) + (size_t)gi * 16 * 64; const float* cim = FIN(I_CIM) + (size_t)gi * 16 * 64;
#pragma unroll
    for (int n = 0; n < 16; ++n) { CM[n * 128 + 2 * p] = f2bf(cre[n * 64 + p]); CM[n * 128 + 2 * p + 1] = f2bf(-cim[n * 64 + p]); }
}
__device__ __forceinline__ void p0_prologue(Frame& F) {
    const int lane = lane_id_opaque(), tid = F.wave * 64 + lane; (void)tid;
    if (F.vcu < 192) p0_ada_item(F, F.vcu);
    p0_s5_tables(F);
    { const size_t n8 = (size_t)8 * 2 * 256 * 1024 / 8; const size_t gth = (size_t)F.vcu * 512 + tid, nth = (size_t)F.G * 512;
      for (size_t i = gth; i < 2 * n8; i += nth) { const bool isk = i < n8; const size_t j = isk ? i : i - n8;
        const float* src = (isk ? FIN(I_CK) : FIN(I_CV)) + j * 8; bf16_t* dst = (bf16_t*)(F.ws + (isk ? WS_CK : WS_CV)) + j * 8;
        const f32x4 a = __builtin_nontemporal_load((const f32x4*)src), b = __builtin_nontemporal_load((const f32x4*)(src + 4));
        u32x4 o; o.x = pk2(a[0], a[1]); o.y = pk2(a[2], a[3]); o.z = pk2(b[0], b[1]); o.w = pk2(b[2], b[3]); *(u32x4*)dst = o; } }
    LAS unsigned* scr = (LAS unsigned*)(F.lds + F.wave * 16384);
    const int gw = F.vcu * NWAVES + F.wave, NGW = F.G * NWAVES;
    constexpr int I_ABI = 32 * 28, I_ABO = 24 * 16, I_CVI = 32 * 48, I_CVO = 32 * 16, I_UP = 32 * 64, I_DN = 128 * 16, I_GLU = 8 * 4;
    constexpr int NITEMS = 2 * I_ABI + 2 * I_ABO + 2 * I_CVI + 2 * I_CVO + 4 * I_UP + 4 * I_DN + 2 * I_GLU;
    for (int it = gw; it < NITEMS; it += NGW) {
        int r = it;
        if (r < 2 * I_ABI) { const int e = r / I_ABI; p0_transpose_item(FIN(I_ABWIN) + (size_t)e * DM * ABIN, DM, ABIN, (bf16_t*)(F.ws + WS_WABIN) + (size_t)e * ABIN * DM, 0, scr, r % I_ABI, lane); continue; } r -= 2 * I_ABI;
        if (r < 2 * I_ABO) { const int e = r / I_ABO; p0_transpose_item(FIN(I_ABWOUT) + (size_t)e * ABOUT * DM, ABOUT, DM, (bf16_t*)(F.ws + WS_WABOUT) + (size_t)e * DM * ABOUT, 0, scr, r % I_ABO, lane); continue; } r -= 2 * I_ABO;
        if (r < 2 * I_CVI) { const int e = r / I_CVI; p0_transpose_item(FIN(I_CVWIN) + (size_t)e * DM * 3 * DM, DM, 3 * DM, (bf16_t*)(F.ws + WS_WCVIN) + (size_t)e * 3 * DM * DM, 1, scr, r % I_CVI, lane); continue; } r -= 2 * I_CVI;
        if (r < 2 * I_CVO) { const int e = r / I_CVO; p0_transpose_item(FIN(I_CVWOUT) + (size_t)e * DM * DM, DM, DM, (bf16_t*)(F.ws + WS_WCVOUT) + (size_t)e * DM * DM, 0, scr, r % I_CVO, lane); continue; } r -= 2 * I_CVO;
        if (r < 4 * I_UP) { const int e = r / I_UP; p0_transpose_item(FIN(I_W1) + (size_t)e * DM * DFF, DM, DFF, (bf16_t*)(F.ws + WS_WUP) + (size_t)e * DFF * DM, 0, scr, r % I_UP, lane); continue; } r -= 4 * I_UP;
        if (r < 4 * I_DN) { const int e = r / I_DN; p0_transpose_item(FIN(I_W2) + (size_t)e * DFF * DM, DFF, DM, (bf16_t*)(F.ws + WS_WDN) + (size_t)e * DM * DFF, 0, scr, r % I_DN, lane); continue; } r -= 4 * I_DN;
        { const int e = r / I_GLU; p0_transpose_item(FIN(I_GLUW) + (size_t)e * S5W * S5W, S5W, S5W, (bf16_t*)(F.ws + WS_WGLU) + (size_t)e * S5W * S5W, 0, scr, r % I_GLU, lane); }
    }
}

__device__ __forceinline__ const bf16_t* wt_of_norm(const unsigned char* ws, int s, int& N) {
    const int l = s >> 1;
    if (s & 1) { N = DFF; return (const bf16_t*)(ws + WS_WUP) + (size_t)l * DFF * DM; }
    if (l & 1) { N = 3 * DM; return (const bf16_t*)(ws + WS_WCVIN) + (size_t)(l >> 1) * 3 * DM * DM; }
    N = ABIN; return (const bf16_t*)(ws + WS_WABIN) + (size_t)(l >> 1) * ABIN * DM;
}
__device__ __forceinline__ void pre_phase(Frame& F) {
    const int lane = lane_id_opaque(), wave = F.wave, tid = wave * 64 + lane;
    GAS unsigned char* wsg_ = (GAS unsigned char*)F.ws; asm volatile("" : "+s"(wsg_)); unsigned char* ws = (unsigned char*)wsg_;
    const int gw = F.vcu * NWAVES + wave, NGW = F.G * NWAVES;
    const float* ADA0 = (const float*)(ws + WS_ADA);
    { float* GV = (float*)(ws + WS_GV);
      for (int i = F.vcu * 512 + tid; i < 8 * 9 * DM; i += F.G * 512) { const int s = i / (9 * DM), r = i % (9 * DM), j = r / DM, col = r % DM, l = s >> 1, which = s & 1;
        GV[i] = F.in[which ? I_N2G : I_N1G][l * DM + col] * (1.f + ADA0[((size_t)l * 9 + j) * 12288 + (which ? 4 : 1) * DM + col]); } }
    { bf16_t* H = (bf16_t*)(ws + WS_H); float* SSQ = (float*)(ws + WS_SSQ); const float* gn = FIN(I_N1G);
      for (int m = gw; m < MTOK; m += NGW) {
        const float* xrow = m < NCTX ? FIN(I_XP) + (size_t)m * DM : FIN(I_XS) + (size_t)(m - NCTX) * DM;
        const f32x4* xr = (const f32x4*)xrow + lane;
        const float* ad = ADA0 + (size_t)ada_row_of_token(m) * 12288;
        u32x2* o8 = (u32x2*)(H + (size_t)m * DM) + lane; float sq = 0.f;
#pragma unroll
        for (int j = 0; j < 8; ++j) { const int col = 4 * lane + 256 * j; const f32x4 v = __builtin_nontemporal_load(xr + 64 * j);
            sq += (v[0] * v[0] + v[1] * v[1]) + (v[2] * v[2] + v[3] * v[3]);
            const f32x4 g = *(const f32x4*)(gn + col), sc = *(const f32x4*)(ad + DM + col);
            const f32x4 h = v * g * (sc + 1.f);
            u32x2 w; w.x = pk2(h[0], h[1]); w.y = pk2(h[2], h[3]); o8[64 * j] = w; }
        sq = wave_sum_dpp(sq);
        if (lane == 0) SSQ[m] = sq; } }
    { float* BIAS = (float*)(ws + WS_BIAS);
      constexpr int T_AB = ABIN / 16, T_CV = 3 * DM / 16, T_UP = DFF / 16, T_PAIR = T_AB + T_UP + T_CV + T_UP;
      for (int it = gw; it < 2 * T_PAIR; it += NGW) {
        int r = it % T_PAIR, s = (it / T_PAIR) * 4;
        if (r >= T_AB) { r -= T_AB; ++s; if (r >= T_UP) { r -= T_UP; ++s; if (r >= T_CV) { r -= T_CV; ++s; } } }
        const int l = s >> 1, which = s & 1, n0 = r * 16;
        int N; const bf16_t* Wt = wt_of_norm(ws, s, N);
        const GAS bf16_t* wp = (const GAS bf16_t*)Wt + (size_t)(n0 + (lane & 15)) * DM + (lane >> 4) * 8;
        const int jj = (lane & 15) < 9 ? (lane & 15) : 8;
        const GAS float* sp = (const GAS float*)ADA0 + ((size_t)l * 9 + jj) * 12288 + (which ? 3 : 0) * DM + (lane >> 4) * 8;
        f32x4 acc = {0.f, 0.f, 0.f, 0.f};
#pragma unroll 8
        for (int ks = 0; ks < DM / 32; ++ks) {
            const bf16x8 a = *(const GAS bf16x8*)(wp + ks * 32);
            const f32x4 b0 = *(const GAS f32x4*)(sp + ks * 32), b1 = *(const GAS f32x4*)(sp + ks * 32 + 4);
            u32x4 hw; hw.x = pk2(b0[0], b0[1]); hw.y = pk2(b0[2], b0[3]); hw.z = pk2(b1[0], b1[1]); hw.w = pk2(b1[2], b1[3]);
            u32x4 lw; lw.x = pk2(b0[0] - bflo(hw.x), b0[1] - bfhi(hw.x)); lw.y = pk2(b0[2] - bflo(hw.y), b0[3] - bfhi(hw.y));
            lw.z = pk2(b1[0] - bflo(hw.z), b1[1] - bfhi(hw.z)); lw.w = pk2(b1[2] - bflo(hw.w), b1[3] - bfhi(hw.w));
            acc = __builtin_amdgcn_mfma_f32_16x16x32_bf16(a, *(const bf16x8*)&hw, acc, 0, 0, 0);
            acc = __builtin_amdgcn_mfma_f32_16x16x32_bf16(a, *(const bf16x8*)&lw, acc, 0, 0, 0);
        }
        if ((lane & 15) < 9) *(GAS f32x4*)(BIAS + ((size_t)s * 9 + (lane & 15)) * DFF + n0 + (lane >> 4) * 4) = acc;
      } }
}
__device__ __forceinline__ void conv_phase(Frame& F, int o) {
    const int lane = lane_id_opaque(), wave = F.wave, tid = wave * 64 + lane; (void)tid;
    GAS unsigned char* wsg_ = (GAS unsigned char*)F.ws; asm volatile("" : "+s"(wsg_)); unsigned char* ws = (unsigned char*)wsg_;

    const int gw = F.vcu * NWAVES + wave, NGW = F.G * NWAVES;
    const bf16_t* Z = (const bf16_t*)(ws + WS_Z); const bf16_t* GB = (const bf16_t*)(ws + WS_GB); bf16_t* A2 = (bf16_t*)(ws + WS_A2);
    const float* cw = FIN(I_CVW) + (size_t)o * 3 * DM; const float* cb = FIN(I_CVB) + (size_t)o * DM;
    for (int it = gw; it < (MTOK / 16) * 4; it += NGW) {
        const int rc = it >> 2, cq = it & 3, m0 = rc * 16, col = cq * 512 + lane * 8;
        float w0[8], w1[8], w2[8], bb[8];
#pragma unroll
        for (int i = 0; i < 8; ++i) { w0[i] = cw[col + i]; w1[i] = cw[DM + col + i]; w2[i] = cw[2 * DM + col + i]; bb[i] = cb[col + i]; }
        const int L = m0 < NCTX ? CTX_L : LAT_L; const int t0 = (m0 < NCTX ? m0 : m0 - NCTX) % L;
        u32x4 zp = (u32x4){0u, 0u, 0u, 0u}, zc, zn;
        if (t0 > 0) zp = *(const u32x4*)(Z + (size_t)(m0 - 1) * DM + col);
        zc = *(const u32x4*)(Z + (size_t)m0 * DM + col);
#pragma unroll 4
        for (int r = 0; r < 16; ++r) { const int m = m0 + r;
            zn = (u32x4){0u, 0u, 0u, 0u}; if (t0 + r + 1 < L) zn = *(const u32x4*)(Z + (size_t)(m + 1) * DM + col);
            const u32x4 gb = *(const u32x4*)(GB + (size_t)m * DM + col);
            float ov[8];
#pragma unroll
            for (int i = 0; i < 4; ++i) {
                const float c0 = w0[2 * i] * bflo(zp[i]) + w1[2 * i] * bflo(zc[i]) + w2[2 * i] * bflo(zn[i]) + bb[2 * i];
                const float c1 = w0[2 * i + 1] * bfhi(zp[i]) + w1[2 * i + 1] * bfhi(zc[i]) + w2[2 * i + 1] * bfhi(zn[i]) + bb[2 * i + 1];
                ov[2 * i] = bflo(gb[i]) * c0; ov[2 * i + 1] = bfhi(gb[i]) * c1; }
            u32x4 ow; ow.x = pk2(ov[0], ov[1]); ow.y = pk2(ov[2], ov[3]); ow.z = pk2(ov[4], ov[5]); ow.w = pk2(ov[6], ov[7]);
            *(u32x4*)(A2 + (size_t)m * DM + col) = ow;
            zp = zc; zc = zn; }
    }
}
#ifndef ATT_SDEPTH
#define ATT_SDEPTH 2
#endif
__device__ __forceinline__ void attn_phase(Frame& F, int e) {
    const int lane = lane_id_opaque(), wave = F.wave, tid = wave * 64 + lane; (void)tid;
    GAS unsigned char* wsg_ = (GAS unsigned char*)F.ws; asm volatile("" : "+s"(wsg_)); unsigned char* ws = (unsigned char*)wsg_;

    const bf16_t* Q = (const bf16_t*)(ws + WS_Q); const bf16_t* Kb = (const bf16_t*)(ws + WS_K); const bf16_t* V = (const bf16_t*)(ws + WS_V);
    bf16_t* AO = (bf16_t*)(ws + WS_AO);
    const bf16_t* CK = (const bf16_t*)(ws + WS_CK); const bf16_t* CV = (const bf16_t*)(ws + WS_CV);
    LAS char* lds = (LAS char*)F.lds;
    const float* gqp = FIN(I_QNG) + e * 128;
    if (tid < 128) ((LAS float*)(lds + att::OFF_GK))[tid] = FIN(I_KNG)[e * 128 + tid];
    for (int u = F.vcu; u < 1024 + 256; u += F.G) {
        __syncthreads();
        if (u < 1024) {
            const int b = u >> 7, h = (u >> 4) & 7, R = (u & 15) * 4;
            int kr0 = R - 4; kr0 = kr0 < 0 ? 0 : (kr0 > 52 ? 52 : kr0);
            LAS float* bl = (LAS float*)(lds + att::OFF_BIAS);
            { const int t2 = wave * 64 + lane_id_opaque();
              if (t2 < 15 * 32) { const int dr = t2 >> 5, dc = t2 & 31; bl[t2] = dc < 31 ? FIN(I_RPB)[((size_t)(e * 8 + h) * 15 + dr) * 31 + dc] * 11.313708498984761f : 0.f; } }
            const size_t seq0 = (size_t)NCTX + (size_t)b * LAT_L;
            const bf16_t* Qb = Q + (seq0 + (size_t)R * 64) * 1024 + h * 128;
            const bf16_t* K0 = CK + (((size_t)b * 2 + e) * 256) * 1024 + h * 128; const bf16_t* V0 = CV + (((size_t)b * 2 + e) * 256) * 1024 + h * 128;
            const bf16_t* K1 = Kb + (seq0 + (size_t)kr0 * 64) * 1024 + h * 128; const bf16_t* V1 = V + (seq0 + (size_t)kr0 * 64) * 1024 + h * 128;
            bf16_t* Ob = AO + (seq0 + (size_t)R * 64) * ABOUT + S5W + h * 128;
            att::attn_unit<true, ATT_SDEPTH>(lds, Qb, K0, V0, 4, K1, V1, 16, Ob, ABOUT, R, kr0, wave, gqp, nullptr, nullptr, false);
        } else {
            const int uc = u - 1024, b = uc >> 3, h = uc & 7;
            const size_t seq0 = (size_t)b * CTX_L;
            const bf16_t* Qb = Q + seq0 * 1024 + h * 128; const bf16_t* K0 = Kb + seq0 * 1024 + h * 128; const bf16_t* V0 = V + seq0 * 1024 + h * 128;
            bf16_t* Ob = AO + seq0 * ABOUT + S5W + h * 128;
            att::attn_unit<false, ATT_SDEPTH>(lds, Qb, K0, V0, 4, K0, V0, 4, Ob, ABOUT, 0, 0, wave, gqp, F.out + O_CK + (((size_t)b * 2 + e) * 256) * 1024 + h * 128, F.out + O_CV + (((size_t)b * 2 + e) * 256) * 1024 + h * 128, true);
        }
    }
}

constexpr int NPHASE = 2 + 6 * NLAYER;
#ifndef REP_PRO
#define REP_PRO 1
#endif
#ifndef REP_PRE
#define REP_PRE 1
#endif
#ifndef REP_S5A
#define REP_S5A 1
#endif
#ifndef REP_S5B
#define REP_S5B 1
#endif
#ifndef REP_ATT
#define REP_ATT 1
#endif
#ifndef REP_CONV
#define REP_CONV 1
#endif
#ifndef REP_UP
#define REP_UP 1
#endif
#ifndef GEMM_STAMP
#define GEMM_STAMP 0
#endif
#ifndef PG8_SP2
#define PG8_SP2 true
#endif
#ifndef PG8_ALIGN
#define PG8_ALIGN true
#endif

__global__ void __launch_bounds__(NWAVES * 64, 2) fwd(Args args) {
    extern __shared__ __attribute__((aligned(16))) unsigned char lds[];
    Frame F;
    F.lds = (LAS unsigned char*)lds;
    F.wave = __builtin_amdgcn_readfirstlane((int)threadIdx.x >> 6);
    F.G = gridDim.x; { const int bx = blockIdx.x; F.vcu = (F.G % 8 == 0) ? (bx % 8) * (F.G / 8) + bx / 8 : bx; }
    F.in = args.in; F.out = (float*)(GAS float*)args.out; F.ws = (unsigned char*)(GAS unsigned char*)args.ws;
    for (int u = threadIdx.x; u < (LDS_BYTES - LDSCTL_OFF) / 4; u += NWAVES * 64) ((LAS unsigned*)(F.lds + LDSCTL_OFF))[u] = 0u;
    __syncthreads();
    volatile LAS unsigned* MISC = (volatile LAS unsigned*)(F.lds + MISC_OFF);
    XcdBarrier bar = xcd_barrier_post((unsigned*)(F.ws + WS_CTL) + CW_BAR, MISC + 8);
#if MK_PER_PHASE
    const int lo = args.ph_lo, hi = args.ph_hi;
#else
    constexpr int lo = 0, hi = NPHASE;
#endif
#define IN(k) (lo <= (k) && (k) < hi)
#if GEMM_STAMP == 7
#define SEAM(k) do { if (lo <= (k) && (k) + 1 < hi) { const unsigned long long t0_ = __builtin_amdgcn_s_memrealtime(); xcd_barrier(bar, F.wave); const unsigned long long dt_ = __builtin_amdgcn_s_memrealtime() - t0_; if (blockIdx.x == 0 && threadIdx.x == 0) atomicAdd((unsigned long long*)(F.ws + WS_CTL + 65536) + 3, dt_); } } while (0)
#else
#define SEAM(k) do { if (lo <= (k) && (k) + 1 < hi) xcd_barrier(bar, F.wave); } while (0)
#endif
#define OPAQUE_WS GAS unsigned char* wsg_ = (GAS unsigned char*)F.ws; asm volatile("" : "+s"(wsg_)); unsigned char* ws = (unsigned char*)wsg_; int bxo = bx; asm volatile("" : "+s"(bxo)); (void)bxo
    LAS unsigned char* ring = F.lds;
    const int bx = (int)blockIdx.x;

    if (IN(0)) { for (int rep = 0; rep < REP_PRO; ++rep) { p0_prologue(F); __syncthreads(); } }
    SEAM(0);
    if (IN(1)) { for (int rep = 0; rep < REP_PRE; ++rep) pre_phase(F); }
    SEAM(1);
#pragma unroll 1
    for (int l = 0; l < NLAYER; ++l) {
        const int pb = 2 + 6 * l, e = l >> 1;
        const float* ADA = (const float*)(F.ws + WS_ADA) + (size_t)l * 9 * 12288;
        const float* rb0 = l == 0 ? FIN(I_XP) : F.out; const float* rb1 = l == 0 ? FIN(I_XS) - (size_t)NCTX * DM : F.out;
        if ((l & 1) == 0) {
            if (IN(pb + 0)) { OPAQUE_WS; pg8::Gemm g{(const bf16_t*)(ws + WS_H), (const bf16_t*)(ws + WS_WABIN) + (size_t)e * ABIN * DM, MTOK, ABIN, DM}; pg8::StaticOrder S; S.init(MTOK, ABIN, F.G, bxo);
                pg8::EpiAbIn E{(bf16_t*)(ws + WS_U), (bf16_t*)(ws + WS_Q), (size_t)(WS_K - WS_Q) / 2, pg8::NormIn{(const float*)(ws + WS_SSQ) + (size_t)(2 * l) * MTOK, (const float*)(ws + WS_BIAS) + (size_t)(2 * l) * 9 * DFF, DFF}};
                pg8::gemm_phase_i<pg8::EpiAbIn, pg8::StaticOrder>(ring, g, S, E, F.wave); }
            SEAM(pb + 0);
            if (IN(pb + 1)) { OPAQUE_WS;
                for (int rep = 0; rep < REP_S5A; ++rep) s5::phase_a(e, (const bf16_t*)(ws + WS_U), (const float4*)(ws + WS_S5A), (const bf16_t*)(ws + WS_S5BB), (float*)(ws + WS_E), (float*)(ws + WS_EC), F.G, F.vcu, F.wave); }
            SEAM(pb + 1);
            if (IN(pb + 2)) { OPAQUE_WS;
                for (int rep = 0; rep < REP_S5B; ++rep) s5::phase_b((LAS char*)F.lds, e, (const bf16_t*)(ws + WS_U), (const float4*)(ws + WS_S5A), (const float2*)(ws + WS_S5A128), (const bf16_t*)(ws + WS_S5BB), (const bf16_t*)(ws + WS_S5CM), (const float*)(ws + WS_E), (const float*)(ws + WS_EC),
                            FIN(I_SRE), FIN(I_SIM), FIN(I_S5D) + (size_t)e * S5W, (const bf16_t*)(ws + WS_WGLU) + (size_t)e * S5W * S5W, FIN(I_GLUB) + (size_t)e * S5W,
                            (bf16_t*)(ws + WS_AO), F.out + O_SRE, F.out + O_SIM, F.G, F.vcu, F.wave);
                for (int rep = 0; rep < REP_ATT; ++rep) attn_phase(F, e); }
            SEAM(pb + 2);
            if (IN(pb + 3)) { OPAQUE_WS; pg8::Gemm g{(const bf16_t*)(ws + WS_AO), (const bf16_t*)(ws + WS_WABOUT) + (size_t)e * DM * ABOUT, MTOK, DM, ABOUT}; pg8::StaticOrder S; S.init(MTOK, DM, F.G, bxo);
                pg8::EpiRes<true> E{rb0, rb1, F.out, ADA + 2 * DM, (const float*)(ws + WS_GV) + (size_t)(2 * l + 1) * 9 * DM, (bf16_t*)(ws + WS_H), (float*)(ws + WS_SSQ) + (size_t)(2 * l + 1) * MTOK};
                pg8::gemm_phase<pg8::EpiRes<true>, pg8::StaticOrder, PG8_ALIGN, PG8_SP2>(ring, g, S, E, F.wave); }
            SEAM(pb + 3);
        } else {
            if (IN(pb + 0)) { OPAQUE_WS; pg8::Gemm g{(const bf16_t*)(ws + WS_H), (const bf16_t*)(ws + WS_WCVIN) + (size_t)e * 3 * DM * DM, MTOK, 3 * DM, DM}; pg8::StaticOrder S; S.init(MTOK, 3 * DM, F.G, bxo);
                pg8::EpiConvIn E{(bf16_t*)(ws + WS_Z), (bf16_t*)(ws + WS_GB), pg8::NormIn{(const float*)(ws + WS_SSQ) + (size_t)(2 * l) * MTOK, (const float*)(ws + WS_BIAS) + (size_t)(2 * l) * 9 * DFF, DFF}};
                pg8::gemm_phase_i<pg8::EpiConvIn, pg8::StaticOrder>(ring, g, S, E, F.wave); }
            SEAM(pb + 0);
            if (IN(pb + 1)) { for (int rep = 0; rep < REP_CONV; ++rep) conv_phase(F, e); }
            SEAM(pb + 2);
            if (IN(pb + 3)) { OPAQUE_WS; pg8::Gemm g{(const bf16_t*)(ws + WS_A2), (const bf16_t*)(ws + WS_WCVOUT) + (size_t)e * DM * DM, MTOK, DM, DM}; pg8::StaticOrder S; S.init(MTOK, DM, F.G, bxo);
                pg8::EpiRes<true> E{rb0, rb1, F.out, ADA + 2 * DM, (const float*)(ws + WS_GV) + (size_t)(2 * l + 1) * 9 * DM, (bf16_t*)(ws + WS_H), (float*)(ws + WS_SSQ) + (size_t)(2 * l + 1) * MTOK};
                pg8::gemm_phase<pg8::EpiRes<true>, pg8::StaticOrder, PG8_ALIGN, PG8_SP2>(ring, g, S, E, F.wave); }
            SEAM(pb + 3);
        }
        if (IN(pb + 4)) { OPAQUE_WS; pg8::Gemm g{(const bf16_t*)(ws + WS_H), (const bf16_t*)(ws + WS_WUP) + (size_t)l * DFF * DM, MTOK, DFF, DM}; pg8::StaticOrder S; S.init(MTOK, DFF, F.G, bxo);
            pg8::EpiRelu2 E{(bf16_t*)(ws + WS_BIG), DFF, pg8::NormIn{(const float*)(ws + WS_SSQ) + (size_t)(2 * l + 1) * MTOK, (const float*)(ws + WS_BIAS) + (size_t)(2 * l + 1) * 9 * DFF, DFF}};
#if GEMM_STAMP
            pg8::gemm_phase_i<pg8::EpiRelu2, pg8::StaticOrder>(ring, g, S, E, F.wave, (unsigned long long*)(ws + WS_CTL + 65536)); }
#else
            for (int rep = 0; rep < REP_UP; ++rep) pg8::gemm_phase_i<pg8::EpiRelu2, pg8::StaticOrder>(ring, g, S, E, F.wave); }
#endif
        SEAM(pb + 4);
        if (IN(pb + 5)) { OPAQUE_WS; pg8::Gemm g{(const bf16_t*)(ws + WS_BIG), (const bf16_t*)(ws + WS_WDN) + (size_t)l * DM * DFF, MTOK, DM, DFF}; pg8::StaticOrder S; S.init(MTOK, DM, F.G, bxo);
            if (l < NLAYER - 1) { pg8::EpiRes<true> E{F.out, F.out, F.out, ADA + 5 * DM, (const float*)(ws + WS_GV) + (size_t)(2 * l + 2) * 9 * DM, (bf16_t*)(ws + WS_H), (float*)(ws + WS_SSQ) + (size_t)(2 * l + 2) * MTOK};
                pg8::gemm_phase<pg8::EpiRes<true>, pg8::StaticOrder, PG8_ALIGN, PG8_SP2>(ring, g, S, E, F.wave); }
            else { pg8::EpiRes<false> E{F.out, F.out, F.out, ADA + 5 * DM, nullptr, nullptr, nullptr};
                pg8::gemm_phase<pg8::EpiRes<false>, pg8::StaticOrder, PG8_ALIGN, PG8_SP2>(ring, g, S, E, F.wave); } }
        SEAM(pb + 5);
    }
#if GEMM_STAMP
    if (blockIdx.x == 0 && threadIdx.x == 0) { unsigned long long* st = (unsigned long long*)(F.ws + WS_CTL + 65536);
        const unsigned long long tk = __hip_atomic_load(st, __ATOMIC_RELAXED, __HIP_MEMORY_SCOPE_AGENT), ck = __hip_atomic_load(st + 1, __ATOMIC_RELAXED, __HIP_MEMORY_SCOPE_AGENT), te = __hip_atomic_load(st + 2, __ATOMIC_RELAXED, __HIP_MEMORY_SCOPE_AGENT);
        unsigned long long wait = 0;
#if GEMM_STAMP == 7
        wait = __hip_atomic_load(st + 3, __ATOMIC_RELAXED, __HIP_MEMORY_SCOPE_AGENT);
#endif
        if (GEMM_STAMP == 1) wait = tk ? ck * 10000ull / tk : 0;
        if (GEMM_STAMP == 2) wait = tk / 4;
        if (GEMM_STAMP == 3) wait = te;
        if (GEMM_STAMP >= 4) { unsigned long long mx = 0, mn = ~0ull, sm = 0; for (unsigned i = 0; i < gridDim.x; ++i) { const unsigned long long v = __hip_atomic_load(st + 8 + i, __ATOMIC_RELAXED, __HIP_MEMORY_SCOPE_AGENT); mx = v > mx ? v : mx; mn = v < mn ? v : mn; sm += v; }
            wait = (GEMM_STAMP == 4 ? mx : GEMM_STAMP == 5 ? mn : sm / gridDim.x) / 4; }
        const unsigned long long t0 = __builtin_amdgcn_s_memrealtime(); while (__builtin_amdgcn_s_memrealtime() - t0 < wait) __builtin_amdgcn_s_sleep(32); }
#endif
#undef IN
#undef SEAM
#undef OPAQUE_WS
}

extern "C" void kernel_launch(void* const* d_in, const int* in_sizes, int n_in, void* d_out, int out_size, void* d_ws, size_t ws_size, hipStream_t stream) {
    static int grid = 0;
    if (grid == 0) {
        if (n_in != 33 || ws_size < WS_END) { fprintf(stderr, "kernel_launch: n_in %d ws %zu (need 33, >= %zu)\n", n_in, ws_size, (size_t)WS_END); grid = -1; return; }
        int dev = 0, cus = 0;
        if (hipGetDevice(&dev) != hipSuccess || hipDeviceGetAttribute(&cus, hipDeviceAttributeMultiprocessorCount, dev) != hipSuccess) { grid = -1; return; }
        if (hipFuncSetAttribute((const void*)fwd, hipFuncAttributeMaxDynamicSharedMemorySize, LDS_BYTES) != hipSuccess) { fprintf(stderr, "kernel_launch: hipFuncSetAttribute failed\n"); grid = -1; return; }
        int per_cu = 0;
        if (hipOccupancyMaxActiveBlocksPerMultiprocessor(&per_cu, (const void*)fwd, NWAVES * 64, LDS_BYTES) != hipSuccess || per_cu < 1) fprintf(stderr, "kernel_launch: occupancy query says %d\n", per_cu);
        (void)hipGetLastError();
        grid = cus;
    }
    if (grid < 0) return;
    (void)hipMemsetAsync((char*)d_ws + WS_CTL, 0, CTL_ZERO_BYTES, stream);
    Args a{};
    for (int i = 0; i < 33; ++i) a.in[i] = (const float*)d_in[i];
    a.out = (float*)d_out; a.ws = (unsigned char*)d_ws;
#if MK_PER_PHASE
    for (int p = 0; p < NPHASE; ++p) {
        if (p > 1) { const int l = (p - 2) / 6, k = (p - 2) % 6; if ((l & 1) && k == 2) continue; }
        a.ph_lo = p; a.ph_hi = p + 1;
        hipLaunchKernelGGL(fwd, dim3(grid), dim3(NWAVES * 64), LDS_BYTES, stream, a);
    }
#else
    a.ph_lo = 0; a.ph_hi = NPHASE;
    hipLaunchKernelGGL(fwd, dim3(grid), dim3(NWAVES * 64), LDS_BYTES, stream, a);
#endif
    const hipError_t le = hipPeekAtLastError();
    if (le != hipSuccess) fprintf(stderr, "kernel_launch: launch failed: %s\n", hipGetErrorName(le));
}
```
